# Optimizing an MI355X kernel written in HIP

```python
import math
import jax, jax.numpy as jnp
from jax import lax
import numpy as np

D_MODEL = 1024
BATCH = 32
SEQ = 256
DEPTH = 4
DEC_BATCH = 8
DEC_SEQ = 2048
PAST_LEN = 256

GRID_W = 64
MIX_WIDTH = D_MODEL
HG_WIDTH = MIX_WIDTH // 2
HG_HEADS = 4
HG_DK = HG_WIDTH // HG_HEADS
HG_DV = HG_WIDTH // HG_HEADS
ML_WIDTH = MIX_WIDTH - HG_WIDTH
ML_HEADS = 4
ML_DK = ML_WIDTH // ML_HEADS
ML_DV = ML_WIDTH // ML_HEADS
N_DIR = 2
D_FF = -(-8 * D_MODEL // (3 * 256)) * 256
HG_CHUNK = 16
ML_CHUNK = 64
CONV_K = 3
EPS = 1e-6
D_IN_PROJ = 5 * HG_WIDTH + 4 * ML_WIDTH + 4 * ML_HEADS
SPLIT_POINTS = (HG_WIDTH, 2 * HG_WIDTH, 3 * HG_WIDTH, 4 * HG_WIDTH, 5 * HG_WIDTH,
                5 * HG_WIDTH + 2 * ML_WIDTH, 5 * HG_WIDTH + 3 * ML_WIDTH, 5 * HG_WIDTH + 4 * ML_WIDTH)

kernel_name = 'hymba_hgrn2_mlstm_flow_step'


def rmsnorm(x, w):
    x32 = x.astype(jnp.float32)
    y = x32 * lax.rsqrt(jnp.mean(x32 * x32, axis=-1, keepdims=True) + EPS)
    return (y * w).astype(x.dtype)


def head_rmsnorm(o, n_heads, w):
    b, l, d = o.shape
    o = o.reshape(b, l, n_heads, d // n_heads)
    o = o * lax.rsqrt(jnp.mean(o * o, axis=-1, keepdims=True) + EPS)
    return o.reshape(b, l, d) * w


def split_heads(t, n_heads):
    b, l, d = t.shape
    return t.reshape(b, l, n_heads, d // n_heads).transpose(0, 2, 1, 3)


def merge_heads(t):
    b, h, l, d = t.shape
    return t.transpose(0, 2, 1, 3).reshape(b, l, h * d)


def dwconv2d(x, taps, bias):
    ch = x.shape[-1]
    y = lax.conv_general_dilated(x, taps[:, :, None, :].astype(x.dtype), (1, 1), 'SAME',
                                 dimension_numbers=('NHWC', 'HWIO', 'NHWC'), feature_group_count=ch)
    return y + bias


def gla_chunk_scan(q, k, v, logf, s0):
    bsz, nh, seqlen, dk = q.shape
    dv = v.shape[-1]
    cs = HG_CHUNK
    nc = seqlen // cs
    qc = q.reshape(bsz, nh, nc, cs, dk)
    kc = k.reshape(bsz, nh, nc, cs, dk)
    vc = v.reshape(bsz, nh, nc, cs, dv)
    bcum = jnp.cumsum(logf.reshape(bsz, nh, nc, cs, dk), axis=3)
    causal = jnp.tril(jnp.ones((cs, cs), dtype=bool))[:, :, None]
    rel = bcum[:, :, :, :, None, :] - bcum[:, :, :, None, :, :]
    decay = jnp.exp(jnp.where(causal, rel, -jnp.inf))
    scores = jnp.einsum('bhntd,bhntsd,bhnsd->bhnts', qc, decay, kc)
    o_intra = jnp.einsum('bhnts,bhnsv->bhntv', scores, vc)
    b_last = bcum[:, :, :, -1, :]
    kv_chunk = jnp.einsum('bhnsd,bhnsv->bhndv', kc * jnp.exp(b_last[:, :, :, None, :] - bcum), vc)

    def step(s, inp):
        a_n, kv_n = inp
        return a_n[..., None] * s + kv_n, s

    s_final, s_start = lax.scan(step, s0, (jnp.moveaxis(jnp.exp(b_last), 2, 0),
                                           jnp.moveaxis(kv_chunk, 2, 0)))
    s_start = jnp.moveaxis(s_start, 0, 2)
    o_inter = jnp.einsum('bhntd,bhndv->bhntv', qc * jnp.exp(bcum), s_start)
    return (o_intra + o_inter).reshape(bsz, nh, seqlen, dv), s_final


def mlstm_chunk_scan(q, k, v, log_i, log_f, c0, n0, m0):
    bsz, nh, seqlen, dk = q.shape
    dv = v.shape[-1]
    cs = ML_CHUNK
    nc = seqlen // cs
    qc = q.reshape(bsz, nh, nc, cs, dk)
    kc = k.reshape(bsz, nh, nc, cs, dk)
    vc = v.reshape(bsz, nh, nc, cs, dv)
    ic = log_i.reshape(bsz, nh, nc, cs)
    bcum = jnp.cumsum(log_f.reshape(bsz, nh, nc, cs), axis=3)
    b_last = bcum[..., -1]
    w_end = b_last[..., None] - bcum + ic
    m_loc = jnp.max(w_end, axis=-1)
    p_end = jnp.exp(w_end - m_loc[..., None])
    kv_loc = jnp.einsum('bhns,bhnsd,bhnsv->bhndv', p_end, kc, vc)
    kn_loc = jnp.einsum('bhns,bhnsd->bhnd', p_end, kc)

    def step(carry, inp):
        c_s, n_s, m_s = carry
        bl, ml, kvl, knl = inp
        m_new = jnp.maximum(bl + m_s, ml)
        a = jnp.exp(bl + m_s - m_new)
        g = jnp.exp(ml - m_new)
        c_new = a[..., None, None] * c_s + g[..., None, None] * kvl
        n_new = a[..., None] * n_s + g[..., None] * knl
        return (c_new, n_new, m_new), (c_s, n_s, m_s)

    mv = lambda t: jnp.moveaxis(t, 2, 0)
    (c_f, n_f, m_f), (c_st, n_st, m_st) = lax.scan(
        step, (c0, n0, m0), (mv(b_last), mv(m_loc), mv(kv_loc), mv(kn_loc)))
    c_st = jnp.moveaxis(c_st, 0, 2)
    n_st = jnp.moveaxis(n_st, 0, 2)
    m_st = jnp.moveaxis(m_st, 0, 2)
    causal = jnp.tril(jnp.ones((cs, cs), dtype=bool))
    d_log = jnp.where(causal, bcum[..., :, None] - bcum[..., None, :] + ic[..., None, :], -jnp.inf)
    inter_log = bcum + m_st[..., None]
    m_t = jnp.maximum(inter_log, jnp.max(d_log, axis=-1))
    scores = jnp.einsum('bhntd,bhnsd->bhnts', qc, kc) * jnp.exp(d_log - m_t[..., None])
    a_inter = jnp.exp(inter_log - m_t)
    num = (jnp.einsum('bhnts,bhnsv->bhntv', scores, vc)
           + a_inter[..., None] * jnp.einsum('bhntd,bhndv->bhntv', qc, c_st))
    den = jnp.sum(scores, axis=-1) + a_inter * jnp.einsum('bhntd,bhnd->bhnt', qc, n_st)
    h = num / jnp.maximum(jnp.abs(den), jnp.exp(-m_t))[..., None]
    return h.reshape(bsz, nh, seqlen, dv), c_f, n_f, m_f


def run_direction(scan_fn, reverse, seq_args, state_args):
    if reverse:
        seq_args = [jnp.flip(a, axis=2) for a in seq_args]
    o, *fin = scan_fn(*seq_args, *state_args)
    if reverse:
        o = jnp.flip(o, axis=2)
    return o, fin


def token_mix(h, grid_hw, conv_taps, conv_b_l, states, lb_l, w_in_l, ml_gate_b_l,
              hg_norm_w_l, ml_norm_w_l, w_out_l):
    bsz, seqlen, _ = h.shape
    proj = jnp.einsum('bld,de->ble', h, w_in_l).astype(jnp.float32)
    hg_q, hg_ff, hg_fb, hg_i, hg_g, ml_qk, ml_v, ml_o, ml_gates = jnp.split(proj, SPLIT_POINTS, axis=-1)
    hg_s0, ml_c0, ml_n0, ml_m0 = [s.astype(jnp.float32) for s in states]

    q_h = split_heads(jax.nn.silu(hg_q), HG_HEADS)
    v_h = split_heads(hg_i, HG_HEADS)
    hg_outs, hg_fin = [], []
    for d, fz in enumerate((hg_ff, hg_fb)):
        lb = lb_l[d].astype(jnp.float32)
        logf = jnp.logaddexp(jnp.log(lb), jnp.log1p(-lb) + jax.nn.log_sigmoid(fz))
        k_h = (1.0 - lb) * jax.nn.sigmoid(-fz)
        o, fin = run_direction(gla_chunk_scan, d == 1,
                               (q_h, split_heads(k_h, HG_HEADS), v_h, split_heads(logf, HG_HEADS)),
                               (hg_s0[:, d],))
        hg_outs.append(o)
        hg_fin.append(fin[0])
    hg_out = head_rmsnorm(merge_heads(hg_outs[0] + hg_outs[1]), HG_HEADS, hg_norm_w_l) * jax.nn.silu(hg_g)

    rows, cols = grid_hw
    qk = dwconv2d(ml_qk.reshape(bsz, rows, cols, 2 * ML_WIDTH), conv_taps, conv_b_l)
    qk = jax.nn.silu(qk.reshape(bsz, seqlen, 2 * ML_WIDTH))
    mq, mk = jnp.split(qk, 2, axis=-1)
    q_m = split_heads(mq, ML_HEADS)
    k_m = split_heads(mk, ML_HEADS) * (ML_DK ** -0.5)
    v_m = split_heads(ml_v, ML_HEADS)
    gates = (ml_gates + ml_gate_b_l).reshape(bsz, seqlen, 4, ML_HEADS).transpose(0, 2, 3, 1)
    ml_outs, c_fin, n_fin, m_fin = [], [], [], []
    for d in range(N_DIR):
        o, fin = run_direction(mlstm_chunk_scan, d == 1,
                               (q_m, k_m, v_m, gates[:, d], jax.nn.log_sigmoid(gates[:, 2 + d])),
                               (ml_c0[:, d], ml_n0[:, d], ml_m0[:, d]))
        ml_outs.append(o)
        c_fin.append(fin[0])
        n_fin.append(fin[1])
        m_fin.append(fin[2])
    ml_out = head_rmsnorm(merge_heads(ml_outs[0] + ml_outs[1]), ML_HEADS, ml_norm_w_l) * jax.nn.sigmoid(ml_o)

    mix = jnp.concatenate([hg_out, ml_out], axis=-1).astype(h.dtype)
    out = jnp.einsum('ble,ed->bld', mix, w_out_l)
    new_states = (jnp.stack(hg_fin, axis=1), jnp.stack(c_fin, axis=1),
                  jnp.stack(n_fin, axis=1), jnp.stack(m_fin, axis=1))
    return out, new_states


def trunk_layer(x, cond, grid_hw, conv_taps, states, n1, n2, w_mod_l, b_mod_l, conv_b_l, lb_l,
                w_in_l, ml_gate_b_l, hg_norm_w_l, ml_norm_w_l, w_out_l, w_gate_l, w_up_l, w_down_l):
    mod = (jax.nn.silu(cond) @ w_mod_l + b_mod_l)[:, None, :]
    sh1, sc1, g1, sh2, sc2, g2 = jnp.split(mod, 6, axis=-1)
    h = rmsnorm(x, n1) * (1.0 + sc1) + sh1
    mix, new_states = token_mix(h, grid_hw, conv_taps, conv_b_l, states, lb_l, w_in_l, ml_gate_b_l,
                                hg_norm_w_l, ml_norm_w_l, w_out_l)
    x = x + g1 * mix
    h = rmsnorm(x, n2) * (1.0 + sc2) + sh2
    ffn = (jax.nn.silu(h @ w_gate_l) * (h @ w_up_l)) @ w_down_l
    x = x + g2 * ffn
    return x, new_states


def setup_inputs(seed: int = 0) -> dict:
    key = jax.random.key(seed)
    ks = jax.random.split(key, 32)
    nrm = lambda k, shape, s=1.0: s * jax.random.normal(k, shape, jnp.float32)
    x_prompt = nrm(ks[0], (BATCH, SEQ, D_MODEL))
    x_sample = nrm(ks[1], (DEC_BATCH, DEC_SEQ, D_MODEL))
    state_hgrn = nrm(ks[2], (DEC_BATCH, DEPTH, N_DIR, HG_HEADS, HG_DK, HG_DV), 0.5)
    state_mlstm_c = nrm(ks[3], (DEC_BATCH, DEPTH, N_DIR, ML_HEADS, ML_DK, ML_DV), 0.5)
    state_mlstm_n = nrm(ks[4], (DEC_BATCH, DEPTH, N_DIR, ML_HEADS, ML_DK), 0.5)
    state_mlstm_m = nrm(ks[5], (DEC_BATCH, DEPTH, N_DIR, ML_HEADS), 0.5)
    c = nrm(ks[6], (DEC_BATCH, D_MODEL))
    c_ctx = nrm(ks[7], (D_MODEL,))
    norm1_w = 1.0 + nrm(ks[8], (DEPTH, D_MODEL), 0.02)
    norm2_w = 1.0 + nrm(ks[9], (DEPTH, D_MODEL), 0.02)
    w_mod = nrm(ks[10], (DEPTH, D_MODEL, 6 * D_MODEL), 0.5 * D_MODEL ** -0.5)
    b_mod = nrm(ks[11], (DEPTH, 6 * D_MODEL), 0.02)
    w_in = nrm(ks[12], (DEPTH, D_MODEL, D_IN_PROJ), D_MODEL ** -0.5)
    conv_w = nrm(ks[13], (DEPTH, CONV_K, CONV_K, 2 * ML_WIDTH), 1.0 / CONV_K)
    conv_b = nrm(ks[14], (DEPTH, 2 * ML_WIDTH), 0.02)
    ml_gate_b = jnp.concatenate([nrm(ks[15], (DEPTH, 2 * ML_HEADS), 0.1),
                                 3.0 + 3.0 * jax.random.uniform(ks[16], (DEPTH, 2 * ML_HEADS), jnp.float32)],
                                axis=-1)
    hg_lb_logits = 1.0 + nrm(ks[17], (DEPTH, N_DIR, HG_WIDTH), 0.5)
    hg_norm_w = 1.0 + nrm(ks[18], (DEPTH, HG_WIDTH), 0.02)
    ml_norm_w = 1.0 + nrm(ks[19], (DEPTH, ML_WIDTH), 0.02)
    w_out = nrm(ks[20], (DEPTH, MIX_WIDTH, D_MODEL), MIX_WIDTH ** -0.5)
    w_gate = nrm(ks[21], (DEPTH, D_MODEL, D_FF), D_MODEL ** -0.5)
    w_up = nrm(ks[22], (DEPTH, D_MODEL, D_FF), D_MODEL ** -0.5)
    w_down = nrm(ks[23], (DEPTH, D_FF, D_MODEL), D_FF ** -0.5)
    final_norm_w = 1.0 + nrm(ks[24], (D_MODEL,), 0.02)
    return {'x_prompt': x_prompt, 'x_sample': x_sample, 'state_hgrn': state_hgrn,
            'state_mlstm_c': state_mlstm_c, 'state_mlstm_n': state_mlstm_n, 'state_mlstm_m': state_mlstm_m,
            'c': c, 'c_ctx': c_ctx, 'norm1_w': norm1_w, 'norm2_w': norm2_w, 'w_mod': w_mod, 'b_mod': b_mod,
            'w_in': w_in, 'conv_w': conv_w, 'conv_b': conv_b, 'ml_gate_b': ml_gate_b,
            'hg_lb_logits': hg_lb_logits, 'hg_norm_w': hg_norm_w, 'ml_norm_w': ml_norm_w, 'w_out': w_out,
            'w_gate': w_gate, 'w_up': w_up, 'w_down': w_down, 'final_norm_w': final_norm_w}


def reference(x_prompt, x_sample, state_hgrn, state_mlstm_c, state_mlstm_n, state_mlstm_m, c, c_ctx,
              norm1_w, norm2_w, w_mod, b_mod, w_in, conv_w, conv_b, ml_gate_b, hg_lb_logits,
              hg_norm_w, ml_norm_w, w_out, w_gate, w_up, w_down, final_norm_w):
    lb_all = jnp.cumsum(jax.nn.softmax(hg_lb_logits.astype(jnp.float32), axis=0), axis=0)
    lb_all = lb_all - lb_all[0]
    n_ctx_req = x_prompt.shape[0]
    ctx_grid = (1, x_prompt.shape[1])
    rows = x_sample.shape[1] // GRID_W
    lat_grid = (rows, GRID_W)
    zero_states = (jnp.zeros((n_ctx_req, N_DIR, HG_HEADS, HG_DK, HG_DV), jnp.float32),
                   jnp.zeros((n_ctx_req, N_DIR, ML_HEADS, ML_DK, ML_DV), jnp.float32),
                   jnp.zeros((n_ctx_req, N_DIR, ML_HEADS, ML_DK), jnp.float32),
                   jnp.zeros((n_ctx_req, N_DIR, ML_HEADS), jnp.float32))
    xp, xs = x_prompt, x_sample
    hg_st, mc_st, mn_st, mm_st = [], [], [], []
    for l in range(DEPTH):
        shared = (norm1_w[l], norm2_w[l], w_mod[l], b_mod[l], conv_b[l], lb_all[l], w_in[l], ml_gate_b[l],
                  hg_norm_w[l], ml_norm_w[l], w_out[l], w_gate[l], w_up[l], w_down[l])
        xp, st = trunk_layer(xp, c_ctx[None, :], ctx_grid, conv_w[l, 1:2], zero_states, *shared)
        hg_st.append(st[0])
        mc_st.append(st[1])
        mn_st.append(st[2])
        mm_st.append(st[3])
        cached = (state_hgrn[:, l], state_mlstm_c[:, l], state_mlstm_n[:, l], state_mlstm_m[:, l])
        xs, _ = trunk_layer(xs, c, lat_grid, conv_w[l], cached, *shared)
    y_prompt = rmsnorm(xp, final_norm_w)
    y_sample = rmsnorm(xs, final_norm_w)
    return (y_prompt, y_sample, jnp.stack(hg_st, axis=1), jnp.stack(mc_st, axis=1),
            jnp.stack(mn_st, axis=1), jnp.stack(mm_st, axis=1))
```

```cpp
#include <hip/hip_runtime.h>
#include <hip/hip_cooperative_groups.h>
#include <cstdio>
#include <cstdint>
namespace cg = cooperative_groups;
typedef _Float16 h16;
typedef _Float16 h16x8 __attribute__((ext_vector_type(8)));
typedef _Float16 h16x4 __attribute__((ext_vector_type(4)));
typedef _Float16 h16x2 __attribute__((ext_vector_type(2)));
typedef float f32x2 __attribute__((ext_vector_type(2)));
namespace pg8 {
#define PG8_LAS __attribute__((address_space(3)))
typedef unsigned short bf16_t;
typedef short bf16x8 __attribute__((ext_vector_type(8)));
typedef float f32x4 __attribute__((ext_vector_type(4)));
typedef unsigned u32x4 __attribute__((ext_vector_type(4)));
constexpr int BM = 256, BK = 64, HALF = 128, HTB = HALF * BK * 2  , STAGE_BYTES = 8 * HTB, NXCD = 8, WGM = 8;

__host__ __device__ __forceinline__ int lds_byte(int r, int c) { const int st = (r >> 4) * 2 + (c >> 5), rr = r & 15, cc = c & 31, ob = rr * 64 + cc * 2; return st * 1024 + (ob ^ (((ob >> 9) & 1) << 5)); }
__host__ __device__ __forceinline__ void stage_rc(int b, int& R, int& C) { const int st = b / 1024, sb = b % 1024, swz = sb ^ (((sb >> 9) & 1) << 5); R = (st >> 1) * 16 + swz / 64; C = (st & 1) * 32 + (swz % 64) / 2; }
__host__ __device__ __forceinline__ int perm32(int rho) { const int n = rho >> 4, i = rho & 15; return 8 * (i >> 2) + 4 * n + (i & 3); }

struct Unit { int pm, pn; };
struct Gemm { const bf16_t* A; const bf16_t* Bt; int M, N, K; };

struct StaticOrder {
    int nM, nN, nwg, G, c;
    __host__ __device__ void init(int M, int N, int G_, int c_) { nM = M / BM; nN = N / BM; nwg = nM * nN; G = G_; c = c_; }
    __host__ __device__ bool next(int i, Unit& u) const {
        const long L = (long)i * G + c; if (L >= nwg) return false;
        int wgid = (int)L; { const int q = nwg / NXCD, r = nwg % NXCD, xcd = wgid % NXCD, off = wgid / NXCD; wgid = (xcd < r ? xcd * (q + 1) : r * (q + 1) + (xcd - r) * q) + off; }
        const int nig = WGM * nN, gid = wgid / nig, fm = gid * WGM, gsz = (nM - fm) < WGM ? (nM - fm) : WGM;
        u.pm = fm + ((wgid % nig) % gsz); u.pn = (wgid % nig) / gsz; return true;
    }
    __device__ __forceinline__ void a_ready(const Unit&) const {}
    __device__ __forceinline__ void done(const Unit&) const {}
};

template <class Epi, class Sched, bool ALIGN_EPI = false, bool SP2 = false>
__device__ __forceinline__ void gemm_phase(PG8_LAS unsigned char* lds, const Gemm g, const Sched& S, const Epi& E) {
    int tid_l = threadIdx.x; asm volatile("" : "+v"(tid_l));
    const int tid = tid_l, wid = __builtin_amdgcn_readfirstlane(tid >> 6), lane = tid & 63, wr = wid >> 2, wc = wid & 3, fr = lane & 15, fq = lane >> 4;
    const int K = g.K, nt = K / BK;
    unsigned voffA[2], voffB[2];
#pragma unroll
    for (int i = 0; i < 2; ++i) { int R, C; stage_rc(tid * 16 + i * 8192, R, C); const int Rb = Epi::PERM ? ((R & ~31) + perm32(R & 31)) : R;
        voffA[i] = (unsigned)(R * K + C) * 2u; voffB[i] = (unsigned)(Rb * K + C) * 2u; }
    const size_t kstep = (size_t)(BK * 2);
    const size_t hstep = (size_t)HALF * K * 2;
    const size_t tstep = 2 * hstep;
    const unsigned ldsw = (unsigned)wid * 1024u;
    const int aoff = lds_byte(wr * 64 + fr, fq * 8), boff = lds_byte(wc * 32 + fr, fq * 8);
#define PG8_SA(b, h) (((b) * 2 + (h)) * HTB)
#define PG8_SB(b, h) ((4 + (b) * 2 + (h)) * HTB)
#define PG8_STAGE(bufoff, gbase, voff) do { _Pragma("unroll") for (int _i = 0; _i < 2; ++_i) \
        __builtin_amdgcn_global_load_lds((const unsigned*)((const char*)(gbase) + (voff)[_i]), (PG8_LAS unsigned*)(lds + (bufoff) + ldsw + _i * 8192), 16, 0, 0); } while (0)
#define PG8_LDA(dst, b, h) do { _Pragma("unroll") for (int m = 0; m < 4; ++m) _Pragma("unroll") for (int k = 0; k < 2; ++k) dst[m][k] = *(const PG8_LAS bf16x8*)(lds + PG8_SA(b, h) + aoff + m * 2048 + k * 1024); } while (0)
#define PG8_LDB(dst, b, h) do { _Pragma("unroll") for (int n = 0; n < 2; ++n) _Pragma("unroll") for (int k = 0; k < 2; ++k) dst[n][k] = *(const PG8_LAS bf16x8*)(lds + PG8_SB(b, h) + boff + n * 2048 + k * 1024); } while (0)
#define PG8_MMA(ai, bj, At, Bt) do { __builtin_amdgcn_s_setprio(1); _Pragma("unroll") for (int m = 0; m < 4; ++m) _Pragma("unroll") for (int n = 0; n < 2; ++n) _Pragma("unroll") for (int k = 0; k < 2; ++k) \
        acc[ai][bj][m][n] = __builtin_amdgcn_mfma_f32_16x16x32_f16(__builtin_bit_cast(h16x8, Bt[n][k]), __builtin_bit_cast(h16x8, At[m][k]), acc[ai][bj][m][n], 0, 0, 0); __builtin_amdgcn_s_setprio(0); } while (0)
#define PG8_WAIT_V(n) asm volatile("s_waitcnt vmcnt(" #n ")" ::: "memory")
#define PG8_WAIT_L(n) asm volatile("s_waitcnt lgkmcnt(" #n ")" ::: "memory")
#define PG8_BAR __builtin_amdgcn_s_barrier()
#define PG8_SCHED __builtin_amdgcn_sched_barrier(0)
    Unit cur, nxt; int ui = 0;
    if (!S.next(0, cur)) return;
    f32x4 acc[2][2][4][2];
#pragma unroll
    for (int a = 0; a < 2; ++a)
#pragma unroll
        for (int b = 0; b < 2; ++b)
#pragma unroll
            for (int m = 0; m < 4; ++m)
#pragma unroll
                for (int n = 0; n < 2; ++n) acc[a][b][m][n] = (f32x4){0.f, 0.f, 0.f, 0.f};
    bf16x8 At[4][2], B0[2][2], B1[2][2];
    const char* cA = (const char*)g.A + (size_t)cur.pm * tstep; const char* cB = (const char*)g.Bt + (size_t)cur.pn * tstep;
    S.a_ready(cur);
    if constexpr (SP2) {
        PG8_STAGE(PG8_SB(0, 0), cB, voffB); PG8_STAGE(PG8_SB(0, 1), cB + hstep, voffB); PG8_STAGE(PG8_SA(0, 0), cA, voffA); PG8_STAGE(PG8_SA(0, 1), cA + hstep, voffA);
        if (wr == 1) PG8_BAR;
        PG8_WAIT_V(2); PG8_BAR;
        PG8_STAGE(PG8_SB(1, 0), cB + kstep, voffB); PG8_STAGE(PG8_SA(1, 0), cA + kstep, voffA); PG8_STAGE(PG8_SB(1, 1), cB + hstep + kstep, voffB);
        PG8_WAIT_V(6); PG8_BAR;
    } else {
        PG8_STAGE(PG8_SB(0, 0), cB, voffB); PG8_STAGE(PG8_SA(0, 0), cA, voffA); PG8_STAGE(PG8_SB(0, 1), cB + hstep, voffB); PG8_STAGE(PG8_SA(0, 1), cA + hstep, voffA);
        if (wr == 1) PG8_BAR;
        PG8_WAIT_V(4); PG8_BAR;
        PG8_STAGE(PG8_SB(1, 0), cB + kstep, voffB); PG8_STAGE(PG8_SA(1, 0), cA + kstep, voffA); PG8_STAGE(PG8_SB(1, 1), cB + hstep + kstep, voffB);
        PG8_WAIT_V(6); PG8_BAR;
    }
    for (;;) {
        const bool has_next = S.next(ui + 1, nxt);
        const char* nA = has_next ? (const char*)g.A + (size_t)nxt.pm * tstep : cA; const char* nB = has_next ? (const char*)g.Bt + (size_t)nxt.pn * tstep : cB;
        for (int t = 0; t < nt; t += 2) {
            const bool last = (t == nt - 2);
            const char* a1 = cA + (size_t)(t + 1) * kstep;
            const char* a2 = last ? nA : cA + (size_t)(t + 2) * kstep; const char* b2 = last ? nB : cB + (size_t)(t + 2) * kstep;
            const char* a3 = a2 + kstep; const char* b3 = b2 + kstep;
            if (last && has_next) S.a_ready(nxt);
            if constexpr (SP2) {
            PG8_LDB(B0, 0, 0); PG8_LDB(B1, 0, 1); PG8_SCHED; PG8_LDA(At, 0, 0); PG8_STAGE(PG8_SA(1, 1), a1 + hstep, voffA);
            PG8_WAIT_V(8); PG8_WAIT_L(0); PG8_BAR; PG8_MMA(0, 0, At, B0); PG8_MMA(0, 1, At, B1); PG8_BAR; PG8_SCHED;
            PG8_LDA(At, 0, 1); PG8_STAGE(PG8_SB(0, 0), b2, voffB); PG8_STAGE(PG8_SB(0, 1), b2 + hstep, voffB); PG8_STAGE(PG8_SA(0, 0), a2, voffA);
            PG8_WAIT_V(8); PG8_WAIT_L(0); PG8_BAR; PG8_MMA(1, 0, At, B0); PG8_MMA(1, 1, At, B1); PG8_BAR; PG8_SCHED;
            PG8_LDB(B0, 1, 0); PG8_LDB(B1, 1, 1); PG8_SCHED; PG8_LDA(At, 1, 0); PG8_STAGE(PG8_SA(0, 1), a2 + hstep, voffA);
            PG8_WAIT_V(8); PG8_WAIT_L(0); PG8_BAR; PG8_MMA(0, 0, At, B0); PG8_MMA(0, 1, At, B1); PG8_BAR; PG8_SCHED;
            PG8_LDA(At, 1, 1); PG8_STAGE(PG8_SB(1, 0), b3, voffB); PG8_STAGE(PG8_SB(1, 1), b3 + hstep, voffB); PG8_STAGE(PG8_SA(1, 0), a3, voffA);
            PG8_WAIT_V(8); PG8_WAIT_L(0); PG8_BAR; PG8_MMA(1, 0, At, B0); PG8_MMA(1, 1, At, B1); PG8_BAR; PG8_SCHED;
            } else {
            PG8_LDB(B0, 0, 0); PG8_SCHED; PG8_LDA(At, 0, 0); PG8_STAGE(PG8_SA(1, 1), a1 + hstep, voffA);
            PG8_WAIT_L(8); PG8_BAR; PG8_WAIT_L(0); PG8_MMA(0, 0, At, B0); PG8_BAR; PG8_SCHED;
            PG8_LDB(B1, 0, 1); PG8_STAGE(PG8_SB(0, 0), b2, voffB);
            PG8_BAR; PG8_WAIT_L(0); PG8_MMA(0, 1, At, B1); PG8_BAR;
            PG8_LDA(At, 0, 1); PG8_STAGE(PG8_SA(0, 0), a2, voffA);
            PG8_BAR; PG8_WAIT_L(0); PG8_MMA(1, 0, At, B0); PG8_BAR; PG8_SCHED;
            PG8_STAGE(PG8_SB(0, 1), b2 + hstep, voffB);
            PG8_WAIT_V(6); PG8_BAR; PG8_MMA(1, 1, At, B1); PG8_BAR;
            PG8_LDB(B0, 1, 0); PG8_SCHED; PG8_LDA(At, 1, 0); PG8_STAGE(PG8_SA(0, 1), a2 + hstep, voffA);
            PG8_WAIT_L(8); PG8_BAR; PG8_WAIT_L(0); PG8_MMA(0, 0, At, B0); PG8_BAR; PG8_SCHED;
            PG8_LDB(B1, 1, 1); PG8_STAGE(PG8_SB(1, 0), b3, voffB);
            PG8_BAR; PG8_WAIT_L(0); PG8_MMA(0, 1, At, B1); PG8_BAR;
            PG8_LDA(At, 1, 1); PG8_STAGE(PG8_SA(1, 0), a3, voffA);
            PG8_BAR; PG8_WAIT_L(0); PG8_MMA(1, 0, At, B0); PG8_BAR; PG8_SCHED;
            PG8_STAGE(PG8_SB(1, 1), b3 + hstep, voffB);
            PG8_WAIT_V(6); PG8_BAR; PG8_MMA(1, 1, At, B1); PG8_BAR;
            }
        }
        if constexpr (ALIGN_EPI) { if (wr == 0) PG8_BAR; }
        if constexpr (!Epi::AFTER_DRAIN) { E(acc, cur, wr, wc, fr, fq); S.done(cur); }
        if (!has_next) break;
#pragma unroll
        for (int a = 0; a < 2; ++a)
#pragma unroll
            for (int b = 0; b < 2; ++b)
#pragma unroll
                for (int m = 0; m < 4; ++m)
#pragma unroll
                    for (int n = 0; n < 2; ++n) acc[a][b][m][n] = (f32x4){0.f, 0.f, 0.f, 0.f};
        cur = nxt; cA = nA; cB = nB; ++ui;
        if constexpr (ALIGN_EPI) { if (wr == 1) PG8_BAR; }
    }
    PG8_WAIT_V(0);
    if constexpr (!ALIGN_EPI) { if (wr == 0) PG8_BAR; }
    PG8_BAR;
    if constexpr (Epi::AFTER_DRAIN) { E.fused(acc, cur, wr, wc, fr, fq, lds, wid, lane); S.done(cur); }
#undef PG8_SA
#undef PG8_SB
#undef PG8_STAGE
#undef PG8_LDA
#undef PG8_LDB
#undef PG8_MMA
#undef PG8_WAIT_V
#undef PG8_WAIT_L
#undef PG8_BAR
#undef PG8_SCHED
}
}
#define LAS __attribute__((address_space(3)))
using pg8::f32x4;
using pg8::u32x4;
constexpr int T_CTX = 8192, T_LAT = 16384, T_ALL = 24576, DM = 1024;
constexpr int NPROJ = 4608, NPROJ_PAD = 4864, NIN = 4624, DFF = 2816, NGU = 5632;
constexpr int NTHR = 512, NWV = 8;
constexpr float EPS = 1e-6f;
constexpr int LDS_BYTES = 132096;

constexpr size_t OUT_HG = 25165824, OUT_MC = 41943040, OUT_MN = 58720256, OUT_MM = 58851328, OUT_TOTAL = 58852352;

constexpr size_t al256(size_t x) { return (x + 255) & ~(size_t)255; }
constexpr size_t WS_WIN = 0;
constexpr size_t WS_WOUT = WS_WIN + al256((size_t)NPROJ_PAD * DM * 2);
constexpr size_t WS_WGU = WS_WOUT + al256((size_t)DM * DM * 2);
constexpr size_t WS_WDN = WS_WGU + al256((size_t)NGU * DM * 2);
constexpr size_t WS_MODP = WS_WDN + al256((size_t)DM * DFF * 2);
constexpr size_t WS_MOD = WS_MODP + al256((size_t)8 * 4 * 9 * 6144 * 4);
constexpr size_t WS_LB = WS_MOD + al256((size_t)4 * 9 * 6144 * 4);
constexpr size_t WS_HN = WS_LB + al256((size_t)4 * 2 * 512 * 4);
constexpr size_t WS_PROJ = WS_HN + al256((size_t)T_ALL * DM * 2);
constexpr size_t WS_GATES = WS_PROJ + al256((size_t)T_ALL * NPROJ * 2);
constexpr size_t WS_QKM = WS_GATES + al256((size_t)T_ALL * 16 * 4);
constexpr size_t WS_OB = WS_QKM + al256((size_t)T_ALL * DM * 2);
constexpr size_t WS_END = WS_OB + al256((size_t)T_ALL * DM * 2);

struct Params {
    const float *x_prompt, *x_sample, *st_hg, *st_mc, *st_mn, *st_mm, *cnd, *c_ctx, *n1w, *n2w, *w_mod, *b_mod, *w_in, *conv_w, *conv_b, *gate_b,
        *lb_logits, *hg_nw, *ml_nw, *w_out, *w_gate, *w_up, *w_down, *fin_w;
    float* out; unsigned char* ws;
};

__device__ __forceinline__ float sigmoidf_(float x) { return 1.f / (1.f + __expf(-x)); }
__device__ __forceinline__ float siluf_(float x) { return x / (1.f + __expf(-x)); }
__device__ __forceinline__ unsigned pkh(float a, float b) { h16x2 v = {(h16)a, (h16)b}; return __builtin_bit_cast(unsigned, v); }
__device__ __forceinline__ float wave_sum(float v) {
#pragma unroll
    for (int o = 1; o < 64; o <<= 1) v += __shfl_xor(v, o);
    return v;
}
__device__ __forceinline__ int row_cidx(int row) { return row < T_CTX ? 0 : 1 + ((row - T_CTX) >> 11); }
__device__ __forceinline__ int ltid() { int t = threadIdx.x; asm volatile("" : "+v"(t)); return t; }
__device__ __forceinline__ float rdlane(float v, int l) { return __builtin_bit_cast(float, __builtin_amdgcn_readlane(__builtin_bit_cast(int, v), l)); }

struct EpiInProj {
    static constexpr bool PERM = true, AFTER_DRAIN = false;
    h16* proj; float* gates; const float* gate_b;
    __device__ __forceinline__ void operator()(const f32x4 (&acc)[2][2][4][2], const pg8::Unit& u, int wr, int wc, int fr, int fq) const {
        const int row0 = u.pm * 256 + wr * 64 + fr;
        if (u.pn == 18) {
            if (wc == 0 && fq < 2) {
                const f32x4 b0 = *(const f32x4*)(gate_b + 8 * fq), b1 = *(const f32x4*)(gate_b + 8 * fq + 4);
#pragma unroll
                for (int ai = 0; ai < 2; ++ai)
#pragma unroll
                    for (int m = 0; m < 4; ++m) {
                        float* g = gates + (size_t)(row0 + ai * 128 + m * 16) * 16 + 8 * fq;
                        *(f32x4*)g = acc[ai][0][m][0] + b0; *(f32x4*)(g + 4) = acc[ai][0][m][1] + b1;
                    }
            }
            return;
        }
#pragma unroll
        for (int bj = 0; bj < 2; ++bj) {
            const int colt = u.pn * 256 + bj * 128, reg = colt >> 9;
            const int act = (reg == 0 || reg == 4) ? 1 : (reg == 8 ? 2 : 0);
            const int col0 = colt + wc * 32 + 8 * fq;
#pragma unroll
            for (int ai = 0; ai < 2; ++ai)
#pragma unroll
                for (int m = 0; m < 4; ++m) {
                    f32x4 v0 = acc[ai][bj][m][0], v1 = acc[ai][bj][m][1];
                    if (act == 1) {
#pragma unroll
                        for (int j = 0; j < 4; ++j) { v0[j] = siluf_(v0[j]); v1[j] = siluf_(v1[j]); }
                    } else if (act == 2) {
#pragma unroll
                        for (int j = 0; j < 4; ++j) { v0[j] = sigmoidf_(v0[j]); v1[j] = sigmoidf_(v1[j]); }
                    }
                    u32x4 w; w.x = pkh(v0[0], v0[1]); w.y = pkh(v0[2], v0[3]); w.z = pkh(v1[0], v1[1]); w.w = pkh(v1[2], v1[3]);
                    *(u32x4*)(proj + (size_t)(row0 + ai * 128 + m * 16) * NPROJ + col0) = w;
                }
        }
    }
};
struct EpiResid {
    static constexpr bool PERM = false, AFTER_DRAIN = false;
    const float* base_ctx; const float* base_lat; float* out; const float* gate;
    __device__ __forceinline__ void operator()(const f32x4 (&acc)[2][2][4][2], const pg8::Unit& u, int wr, int wc, int fr, int fq) const {
        const int cidx = u.pm < 32 ? 0 : 1 + ((u.pm - 32) >> 3);
        const float* gt = gate + cidx * 6144;
        const float* bs = u.pm < 32 ? base_ctx : base_lat - (size_t)T_CTX * DM;
        const int colb = u.pn * 256 + wc * 32 + 4 * fq;
        f32x4 g[2][2];
#pragma unroll
        for (int bj = 0; bj < 2; ++bj)
#pragma unroll
            for (int n = 0; n < 2; ++n) g[bj][n] = *(const f32x4*)(gt + colb + bj * 128 + n * 16);
#pragma unroll
        for (int ai = 0; ai < 2; ++ai)
#pragma unroll
            for (int m = 0; m < 4; ++m) {
                const size_t off = (size_t)(u.pm * 256 + ai * 128 + wr * 64 + m * 16 + fr) * DM + colb;
                f32x4 x[2][2];
#pragma unroll
                for (int bj = 0; bj < 2; ++bj)
#pragma unroll
                    for (int n = 0; n < 2; ++n) x[bj][n] = *(const f32x4*)(bs + off + bj * 128 + n * 16);
#pragma unroll
                for (int bj = 0; bj < 2; ++bj)
#pragma unroll
                    for (int n = 0; n < 2; ++n) *(f32x4*)(out + off + bj * 128 + n * 16) = x[bj][n] + g[bj][n] * acc[ai][bj][m][n];
                asm volatile("" ::: "memory");
            }
    }
};
struct EpiGateUp {
    static constexpr bool PERM = true, AFTER_DRAIN = false;
    h16* ff;
    __device__ __forceinline__ void operator()(const f32x4 (&acc)[2][2][4][2], const pg8::Unit& u, int wr, int wc, int fr, int fq) const {
        const int row0 = u.pm * 256 + wr * 64 + fr, col0 = u.pn * 128 + wc * 32 + 8 * fq;
#pragma unroll
        for (int ai = 0; ai < 2; ++ai)
#pragma unroll
            for (int m = 0; m < 4; ++m) {
                f32x4 v0, v1;
#pragma unroll
                for (int j = 0; j < 4; ++j) { v0[j] = siluf_(acc[ai][0][m][0][j]) * acc[ai][1][m][0][j]; v1[j] = siluf_(acc[ai][0][m][1][j]) * acc[ai][1][m][1][j]; }
                u32x4 w; w.x = pkh(v0[0], v0[1]); w.y = pkh(v0[2], v0[3]); w.z = pkh(v1[0], v1[1]); w.w = pkh(v1[2], v1[3]);
                *(u32x4*)(ff + (size_t)(row0 + ai * 128 + m * 16) * DFF + col0) = w;
            }
    }
};

__device__ __forceinline__ void phase_mod_partial(const Params& p, LAS float* ldsf) {
    const int tidx = ltid();
    for (int e = tidx; e < 9 * 1024; e += NTHR) { const int c = e >> 10, k = e & 1023; const float v = c == 0 ? p.c_ctx[k] : p.cnd[(c - 1) * 1024 + k]; ldsf[e] = siluf_(v); }
    __syncthreads();
    float* modp = (float*)(p.ws + WS_MODP);
    const int wave = tidx >> 6, lane = tidx & 63;
    const int gw = blockIdx.x * NWV + wave, NGW = gridDim.x * NWV;
    for (int it = gw; it < 4 * 96 * 8; it += NGW) {
        const int kq = it & 7, cgp = (it >> 3) % 96, l = it / (8 * 96);
        const int j = cgp * 64 + lane;
        const float* w = p.w_mod + ((size_t)l * 1024 + kq * 128) * 6144 + j;
        float acc[9];
#pragma unroll
        for (int c = 0; c < 9; ++c) acc[c] = 0.f;
#pragma unroll 4
        for (int k4 = 0; k4 < 32; ++k4) {
            const float w0 = w[(size_t)(4 * k4 + 0) * 6144], w1 = w[(size_t)(4 * k4 + 1) * 6144], w2 = w[(size_t)(4 * k4 + 2) * 6144], w3 = w[(size_t)(4 * k4 + 3) * 6144];
#pragma unroll
            for (int c = 0; c < 9; ++c) { const f32x4 s = *(const LAS f32x4*)(ldsf + c * 1024 + kq * 128 + 4 * k4); acc[c] += s.x * w0 + s.y * w1 + s.z * w2 + s.w * w3; }
        }
#pragma unroll
        for (int c = 0; c < 9; ++c) modp[(((size_t)kq * 4 + l) * 9 + c) * 6144 + j] = acc[c];
    }
    if (blockIdx.x == 0) {
        float* lb = (float*)(p.ws + WS_LB);
        for (int e = tidx; e < 1024; e += NTHR) {
            const float x0 = p.lb_logits[e], x1 = p.lb_logits[1024 + e], x2 = p.lb_logits[2048 + e], x3 = p.lb_logits[3072 + e];
            const float mx = fmaxf(fmaxf(x0, x1), fmaxf(x2, x3));
            const float e0 = expf(x0 - mx), e1 = expf(x1 - mx), e2 = expf(x2 - mx), e3 = expf(x3 - mx);
            const float inv = 1.f / (e0 + e1 + e2 + e3);
            lb[e] = 0.f; lb[1024 + e] = e1 * inv; lb[2048 + e] = (e1 + e2) * inv; lb[3072 + e] = (e1 + e2 + e3) * inv;
        }
    }
}
__device__ __forceinline__ void phase_mod_reduce(const Params& p) {
    const float* modp = (const float*)(p.ws + WS_MODP); float* mod = (float*)(p.ws + WS_MOD);
    for (int e = blockIdx.x * NTHR + ltid(); e < 4 * 9 * 6144; e += gridDim.x * NTHR) {
        const int j = e % 6144, l = e / (9 * 6144);
        float s = p.b_mod[l * 6144 + j];
#pragma unroll
        for (int kq = 0; kq < 8; ++kq) s += modp[(size_t)kq * (4 * 9 * 6144) + e];
        mod[e] = s;
    }
}

__device__ __forceinline__ void transpose_item(const float* W, int K, int N, h16* WT, int kb, int n0, int dst_row0, LAS float* scr, int lane) {
    const int k0 = 64 * kb, n = n0 + (lane & 31);
#pragma unroll 8
    for (int i = 0; i < 32; ++i) { const int kk = 2 * i + (lane >> 5); scr[kk * 33 + (lane & 31)] = (n < N) ? W[(size_t)(k0 + kk) * N + n] : 0.f; }
    asm volatile("s_waitcnt lgkmcnt(0)" ::: "memory");
    const int c = lane & 7;
#pragma unroll
    for (int j = 0; j < 4; ++j) {
        const int nn = (lane >> 3) + 8 * j; const LAS float* s = scr + (8 * c) * 33 + nn;
        u32x4 o; o.x = pkh(s[0 * 33], s[1 * 33]); o.y = pkh(s[2 * 33], s[3 * 33]); o.z = pkh(s[4 * 33], s[5 * 33]); o.w = pkh(s[6 * 33], s[7 * 33]);
        *(u32x4*)(WT + (size_t)(dst_row0 + nn) * K + k0 + 8 * c) = o;
    }
    asm volatile("s_waitcnt lgkmcnt(0)" ::: "memory");
}
__device__ __forceinline__ void convert_weights(const Params& p, int l, LAS float* scr, int gw, int NGW, int lane) {
    h16* win = (h16*)(p.ws + WS_WIN); h16* wout = (h16*)(p.ws + WS_WOUT); h16* wgu = (h16*)(p.ws + WS_WGU); h16* wdn = (h16*)(p.ws + WS_WDN);
    constexpr int I_IN = 16 * 152, I_OUT = 16 * 32, I_G = 16 * 88, I_DN = 44 * 32;
    for (int it = gw; it < I_IN + I_OUT + 2 * I_G + I_DN; it += NGW) {
        int r = it;
        if (r < I_IN) { const int kb = r / 152, nb = r % 152; transpose_item(p.w_in + (size_t)l * DM * NIN, DM, NIN, win, kb, 32 * nb, 32 * nb, scr, lane); continue; } r -= I_IN;
        if (r < I_OUT) { const int kb = r / 32, nb = r % 32; transpose_item(p.w_out + (size_t)l * DM * DM, DM, DM, wout, kb, 32 * nb, 32 * nb, scr, lane); continue; } r -= I_OUT;
        if (r < I_G) { const int kb = r / 88, nb = r % 88, n0 = 32 * nb; transpose_item(p.w_gate + (size_t)l * DM * DFF, DM, DFF, wgu, kb, n0, (n0 >> 7) * 256 + (n0 & 127), scr, lane); continue; } r -= I_G;
        if (r < I_G) { const int kb = r / 88, nb = r % 88, n0 = 32 * nb; transpose_item(p.w_up + (size_t)l * DM * DFF, DM, DFF, wgu, kb, n0, (n0 >> 7) * 256 + 128 + (n0 & 127), scr, lane); continue; } r -= I_G;
        { const int kb = r / 32, nb = r % 32; transpose_item(p.w_down + (size_t)l * DFF * DM, DFF, DM, wdn, kb, 32 * nb, 32 * nb, scr, lane); }
    }
}
__device__ __forceinline__ void norm_mod_row(const float* xrow, const float* nw, const float* sc, const float* sh, h16* orow, int lane) {
    const f32x4* xr = (const f32x4*)xrow + lane;
    f32x4 v[4]; float s = 0.f;
#pragma unroll
    for (int j = 0; j < 4; ++j) { v[j] = xr[64 * j]; s += (v[j].x * v[j].x + v[j].y * v[j].y) + (v[j].z * v[j].z + v[j].w * v[j].w); }
    const float rstd = rsqrtf(wave_sum(s) * (1.f / DM) + EPS);
#pragma unroll
    for (int j = 0; j < 4; ++j) {
        const int col = 4 * lane + 256 * j;
        const f32x4 w4 = *(const f32x4*)(nw + col), s4 = *(const f32x4*)(sc + col), h4 = *(const f32x4*)(sh + col);
        const f32x4 y = v[j] * rstd * w4 * (1.f + s4) + h4;
        uint2 o; o.x = pkh(y.x, y.y); o.y = pkh(y.z, y.w);
        *(uint2*)(orow + col) = o;
    }
}
__device__ __forceinline__ void phase_norm(const Params& p, int l, int which, bool from_inputs, int gw, int NGW, int lane) {
    const float* mod = (const float*)(p.ws + WS_MOD) + (size_t)l * 9 * 6144;
    const float* nw = (which == 0 ? p.n1w : p.n2w) + l * DM;
    h16* hn = (h16*)(p.ws + WS_HN);
    for (int r = gw; r < T_ALL; r += NGW) {
        const float* xrow = from_inputs ? (r < T_CTX ? p.x_prompt + (size_t)r * DM : p.x_sample + (size_t)(r - T_CTX) * DM) : p.out + (size_t)r * DM;
        const float* m = mod + row_cidx(r) * 6144 + which * 3072;
        norm_mod_row(xrow, nw, m + 1024, m, hn + (size_t)r * DM, lane);
    }
}
__device__ __forceinline__ void phase_final_norm(const Params& p, int gw, int NGW, int lane) {
    for (int r = gw; r < T_ALL; r += NGW) {
        f32x4* xr = (f32x4*)(p.out + (size_t)r * DM) + lane;
        f32x4 v[4]; float s = 0.f;
#pragma unroll
        for (int j = 0; j < 4; ++j) { v[j] = xr[64 * j]; s += (v[j].x * v[j].x + v[j].y * v[j].y) + (v[j].z * v[j].z + v[j].w * v[j].w); }
        const float rstd = rsqrtf(wave_sum(s) * (1.f / DM) + EPS);
#pragma unroll
        for (int j = 0; j < 4; ++j) { const f32x4 w4 = *(const f32x4*)(p.fin_w + 4 * lane + 256 * j); xr[64 * j] = v[j] * rstd * w4; }
    }
}
__device__ __forceinline__ void phase_conv(const Params& p, int l) {
    const h16* proj = (const h16*)(p.ws + WS_PROJ); h16* qkm = (h16*)(p.ws + WS_QKM);
    const float* cw = p.conv_w + (size_t)l * 9 * 1024; const float* cb = p.conv_b + l * 1024;
    for (int idx = blockIdx.x * NTHR + ltid(); idx < T_ALL * 128; idx += gridDim.x * NTHR) {
        const int r = idx >> 7, ch0 = (idx & 127) * 8;
        float acc[8];
        { const f32x4 b0 = *(const f32x4*)(cb + ch0), b1 = *(const f32x4*)(cb + ch0 + 4); acc[0] = b0.x; acc[1] = b0.y; acc[2] = b0.z; acc[3] = b0.w; acc[4] = b1.x; acc[5] = b1.y; acc[6] = b1.z; acc[7] = b1.w; }
        const h16* src = proj + 2560 + ch0;
        const bool lat = r >= T_CTX;
        const int pp = lat ? ((r - T_CTX) & 2047) : (r & 255);
        const int gy = lat ? (pp >> 6) : 0, gx = lat ? (pp & 63) : pp;
        const int H = lat ? 32 : 1, W = lat ? 64 : 256;
#pragma unroll
        for (int a = 0; a < 3; ++a) {
            const int yy = gy + a - 1;
            if (!lat && a != 1) continue;
            if (yy < 0 || yy >= H) continue;
#pragma unroll
            for (int b = 0; b < 3; ++b) {
                const int xx = gx + b - 1;
                if (xx < 0 || xx >= W) continue;
                const int rr = r + (a - 1) * 64 + (b - 1);
                const h16x8 x = *(const h16x8*)(src + (size_t)rr * NPROJ);
                const f32x4 t0 = *(const f32x4*)(cw + (a * 3 + b) * 1024 + ch0), t1 = *(const f32x4*)(cw + (a * 3 + b) * 1024 + ch0 + 4);
                acc[0] += t0.x * (float)x[0]; acc[1] += t0.y * (float)x[1]; acc[2] += t0.z * (float)x[2]; acc[3] += t0.w * (float)x[3];
                acc[4] += t1.x * (float)x[4]; acc[5] += t1.y * (float)x[5]; acc[6] += t1.z * (float)x[6]; acc[7] += t1.w * (float)x[7];
            }
        }
        const float sc = ch0 >= 512 ? 0.08838834764831845f : 1.f;
        u32x4 w; w.x = pkh(siluf_(acc[0]) * sc, siluf_(acc[1]) * sc); w.y = pkh(siluf_(acc[2]) * sc, siluf_(acc[3]) * sc);
        w.z = pkh(siluf_(acc[4]) * sc, siluf_(acc[5]) * sc); w.w = pkh(siluf_(acc[6]) * sc, siluf_(acc[7]) * sc);
        *(u32x4*)(qkm + (size_t)r * DM + ch0) = w;
    }
}

template <int TYPE  >
__device__ __forceinline__ void scan_item(const Params& p, int l, int lat, int b, int h, int dir, LAS float* lds) {
    const int tid = ltid(), lane = tid & 63, w = __builtin_amdgcn_readfirstlane(tid >> 6);
    const int L = lat ? 2048 : 256, row0 = lat ? T_CTX + b * 2048 : b * 256, NB = L / 16;
    LAS float* qs = lds;
    LAS float* fs = lds + 2048;
    LAS float* vs = lds + 4096;
    LAS float* part = lds + 6144;
    LAS float* partn = lds + 6144 + 16384;
    LAS float* scal = partn + 128;
    LAS float* mst = scal + 128;
    const h16* proj = (const h16*)(p.ws + WS_PROJ); const h16* qkm = (const h16*)(p.ws + WS_QKM); const float* gates = (const float*)(p.ws + WS_GATES);
    h16* odst = (h16*)(p.ws + (dir ? WS_OB : WS_HN));
    const size_t sidx = (((size_t)b * 4 + l) * 2 + dir) * 4 + h;

    f32x2 S[16]; float nv = 0.f;
    if (lat) {
        const float* src = (TYPE == 0 ? p.st_hg : p.st_mc) + sidx * 16384;
#pragma unroll
        for (int dd = 0; dd < 16; ++dd) S[dd] = *(const f32x2*)(src + (16 * w + dd) * 128 + 2 * lane);
        if (TYPE == 1) { nv = lane < 16 ? p.st_mn[sidx * 128 + 16 * w + lane] : 0.f; if (tid == 0) mst[0] = p.st_mm[sidx]; }
    } else {
#pragma unroll
        for (int dd = 0; dd < 16; ++dd) S[dd] = (f32x2){0.f, 0.f};
        if (TYPE == 1 && tid == 0) mst[0] = 0.f;
    }
    const int tl = tid >> 5, d0 = 4 * (tid & 31);
    f32x4 lb4 = {0.f, 0.f, 0.f, 0.f};
    if (TYPE == 0) lb4 = *(const f32x4*)((const float*)(p.ws + WS_LB) + (l * 2 + dir) * 512 + h * 128 + d0);
    h16x4 pq, pz, pv; float pgi = 0.f, pgf = 0.f;
#define SCAN_LOAD(ii) do { const int pos_ = 16 * (ii) + tl, tok_ = dir ? L - 1 - pos_ : pos_; const size_t r_ = (size_t)(row0 + tok_); \
        if (TYPE == 0) { pq = *(const h16x4*)(proj + r_ * NPROJ + h * 128 + d0); pz = *(const h16x4*)(proj + r_ * NPROJ + 512 + dir * 512 + h * 128 + d0); pv = *(const h16x4*)(proj + r_ * NPROJ + 1536 + h * 128 + d0); } \
        else { pq = *(const h16x4*)(qkm + r_ * DM + h * 128 + d0); pz = *(const h16x4*)(qkm + r_ * DM + 512 + h * 128 + d0); pv = *(const h16x4*)(proj + r_ * NPROJ + 3584 + h * 128 + d0); \
               if (w == 0) { const int ps_ = 16 * (ii) + (lane & 15), tk_ = dir ? L - 1 - ps_ : ps_; const float* g_ = gates + (size_t)(row0 + tk_) * 16; pgi = g_[dir * 4 + h]; pgf = g_[8 + dir * 4 + h]; } } } while (0)
    SCAN_LOAD(0);
    for (int i = 0; i < NB; ++i) {
        const int par = i & 1;
        const int pos = 16 * i + tl, tok = dir ? L - 1 - pos : pos;
        const size_t r = (size_t)(row0 + tok);
        {
            *(LAS f32x4*)(qs + tl * 128 + d0) = (f32x4){(float)pq[0], (float)pq[1], (float)pq[2], (float)pq[3]};
            *(LAS f32x4*)(vs + tl * 128 + d0) = (f32x4){(float)pv[0], (float)pv[1], (float)pv[2], (float)pv[3]};
            if (TYPE == 0) {
                f32x4 f4;
#pragma unroll
                for (int j = 0; j < 4; ++j) f4[j] = lb4[j] + (1.f - lb4[j]) * sigmoidf_((float)pz[j]);
                *(LAS f32x4*)(fs + tl * 128 + d0) = f4;
            } else {
                *(LAS f32x4*)(fs + tl * 128 + d0) = (f32x4){(float)pz[0], (float)pz[1], (float)pz[2], (float)pz[3]};
                if (w == 0) {
                    const int t = lane & 15;
                    const float m0 = mst[0];
                    const float gi = pgi, lf = fminf(pgf, 0.f) - log1pf(__expf(-fabsf(pgf)));
                    float bc = lf;
#pragma unroll
                    for (int o = 1; o < 16; o <<= 1) { const float x = __shfl_up(bc, o, 16); if (t >= o) bc += x; }
                    float pm = gi - bc;
#pragma unroll
                    for (int o = 1; o < 16; o <<= 1) { const float x = __shfl_up(pm, o, 16); if (t >= o) pm = fmaxf(pm, x); }
                    const float mt = bc + fmaxf(m0, pm);
                    float mp = __shfl_up(mt, 1, 16); if (t == 0) mp = m0;
                    if (lane < 16) {
                        scal[(par * 16 + t) * 4 + 0] = __expf(lf + mp - mt);
                        scal[(par * 16 + t) * 4 + 1] = __expf(gi - mt);
                        scal[(par * 16 + t) * 4 + 2] = __expf(-mt);
                    }
                    asm volatile("s_waitcnt lgkmcnt(0)" ::: "memory");
                    if (lane == 15) mst[0] = mt;
                }
            }
        }
        if (i + 1 < NB) SCAN_LOAD(i + 1);
        __syncthreads();
#pragma unroll 2
        for (int t = 0; t < 16; ++t) {
            float fv = 0.f, qv = 0.f;
            if (lane < 16) { fv = fs[t * 128 + 16 * w + lane]; qv = qs[t * 128 + 16 * w + lane]; }
            const f32x2 v2 = *(const LAS f32x2*)(vs + t * 128 + 2 * lane);
            f32x2 o = {0.f, 0.f};
            if (TYPE == 0) {
#pragma unroll
                for (int dd = 0; dd < 16; ++dd) { const float sf = rdlane(fv, dd), sq = rdlane(qv, dd); S[dd] = v2 + sf * (S[dd] - v2); o += S[dd] * sq; }
            } else {
                const float a = __builtin_bit_cast(float, __builtin_amdgcn_readfirstlane(__builtin_bit_cast(int, scal[(par * 16 + t) * 4 + 0])));
                const float g = __builtin_bit_cast(float, __builtin_amdgcn_readfirstlane(__builtin_bit_cast(int, scal[(par * 16 + t) * 4 + 1])));
                const float gk = g * fv;
                nv = a * nv + gk;
                float nq = nv * qv;
                nq += __shfl_xor(nq, 8); nq += __shfl_xor(nq, 4); nq += __shfl_xor(nq, 2); nq += __shfl_xor(nq, 1);
                if (lane == 0) partn[t * 8 + w] = nq;
#pragma unroll
                for (int dd = 0; dd < 16; ++dd) { const float sk = rdlane(gk, dd), sq = rdlane(qv, dd); S[dd] = a * S[dd] + sk * v2; o += S[dd] * sq; }
            }
            *(LAS f32x2*)(part + (t * 8 + w) * 128 + 2 * lane) = o;
        }
        __syncthreads();
        {
            f32x4 acc = {0.f, 0.f, 0.f, 0.f};
#pragma unroll
            for (int ww = 0; ww < 8; ++ww) acc += *(const LAS f32x4*)(part + (tl * 8 + ww) * 128 + d0);
            if (TYPE == 1) {
                float den = 0.f;
#pragma unroll
                for (int ww = 0; ww < 8; ++ww) den += partn[tl * 8 + ww];
                const float sc = 1.f / fmaxf(fabsf(den), scal[(par * 16 + tl) * 4 + 2]);
                acc = acc * sc;
            }
            uint2 o; o.x = pkh(acc.x, acc.y); o.y = pkh(acc.z, acc.w);
            *(uint2*)(odst + r * DM + TYPE * 512 + h * 128 + d0) = o;
        }
    }
    if (!lat) {
        float* dst = p.out + (TYPE == 0 ? OUT_HG : OUT_MC) + sidx * 16384;
#pragma unroll
        for (int dd = 0; dd < 16; ++dd) *(f32x2*)(dst + (16 * w + dd) * 128 + 2 * lane) = S[dd];
        if (TYPE == 1) { if (lane < 16) p.out[OUT_MN + sidx * 128 + 16 * w + lane] = nv; if (tid == 0) p.out[OUT_MM + sidx] = mst[0]; }
    }
    __syncthreads();
#undef SCAN_LOAD
}
__device__ __forceinline__ void scan_dispatch(const Params& p, int l, int it, LAS float* lds) {
    if (it < 128) { const int type = it >> 6, r = it & 63, b = r >> 3, h = (r >> 1) & 3, dir = r & 1; if (type == 0) scan_item<0>(p, l, 1, b, h, dir, lds); else scan_item<1>(p, l, 1, b, h, dir, lds); }
    else { const int q = it - 128, type = q >> 8, r = q & 255, b = r >> 3, h = (r >> 1) & 3, dir = r & 1; if (type == 0) scan_item<0>(p, l, 0, b, h, dir, lds); else scan_item<1>(p, l, 0, b, h, dir, lds); }
}
__device__ __forceinline__ void phase_scan(const Params& p, int l, LAS float* lds) {
    const int G = gridDim.x, bid = blockIdx.x;
    if (G == 256) {
        if (bid < 128) scan_dispatch(p, l, bid, lds);
        else for (int it = 128 + (bid - 128); it < 640; it += 128) scan_dispatch(p, l, it, lds);
    } else {
        for (int it = bid; it < 640; it += G) scan_dispatch(p, l, it, lds);
    }
}
__device__ __forceinline__ void phase_mixnorm(const Params& p, int l, int gw, int NGW, int lane) {
    const h16* of = (const h16*)(p.ws + WS_HN); const h16* ob = (const h16*)(p.ws + WS_OB); const h16* proj = (const h16*)(p.ws + WS_PROJ);
    h16* mix = (h16*)(p.ws + WS_QKM);
    const int col = 16 * lane;
    const float* nw = col < 512 ? p.hg_nw + l * 512 + col : p.ml_nw + l * 512 + (col - 512);
    float wv[16];
#pragma unroll
    for (int j = 0; j < 4; ++j) { const f32x4 t = *(const f32x4*)(nw + 4 * j); wv[4 * j] = t.x; wv[4 * j + 1] = t.y; wv[4 * j + 2] = t.z; wv[4 * j + 3] = t.w; }
    const int gcol = col < 512 ? 2048 + col : 4096 + (col - 512);
    for (int r = gw; r < T_ALL; r += NGW) {
        const h16x8 a0 = *(const h16x8*)(of + (size_t)r * DM + col), a1 = *(const h16x8*)(of + (size_t)r * DM + col + 8);
        const h16x8 b0 = *(const h16x8*)(ob + (size_t)r * DM + col), b1 = *(const h16x8*)(ob + (size_t)r * DM + col + 8);
        const h16x8 g0 = *(const h16x8*)(proj + (size_t)r * NPROJ + gcol), g1 = *(const h16x8*)(proj + (size_t)r * NPROJ + gcol + 8);
        float o[16]; float ss = 0.f;
#pragma unroll
        for (int j = 0; j < 8; ++j) { o[j] = (float)a0[j] + (float)b0[j]; o[8 + j] = (float)a1[j] + (float)b1[j]; }
#pragma unroll
        for (int j = 0; j < 16; ++j) ss += o[j] * o[j];
        ss += __shfl_xor(ss, 1); ss += __shfl_xor(ss, 2); ss += __shfl_xor(ss, 4);
        const float rstd = rsqrtf(ss * (1.f / 128.f) + EPS);
        u32x4 w0, w1;
        w0.x = pkh(o[0] * rstd * wv[0] * (float)g0[0], o[1] * rstd * wv[1] * (float)g0[1]); w0.y = pkh(o[2] * rstd * wv[2] * (float)g0[2], o[3] * rstd * wv[3] * (float)g0[3]);
        w0.z = pkh(o[4] * rstd * wv[4] * (float)g0[4], o[5] * rstd * wv[5] * (float)g0[5]); w0.w = pkh(o[6] * rstd * wv[6] * (float)g0[6], o[7] * rstd * wv[7] * (float)g0[7]);
        w1.x = pkh(o[8] * rstd * wv[8] * (float)g1[0], o[9] * rstd * wv[9] * (float)g1[1]); w1.y = pkh(o[10] * rstd * wv[10] * (float)g1[2], o[11] * rstd * wv[11] * (float)g1[3]);
        w1.z = pkh(o[12] * rstd * wv[12] * (float)g1[4], o[13] * rstd * wv[13] * (float)g1[5]); w1.w = pkh(o[14] * rstd * wv[14] * (float)g1[6], o[15] * rstd * wv[15] * (float)g1[7]);
        *(u32x4*)(mix + (size_t)r * DM + col) = w0; *(u32x4*)(mix + (size_t)r * DM + col + 8) = w1;
    }
}

__global__ void __launch_bounds__(NTHR, 2) fwd_megakernel(Params p) {
    extern __shared__ __attribute__((aligned(16))) unsigned char lds_raw[];
    cg::grid_group grid = cg::this_grid();
    LAS unsigned char* lds = (LAS unsigned char*)lds_raw;
    LAS float* ldsf = (LAS float*)lds_raw;
    const int G = gridDim.x, NGW = G * NWV;
#define PHASE_IDS() const int tid = ltid(), lane = tid & 63, wave = __builtin_amdgcn_readfirstlane(tid >> 6), gw = blockIdx.x * NWV + wave; (void)tid; (void)lane; (void)gw
    const float* mod = (const float*)(p.ws + WS_MOD);
    h16* hn = (h16*)(p.ws + WS_HN); h16* proj = (h16*)(p.ws + WS_PROJ); h16* mix = (h16*)(p.ws + WS_QKM); h16* ff = (h16*)(p.ws + WS_PROJ);

    phase_mod_partial(p, ldsf);
    grid.sync();
    phase_mod_reduce(p);
    grid.sync();
    for (int l = 0; l < 4; ++l) {
        { PHASE_IDS(); convert_weights(p, l, ldsf + wave * 2176, gw, NGW, lane); }
        { PHASE_IDS(); phase_norm(p, l, 0, l == 0, gw, NGW, lane); }
        grid.sync();
        {
            pg8::Gemm g{(const pg8::bf16_t*)hn, (const pg8::bf16_t*)(p.ws + WS_WIN), T_ALL, NPROJ_PAD, DM}; pg8::StaticOrder S; S.init(T_ALL, NPROJ_PAD, G, (int)blockIdx.x);
            EpiInProj E{proj, (float*)(p.ws + WS_GATES), p.gate_b + l * 16};
            pg8::gemm_phase<EpiInProj, pg8::StaticOrder, true, true>(lds, g, S, E);
        }
        grid.sync();
        phase_conv(p, l);
        grid.sync();
        phase_scan(p, l, ldsf);
        grid.sync();
        { PHASE_IDS(); phase_mixnorm(p, l, gw, NGW, lane); }
        grid.sync();
        {
            pg8::Gemm g{(const pg8::bf16_t*)mix, (const pg8::bf16_t*)(p.ws + WS_WOUT), T_ALL, DM, DM}; pg8::StaticOrder S; S.init(T_ALL, DM, G, (int)blockIdx.x);
            EpiResid E{l == 0 ? p.x_prompt : p.out, l == 0 ? p.x_sample : p.out + (size_t)T_CTX * DM, p.out, mod + (size_t)l * 9 * 6144 + 2048};
            pg8::gemm_phase<EpiResid, pg8::StaticOrder, true, true>(lds, g, S, E);
        }
        grid.sync();
        { PHASE_IDS(); phase_norm(p, l, 1, false, gw, NGW, lane); }
        grid.sync();
        {
            pg8::Gemm g{(const pg8::bf16_t*)hn, (const pg8::bf16_t*)(p.ws + WS_WGU), T_ALL, NGU, DM}; pg8::StaticOrder S; S.init(T_ALL, NGU, G, (int)blockIdx.x);
            EpiGateUp E{ff};
            pg8::gemm_phase<EpiGateUp, pg8::StaticOrder, true, true>(lds, g, S, E);
        }
        grid.sync();
        {
            pg8::Gemm g{(const pg8::bf16_t*)ff, (const pg8::bf16_t*)(p.ws + WS_WDN), T_ALL, DM, DFF}; pg8::StaticOrder S; S.init(T_ALL, DM, G, (int)blockIdx.x);
            EpiResid E{p.out, p.out + (size_t)T_CTX * DM, p.out, mod + (size_t)l * 9 * 6144 + 5120};
            pg8::gemm_phase<EpiResid, pg8::StaticOrder, true, true>(lds, g, S, E);
        }
        grid.sync();
    }
    { PHASE_IDS(); phase_final_norm(p, gw, NGW, lane); }
}

extern "C" void kernel_launch(void* const* d_in, const int* in_sizes, int n_in, void* d_out, int out_size, void* d_ws, size_t ws_size, hipStream_t stream) {
    static int grid_blocks = 0;
    if (grid_blocks == 0) {
        if (n_in != 24 || (size_t)out_size != OUT_TOTAL || ws_size < WS_END) {
            fprintf(stderr, "kernel_launch: unexpected sizes n_in %d out %d ws %zu (need %zu)\n", n_in, out_size, ws_size, (size_t)WS_END); grid_blocks = -1; return;
        }
        int dev = 0, cus = 0, per_cu = 0;
        hipGetDevice(&dev);
        hipDeviceGetAttribute(&cus, hipDeviceAttributeMultiprocessorCount, dev);
        hipFuncSetAttribute((const void*)fwd_megakernel, hipFuncAttributeMaxDynamicSharedMemorySize, LDS_BYTES);
        hipOccupancyMaxActiveBlocksPerMultiprocessor(&per_cu, (const void*)fwd_megakernel, NTHR, LDS_BYTES);
        if (per_cu < 1) { fprintf(stderr, "kernel_launch: occupancy query says %d blocks per CU\n", per_cu); per_cu = 1; }
        grid_blocks = cus * 1;
        (void)hipGetLastError();
    }
    if (grid_blocks < 0) return;
    Params p{};
    const float** f = (const float**)&p;
    for (int i = 0; i < 24; ++i) f[i] = (const float*)d_in[i];
    p.out = (float*)d_out; p.ws = (unsigned char*)d_ws;
    void* args[] = {&p};
    hipError_t e = hipLaunchCooperativeKernel((const void*)fwd_megakernel, dim3(grid_blocks), dim3(NTHR), args, LDS_BYTES, stream);
    if (e != hipSuccess) fprintf(stderr, "cooperative launch failed: %s (grid %d)\n", hipGetErrorString(e), grid_blocks);
}
```

```cpp
#include <hip/hip_runtime.h>
#include <hip/hip_cooperative_groups.h>
#include <cstdio>
#include <cstdint>
namespace cg = cooperative_groups;
typedef _Float16 h16;
typedef _Float16 h16x8 __attribute__((ext_vector_type(8)));
typedef _Float16 h16x4 __attribute__((ext_vector_type(4)));
typedef _Float16 h16x2 __attribute__((ext_vector_type(2)));
typedef float f32x2 __attribute__((ext_vector_type(2)));
namespace pg8 {
#define PG8_LAS __attribute__((address_space(3)))
typedef unsigned short bf16_t;
typedef short bf16x8 __attribute__((ext_vector_type(8)));
typedef float f32x4 __attribute__((ext_vector_type(4)));
typedef unsigned u32x4 __attribute__((ext_vector_type(4)));
constexpr int BM = 256, BK = 64, HALF = 128, HTB = HALF * BK * 2  , STAGE_BYTES = 8 * HTB, NXCD = 8, WGM = 8;

__host__ __device__ __forceinline__ int lds_byte(int r, int c) { const int st = (r >> 4) * 2 + (c >> 5), rr = r & 15, cc = c & 31, ob = rr * 64 + cc * 2; return st * 1024 + (ob ^ (((ob >> 9) & 1) << 5)); }
__host__ __device__ __forceinline__ void stage_rc(int b, int& R, int& C) { const int st = b / 1024, sb = b % 1024, swz = sb ^ (((sb >> 9) & 1) << 5); R = (st >> 1) * 16 + swz / 64; C = (st & 1) * 32 + (swz % 64) / 2; }
__host__ __device__ __forceinline__ int perm32(int rho) { const int n = rho >> 4, i = rho & 15; return 8 * (i >> 2) + 4 * n + (i & 3); }

struct Unit { int pm, pn; };
struct Gemm { const bf16_t* A; const bf16_t* Bt; int M, N, K; };

struct StaticOrder {
    int nM, nN, nwg, G, c;
    __host__ __device__ void init(int M, int N, int G_, int c_) { nM = M / BM; nN = N / BM; nwg = nM * nN; G = G_; c = c_; }
    __host__ __device__ bool next(int i, Unit& u) const {
        const long L = (long)i * G + c; if (L >= nwg) return false;
        int wgid = (int)L; { const int q = nwg / NXCD, r = nwg % NXCD, xcd = wgid % NXCD, off = wgid / NXCD; wgid = (xcd < r ? xcd * (q + 1) : r * (q + 1) + (xcd - r) * q) + off; }
        const int nig = WGM * nN, gid = wgid / nig, fm = gid * WGM, gsz = (nM - fm) < WGM ? (nM - fm) : WGM;
        u.pm = fm + ((wgid % nig) % gsz); u.pn = (wgid % nig) / gsz; return true;
    }
    __device__ __forceinline__ void a_ready(const Unit&) const {}
    __device__ __forceinline__ void done(const Unit&) const {}
};

template <class Epi, class Sched, bool ALIGN_EPI = false, bool SP2 = false>
__device__ __forceinline__ void gemm_phase(PG8_LAS unsigned char* lds, const Gemm g, const Sched& S, const Epi& E) {
    int tid_l = threadIdx.x; asm volatile("" : "+v"(tid_l));
    const int tid = tid_l, wid = __builtin_amdgcn_readfirstlane(tid >> 6), lane = tid & 63, wr = wid >> 2, wc = wid & 3, fr = lane & 15, fq = lane >> 4;
    const int K = g.K, nt = K / BK;
    unsigned voffA[2], voffB[2];
#pragma unroll
    for (int i = 0; i < 2; ++i) { int R, C; stage_rc(tid * 16 + i * 8192, R, C); const int Rb = Epi::PERM ? ((R & ~31) + perm32(R & 31)) : R;
        voffA[i] = (unsigned)(R * K + C) * 2u; voffB[i] = (unsigned)(Rb * K + C) * 2u; }
    const size_t kstep = (size_t)(BK * 2);
    const size_t hstep = (size_t)HALF * K * 2;
    const size_t tstep = 2 * hstep;
    const unsigned ldsw = (unsigned)wid * 1024u;
    const int aoff = lds_byte(wr * 64 + fr, fq * 8), boff = lds_byte(wc * 32 + fr, fq * 8);
#define PG8_SA(b, h) (((b) * 2 + (h)) * HTB)
#define PG8_SB(b, h) ((4 + (b) * 2 + (h)) * HTB)
#define PG8_STAGE(bufoff, gbase, voff) do { _Pragma("unroll") for (int _i = 0; _i < 2; ++_i) \
        __builtin_amdgcn_global_load_lds((const unsigned*)((const char*)(gbase) + (voff)[_i]), (PG8_LAS unsigned*)(lds + (bufoff) + ldsw + _i * 8192), 16, 0, 0); } while (0)
#define PG8_LDA(dst, b, h) do { _Pragma("unroll") for (int m = 0; m < 4; ++m) _Pragma("unroll") for (int k = 0; k < 2; ++k) dst[m][k] = *(const PG8_LAS bf16x8*)(lds + PG8_SA(b, h) + aoff + m * 2048 + k * 1024); } while (0)
#define PG8_LDB(dst, b, h) do { _Pragma("unroll") for (int n = 0; n < 2; ++n) _Pragma("unroll") for (int k = 0; k < 2; ++k) dst[n][k] = *(const PG8_LAS bf16x8*)(lds + PG8_SB(b, h) + boff + n * 2048 + k * 1024); } while (0)
#define PG8_MMA(ai, bj, At, Bt) do { __builtin_amdgcn_s_setprio(1); _Pragma("unroll") for (int m = 0; m < 4; ++m) _Pragma("unroll") for (int n = 0; n < 2; ++n) _Pragma("unroll") for (int k = 0; k < 2; ++k) \
        acc[ai][bj][m][n] = __builtin_amdgcn_mfma_f32_16x16x32_f16(__builtin_bit_cast(h16x8, Bt[n][k]), __builtin_bit_cast(h16x8, At[m][k]), acc[ai][bj][m][n], 0, 0, 0); __builtin_amdgcn_s_setprio(0); } while (0)
#define PG8_WAIT_V(n) asm volatile("s_waitcnt vmcnt(" #n ")" ::: "memory")
#define PG8_WAIT_L(n) asm volatile("s_waitcnt lgkmcnt(" #n ")" ::: "memory")
#define PG8_BAR __builtin_amdgcn_s_barrier()
#define PG8_SCHED __builtin_amdgcn_sched_barrier(0)
    Unit cur, nxt; int ui = 0;
    if (!S.next(0, cur)) return;
    f32x4 acc[2][2][4][2];
#pragma unroll
    for (int a = 0; a < 2; ++a)
#pragma unroll
        for (int b = 0; b < 2; ++b)
#pragma unroll
            for (int m = 0; m < 4; ++m)
#pragma unroll
                for (int n = 0; n < 2; ++n) acc[a][b][m][n] = (f32x4){0.f, 0.f, 0.f, 0.f};
    bf16x8 At[4][2], B0[2][2], B1[2][2];
    const char* cA = (const char*)g.A + (size_t)cur.pm * tstep; const char* cB = (const char*)g.Bt + (size_t)cur.pn * tstep;
    S.a_ready(cur);
    if constexpr (SP2) {
        PG8_STAGE(PG8_SB(0, 0), cB, voffB); PG8_STAGE(PG8_SB(0, 1), cB + hstep, voffB); PG8_STAGE(PG8_SA(0, 0), cA, voffA); PG8_STAGE(PG8_SA(0, 1), cA + hstep, voffA);
        if (wr == 1) PG8_BAR;
        PG8_WAIT_V(2); PG8_BAR;
        PG8_STAGE(PG8_SB(1, 0), cB + kstep, voffB); PG8_STAGE(PG8_SA(1, 0), cA + kstep, voffA); PG8_STAGE(PG8_SB(1, 1), cB + hstep + kstep, voffB);
        PG8_WAIT_V(6); PG8_BAR;
    } else {
        PG8_STAGE(PG8_SB(0, 0), cB, voffB); PG8_STAGE(PG8_SA(0, 0), cA, voffA); PG8_STAGE(PG8_SB(0, 1), cB + hstep, voffB); PG8_STAGE(PG8_SA(0, 1), cA + hstep, voffA);
        if (wr == 1) PG8_BAR;
        PG8_WAIT_V(4); PG8_BAR;
        PG8_STAGE(PG8_SB(1, 0), cB + kstep, voffB); PG8_STAGE(PG8_SA(1, 0), cA + kstep, voffA); PG8_STAGE(PG8_SB(1, 1), cB + hstep + kstep, voffB);
        PG8_WAIT_V(6); PG8_BAR;
    }
    for (;;) {
        const bool has_next = S.next(ui + 1, nxt);
        const char* nA = has_next ? (const char*)g.A + (size_t)nxt.pm * tstep : cA; const char* nB = has_next ? (const char*)g.Bt + (size_t)nxt.pn * tstep : cB;
        for (int t = 0; t < nt; t += 2) {
            const bool last = (t == nt - 2);
            const char* a1 = cA + (size_t)(t + 1) * kstep;
            const char* a2 = last ? nA : cA + (size_t)(t + 2) * kstep; const char* b2 = last ? nB : cB + (size_t)(t + 2) * kstep;
            const char* a3 = a2 + kstep; const char* b3 = b2 + kstep;
            if (last && has_next) S.a_ready(nxt);
            if constexpr (SP2) {
            PG8_LDB(B0, 0, 0); PG8_LDB(B1, 0, 1); PG8_SCHED; PG8_LDA(At, 0, 0); PG8_STAGE(PG8_SA(1, 1), a1 + hstep, voffA);
            PG8_WAIT_V(8); PG8_WAIT_L(0); PG8_BAR; PG8_MMA(0, 0, At, B0); PG8_MMA(0, 1, At, B1); PG8_BAR; PG8_SCHED;
            PG8_LDA(At, 0, 1); PG8_STAGE(PG8_SB(0, 0), b2, voffB); PG8_STAGE(PG8_SB(0, 1), b2 + hstep, voffB); PG8_STAGE(PG8_SA(0, 0), a2, voffA);
            PG8_WAIT_V(8); PG8_WAIT_L(0); PG8_BAR; PG8_MMA(1, 0, At, B0); PG8_MMA(1, 1, At, B1); PG8_BAR; PG8_SCHED;
            PG8_LDB(B0, 1, 0); PG8_LDB(B1, 1, 1); PG8_SCHED; PG8_LDA(At, 1, 0); PG8_STAGE(PG8_SA(0, 1), a2 + hstep, voffA);
            PG8_WAIT_V(8); PG8_WAIT_L(0); PG8_BAR; PG8_MMA(0, 0, At, B0); PG8_MMA(0, 1, At, B1); PG8_BAR; PG8_SCHED;
            PG8_LDA(At, 1, 1); PG8_STAGE(PG8_SB(1, 0), b3, voffB); PG8_STAGE(PG8_SB(1, 1), b3 + hstep, voffB); PG8_STAGE(PG8_SA(1, 0), a3, voffA);
            PG8_WAIT_V(8); PG8_WAIT_L(0); PG8_BAR; PG8_MMA(1, 0, At, B0); PG8_MMA(1, 1, At, B1); PG8_BAR; PG8_SCHED;
            } else {
            PG8_LDB(B0, 0, 0); PG8_SCHED; PG8_LDA(At, 0, 0); PG8_STAGE(PG8_SA(1, 1), a1 + hstep, voffA);
            PG8_WAIT_L(8); PG8_BAR; PG8_WAIT_L(0); PG8_MMA(0, 0, At, B0); PG8_BAR; PG8_SCHED;
            PG8_LDB(B1, 0, 1); PG8_STAGE(PG8_SB(0, 0), b2, voffB);
            PG8_BAR; PG8_WAIT_L(0); PG8_MMA(0, 1, At, B1); PG8_BAR;
            PG8_LDA(At, 0, 1); PG8_STAGE(PG8_SA(0, 0), a2, voffA);
            PG8_BAR; PG8_WAIT_L(0); PG8_MMA(1, 0, At, B0); PG8_BAR; PG8_SCHED;
            PG8_STAGE(PG8_SB(0, 1), b2 + hstep, voffB);
            PG8_WAIT_V(6); PG8_BAR; PG8_MMA(1, 1, At, B1); PG8_BAR;
            PG8_LDB(B0, 1, 0); PG8_SCHED; PG8_LDA(At, 1, 0); PG8_STAGE(PG8_SA(0, 1), a2 + hstep, voffA);
            PG8_WAIT_L(8); PG8_BAR; PG8_WAIT_L(0); PG8_MMA(0, 0, At, B0); PG8_BAR; PG8_SCHED;
            PG8_LDB(B1, 1, 1); PG8_STAGE(PG8_SB(1, 0), b3, voffB);
            PG8_BAR; PG8_WAIT_L(0); PG8_MMA(0, 1, At, B1); PG8_BAR;
            PG8_LDA(At, 1, 1); PG8_STAGE(PG8_SA(1, 0), a3, voffA);
            PG8_BAR; PG8_WAIT_L(0); PG8_MMA(1, 0, At, B0); PG8_BAR; PG8_SCHED;
            PG8_STAGE(PG8_SB(1, 1), b3 + hstep, voffB);
            PG8_WAIT_V(6); PG8_BAR; PG8_MMA(1, 1, At, B1); PG8_BAR;
            }
        }
        if constexpr (ALIGN_EPI) { if (wr == 0) PG8_BAR; }
        if constexpr (!Epi::AFTER_DRAIN) { E(acc, cur, wr, wc, fr, fq); S.done(cur); }
        if (!has_next) break;
#pragma unroll
        for (int a = 0; a < 2; ++a)
#pragma unroll
            for (int b = 0; b < 2; ++b)
#pragma unroll
                for (int m = 0; m < 4; ++m)
#pragma unroll
                    for (int n = 0; n < 2; ++n) acc[a][b][m][n] = (f32x4){0.f, 0.f, 0.f, 0.f};
        cur = nxt; cA = nA; cB = nB; ++ui;
        if constexpr (ALIGN_EPI) { if (wr == 1) PG8_BAR; }
    }
    PG8_WAIT_V(0);
    if constexpr (!ALIGN_EPI) { if (wr == 0) PG8_BAR; }
    PG8_BAR;
    if constexpr (Epi::AFTER_DRAIN) { E.fused(acc, cur, wr, wc, fr, fq, lds, wid, lane); S.done(cur); }
#undef PG8_SA
#undef PG8_SB
#undef PG8_STAGE
#undef PG8_LDA
#undef PG8_LDB
#undef PG8_MMA
#undef PG8_WAIT_V
#undef PG8_WAIT_L
#undef PG8_BAR
#undef PG8_SCHED
}
}
#define LAS __attribute__((address_space(3)))
using pg8::f32x4;
using pg8::u32x4;
constexpr int T_CTX = 8192, T_LAT = 16384, T_ALL = 24576, DM = 1024;
constexpr int NPROJ = 4608, NPROJ_PAD = 4608, NIN = 4624, DFF = 2816, NGU = 5632;
constexpr int NTHR = 512, NWV = 8;
constexpr float EPS = 1e-6f;
constexpr int LDS_BYTES = 132096;

constexpr size_t OUT_HG = 25165824, OUT_MC = 41943040, OUT_MN = 58720256, OUT_MM = 58851328, OUT_TOTAL = 58852352;

constexpr size_t al256(size_t x) { return (x + 255) & ~(size_t)255; }
constexpr size_t WS_WIN = 0;
constexpr size_t WS_WOUT = WS_WIN + al256((size_t)NPROJ_PAD * DM * 2);
constexpr size_t WS_WGU = WS_WOUT + al256((size_t)DM * DM * 2);
constexpr size_t WS_WDN = WS_WGU + al256((size_t)NGU * DM * 2);
constexpr size_t WS_MODP = WS_WDN + al256((size_t)DM * DFF * 2);
constexpr size_t WS_MOD = WS_MODP + al256((size_t)8 * 4 * 9 * 6144 * 4);
constexpr size_t WS_LB = WS_MOD + al256((size_t)4 * 9 * 6144 * 4);
constexpr size_t WS_HN = WS_LB + al256((size_t)4 * 2 * 512 * 4);
constexpr size_t WS_PROJ = WS_HN + al256((size_t)T_ALL * DM * 2);
constexpr size_t WS_GATES = WS_PROJ + al256((size_t)T_ALL * NPROJ * 2);
constexpr size_t WS_QKM = WS_GATES + al256((size_t)T_ALL * 16 * 4);
constexpr size_t WS_OB = WS_QKM + al256((size_t)T_ALL * DM * 2);
constexpr size_t WS_BAR = WS_OB + al256((size_t)T_ALL * DM * 2);
constexpr size_t WS_WG16 = WS_BAR + 16384;
constexpr size_t WS_END = WS_WG16 + 32768;

#if defined(SWAP_OBUF)
#define ODIR(d) (!(d))
#else
#define ODIR(d) (d)
#endif
struct Params {
    const float *x_prompt, *x_sample, *st_hg, *st_mc, *st_mn, *st_mm, *cnd, *c_ctx, *n1w, *n2w, *w_mod, *b_mod, *w_in, *conv_w, *conv_b, *gate_b,
        *lb_logits, *hg_nw, *ml_nw, *w_out, *w_gate, *w_up, *w_down, *fin_w;
    float* out; unsigned char* ws;
};

__device__ __forceinline__ float sigmoidf_(float x) { return 1.f / (1.f + __expf(-x)); }
__device__ __forceinline__ float siluf_(float x) { return x / (1.f + __expf(-x)); }
__device__ __forceinline__ unsigned pkh(float a, float b) { h16x2 v = {(h16)a, (h16)b}; return __builtin_bit_cast(unsigned, v); }
__device__ __forceinline__ float wave_sum(float v) {
#pragma unroll
    for (int o = 1; o < 64; o <<= 1) v += __shfl_xor(v, o);
    return v;
}
__device__ __forceinline__ int row_cidx(int row) { return row < T_CTX ? 0 : 1 + ((row - T_CTX) >> 11); }
__device__ __forceinline__ int ltid() { int t = threadIdx.x; asm volatile("" : "+v"(t)); return t; }
__device__ __forceinline__ float rdlane(float v, int l) { return __builtin_bit_cast(float, __builtin_amdgcn_readlane(__builtin_bit_cast(int, v), l)); }

struct EpiInProj {
    static constexpr bool PERM = true, AFTER_DRAIN = false;
    h16* proj; float* gates; const float* gate_b;
    __device__ __forceinline__ void operator()(const f32x4 (&acc)[2][2][4][2], const pg8::Unit& u, int wr, int wc, int fr, int fq) const {
        const int row0 = u.pm * 256 + wr * 64 + fr;
#pragma unroll
        for (int bj = 0; bj < 2; ++bj) {
            const int colt = u.pn * 256 + bj * 128, reg = colt >> 9;
            const int act = (reg == 0 || reg == 4) ? 1 : (reg == 8 ? 2 : 0);
            const int col0 = colt + wc * 32 + 8 * fq;
#pragma unroll
            for (int ai = 0; ai < 2; ++ai)
#pragma unroll
                for (int m = 0; m < 4; ++m) {
                    f32x4 v0 = acc[ai][bj][m][0], v1 = acc[ai][bj][m][1];
                    if (act == 1) {
#pragma unroll
                        for (int j = 0; j < 4; ++j) { v0[j] = siluf_(v0[j]); v1[j] = siluf_(v1[j]); }
                    } else if (act == 2) {
#pragma unroll
                        for (int j = 0; j < 4; ++j) { v0[j] = sigmoidf_(v0[j]); v1[j] = sigmoidf_(v1[j]); }
                    }
                    u32x4 w; w.x = pkh(v0[0], v0[1]); w.y = pkh(v0[2], v0[3]); w.z = pkh(v1[0], v1[1]); w.w = pkh(v1[2], v1[3]);
                    *(u32x4*)(proj + (size_t)(row0 + ai * 128 + m * 16) * NPROJ + col0) = w;
                }
        }
    }
};
struct EpiResid {
    static constexpr bool PERM = false, AFTER_DRAIN = false;
    const float* base_ctx; const float* base_lat; float* out; const float* gate;
    __device__ __forceinline__ void operator()(const f32x4 (&acc)[2][2][4][2], const pg8::Unit& u, int wr, int wc, int fr, int fq) const {
        const int cidx = u.pm < 32 ? 0 : 1 + ((u.pm - 32) >> 3);
        const float* gt = gate + cidx * 6144;
        const float* bs = u.pm < 32 ? base_ctx : base_lat - (size_t)T_CTX * DM;
        const int colb = u.pn * 256 + wc * 32 + 4 * fq;
        f32x4 g[2][2];
#pragma unroll
        for (int bj = 0; bj < 2; ++bj)
#pragma unroll
            for (int n = 0; n < 2; ++n) g[bj][n] = *(const f32x4*)(gt + colb + bj * 128 + n * 16);
#pragma unroll
        for (int ai = 0; ai < 2; ++ai)
#pragma unroll
            for (int m = 0; m < 4; ++m) {
                const size_t off = (size_t)(u.pm * 256 + ai * 128 + wr * 64 + m * 16 + fr) * DM + colb;
                f32x4 x[2][2];
#pragma unroll
                for (int bj = 0; bj < 2; ++bj)
#pragma unroll
                    for (int n = 0; n < 2; ++n) x[bj][n] = *(const f32x4*)(bs + off + bj * 128 + n * 16);
#pragma unroll
                for (int bj = 0; bj < 2; ++bj)
#pragma unroll
                    for (int n = 0; n < 2; ++n) *(f32x4*)(out + off + bj * 128 + n * 16) = x[bj][n] + g[bj][n] * acc[ai][bj][m][n];
                asm volatile("" ::: "memory");
            }
    }
};
struct EpiGateUp {
    static constexpr bool PERM = true, AFTER_DRAIN = false;
    h16* ff;
    __device__ __forceinline__ void operator()(const f32x4 (&acc)[2][2][4][2], const pg8::Unit& u, int wr, int wc, int fr, int fq) const {
        const int row0 = u.pm * 256 + wr * 64 + fr, col0 = u.pn * 128 + wc * 32 + 8 * fq;
#pragma unroll
        for (int ai = 0; ai < 2; ++ai)
#pragma unroll
            for (int m = 0; m < 4; ++m) {
                f32x4 v0, v1;
#pragma unroll
                for (int j = 0; j < 4; ++j) { v0[j] = siluf_(acc[ai][0][m][0][j]) * acc[ai][1][m][0][j]; v1[j] = siluf_(acc[ai][0][m][1][j]) * acc[ai][1][m][1][j]; }
                u32x4 w; w.x = pkh(v0[0], v0[1]); w.y = pkh(v0[2], v0[3]); w.z = pkh(v1[0], v1[1]); w.w = pkh(v1[2], v1[3]);
                *(u32x4*)(ff + (size_t)(row0 + ai * 128 + m * 16) * DFF + col0) = w;
            }
    }
};

__device__ __forceinline__ void phase_mod_partial(const Params& p, LAS float* ldsf) {
    const int tidx = ltid();
    for (int e = tidx; e < 9 * 1024; e += NTHR) { const int c = e >> 10, k = e & 1023; const float v = c == 0 ? p.c_ctx[k] : p.cnd[(c - 1) * 1024 + k]; ldsf[e] = siluf_(v); }
    __syncthreads();
    float* modp = (float*)(p.ws + WS_MODP);
    const int wave = tidx >> 6, lane = tidx & 63;
    const int gw = blockIdx.x * NWV + wave, NGW = gridDim.x * NWV;
    for (int it = gw; it < 4 * 96 * 8; it += NGW) {
        const int kq = it & 7, cgp = (it >> 3) % 96, l = it / (8 * 96);
        const int j = cgp * 64 + lane;
        const float* w = p.w_mod + ((size_t)l * 1024 + kq * 128) * 6144 + j;
        float acc[9];
#pragma unroll
        for (int c = 0; c < 9; ++c) acc[c] = 0.f;
#pragma unroll 4
        for (int k4 = 0; k4 < 32; ++k4) {
            const float w0 = w[(size_t)(4 * k4 + 0) * 6144], w1 = w[(size_t)(4 * k4 + 1) * 6144], w2 = w[(size_t)(4 * k4 + 2) * 6144], w3 = w[(size_t)(4 * k4 + 3) * 6144];
#pragma unroll
            for (int c = 0; c < 9; ++c) { const f32x4 s = *(const LAS f32x4*)(ldsf + c * 1024 + kq * 128 + 4 * k4); acc[c] += s.x * w0 + s.y * w1 + s.z * w2 + s.w * w3; }
        }
#pragma unroll
        for (int c = 0; c < 9; ++c) modp[(((size_t)kq * 4 + l) * 9 + c) * 6144 + j] = acc[c];
    }
    if (blockIdx.x == 0) {
        float* lb = (float*)(p.ws + WS_LB);
        for (int e = tidx; e < 1024; e += NTHR) {
            const float x0 = p.lb_logits[e], x1 = p.lb_logits[1024 + e], x2 = p.lb_logits[2048 + e], x3 = p.lb_logits[3072 + e];
            const float mx = fmaxf(fmaxf(x0, x1), fmaxf(x2, x3));
            const float e0 = expf(x0 - mx), e1 = expf(x1 - mx), e2 = expf(x2 - mx), e3 = expf(x3 - mx);
            const float inv = 1.f / (e0 + e1 + e2 + e3);
            lb[e] = 0.f; lb[1024 + e] = e1 * inv; lb[2048 + e] = (e1 + e2) * inv; lb[3072 + e] = (e1 + e2 + e3) * inv;
        }
    }
}
__device__ __forceinline__ void phase_mod_reduce(const Params& p) {
    const float* modp = (const float*)(p.ws + WS_MODP); float* mod = (float*)(p.ws + WS_MOD);
    for (int e = blockIdx.x * NTHR + ltid(); e < 4 * 9 * 6144; e += gridDim.x * NTHR) {
        const int j = e % 6144, l = e / (9 * 6144);
        float s = p.b_mod[l * 6144 + j];
#pragma unroll
        for (int kq = 0; kq < 8; ++kq) s += modp[(size_t)kq * (4 * 9 * 6144) + e];
        mod[e] = s;
    }
}

__device__ __forceinline__ void transpose_item(const float* W, int K, int N, h16* WT, int kb, int n0, int dst_row0, LAS float* scr, int lane) {
    const int k0 = 64 * kb, n = n0 + (lane & 31);
#pragma unroll 8
    for (int i = 0; i < 32; ++i) { const int kk = 2 * i + (lane >> 5); scr[kk * 33 + (lane & 31)] = (n < N) ? W[(size_t)(k0 + kk) * N + n] : 0.f; }
    asm volatile("s_waitcnt lgkmcnt(0)" ::: "memory");
    const int c = lane & 7;
#pragma unroll
    for (int j = 0; j < 4; ++j) {
        const int nn = (lane >> 3) + 8 * j; const LAS float* s = scr + (8 * c) * 33 + nn;
        u32x4 o; o.x = pkh(s[0 * 33], s[1 * 33]); o.y = pkh(s[2 * 33], s[3 * 33]); o.z = pkh(s[4 * 33], s[5 * 33]); o.w = pkh(s[6 * 33], s[7 * 33]);
        *(u32x4*)(WT + (size_t)(dst_row0 + nn) * K + k0 + 8 * c) = o;
    }
    asm volatile("s_waitcnt lgkmcnt(0)" ::: "memory");
}
__device__ __forceinline__ void convert_weights(const Params& p, int l, LAS float* scr, int gw, int NGW, int lane) {
    {
        h16* wg = (h16*)(p.ws + WS_WG16);
        const float* src = p.w_in + (size_t)l * DM * NIN + NPROJ;
        for (int e = gw * 64 + lane; e < 16 * 1024; e += NGW * 64) { const int k = e >> 4, g = e & 15; wg[g * 1024 + k] = (h16)src[(size_t)k * NIN + g]; }
    }
    h16* win = (h16*)(p.ws + WS_WIN); h16* wout = (h16*)(p.ws + WS_WOUT); h16* wgu = (h16*)(p.ws + WS_WGU); h16* wdn = (h16*)(p.ws + WS_WDN);
    constexpr int I_IN = 16 * 144, I_OUT = 16 * 32, I_G = 16 * 88, I_DN = 44 * 32;
    for (int it = gw; it < I_IN + I_OUT + 2 * I_G + I_DN; it += NGW) {
        int r = it;
        if (r < I_IN) { const int kb = r / 144, nb = r % 144; transpose_item(p.w_in + (size_t)l * DM * NIN, DM, NIN, win, kb, 32 * nb, 32 * nb, scr, lane); continue; } r -= I_IN;
        if (r < I_OUT) { const int kb = r / 32, nb = r % 32; transpose_item(p.w_out + (size_t)l * DM * DM, DM, DM, wout, kb, 32 * nb, 32 * nb, scr, lane); continue; } r -= I_OUT;
        if (r < I_G) { const int kb = r / 88, nb = r % 88, n0 = 32 * nb; transpose_item(p.w_gate + (size_t)l * DM * DFF, DM, DFF, wgu, kb, n0, (n0 >> 7) * 256 + (n0 & 127), scr, lane); continue; } r -= I_G;
        if (r < I_G) { const int kb = r / 88, nb = r % 88, n0 = 32 * nb; transpose_item(p.w_up + (size_t)l * DM * DFF, DM, DFF, wgu, kb, n0, (n0 >> 7) * 256 + 128 + (n0 & 127), scr, lane); continue; } r -= I_G;
        { const int kb = r / 32, nb = r % 32; transpose_item(p.w_down + (size_t)l * DFF * DM, DFF, DM, wdn, kb, 32 * nb, 32 * nb, scr, lane); }
    }
}
__device__ __forceinline__ void norm_mod_row(const float* xrow, const float* nw, const float* sc, const float* sh, h16* orow, int lane) {
    const f32x4* xr = (const f32x4*)xrow + lane;
    f32x4 v[4]; float s = 0.f;
#pragma unroll
    for (int j = 0; j < 4; ++j) { v[j] = xr[64 * j]; s += (v[j].x * v[j].x + v[j].y * v[j].y) + (v[j].z * v[j].z + v[j].w * v[j].w); }
    const float rstd = rsqrtf(wave_sum(s) * (1.f / DM) + EPS);
#pragma unroll
    for (int j = 0; j < 4; ++j) {
        const int col = 4 * lane + 256 * j;
        const f32x4 w4 = *(const f32x4*)(nw + col), s4 = *(const f32x4*)(sc + col), h4 = *(const f32x4*)(sh + col);
        const f32x4 y = v[j] * rstd * w4 * (1.f + s4) + h4;
        uint2 o; o.x = pkh(y.x, y.y); o.y = pkh(y.z, y.w);
        *(uint2*)(orow + col) = o;
    }
}
__device__ __forceinline__ void phase_norm(const Params& p, int l, int which, bool from_inputs, int gw, int NGW, int lane) {
    const float* mod = (const float*)(p.ws + WS_MOD) + (size_t)l * 9 * 6144;
    const float* nw = (which == 0 ? p.n1w : p.n2w) + l * DM;
    h16* hn = (h16*)(p.ws + WS_HN);
    for (int r = gw; r < T_ALL; r += NGW) {
        const float* xrow = from_inputs ? (r < T_CTX ? p.x_prompt + (size_t)r * DM : p.x_sample + (size_t)(r - T_CTX) * DM) : p.out + (size_t)r * DM;
        const float* m = mod + row_cidx(r) * 6144 + which * 3072;
        norm_mod_row(xrow, nw, m + 1024, m, hn + (size_t)r * DM, lane);
    }
}
__device__ __forceinline__ void phase_final_norm(const Params& p, int gw, int NGW, int lane) {
    for (int r = gw; r < T_ALL; r += NGW) {
        f32x4* xr = (f32x4*)(p.out + (size_t)r * DM) + lane;
        f32x4 v[4]; float s = 0.f;
#pragma unroll
        for (int j = 0; j < 4; ++j) { v[j] = xr[64 * j]; s += (v[j].x * v[j].x + v[j].y * v[j].y) + (v[j].z * v[j].z + v[j].w * v[j].w); }
        const float rstd = rsqrtf(wave_sum(s) * (1.f / DM) + EPS);
#pragma unroll
        for (int j = 0; j < 4; ++j) { const f32x4 w4 = *(const f32x4*)(p.fin_w + 4 * lane + 256 * j); xr[64 * j] = v[j] * rstd * w4; }
    }
}
__device__ __forceinline__ void phase_gates(const Params& p, int l, int gw, int NGW, int lane) {
    const h16* hn = (const h16*)(p.ws + WS_HN); const h16* wg = (const h16*)(p.ws + WS_WG16);
    float* gates = (float*)(p.ws + WS_GATES);
    const int c = lane & 15, q = lane >> 4;
    for (int grp = gw; grp < T_ALL / 16; grp += NGW) {
        const h16* ar = hn + (size_t)(16 * grp + c) * DM + 8 * q;
        const h16* br = wg + (size_t)c * DM + 8 * q;
        f32x4 acc = {0.f, 0.f, 0.f, 0.f};
#pragma unroll 8
        for (int kp = 0; kp < 32; ++kp) {
            const h16x8 a = *(const h16x8*)(ar + 32 * kp), bq = *(const h16x8*)(br + 32 * kp);
            acc = __builtin_amdgcn_mfma_f32_16x16x32_f16(a, bq, acc, 0, 0, 0);
        }
        const float bias = p.gate_b[l * 16 + c];
#pragma unroll
        for (int j = 0; j < 4; ++j) gates[(size_t)(16 * grp + 4 * q + j) * 16 + c] = acc[j] + bias;
    }
}
__device__ __forceinline__ void phase_conv(const Params& p, int l) {
    const h16* proj = (const h16*)(p.ws + WS_PROJ); h16* qkm = (h16*)(p.ws + WS_QKM);
    const float* cw = p.conv_w + (size_t)l * 9 * 1024; const float* cb = p.conv_b + l * 1024;
    for (int idx = blockIdx.x * NTHR + ltid(); idx < T_ALL * 128; idx += gridDim.x * NTHR) {
        const int r = idx >> 7, ch0 = (idx & 127) * 8;
        float acc[8];
        { const f32x4 b0 = *(const f32x4*)(cb + ch0), b1 = *(const f32x4*)(cb + ch0 + 4); acc[0] = b0.x; acc[1] = b0.y; acc[2] = b0.z; acc[3] = b0.w; acc[4] = b1.x; acc[5] = b1.y; acc[6] = b1.z; acc[7] = b1.w; }
        const h16* src = proj + 2560 + ch0;
        const bool lat = r >= T_CTX;
        const int pp = lat ? ((r - T_CTX) & 2047) : (r & 255);
        const int gy = lat ? (pp >> 6) : 0, gx = lat ? (pp & 63) : pp;
        const int H = lat ? 32 : 1, W = lat ? 64 : 256;
#pragma unroll
        for (int a = 0; a < 3; ++a) {
            const int yy = gy + a - 1;
            if (!lat && a != 1) continue;
            if (yy < 0 || yy >= H) continue;
#pragma unroll
            for (int b = 0; b < 3; ++b) {
                const int xx = gx + b - 1;
                if (xx < 0 || xx >= W) continue;
                const int rr = r + (a - 1) * 64 + (b - 1);
                const h16x8 x = *(const h16x8*)(src + (size_t)rr * NPROJ);
                const f32x4 t0 = *(const f32x4*)(cw + (a * 3 + b) * 1024 + ch0), t1 = *(const f32x4*)(cw + (a * 3 + b) * 1024 + ch0 + 4);
                acc[0] += t0.x * (float)x[0]; acc[1] += t0.y * (float)x[1]; acc[2] += t0.z * (float)x[2]; acc[3] += t0.w * (float)x[3];
                acc[4] += t1.x * (float)x[4]; acc[5] += t1.y * (float)x[5]; acc[6] += t1.z * (float)x[6]; acc[7] += t1.w * (float)x[7];
            }
        }
        const float sc = ch0 >= 512 ? 0.08838834764831845f : 1.f;
        u32x4 w; w.x = pkh(siluf_(acc[0]) * sc, siluf_(acc[1]) * sc); w.y = pkh(siluf_(acc[2]) * sc, siluf_(acc[3]) * sc);
        w.z = pkh(siluf_(acc[4]) * sc, siluf_(acc[5]) * sc); w.w = pkh(siluf_(acc[6]) * sc, siluf_(acc[7]) * sc);
        *(u32x4*)(qkm + (size_t)r * DM + ch0) = w;
    }
}

template <int TYPE  , int CMP = 0>
__device__ __forceinline__ void scan_item(const Params& p, int l, int lat, int b, int h, int dir, LAS float* lds) {
    const int tid = ltid(), lane = tid & 63, w = __builtin_amdgcn_readfirstlane(tid >> 6);
    const int L = lat ? 2048 : 256, row0 = lat ? T_CTX + b * 2048 : b * 256, NB = L / 16;
    LAS float* qs = lds;
    LAS float* fs = lds + 2048;
    LAS float* vs = lds + 4096;
    LAS float* part = lds + 6144;
    LAS float* partn = lds + 6144 + 16384;
    LAS float* scal = partn + 128;
    LAS float* mst = scal + 128;
    LAS float* cerr = mst + 16;
    LAS float* cref = cerr + 32;
    const h16* proj = (const h16*)(p.ws + WS_PROJ); const h16* qkm = (const h16*)(p.ws + WS_QKM); const float* gates = (const float*)(p.ws + WS_GATES);
    h16* odst = (h16*)(p.ws + (ODIR(dir) ? WS_OB : WS_HN));
    const size_t sidx = (((size_t)b * 4 + l) * 2 + dir) * 4 + h;
    if (CMP) { if (tid < 64) cerr[tid] = 0.f; __syncthreads(); }

    f32x2 S[16]; float nv = 0.f;
    if (lat) {
        const float* src = (TYPE == 0 ? p.st_hg : p.st_mc) + sidx * 16384;
#pragma unroll
        for (int dd = 0; dd < 16; ++dd) S[dd] = *(const f32x2*)(src + (16 * w + dd) * 128 + 2 * lane);
        if (TYPE == 1) { nv = lane < 16 ? p.st_mn[sidx * 128 + 16 * w + lane] : 0.f; if (tid == 0) mst[0] = p.st_mm[sidx]; }
    } else {
#pragma unroll
        for (int dd = 0; dd < 16; ++dd) S[dd] = (f32x2){0.f, 0.f};
        if (TYPE == 1 && tid == 0) mst[0] = 0.f;
    }
    const int tl = tid >> 5, d0 = 4 * (tid & 31);
    f32x4 lb4 = {0.f, 0.f, 0.f, 0.f};
    if (TYPE == 0) lb4 = *(const f32x4*)((const float*)(p.ws + WS_LB) + (l * 2 + dir) * 512 + h * 128 + d0);
    h16x4 pq, pz, pv; float pgi = 0.f, pgf = 0.f;
#define SCAN_LOAD(ii) do { const int pos_ = 16 * (ii) + tl, tok_ = dir ? L - 1 - pos_ : pos_; const size_t r_ = (size_t)(row0 + tok_); \
        if (TYPE == 0) { pq = *(const h16x4*)(proj + r_ * NPROJ + h * 128 + d0); pz = *(const h16x4*)(proj + r_ * NPROJ + 512 + dir * 512 + h * 128 + d0); pv = *(const h16x4*)(proj + r_ * NPROJ + 1536 + h * 128 + d0); } \
        else { pq = *(const h16x4*)(qkm + r_ * DM + h * 128 + d0); pz = *(const h16x4*)(qkm + r_ * DM + 512 + h * 128 + d0); pv = *(const h16x4*)(proj + r_ * NPROJ + 3584 + h * 128 + d0); \
               if (w == 0) { const int ps_ = 16 * (ii) + (lane & 15), tk_ = dir ? L - 1 - ps_ : ps_; const float* g_ = gates + (size_t)(row0 + tk_) * 16; pgi = g_[dir * 4 + h]; pgf = g_[8 + dir * 4 + h]; } } } while (0)
    SCAN_LOAD(0);
    for (int i = 0; i < NB; ++i) {
        const int par = i & 1;
        const int pos = 16 * i + tl, tok = dir ? L - 1 - pos : pos;
        const size_t r = (size_t)(row0 + tok);
        {
            *(LAS f32x4*)(qs + tl * 128 + d0) = (f32x4){(float)pq[0], (float)pq[1], (float)pq[2], (float)pq[3]};
            *(LAS f32x4*)(vs + tl * 128 + d0) = (f32x4){(float)pv[0], (float)pv[1], (float)pv[2], (float)pv[3]};
            if (TYPE == 0) {
                f32x4 f4;
#pragma unroll
                for (int j = 0; j < 4; ++j) f4[j] = lb4[j] + (1.f - lb4[j]) * sigmoidf_((float)pz[j]);
                *(LAS f32x4*)(fs + tl * 128 + d0) = f4;
            } else {
                *(LAS f32x4*)(fs + tl * 128 + d0) = (f32x4){(float)pz[0], (float)pz[1], (float)pz[2], (float)pz[3]};
                if (w == 0) {
                    const int t = lane & 15;
                    const float m0 = mst[0];
                    const float gi = pgi, lf = fminf(pgf, 0.f) - log1pf(__expf(-fabsf(pgf)));
                    float bc = lf;
#pragma unroll
                    for (int o = 1; o < 16; o <<= 1) { const float x = __shfl_up(bc, o, 16); if (t >= o) bc += x; }
                    float pm = gi - bc;
#pragma unroll
                    for (int o = 1; o < 16; o <<= 1) { const float x = __shfl_up(pm, o, 16); if (t >= o) pm = fmaxf(pm, x); }
                    const float mt = bc + fmaxf(m0, pm);
                    float mp = __shfl_up(mt, 1, 16); if (t == 0) mp = m0;
                    if (lane < 16) {
                        scal[(par * 16 + t) * 4 + 0] = __expf(lf + mp - mt);
                        scal[(par * 16 + t) * 4 + 1] = __expf(gi - mt);
                        scal[(par * 16 + t) * 4 + 2] = __expf(-mt);
                    }
                    asm volatile("s_waitcnt lgkmcnt(0)" ::: "memory");
                    if (lane == 15) mst[0] = mt;
                }
            }
        }
        if (i + 1 < NB) SCAN_LOAD(i + 1);
        __syncthreads();
#pragma unroll 2
        for (int t = 0; t < 16; ++t) {
            float fv = 0.f, qv = 0.f;
            if (lane < 16) { fv = fs[t * 128 + 16 * w + lane]; qv = qs[t * 128 + 16 * w + lane]; }
            const f32x2 v2 = *(const LAS f32x2*)(vs + t * 128 + 2 * lane);
            f32x2 o = {0.f, 0.f};
            if (TYPE == 0) {
#pragma unroll
                for (int dd = 0; dd < 16; ++dd) { const float sf = rdlane(fv, dd), sq = rdlane(qv, dd); S[dd] = v2 + sf * (S[dd] - v2); o += S[dd] * sq; }
            } else {
                const float a = __builtin_bit_cast(float, __builtin_amdgcn_readfirstlane(__builtin_bit_cast(int, scal[(par * 16 + t) * 4 + 0])));
                const float g = __builtin_bit_cast(float, __builtin_amdgcn_readfirstlane(__builtin_bit_cast(int, scal[(par * 16 + t) * 4 + 1])));
                const float gk = g * fv;
                nv = a * nv + gk;
                float nq = nv * qv;
                nq += __shfl_xor(nq, 8); nq += __shfl_xor(nq, 4); nq += __shfl_xor(nq, 2); nq += __shfl_xor(nq, 1);
                if (lane == 0) partn[t * 8 + w] = nq;
#pragma unroll
                for (int dd = 0; dd < 16; ++dd) { const float sk = rdlane(gk, dd), sq = rdlane(qv, dd); S[dd] = a * S[dd] + sk * v2; o += S[dd] * sq; }
            }
            *(LAS f32x2*)(part + (t * 8 + w) * 128 + 2 * lane) = o;
        }
        __syncthreads();
        {
            f32x4 acc = {0.f, 0.f, 0.f, 0.f};
#pragma unroll
            for (int ww = 0; ww < 8; ++ww) acc += *(const LAS f32x4*)(part + (tl * 8 + ww) * 128 + d0);
            if (TYPE == 1) {
                float den = 0.f;
#pragma unroll
                for (int ww = 0; ww < 8; ++ww) den += partn[tl * 8 + ww];
                const float sc = 1.f / fmaxf(fabsf(den), scal[(par * 16 + tl) * 4 + 2]);
                acc = acc * sc;
            }
            uint2 o; o.x = pkh(acc.x, acc.y); o.y = pkh(acc.z, acc.w);
            if (CMP) {
                const h16x4 old = *(const h16x4*)(odst + r * DM + TYPE * 512 + h * 128 + d0);
                float e = 0.f, rr = 0.f;
#pragma unroll
                for (int j = 0; j < 4; ++j) { const float df = (float)old[j] - acc[j]; e += df * df; rr += acc[j] * acc[j]; }
                e = wave_sum(e); rr = wave_sum(rr);
                if (lane == 0) { atomicAdd((float*)(cerr + (i >> 2)), e); atomicAdd((float*)(cref + (i >> 2)), rr); }
            }
            *(uint2*)(odst + r * DM + TYPE * 512 + h * 128 + d0) = o;
        }
    }
    if (CMP) {
        __syncthreads();
        if (tid == 0) {
            float best = -1.f; int bc_ = 0; float tot_e = 0.f, tot_r = 0.f;
            for (int cI = 0; cI < 32; ++cI) { const float rt = cerr[cI] / fmaxf(cref[cI], 1e-30f); tot_e += cerr[cI]; tot_r += cref[cI]; if (rt > best) { best = rt; bc_ = cI; } }
            float* dg = (float*)(p.ws + WS_MODP) + 4 * blockIdx.x;
#if defined(DIAG_ALL)
            const float tot = tot_e / fmaxf(tot_r, 1e-30f);
            if (tot > dg[0]) { dg[0] = tot; dg[1] = (float)(l * 8 + TYPE * 4 + lat * 2 + dir); dg[2] = best; dg[3] = (float)bc_; }
#else
            dg[0] = best; dg[1] = (float)bc_; dg[2] = tot_e / fmaxf(tot_r, 1e-30f); dg[3] = 0.f;
#endif
        }
    }
    if (!lat) {
        float* dst = p.out + (TYPE == 0 ? OUT_HG : OUT_MC) + sidx * 16384;
#pragma unroll
        for (int dd = 0; dd < 16; ++dd) *(f32x2*)(dst + (16 * w + dd) * 128 + 2 * lane) = S[dd];
        if (TYPE == 1) { if (lane < 16) p.out[OUT_MN + sidx * 128 + 16 * w + lane] = nv; if (tid == 0) p.out[OUT_MM + sidx] = mst[0]; }
    }
    __syncthreads();
#undef SCAN_LOAD
}
typedef unsigned u32x2 __attribute__((ext_vector_type(2)));
typedef short s16x8 __attribute__((ext_vector_type(8)));
typedef short s16x4 __attribute__((ext_vector_type(4)));
typedef __bf16 bf16x2_t __attribute__((ext_vector_type(2)));
__device__ __forceinline__ unsigned pkb(float a, float b) { f32x2 v = {a, b}; bf16x2_t r = __builtin_convertvector(v, bf16x2_t); return __builtin_bit_cast(unsigned, r); }
__device__ __forceinline__ unsigned short f2b(float a) { return (unsigned short)(pkb(a, 0.f) & 0xffffu); }
__device__ __forceinline__ s16x4 tr_read(LAS const unsigned char* ptr) { return __builtin_bit_cast(s16x4, __builtin_amdgcn_ds_read_tr16_b64_v4i16((LAS s16x4*)ptr)); }
constexpr int HP = 272;
__device__ __forceinline__ void scan_hgrn_mfma(const Params& p, int l, int lat, int b, int h, int dir, LAS unsigned char* lds) {
    const int tid = ltid(), lane = tid & 63, w = __builtin_amdgcn_readfirstlane(tid >> 6), c = lane & 15, q = lane >> 4;
    const int L = lat ? 2048 : 256, row0 = lat ? T_CTX + b * 2048 : b * 256, NB = L / 16;
    constexpr int IMG = 16 * HP, BUF = 4 * IMG + 512;
    LAS float* GS = (LAS float*)(lds + 2 * BUF);
    const h16* proj = (const h16*)(p.ws + WS_PROJ);
    h16* odst = (h16*)(p.ws + (ODIR(dir) ? WS_OB : WS_HN));
    const size_t sidx = (((size_t)b * 4 + l) * 2 + dir) * 4 + h;
    f32x4 S[8];
    if (lat) {
        const float* src = p.st_hg + sidx * 16384;
#pragma unroll
        for (int dt = 0; dt < 8; ++dt)
#pragma unroll
            for (int j = 0; j < 4; ++j) S[dt][j] = src[(16 * dt + 4 * q + j) * 128 + 16 * w + c];
    } else {
#pragma unroll
        for (int dt = 0; dt < 8; ++dt) S[dt] = (f32x4){0.f, 0.f, 0.f, 0.f};
    }
    const int pt = lane & 15, d0 = 16 * w + 4 * (lane >> 4);
    const f32x4 lb4 = *(const f32x4*)((const float*)(p.ws + WS_LB) + (l * 2 + dir) * 512 + h * 128 + d0);
    h16x4 rq, rz, rv;
#define HG_LOAD(ii) do { const int pos_ = 16 * (ii) + pt, tok_ = dir ? L - 1 - pos_ : pos_; const h16* r_ = proj + (size_t)(row0 + tok_) * NPROJ + h * 128 + d0; \
        rq = *(const h16x4*)(r_); rz = *(const h16x4*)(r_ + 512 + dir * 512); rv = *(const h16x4*)(r_ + 1536); } while (0)
#define HG_ROW_SHR(x, ctl) __builtin_bit_cast(float, __builtin_amdgcn_update_dpp(0, __builtin_bit_cast(int, (x)), (ctl), 0xF, 0xF, false))
    HG_LOAD(0);
    for (int i = 0; i < NB; ++i) {
        LAS unsigned char* buf = lds + (i & 1) * BUF;
        LAS unsigned char* QT = buf; LAS unsigned char* KT = buf + IMG; LAS unsigned char* KH = buf + 2 * IMG; LAS unsigned char* VV = buf + 3 * IMG; LAS float* AD = (LAS float*)(buf + 4 * IMG);
        asm volatile("s_waitcnt vmcnt(0)" ::: "memory");
        {
            float kk[4], G[4], tot[4];
#pragma unroll
            for (int j = 0; j < 4; ++j) { const float f = lb4[j] + (1.f - lb4[j]) * sigmoidf_((float)rz[j]); kk[j] = 1.f - f; G[j] = __logf(f); }
#pragma unroll
            for (int j = 0; j < 4; ++j) {
                G[j] += HG_ROW_SHR(G[j], 0x111); G[j] += HG_ROW_SHR(G[j], 0x112); G[j] += HG_ROW_SHR(G[j], 0x114); G[j] += HG_ROW_SHR(G[j], 0x118);
                tot[j] = __shfl(G[j], 15, 16);
            }
            float oq[4], ok[4], oh[4];
#pragma unroll
            for (int j = 0; j < 4; ++j) { const float e = __expf(G[j]), ei = __expf(fminf(-G[j], 60.f)), eh = __expf(tot[j] - G[j]); oq[j] = (float)rq[j] * e; ok[j] = kk[j] * ei; oh[j] = kk[j] * eh; }
            u32x2 wq, wk, wh, wv;
            wq.x = pkb(oq[0], oq[1]); wq.y = pkb(oq[2], oq[3]); wk.x = pkb(ok[0], ok[1]); wk.y = pkb(ok[2], ok[3]);
            wh.x = pkb(oh[0], oh[1]); wh.y = pkb(oh[2], oh[3]); wv.x = pkb((float)rv[0], (float)rv[1]); wv.y = pkb((float)rv[2], (float)rv[3]);
            *(LAS u32x2*)(QT + pt * HP + 2 * d0) = wq; *(LAS u32x2*)(KT + pt * HP + 2 * d0) = wk; *(LAS u32x2*)(KH + pt * HP + 2 * d0) = wh; *(LAS u32x2*)(VV + pt * HP + 2 * d0) = wv;
            if (pt == 15) *(LAS f32x4*)(AD + d0) = (f32x4){__expf(tot[0]), __expf(tot[1]), __expf(tot[2]), __expf(tot[3])};
        }
        { const int nx = (i + 1 < NB) ? i + 1 : NB - 1; HG_LOAD(nx); }
        __syncthreads();
        {
            f32x4 accP = {0.f, 0.f, 0.f, 0.f};
#pragma unroll
            for (int kp = 0; kp < 4; ++kp) {
                const s16x8 a = *(const LAS s16x8*)(KT + c * HP + 2 * (32 * kp + 8 * q));
                const s16x8 bq = *(const LAS s16x8*)(QT + c * HP + 2 * (32 * kp + 8 * q));
                accP = __builtin_amdgcn_mfma_f32_16x16x32_bf16(a, bq, accP, 0, 0, 0);
            }
#pragma unroll
            for (int j = 0; j < 4; ++j) accP[j] = (4 * q + j > c) ? 0.f : accP[j];
            u32x2 pb; pb.x = pkb(accP[0], accP[1]); pb.y = pkb(accP[2], accP[3]);
            const s16x4 vtr = tr_read(VV + (4 * q + (c >> 2)) * HP + 2 * (16 * w + 4 * (c & 3)));
            f32x4 accO = {0.f, 0.f, 0.f, 0.f};
            accO = __builtin_amdgcn_mfma_f32_16x16x16bf16_1k(vtr, __builtin_bit_cast(s16x4, pb), accO, 0, 0, 0);
#pragma unroll
            for (int kp = 0; kp < 4; ++kp) {
                u32x4 sa; sa.x = pkb(S[2 * kp][0], S[2 * kp][1]); sa.y = pkb(S[2 * kp][2], S[2 * kp][3]); sa.z = pkb(S[2 * kp + 1][0], S[2 * kp + 1][1]); sa.w = pkb(S[2 * kp + 1][2], S[2 * kp + 1][3]);
                const u32x2 b0 = *(const LAS u32x2*)(QT + c * HP + 2 * (32 * kp + 4 * q)), b1 = *(const LAS u32x2*)(QT + c * HP + 2 * (32 * kp + 16 + 4 * q));
                u32x4 bb; bb.x = b0.x; bb.y = b0.y; bb.z = b1.x; bb.w = b1.y;
                accO = __builtin_amdgcn_mfma_f32_16x16x32_bf16(__builtin_bit_cast(s16x8, sa), __builtin_bit_cast(s16x8, bb), accO, 0, 0, 0);
            }
            {
                const int pos = 16 * i + c, tok = dir ? L - 1 - pos : pos;
                uint2 o; o.x = pkh(accO[0], accO[1]); o.y = pkh(accO[2], accO[3]);
                *(uint2*)(odst + (size_t)(row0 + tok) * DM + h * 128 + 16 * w + 4 * q) = o;
            }
#pragma unroll
            for (int dt = 0; dt < 8; ++dt) {
                const s16x4 ktr = tr_read(KH + (4 * q + (c >> 2)) * HP + 2 * (16 * dt + 4 * (c & 3)));
                const f32x4 ad = *(const LAS f32x4*)(AD + 16 * dt + 4 * q);
                S[dt] = S[dt] * ad;
                S[dt] = __builtin_amdgcn_mfma_f32_16x16x16bf16_1k(ktr, vtr, S[dt], 0, 0, 0);
            }
        }
#if defined(HG_EXTRA_SYNC)
        asm volatile("s_waitcnt vmcnt(0) lgkmcnt(0)" ::: "memory");
        __syncthreads();
#endif
    }
    if (!lat) {
        float* dst = p.out + OUT_HG + sidx * 16384;
#pragma unroll
        for (int dt = 0; dt < 8; ++dt)
#pragma unroll
            for (int j = 0; j < 4; ++j) dst[(16 * dt + 4 * q + j) * 128 + 16 * w + c] = S[dt][j];
    }
    __syncthreads();
#undef HG_LOAD
#undef HG_ROW_SHR
}
constexpr int MP = 272;
constexpr int PP = 144;
__device__ __forceinline__ void scan_mlstm_mfma(const Params& p, int l, int lat, int b, int h, int dir, LAS unsigned char* lds) {
    const int tid = ltid(), lane = tid & 63, w = __builtin_amdgcn_readfirstlane(tid >> 6), c = lane & 15, q = lane >> 4;
    const int L = lat ? 2048 : 256, row0 = lat ? T_CTX + b * 2048 : b * 256, NC = L / 64;
    constexpr int IMG = 64 * MP, BUF = 3 * IMG + 1536;
    LAS unsigned char* PM = lds + 2 * BUF;
    LAS float* DENP = (LAS float*)(PM + 64 * PP);
    LAS float* QNP = DENP + 256;
    LAS float* NP = QNP + 512;
    LAS float* NV = NP + 512;
    LAS float* mst = NV + 128;
    const h16* proj = (const h16*)(p.ws + WS_PROJ); const h16* qkm = (const h16*)(p.ws + WS_QKM); const float* gates = (const float*)(p.ws + WS_GATES);
    h16* odst = (h16*)(p.ws + (ODIR(dir) ? WS_OB : WS_HN));
    const size_t sidx = (((size_t)b * 4 + l) * 2 + dir) * 4 + h;
    f32x4 C[8];
    if (lat) {
        const float* src = p.st_mc + sidx * 16384;
#pragma unroll
        for (int dt = 0; dt < 8; ++dt)
#pragma unroll
            for (int j = 0; j < 4; ++j) C[dt][j] = src[(16 * dt + 4 * q + j) * 128 + 16 * w + c];
        if (tid < 128) NV[tid] = p.st_mn[sidx * 128 + tid];
        if (tid == 0) mst[0] = p.st_mm[sidx];
    } else {
#pragma unroll
        for (int dt = 0; dt < 8; ++dt) C[dt] = (f32x4){0.f, 0.f, 0.f, 0.f};
        if (tid < 128) NV[tid] = 0.f;
        if (tid == 0) mst[0] = 0.f;
    }
    u32x4 pq[2], pk[2], pv[2]; float pgi = 0.f, pgf = 0.f;
#define ML_LOAD(ii) do { _Pragma("unroll") for (int j_ = 0; j_ < 2; ++j_) { const int e_ = tid + 512 * j_, rw_ = e_ >> 4, pc_ = e_ & 15; const int pos_ = 64 * (ii) + rw_, tok_ = dir ? L - 1 - pos_ : pos_; \
            const size_t r_ = (size_t)(row0 + tok_); pq[j_] = *(const u32x4*)(qkm + r_ * DM + h * 128 + 8 * pc_); pk[j_] = *(const u32x4*)(qkm + r_ * DM + 512 + h * 128 + 8 * pc_); \
            pv[j_] = *(const u32x4*)(proj + r_ * NPROJ + 3584 + h * 128 + 8 * pc_); } \
        if (w == 0) { const int ps_ = 64 * (ii) + lane, tk_ = dir ? L - 1 - ps_ : ps_; const float* g_ = gates + (size_t)(row0 + tk_) * 16; pgi = g_[dir * 4 + h]; pgf = g_[8 + dir * 4 + h]; } } while (0)
    ML_LOAD(0);
    for (int i = 0; i < NC; ++i) {
        LAS unsigned char* buf = lds + (i & 1) * BUF;
        LAS unsigned char* QM = buf; LAS unsigned char* KM = buf + IMG; LAS unsigned char* VM = buf + 2 * IMG;
        LAS float* U = (LAS float*)(buf + 3 * IMG); LAS float* MM = U + 64; LAS float* AI = U + 128; LAS float* EN = U + 192; LAS float* UE = U + 256;
        asm volatile("s_waitcnt vmcnt(0)" ::: "memory");
#pragma unroll
        for (int j = 0; j < 2; ++j) { const int e = tid + 512 * j, rw = e >> 4, pc = e & 15;
            *(LAS u32x4*)(QM + rw * MP + 16 * pc) = pq[j]; *(LAS u32x4*)(KM + rw * MP + 16 * pc) = pk[j]; *(LAS u32x4*)(VM + rw * MP + 16 * pc) = pv[j]; }
        if (w == 0) {
            const float m0 = mst[0];
            const float gi = pgi, lf = fminf(pgf, 0.f) - log1pf(__expf(-fabsf(pgf)));
            float bc = lf;
#pragma unroll
            for (int o = 1; o < 64; o <<= 1) { const float x = __shfl_up(bc, o); if (lane >= o) bc += x; }
            const float u = gi - bc;
            float pm = u;
#pragma unroll
            for (int o = 1; o < 64; o <<= 1) { const float x = __shfl_up(pm, o); if (lane >= o) pm = fmaxf(pm, x); }
            const float Mt = fmaxf(m0, pm);
            const float M63 = rdlane(Mt, 63), bc63 = rdlane(bc, 63);
            U[lane] = u; MM[lane] = Mt; AI[lane] = __expf(m0 - Mt); EN[lane] = __expf(-(bc + Mt)); UE[lane] = __expf(u - M63);
            asm volatile("s_waitcnt lgkmcnt(0)" ::: "memory");
            if (lane == 0) mst[0] = bc63 + M63;
        }
        { const int nx = (i + 1 < NC) ? i + 1 : NC - 1; ML_LOAD(nx); }
        __syncthreads();
        {
            const int tt = w >> 1;
#pragma unroll
            for (int k2 = 0; k2 < 2; ++k2) {
                const int st = 2 * (w & 1) + k2;
                if (st <= tt) {
                    f32x4 accP = {0.f, 0.f, 0.f, 0.f};
#pragma unroll
                    for (int kp = 0; kp < 4; ++kp) {
                        const h16x8 a = *(const LAS h16x8*)(KM + (16 * st + c) * MP + 2 * (32 * kp + 8 * q));
                        const h16x8 bq = *(const LAS h16x8*)(QM + (16 * tt + c) * MP + 2 * (32 * kp + 8 * q));
                        accP = __builtin_amdgcn_mfma_f32_16x16x32_f16(a, bq, accP, 0, 0, 0);
                    }
                    const f32x4 u4 = *(const LAS f32x4*)(U + 16 * st + 4 * q); const float mt = MM[16 * tt + c];
                    float pj[4];
#pragma unroll
                    for (int j = 0; j < 4; ++j) { const float e = accP[j] * __expf(u4[j] - mt); pj[j] = (16 * st + 4 * q + j <= 16 * tt + c) ? e : 0.f; }
                    u32x2 pw; pw.x = pkh(pj[0], pj[1]); pw.y = pkh(pj[2], pj[3]);
                    *(LAS u32x2*)(PM + (16 * tt + c) * PP + 2 * (16 * st + 4 * q)) = pw;
                    float cs = (pj[0] + pj[1]) + (pj[2] + pj[3]);
                    cs += __shfl_xor(cs, 16); cs += __shfl_xor(cs, 32);
                    if (q == 0) DENP[st * 64 + 16 * tt + c] = cs;
                }
            }
            {
                const h16x8 qa = *(const LAS h16x8*)(QM + lane * MP + 2 * (16 * w)), qb = *(const LAS h16x8*)(QM + lane * MP + 2 * (16 * w + 8));
                const f32x4 n0 = *(const LAS f32x4*)(NV + 16 * w), n1 = *(const LAS f32x4*)(NV + 16 * w + 4), n2 = *(const LAS f32x4*)(NV + 16 * w + 8), n3 = *(const LAS f32x4*)(NV + 16 * w + 12);
                float s = 0.f;
#pragma unroll
                for (int j = 0; j < 4; ++j) s += (float)qa[j] * n0[j] + (float)qa[4 + j] * n1[j] + (float)qb[j] * n2[j] + (float)qb[4 + j] * n3[j];
                QNP[w * 64 + lane] = s;
            }
            {
                const int d = tid & 127, part = tid >> 7;
                float s = 0.f;
#pragma unroll
                for (int ss = 0; ss < 16; ++ss) s += UE[16 * part + ss] * (float)*(const LAS h16*)(KM + (16 * part + ss) * MP + 2 * d);
                NP[part * 128 + d] = s;
            }
        }
        __syncthreads();
        {
            h16x4 vtr[4];
#pragma unroll
            for (int st = 0; st < 4; ++st) vtr[st] = __builtin_bit_cast(h16x4, tr_read(VM + (16 * st + 4 * q + (c >> 2)) * MP + 2 * (16 * w + 4 * (c & 3))));
            h16x8 cp[4];
#pragma unroll
            for (int kp = 0; kp < 4; ++kp) { u32x4 sa; sa.x = pkh(C[2 * kp][0], C[2 * kp][1]); sa.y = pkh(C[2 * kp][2], C[2 * kp][3]); sa.z = pkh(C[2 * kp + 1][0], C[2 * kp + 1][1]); sa.w = pkh(C[2 * kp + 1][2], C[2 * kp + 1][3]); cp[kp] = __builtin_bit_cast(h16x8, sa); }
#pragma unroll
            for (int tt = 0; tt < 4; ++tt) {
                const int t = 16 * tt + c;
                f32x4 accI = {0.f, 0.f, 0.f, 0.f}, accN = {0.f, 0.f, 0.f, 0.f};
#pragma unroll
                for (int kp = 0; kp < 4; ++kp) {
                    const u32x2 b0 = *(const LAS u32x2*)(QM + t * MP + 2 * (32 * kp + 4 * q)), b1 = *(const LAS u32x2*)(QM + t * MP + 2 * (32 * kp + 16 + 4 * q));
                    u32x4 bb; bb.x = b0.x; bb.y = b0.y; bb.z = b1.x; bb.w = b1.y;
                    accI = __builtin_amdgcn_mfma_f32_16x16x32_f16(cp[kp], __builtin_bit_cast(h16x8, bb), accI, 0, 0, 0);
                }
                float den = 0.f;
#pragma unroll
                for (int st = 0; st < 4; ++st) if (st <= tt) {
                    const u32x2 pb = *(const LAS u32x2*)(PM + t * PP + 2 * (16 * st + 4 * q));
                    accN = __builtin_amdgcn_mfma_f32_16x16x16f16(vtr[st], __builtin_bit_cast(h16x4, pb), accN, 0, 0, 0);
                    den += DENP[st * 64 + t];
                }
                float qn = 0.f;
#pragma unroll
                for (int ww = 0; ww < 8; ++ww) qn += QNP[ww * 64 + t];
                const float ai = AI[t];
                den += ai * qn;
                const float sc = 1.f / fmaxf(fabsf(den), EN[t]);
                const f32x4 hv = (accN + accI * ai) * sc;
                const int pos = 64 * i + t, tok = dir ? L - 1 - pos : pos;
                u32x2 o; o.x = pkh(hv[0], hv[1]); o.y = pkh(hv[2], hv[3]);
                *(u32x2*)(odst + (size_t)(row0 + tok) * DM + 512 + h * 128 + 16 * w + 4 * q) = o;
            }
            const float a63 = AI[63];
            h16x4 vs[4];
#pragma unroll
            for (int st = 0; st < 4; ++st) { const f32x4 ue4 = *(const LAS f32x4*)(UE + 16 * st + 4 * q);
#pragma unroll
                for (int j = 0; j < 4; ++j) vs[st][j] = (h16)((float)vtr[st][j] * ue4[j]); }
#pragma unroll
            for (int dt = 0; dt < 8; ++dt) {
                C[dt] = C[dt] * a63;
#pragma unroll
                for (int st = 0; st < 4; ++st) {
                    const h16x4 ktr = __builtin_bit_cast(h16x4, tr_read(KM + (16 * st + 4 * q + (c >> 2)) * MP + 2 * (16 * dt + 4 * (c & 3))));
                    C[dt] = __builtin_amdgcn_mfma_f32_16x16x16f16(ktr, vs[st], C[dt], 0, 0, 0);
                }
            }
            if (tid < 128) NV[tid] = a63 * NV[tid] + (NP[tid] + NP[128 + tid]) + (NP[256 + tid] + NP[384 + tid]);
        }
#if defined(ML_EXTRA_SYNC)
        asm volatile("s_waitcnt vmcnt(0) lgkmcnt(0)" ::: "memory");
        __syncthreads();
#endif
    }
    __syncthreads();
    if (!lat) {
        float* dst = p.out + OUT_MC + sidx * 16384;
#pragma unroll
        for (int dt = 0; dt < 8; ++dt)
#pragma unroll
            for (int j = 0; j < 4; ++j) dst[(16 * dt + 4 * q + j) * 128 + 16 * w + c] = C[dt][j];
        if (tid < 128) p.out[OUT_MN + sidx * 128 + tid] = NV[tid];
        if (tid == 0) p.out[OUT_MM + sidx] = mst[0];
    }
    __syncthreads();
#undef ML_LOAD
}
#if defined(DIAG_ALL)
#define SCAN_HG(p, l, lat, b, h, dir, lds) do { scan_hgrn_mfma(p, l, lat, b, h, dir, (LAS unsigned char*)(lds)); asm volatile("s_waitcnt vmcnt(0)" ::: "memory"); __syncthreads(); scan_item<0, 1>(p, l, lat, b, h, dir, lds); } while (0)
#elif defined(HGRN_VALU)
#define SCAN_HG(p, l, lat, b, h, dir, lds) scan_item<0>(p, l, lat, b, h, dir, lds)
#else
#define SCAN_HG(p, l, lat, b, h, dir, lds) scan_hgrn_mfma(p, l, lat, b, h, dir, (LAS unsigned char*)(lds))
#endif
#if defined(MLSTM_VALU)
#define SCAN_ML(p, l, lat, b, h, dir, lds) scan_item<1>(p, l, lat, b, h, dir, lds)
#else
#if defined(DIAG_ALL)
#define SCAN_ML(p, l, lat, b, h, dir, lds) do { scan_mlstm_mfma(p, l, lat, b, h, dir, (LAS unsigned char*)(lds)); asm volatile("s_waitcnt vmcnt(0)" ::: "memory"); __syncthreads(); scan_item<1, 1>(p, l, lat, b, h, dir, lds); } while (0)
#elif defined(MLSTM_DIAG)
#define SCAN_ML(p, l, lat, b, h, dir, lds) do { scan_mlstm_mfma(p, l, lat, b, h, dir, (LAS unsigned char*)(lds)); \
        if ((lat) && (dir) == 0 && (l) == DIAG_LAYER) { asm volatile("s_waitcnt vmcnt(0)" ::: "memory"); __syncthreads(); scan_item<1, 1>(p, l, lat, b, h, dir, lds); } } while (0)
#elif defined(MLSTM_VALU_CTX)
#define SCAN_ML(p, l, lat, b, h, dir, lds) do { if (lat) scan_mlstm_mfma(p, l, lat, b, h, dir, (LAS unsigned char*)(lds)); else scan_item<1>(p, l, lat, b, h, dir, lds); } while (0)
#elif defined(MLSTM_MFMA_DIR0)
#define SCAN_ML(p, l, lat, b, h, dir, lds) do { if ((dir) == 0) scan_mlstm_mfma(p, l, lat, b, h, dir, (LAS unsigned char*)(lds)); else scan_item<1>(p, l, lat, b, h, dir, lds); } while (0)
#elif defined(MLSTM_BISECT)
#define SCAN_ML(p, l, lat, b, h, dir, lds) do { if (!((lat) && (dir) == 0 && (MLSTM_BISECT_COND))) scan_mlstm_mfma(p, l, lat, b, h, dir, (LAS unsigned char*)(lds)); else scan_item<1>(p, l, lat, b, h, dir, lds); } while (0)
#elif defined(MLSTM_VALU_LAT)
#define SCAN_ML(p, l, lat, b, h, dir, lds) do { if (!(lat)) scan_mlstm_mfma(p, l, lat, b, h, dir, (LAS unsigned char*)(lds)); else scan_item<1>(p, l, lat, b, h, dir, lds); } while (0)
#else
#define SCAN_ML(p, l, lat, b, h, dir, lds) scan_mlstm_mfma(p, l, lat, b, h, dir, (LAS unsigned char*)(lds))
#endif
#endif
__device__ __forceinline__ void scan_dispatch(const Params& p, int l, int it, LAS float* lds) {
    if (it < 128) { const int type = it >> 6, r = it & 63, b = r >> 3, h = (r >> 1) & 3, dir = r & 1; if (type == 0) SCAN_HG(p, l, 1, b, h, dir, lds); else SCAN_ML(p, l, 1, b, h, dir, lds); }
    else { const int q = it - 128, type = q >> 8, r = q & 255, b = r >> 3, h = (r >> 1) & 3, dir = r & 1; if (type == 0) SCAN_HG(p, l, 0, b, h, dir, lds); else SCAN_ML(p, l, 0, b, h, dir, lds); }
}
__device__ __forceinline__ void phase_scan(const Params& p, int l, LAS float* lds) {
    const int G = gridDim.x, bid = blockIdx.x;
    if (G == 256) {
        if (bid < 128) scan_dispatch(p, l, bid, lds);
        else for (int it = 128 + (bid - 128); it < 640; it += 128) scan_dispatch(p, l, it, lds);
    } else {
        for (int it = bid; it < 640; it += G) scan_dispatch(p, l, it, lds);
    }
}
__device__ __forceinline__ void phase_mixnorm(const Params& p, int l, int gw, int NGW, int lane) {
    const h16* of = (const h16*)(p.ws + WS_HN); const h16* ob = (const h16*)(p.ws + WS_OB); const h16* proj = (const h16*)(p.ws + WS_PROJ);
    h16* mix = (h16*)(p.ws + WS_QKM);
    const int col = 16 * lane;
    const float* nw = col < 512 ? p.hg_nw + l * 512 + col : p.ml_nw + l * 512 + (col - 512);
    float wv[16];
#pragma unroll
    for (int j = 0; j < 4; ++j) { const f32x4 t = *(const f32x4*)(nw + 4 * j); wv[4 * j] = t.x; wv[4 * j + 1] = t.y; wv[4 * j + 2] = t.z; wv[4 * j + 3] = t.w; }
    const int gcol = col < 512 ? 2048 + col : 4096 + (col - 512);
    for (int r = gw; r < T_ALL; r += NGW) {
        const h16x8 a0 = *(const h16x8*)(of + (size_t)r * DM + col), a1 = *(const h16x8*)(of + (size_t)r * DM + col + 8);
        const h16x8 b0 = *(const h16x8*)(ob + (size_t)r * DM + col), b1 = *(const h16x8*)(ob + (size_t)r * DM + col + 8);
        const h16x8 g0 = *(const h16x8*)(proj + (size_t)r * NPROJ + gcol), g1 = *(const h16x8*)(proj + (size_t)r * NPROJ + gcol + 8);
        float o[16]; float ss = 0.f;
#pragma unroll
        for (int j = 0; j < 8; ++j) { o[j] = (float)a0[j] + (float)b0[j]; o[8 + j] = (float)a1[j] + (float)b1[j]; }
#pragma unroll
        for (int j = 0; j < 16; ++j) ss += o[j] * o[j];
        ss += __shfl_xor(ss, 1); ss += __shfl_xor(ss, 2); ss += __shfl_xor(ss, 4);
        const float rstd = rsqrtf(ss * (1.f / 128.f) + EPS);
        u32x4 w0, w1;
        w0.x = pkh(o[0] * rstd * wv[0] * (float)g0[0], o[1] * rstd * wv[1] * (float)g0[1]); w0.y = pkh(o[2] * rstd * wv[2] * (float)g0[2], o[3] * rstd * wv[3] * (float)g0[3]);
        w0.z = pkh(o[4] * rstd * wv[4] * (float)g0[4], o[5] * rstd * wv[5] * (float)g0[5]); w0.w = pkh(o[6] * rstd * wv[6] * (float)g0[6], o[7] * rstd * wv[7] * (float)g0[7]);
        w1.x = pkh(o[8] * rstd * wv[8] * (float)g1[0], o[9] * rstd * wv[9] * (float)g1[1]); w1.y = pkh(o[10] * rstd * wv[10] * (float)g1[2], o[11] * rstd * wv[11] * (float)g1[3]);
        w1.z = pkh(o[12] * rstd * wv[12] * (float)g1[4], o[13] * rstd * wv[13] * (float)g1[5]); w1.w = pkh(o[14] * rstd * wv[14] * (float)g1[6], o[15] * rstd * wv[15] * (float)g1[7]);
        *(u32x4*)(mix + (size_t)r * DM + col) = w0; *(u32x4*)(mix + (size_t)r * DM + col + 8) = w1;
    }
}

#define XB_TMO      128
#define XB_XCNT(j)  (256  + 64 * (j))
#define XB_XSUB(j)  (1280 + 64 * (j))
#define XB_XGEN(j)  (2304 + 64 * (j))
#define XB_TOP      3328
#define XB_TOPGEN   3392
#define XCD_BAR_WORDS 3456
#define XB_SPIN_CAP (1u << 18)

__device__ __forceinline__ unsigned xb_ld(unsigned* p)              { return __hip_atomic_load(p, __ATOMIC_RELAXED, __HIP_MEMORY_SCOPE_AGENT); }
__device__ __forceinline__ unsigned xb_add(unsigned* p, unsigned v) { return __hip_atomic_fetch_add(p, v, __ATOMIC_RELAXED, __HIP_MEMORY_SCOPE_AGENT); }
__device__ __forceinline__ unsigned xb_xcc_id() { return (unsigned)__builtin_amdgcn_s_getreg((3 << 11) | 20) & 0xFu; }
#define XB_SPIN(cond, bar) do { unsigned _sp = 0; while (cond) { __builtin_amdgcn_s_sleep(1); \
    if ((++_sp & 255u) == 0u) { if (xb_ld(&(bar)[XB_TMO])) break; if (_sp > XB_SPIN_CAP) { atomicAdd(&(bar)[XB_TMO], 1u); break; } } } } while (0)

struct XcdBarrier {
    unsigned* bar; unsigned x;
    volatile LAS unsigned* st;
};

__device__ __forceinline__ XcdBarrier xcd_barrier_post(unsigned* bar, volatile LAS unsigned* st) {
    XcdBarrier b; b.bar = bar; b.x = xb_xcc_id(); b.st = st;
    if (threadIdx.x == 0) (void)xb_add(&bar[XB_XCNT(b.x)], 1u);
    return b;
}
__device__ __forceinline__ void xcd_barrier_complete(unsigned* bar, unsigned x, unsigned& nloc, unsigned& nx) {
    const unsigned G = gridDim.x * gridDim.y * gridDim.z;
    unsigned sum, cnt, mine, sp = 0u;
    for (;;) {
        sum = 0u; cnt = 0u; mine = 0u;
#pragma unroll
        for (unsigned j = 0; j < 16; ++j) { const unsigned c = xb_ld(&bar[XB_XCNT(j)]); sum += c; cnt += (c > 0u) ? 1u : 0u; mine = (j == x) ? c : mine; }
        if (sum == G) break;
        __builtin_amdgcn_s_sleep(1);
        if ((++sp & 255u) == 0u) { if (xb_ld(&bar[XB_TMO])) break; if (sp > XB_SPIN_CAP) { atomicAdd(&bar[XB_TMO], 1u); break; } }
    }
    nloc = mine > 0u ? mine : 1u; nx = cnt > 0u ? cnt : 1u;
}

__device__ __forceinline__ void xcd_barrier(const XcdBarrier& b) {
    asm volatile("s_waitcnt vmcnt(0)" ::: "memory");
    __syncthreads();
    if (threadIdx.x == 0) {
        unsigned* bar = b.bar;
        __builtin_amdgcn_s_waitcnt(0);
        unsigned nloc = b.st[0], nx = b.st[1];
        if (nloc == 0u) { xcd_barrier_complete(bar, b.x, nloc, nx); b.st[0] = nloc; b.st[1] = nx; }
        const unsigned old = xb_add(&bar[XB_XSUB(b.x)], 1u);
        const unsigned gen = old / nloc;
        if (old + 1u == (gen + 1u) * nloc) {
            __builtin_amdgcn_fence(__ATOMIC_RELEASE, "agent");
            asm volatile("s_waitcnt vmcnt(0)" ::: "memory");
            const unsigned og = xb_add(&bar[XB_TOP], 1u);
            const unsigned tg = og / nx;
            if (og + 1u == (tg + 1u) * nx) xb_add(&bar[XB_TOPGEN], 1u);
            else XB_SPIN(xb_ld(&bar[XB_TOPGEN]) == tg, bar);
            __builtin_amdgcn_fence(__ATOMIC_ACQUIRE, "agent");
            xb_add(&bar[XB_XGEN(b.x)], 1u);
            asm volatile("s_waitcnt vmcnt(0)" ::: "memory");
        } else {
            XB_SPIN(xb_ld(&bar[XB_XGEN(b.x)]) == gen, bar);
            __builtin_amdgcn_fence(__ATOMIC_ACQUIRE, "agent");
            asm volatile("s_waitcnt vmcnt(0)" ::: "memory");
        }
    }
    __syncthreads();
}


__global__ void __launch_bounds__(NTHR, 2) fwd_megakernel(Params p) {
    extern __shared__ __attribute__((aligned(16))) unsigned char lds_raw[];
    cg::grid_group grid = cg::this_grid();
#if defined(USE_CG_SYNC)
#define GSYNC() do { asm volatile("s_waitcnt vmcnt(0)" ::: "memory"); grid.sync(); } while (0)
#else
#define GSYNC() do { XcdBarrier xb_; xb_.bar = (unsigned*)(p.ws + WS_BAR); xb_.x = xb_xcc_id(); xb_.st = (volatile LAS unsigned*)(lds + 131072 + 512); xcd_barrier(xb_); } while (0)
#endif
    LAS unsigned char* lds = (LAS unsigned char*)lds_raw;
    LAS float* ldsf = (LAS float*)lds_raw;
    const int G = gridDim.x, NGW = G * NWV;
#define PHASE_IDS() const int tid = ltid(), lane = tid & 63, wave = __builtin_amdgcn_readfirstlane(tid >> 6), gw = blockIdx.x * NWV + wave; (void)tid; (void)lane; (void)gw
    const float* mod = (const float*)(p.ws + WS_MOD);
    h16* hn = (h16*)(p.ws + WS_HN); h16* proj = (h16*)(p.ws + WS_PROJ); h16* mix = (h16*)(p.ws + WS_QKM); h16* ff = (h16*)(p.ws + WS_PROJ);

    volatile LAS unsigned* xst = (volatile LAS unsigned*)(lds + 131072 + 512);
    if (ltid() < 4) xst[ltid()] = 0u;
    __syncthreads();
    XcdBarrier xbar = xcd_barrier_post((unsigned*)(p.ws + WS_BAR), xst);
    phase_mod_partial(p, ldsf);
    asm volatile("s_waitcnt vmcnt(0)" ::: "memory"); grid.sync();
    (void)xbar;
    phase_mod_reduce(p);
    GSYNC();
#if defined(DIAG_ALL)
    if (ltid() == 0) { float* dg = (float*)(p.ws + WS_MODP) + 4 * blockIdx.x; dg[0] = 0.f; dg[1] = 0.f; dg[2] = 0.f; dg[3] = 0.f; }
#endif
    for (int l = 0; l < 4; ++l) {
        { PHASE_IDS(); convert_weights(p, l, ldsf + wave * 2176, gw, NGW, lane); }
        { PHASE_IDS(); phase_norm(p, l, 0, l == 0, gw, NGW, lane); }
        GSYNC();
        {
            pg8::Gemm g{(const pg8::bf16_t*)hn, (const pg8::bf16_t*)(p.ws + WS_WIN), T_ALL, NPROJ_PAD, DM}; pg8::StaticOrder S; S.init(T_ALL, NPROJ_PAD, G, (int)blockIdx.x);
            EpiInProj E{proj, (float*)(p.ws + WS_GATES), p.gate_b + l * 16};
            pg8::gemm_phase<EpiInProj, pg8::StaticOrder, true, true>(lds, g, S, E);
#if defined(PROBE_GEMM2)
            GSYNC();
            pg8::gemm_phase<EpiInProj, pg8::StaticOrder, true, true>(lds, g, S, E);
#endif
        }
        GSYNC();
        { PHASE_IDS(); phase_gates(p, l, gw, NGW, lane); }
        phase_conv(p, l);
        GSYNC();
        phase_scan(p, l, ldsf);
#if defined(DELAY_AFTER_SCAN)
        { if (ltid() == 0) { const unsigned long long t0_ = __builtin_amdgcn_s_memrealtime(); while (__builtin_amdgcn_s_memrealtime() - t0_ < (unsigned long long)(DELAY_AFTER_SCAN) * 100ull) __builtin_amdgcn_s_sleep(8); } __syncthreads(); }
#endif
#if defined(LDS_CLEAR)
        { __syncthreads(); const int t_ = ltid(); for (int e = t_; e < 32768; e += NTHR) ldsf[e] = LDS_CLEAR_VAL; __syncthreads(); }
#endif
        GSYNC();
#if defined(MLSTM_DIAG)
        if (l == DIAG_LAYER && blockIdx.x == 0 && ltid() == 0) {
            const float* dg = (const float*)(p.ws + WS_MODP);
            float best = -1.f; int code = 0;
            for (int bb = 64; bb < 128; bb += 2) { const float rt = dg[4 * bb + DIAG_FIELD]; if (rt > best) { best = rt; int lg = 0; float x = rt; while (x < 1.f && lg < 31) { x *= 2.f; ++lg; } code = DIAG_CODE; } }
            const unsigned long long t0 = __builtin_amdgcn_s_memrealtime();
            while (__builtin_amdgcn_s_memrealtime() - t0 < (unsigned long long)code * 5000ull) __builtin_amdgcn_s_sleep(8);
        }
#endif
#if defined(PROBE_GSYNC10)
        for (int rep = 0; rep < 10; ++rep) GSYNC();
#endif
#if defined(PROBE_SCAN_TYPE)
        { const int bid_ = blockIdx.x;
          if (bid_ < 128) { if ((bid_ >> 6) == PROBE_SCAN_TYPE) scan_dispatch(p, l, bid_, ldsf); }
          else for (int it = 128 + (bid_ - 128); it < 640; it += 128) { if (((it - 128) >> 8) == PROBE_SCAN_TYPE) scan_dispatch(p, l, it, ldsf); } }
        GSYNC();
#endif
#if defined(PROBE_SCAN2)
        phase_scan(p, l, ldsf);
        GSYNC();
#endif
        { PHASE_IDS(); phase_mixnorm(p, l, gw, NGW, lane); }
        GSYNC();
        {
            pg8::Gemm g{(const pg8::bf16_t*)mix, (const pg8::bf16_t*)(p.ws + WS_WOUT), T_ALL, DM, DM}; pg8::StaticOrder S; S.init(T_ALL, DM, G, (int)blockIdx.x);
            EpiResid E{l == 0 ? p.x_prompt : p.out, l == 0 ? p.x_sample : p.out + (size_t)T_CTX * DM, p.out, mod + (size_t)l * 9 * 6144 + 2048};
#if defined(PROBE_GEMM2)
            { EpiResid E2 = E; E2.out = (float*)(p.ws + WS_PROJ); pg8::gemm_phase<EpiResid, pg8::StaticOrder, true, true>(lds, g, S, E2); GSYNC(); }
#endif
            pg8::gemm_phase<EpiResid, pg8::StaticOrder, true, true>(lds, g, S, E);
        }
        GSYNC();
        { PHASE_IDS(); phase_norm(p, l, 1, false, gw, NGW, lane); }
        GSYNC();
        {
            pg8::Gemm g{(const pg8::bf16_t*)hn, (const pg8::bf16_t*)(p.ws + WS_WGU), T_ALL, NGU, DM}; pg8::StaticOrder S; S.init(T_ALL, NGU, G, (int)blockIdx.x);
            EpiGateUp E{ff};
            pg8::gemm_phase<EpiGateUp, pg8::StaticOrder, true, true>(lds, g, S, E);
#if defined(PROBE_GEMM2)
            GSYNC();
            pg8::gemm_phase<EpiGateUp, pg8::StaticOrder, true, true>(lds, g, S, E);
#endif
        }
        GSYNC();
        {
            pg8::Gemm g{(const pg8::bf16_t*)ff, (const pg8::bf16_t*)(p.ws + WS_WDN), T_ALL, DM, DFF}; pg8::StaticOrder S; S.init(T_ALL, DM, G, (int)blockIdx.x);
            EpiResid E{p.out, p.out + (size_t)T_CTX * DM, p.out, mod + (size_t)l * 9 * 6144 + 5120};
#if defined(PROBE_GEMM2)
            { EpiResid E2 = E; E2.out = (float*)(p.ws + WS_QKM); pg8::gemm_phase<EpiResid, pg8::StaticOrder, true, true>(lds, g, S, E2); GSYNC(); }
#endif
            pg8::gemm_phase<EpiResid, pg8::StaticOrder, true, true>(lds, g, S, E);
        }
        GSYNC();
    }
    { PHASE_IDS(); phase_final_norm(p, gw, NGW, lane); }
#if defined(DIAG_ALL)
    if (blockIdx.x == 0 && ltid() == 0) {
        const float* dg = (const float*)(p.ws + WS_MODP);
        float best = -1.f; int code = 0;
        for (int bb = 0; bb < (int)gridDim.x; ++bb) { const float rt = dg[4 * bb]; if (rt > best) { best = rt; int lg = 0; float x = rt; while (x < 1.f && lg < 31) { x *= 2.f; ++lg; } code = DIAG_ALL_CODE; } }
        const unsigned long long t0 = __builtin_amdgcn_s_memrealtime();
        while (__builtin_amdgcn_s_memrealtime() - t0 < (unsigned long long)code * 5000ull) __builtin_amdgcn_s_sleep(8);
    }
#endif
}

extern "C" void kernel_launch(void* const* d_in, const int* in_sizes, int n_in, void* d_out, int out_size, void* d_ws, size_t ws_size, hipStream_t stream) {
    static int grid_blocks = 0;
    if (grid_blocks == 0) {
        if (n_in != 24 || (size_t)out_size != OUT_TOTAL || ws_size < WS_END) {
            fprintf(stderr, "kernel_launch: unexpected sizes n_in %d out %d ws %zu (need %zu)\n", n_in, out_size, ws_size, (size_t)WS_END); grid_blocks = -1; return;
        }
        int dev = 0, cus = 0, per_cu = 0;
        hipGetDevice(&dev);
        hipDeviceGetAttribute(&cus, hipDeviceAttributeMultiprocessorCount, dev);
        hipFuncSetAttribute((const void*)fwd_megakernel, hipFuncAttributeMaxDynamicSharedMemorySize, LDS_BYTES);
        hipOccupancyMaxActiveBlocksPerMultiprocessor(&per_cu, (const void*)fwd_megakernel, NTHR, LDS_BYTES);
        if (per_cu < 1) { fprintf(stderr, "kernel_launch: occupancy query says %d blocks per CU\n", per_cu); per_cu = 1; }
        grid_blocks = cus * 1;
        (void)hipGetLastError();
    }
    if (grid_blocks < 0) return;
    Params p{};
    const float** f = (const float**)&p;
    for (int i = 0; i < 24; ++i) f[i] = (const float*)d_in[i];
    p.out = (float*)d_out; p.ws = (unsigned char*)d_ws;
    if (hipMemsetAsync((char*)d_ws + WS_BAR, 0, 16384, stream) != hipSuccess) { fprintf(stderr, "kernel_launch: memset of the barrier words failed\n"); return; }
    void* args[] = {&p};
    hipError_t e = hipLaunchCooperativeKernel((const void*)fwd_megakernel, dim3(grid_blocks), dim3(NTHR), args, LDS_BYTES, stream);
    if (e != hipSuccess) fprintf(stderr, "cooperative launch failed: %s (grid %d)\n", hipGetErrorString(e), grid_blocks);
}
```

```cpp
#include <hip/hip_runtime.h>
#include <hip/hip_cooperative_groups.h>
#include <cstdio>
#include <cstdint>
namespace cg = cooperative_groups;
typedef _Float16 h16;
typedef _Float16 h16x8 __attribute__((ext_vector_type(8)));
typedef _Float16 h16x4 __attribute__((ext_vector_type(4)));
typedef _Float16 h16x2 __attribute__((ext_vector_type(2)));
typedef float f32x2 __attribute__((ext_vector_type(2)));
namespace pg8 {
#define PG8_LAS __attribute__((address_space(3)))
typedef unsigned short bf16_t;
typedef short bf16x8 __attribute__((ext_vector_type(8)));
typedef float f32x4 __attribute__((ext_vector_type(4)));
typedef unsigned u32x4 __attribute__((ext_vector_type(4)));
constexpr int BM = 256, BK = 64, HALF = 128, HTB = HALF * BK * 2  , STAGE_BYTES = 8 * HTB, NXCD = 8, WGM = 8;

__host__ __device__ __forceinline__ int lds_byte(int r, int c) { const int st = (r >> 4) * 2 + (c >> 5), rr = r & 15, cc = c & 31, ob = rr * 64 + cc * 2; return st * 1024 + (ob ^ (((ob >> 9) & 1) << 5)); }
__host__ __device__ __forceinline__ void stage_rc(int b, int& R, int& C) { const int st = b / 1024, sb = b % 1024, swz = sb ^ (((sb >> 9) & 1) << 5); R = (st >> 1) * 16 + swz / 64; C = (st & 1) * 32 + (swz % 64) / 2; }
__host__ __device__ __forceinline__ int perm32(int rho) { const int n = rho >> 4, i = rho & 15; return 8 * (i >> 2) + 4 * n + (i & 3); }

struct Unit { int pm, pn; };
struct Gemm { const bf16_t* A; const bf16_t* Bt; int M, N, K; };

struct StaticOrder {
    int nM, nN, nwg, G, c;
    __host__ __device__ void init(int M, int N, int G_, int c_) { nM = M / BM; nN = N / BM; nwg = nM * nN; G = G_; c = c_; }
    __host__ __device__ bool next(int i, Unit& u) const {
        const long L = (long)i * G + c; if (L >= nwg) return false;
        int wgid = (int)L; { const int q = nwg / NXCD, r = nwg % NXCD, xcd = wgid % NXCD, off = wgid / NXCD; wgid = (xcd < r ? xcd * (q + 1) : r * (q + 1) + (xcd - r) * q) + off; }
        const int nig = WGM * nN, gid = wgid / nig, fm = gid * WGM, gsz = (nM - fm) < WGM ? (nM - fm) : WGM;
        u.pm = fm + ((wgid % nig) % gsz); u.pn = (wgid % nig) / gsz; return true;
    }
    __device__ __forceinline__ void a_ready(const Unit&) const {}
    __device__ __forceinline__ void done(const Unit&) const {}
};

template <class Epi, class Sched, bool ALIGN_EPI = false, bool SP2 = false>
__device__ __forceinline__ void gemm_phase(PG8_LAS unsigned char* lds, const Gemm g, const Sched& S, const Epi& E) {
    int tid_l = threadIdx.x; asm volatile("" : "+v"(tid_l));
    const int tid = tid_l, wid = __builtin_amdgcn_readfirstlane(tid >> 6), lane = tid & 63, wr = wid >> 2, wc = wid & 3, fr = lane & 15, fq = lane >> 4;
    const int K = g.K, nt = K / BK;
    unsigned voffA[2], voffB[2];
#pragma unroll
    for (int i = 0; i < 2; ++i) { int R, C; stage_rc(tid * 16 + i * 8192, R, C); const int Rb = Epi::PERM ? ((R & ~31) + perm32(R & 31)) : R;
        voffA[i] = (unsigned)(R * K + C) * 2u; voffB[i] = (unsigned)(Rb * K + C) * 2u; }
    const size_t kstep = (size_t)(BK * 2);
    const size_t hstep = (size_t)HALF * K * 2;
    const size_t tstep = 2 * hstep;
    const unsigned ldsw = (unsigned)wid * 1024u;
    const int aoff = lds_byte(wr * 64 + fr, fq * 8), boff = lds_byte(wc * 32 + fr, fq * 8);
#define PG8_SA(b, h) (((b) * 2 + (h)) * HTB)
#define PG8_SB(b, h) ((4 + (b) * 2 + (h)) * HTB)
#define PG8_STAGE(bufoff, gbase, voff) do { _Pragma("unroll") for (int _i = 0; _i < 2; ++_i) \
        __builtin_amdgcn_global_load_lds((const unsigned*)((const char*)(gbase) + (voff)[_i]), (PG8_LAS unsigned*)(lds + (bufoff) + ldsw + _i * 8192), 16, 0, 0); } while (0)
#define PG8_LDA(dst, b, h) do { _Pragma("unroll") for (int m = 0; m < 4; ++m) _Pragma("unroll") for (int k = 0; k < 2; ++k) dst[m][k] = *(const PG8_LAS bf16x8*)(lds + PG8_SA(b, h) + aoff + m * 2048 + k * 1024); } while (0)
#define PG8_LDB(dst, b, h) do { _Pragma("unroll") for (int n = 0; n < 2; ++n) _Pragma("unroll") for (int k = 0; k < 2; ++k) dst[n][k] = *(const PG8_LAS bf16x8*)(lds + PG8_SB(b, h) + boff + n * 2048 + k * 1024); } while (0)
#define PG8_MMA(ai, bj, At, Bt) do { __builtin_amdgcn_s_setprio(1); _Pragma("unroll") for (int m = 0; m < 4; ++m) _Pragma("unroll") for (int n = 0; n < 2; ++n) _Pragma("unroll") for (int k = 0; k < 2; ++k) \
        acc[ai][bj][m][n] = __builtin_amdgcn_mfma_f32_16x16x32_f16(__builtin_bit_cast(h16x8, Bt[n][k]), __builtin_bit_cast(h16x8, At[m][k]), acc[ai][bj][m][n], 0, 0, 0); __builtin_amdgcn_s_setprio(0); } while (0)
#define PG8_WAIT_V(n) asm volatile("s_waitcnt vmcnt(" #n ")" ::: "memory")
#define PG8_WAIT_L(n) asm volatile("s_waitcnt lgkmcnt(" #n ")" ::: "memory")
#define PG8_BAR __builtin_amdgcn_s_barrier()
#define PG8_SCHED __builtin_amdgcn_sched_barrier(0)
    Unit cur, nxt; int ui = 0;
    if (!S.next(0, cur)) return;
    f32x4 acc[2][2][4][2];
#pragma unroll
    for (int a = 0; a < 2; ++a)
#pragma unroll
        for (int b = 0; b < 2; ++b)
#pragma unroll
            for (int m = 0; m < 4; ++m)
#pragma unroll
                for (int n = 0; n < 2; ++n) acc[a][b][m][n] = (f32x4){0.f, 0.f, 0.f, 0.f};
    bf16x8 At[4][2], B0[2][2], B1[2][2];
    const char* cA = (const char*)g.A + (size_t)cur.pm * tstep; const char* cB = (const char*)g.Bt + (size_t)cur.pn * tstep;
    S.a_ready(cur);
    if constexpr (SP2) {
        PG8_STAGE(PG8_SB(0, 0), cB, voffB); PG8_STAGE(PG8_SB(0, 1), cB + hstep, voffB); PG8_STAGE(PG8_SA(0, 0), cA, voffA); PG8_STAGE(PG8_SA(0, 1), cA + hstep, voffA);
        if (wr == 1) PG8_BAR;
        PG8_WAIT_V(2); PG8_BAR;
        PG8_STAGE(PG8_SB(1, 0), cB + kstep, voffB); PG8_STAGE(PG8_SA(1, 0), cA + kstep, voffA); PG8_STAGE(PG8_SB(1, 1), cB + hstep + kstep, voffB);
        PG8_WAIT_V(6); PG8_BAR;
    } else {
        PG8_STAGE(PG8_SB(0, 0), cB, voffB); PG8_STAGE(PG8_SA(0, 0), cA, voffA); PG8_STAGE(PG8_SB(0, 1), cB + hstep, voffB); PG8_STAGE(PG8_SA(0, 1), cA + hstep, voffA);
        if (wr == 1) PG8_BAR;
        PG8_WAIT_V(4); PG8_BAR;
        PG8_STAGE(PG8_SB(1, 0), cB + kstep, voffB); PG8_STAGE(PG8_SA(1, 0), cA + kstep, voffA); PG8_STAGE(PG8_SB(1, 1), cB + hstep + kstep, voffB);
        PG8_WAIT_V(6); PG8_BAR;
    }
    for (;;) {
        const bool has_next = S.next(ui + 1, nxt);
        const char* nA = has_next ? (const char*)g.A + (size_t)nxt.pm * tstep : cA; const char* nB = has_next ? (const char*)g.Bt + (size_t)nxt.pn * tstep : cB;
        for (int t = 0; t < nt; t += 2) {
            const bool last = (t == nt - 2);
            const char* a1 = cA + (size_t)(t + 1) * kstep;
            const char* a2 = last ? nA : cA + (size_t)(t + 2) * kstep; const char* b2 = last ? nB : cB + (size_t)(t + 2) * kstep;
            const char* a3 = a2 + kstep; const char* b3 = b2 + kstep;
            if (last && has_next) S.a_ready(nxt);
            if constexpr (SP2) {
            PG8_LDB(B0, 0, 0); PG8_LDB(B1, 0, 1); PG8_SCHED; PG8_LDA(At, 0, 0); PG8_STAGE(PG8_SA(1, 1), a1 + hstep, voffA);
            PG8_WAIT_V(8); PG8_WAIT_L(0); PG8_BAR; PG8_MMA(0, 0, At, B0); PG8_MMA(0, 1, At, B1); PG8_BAR; PG8_SCHED;
            PG8_LDA(At, 0, 1); PG8_STAGE(PG8_SB(0, 0), b2, voffB); PG8_STAGE(PG8_SB(0, 1), b2 + hstep, voffB); PG8_STAGE(PG8_SA(0, 0), a2, voffA);
            PG8_WAIT_V(8); PG8_WAIT_L(0); PG8_BAR; PG8_MMA(1, 0, At, B0); PG8_MMA(1, 1, At, B1); PG8_BAR; PG8_SCHED;
            PG8_LDB(B0, 1, 0); PG8_LDB(B1, 1, 1); PG8_SCHED; PG8_LDA(At, 1, 0); PG8_STAGE(PG8_SA(0, 1), a2 + hstep, voffA);
            PG8_WAIT_V(8); PG8_WAIT_L(0); PG8_BAR; PG8_MMA(0, 0, At, B0); PG8_MMA(0, 1, At, B1); PG8_BAR; PG8_SCHED;
            PG8_LDA(At, 1, 1); PG8_STAGE(PG8_SB(1, 0), b3, voffB); PG8_STAGE(PG8_SB(1, 1), b3 + hstep, voffB); PG8_STAGE(PG8_SA(1, 0), a3, voffA);
            PG8_WAIT_V(8); PG8_WAIT_L(0); PG8_BAR; PG8_MMA(1, 0, At, B0); PG8_MMA(1, 1, At, B1); PG8_BAR; PG8_SCHED;
            } else {
            PG8_LDB(B0, 0, 0); PG8_SCHED; PG8_LDA(At, 0, 0); PG8_STAGE(PG8_SA(1, 1), a1 + hstep, voffA);
            PG8_WAIT_L(8); PG8_BAR; PG8_WAIT_L(0); PG8_MMA(0, 0, At, B0); PG8_BAR; PG8_SCHED;
            PG8_LDB(B1, 0, 1); PG8_STAGE(PG8_SB(0, 0), b2, voffB);
            PG8_BAR; PG8_WAIT_L(0); PG8_MMA(0, 1, At, B1); PG8_BAR;
            PG8_LDA(At, 0, 1); PG8_STAGE(PG8_SA(0, 0), a2, voffA);
            PG8_BAR; PG8_WAIT_L(0); PG8_MMA(1, 0, At, B0); PG8_BAR; PG8_SCHED;
            PG8_STAGE(PG8_SB(0, 1), b2 + hstep, voffB);
            PG8_WAIT_V(6); PG8_BAR; PG8_MMA(1, 1, At, B1); PG8_BAR;
            PG8_LDB(B0, 1, 0); PG8_SCHED; PG8_LDA(At, 1, 0); PG8_STAGE(PG8_SA(0, 1), a2 + hstep, voffA);
            PG8_WAIT_L(8); PG8_BAR; PG8_WAIT_L(0); PG8_MMA(0, 0, At, B0); PG8_BAR; PG8_SCHED;
            PG8_LDB(B1, 1, 1); PG8_STAGE(PG8_SB(1, 0), b3, voffB);
            PG8_BAR; PG8_WAIT_L(0); PG8_MMA(0, 1, At, B1); PG8_BAR;
            PG8_LDA(At, 1, 1); PG8_STAGE(PG8_SA(1, 0), a3, voffA);
            PG8_BAR; PG8_WAIT_L(0); PG8_MMA(1, 0, At, B0); PG8_BAR; PG8_SCHED;
            PG8_STAGE(PG8_SB(1, 1), b3 + hstep, voffB);
            PG8_WAIT_V(6); PG8_BAR; PG8_MMA(1, 1, At, B1); PG8_BAR;
            }
        }
        if constexpr (ALIGN_EPI) { if (wr == 0) PG8_BAR; }
        if constexpr (!Epi::AFTER_DRAIN) { E(acc, cur, wr, wc, fr, fq); S.done(cur); }
        if (!has_next) break;
#pragma unroll
        for (int a = 0; a < 2; ++a)
#pragma unroll
            for (int b = 0; b < 2; ++b)
#pragma unroll
                for (int m = 0; m < 4; ++m)
#pragma unroll
                    for (int n = 0; n < 2; ++n) acc[a][b][m][n] = (f32x4){0.f, 0.f, 0.f, 0.f};
        cur = nxt; cA = nA; cB = nB; ++ui;
        if constexpr (ALIGN_EPI) { if (wr == 1) PG8_BAR; }
    }
    PG8_WAIT_V(0);
    if constexpr (!ALIGN_EPI) { if (wr == 0) PG8_BAR; }
    PG8_BAR;
    if constexpr (Epi::AFTER_DRAIN) { E.fused(acc, cur, wr, wc, fr, fq, lds, wid, lane); S.done(cur); }
#undef PG8_SA
#undef PG8_SB
#undef PG8_STAGE
#undef PG8_LDA
#undef PG8_LDB
#undef PG8_MMA
#undef PG8_WAIT_V
#undef PG8_WAIT_L
#undef PG8_BAR
#undef PG8_SCHED
}
}
#define LAS __attribute__((address_space(3)))
using pg8::f32x4;
using pg8::u32x4;
constexpr int T_CTX = 8192, T_LAT = 16384, T_ALL = 24576, DM = 1024;
constexpr int NPROJ = 4608, NPROJ_PAD = 4608, NIN = 4624, DFF = 2816, NGU = 5632;
constexpr int NTHR = 512, NWV = 8;
constexpr float EPS = 1e-6f;
constexpr int LDS_BYTES = 132096;

constexpr size_t OUT_HG = 25165824, OUT_MC = 41943040, OUT_MN = 58720256, OUT_MM = 58851328, OUT_TOTAL = 58852352;

constexpr size_t al256(size_t x) { return (x + 255) & ~(size_t)255; }
constexpr size_t WS_WIN = 0;
constexpr size_t WS_WOUT = WS_WIN + al256((size_t)NPROJ_PAD * DM * 2);
constexpr size_t WS_WGU = WS_WOUT + al256((size_t)DM * DM * 2);
constexpr size_t WS_WDN = WS_WGU + al256((size_t)NGU * DM * 2);
constexpr size_t WS_MODP = WS_WDN + al256((size_t)DM * DFF * 2);
constexpr size_t WS_MOD = WS_MODP + al256((size_t)8 * 4 * 9 * 6144 * 4);
constexpr size_t WS_LB = WS_MOD + al256((size_t)4 * 9 * 6144 * 4);
constexpr size_t WS_HN = WS_LB + al256((size_t)4 * 2 * 512 * 4);
constexpr size_t WS_PROJ = WS_HN + al256((size_t)T_ALL * DM * 2);
constexpr size_t WS_GATES = WS_PROJ + al256((size_t)T_ALL * NPROJ * 2);
constexpr size_t WS_QKM = WS_GATES + al256((size_t)T_ALL * 16 * 4);
constexpr size_t WS_OB = WS_QKM + al256((size_t)T_ALL * DM * 2);
constexpr size_t WS_BAR = WS_OB + al256((size_t)T_ALL * DM * 2);
constexpr size_t WS_WG16 = WS_BAR + 16384;
constexpr size_t WS_END = WS_WG16 + 32768;

#if defined(SWAP_OBUF)
#define ODIR(d) (!(d))
#else
#define ODIR(d) (d)
#endif
struct Params {
    const float *x_prompt, *x_sample, *st_hg, *st_mc, *st_mn, *st_mm, *cnd, *c_ctx, *n1w, *n2w, *w_mod, *b_mod, *w_in, *conv_w, *conv_b, *gate_b,
        *lb_logits, *hg_nw, *ml_nw, *w_out, *w_gate, *w_up, *w_down, *fin_w;
    float* out; unsigned char* ws;
};

__device__ __forceinline__ float sigmoidf_(float x) { return 1.f / (1.f + __expf(-x)); }
__device__ __forceinline__ float siluf_(float x) { return x / (1.f + __expf(-x)); }
__device__ __forceinline__ unsigned pkh(float a, float b) { h16x2 v = {(h16)a, (h16)b}; return __builtin_bit_cast(unsigned, v); }
__device__ __forceinline__ float wave_sum(float v) {
#pragma unroll
    for (int o = 1; o < 64; o <<= 1) v += __shfl_xor(v, o);
    return v;
}
__device__ __forceinline__ int row_cidx(int row) { return row < T_CTX ? 0 : 1 + ((row - T_CTX) >> 11); }
__device__ __forceinline__ int ltid() { int t = threadIdx.x; asm volatile("" : "+v"(t)); return t; }
__device__ __forceinline__ float rdlane(float v, int l) { return __builtin_bit_cast(float, __builtin_amdgcn_readlane(__builtin_bit_cast(int, v), l)); }

struct EpiInProj {
    static constexpr bool PERM = true, AFTER_DRAIN = false;
    h16* proj; float* gates; const float* gate_b;
    __device__ __forceinline__ void operator()(const f32x4 (&acc)[2][2][4][2], const pg8::Unit& u, int wr, int wc, int fr, int fq) const {
        const int row0 = u.pm * 256 + wr * 64 + fr;
#pragma unroll
        for (int bj = 0; bj < 2; ++bj) {
            const int colt = u.pn * 256 + bj * 128, reg = colt >> 9;
            const int act = (reg == 0 || reg == 4) ? 1 : (reg == 8 ? 2 : 0);
            const int col0 = colt + wc * 32 + 8 * fq;
#pragma unroll
            for (int ai = 0; ai < 2; ++ai)
#pragma unroll
                for (int m = 0; m < 4; ++m) {
                    f32x4 v0 = acc[ai][bj][m][0], v1 = acc[ai][bj][m][1];
                    if (act == 1) {
#pragma unroll
                        for (int j = 0; j < 4; ++j) { v0[j] = siluf_(v0[j]); v1[j] = siluf_(v1[j]); }
                    } else if (act == 2) {
#pragma unroll
                        for (int j = 0; j < 4; ++j) { v0[j] = sigmoidf_(v0[j]); v1[j] = sigmoidf_(v1[j]); }
                    }
                    u32x4 w; w.x = pkh(v0[0], v0[1]); w.y = pkh(v0[2], v0[3]); w.z = pkh(v1[0], v1[1]); w.w = pkh(v1[2], v1[3]);
                    *(u32x4*)(proj + (size_t)(row0 + ai * 128 + m * 16) * NPROJ + col0) = w;
                }
        }
    }
};
struct EpiResid {
    static constexpr bool PERM = false, AFTER_DRAIN = false;
    const float* base_ctx; const float* base_lat; float* out; const float* gate;
    __device__ __forceinline__ void operator()(const f32x4 (&acc)[2][2][4][2], const pg8::Unit& u, int wr, int wc, int fr, int fq) const {
        const int cidx = u.pm < 32 ? 0 : 1 + ((u.pm - 32) >> 3);
        const float* gt = gate + cidx * 6144;
        const float* bs = u.pm < 32 ? base_ctx : base_lat - (size_t)T_CTX * DM;
        const int colb = u.pn * 256 + wc * 32 + 4 * fq;
        f32x4 g[2][2];
#pragma unroll
        for (int bj = 0; bj < 2; ++bj)
#pragma unroll
            for (int n = 0; n < 2; ++n) g[bj][n] = *(const f32x4*)(gt + colb + bj * 128 + n * 16);
#pragma unroll
        for (int ai = 0; ai < 2; ++ai)
#pragma unroll
            for (int m = 0; m < 4; ++m) {
                const size_t off = (size_t)(u.pm * 256 + ai * 128 + wr * 64 + m * 16 + fr) * DM + colb;
                f32x4 x[2][2];
#pragma unroll
                for (int bj = 0; bj < 2; ++bj)
#pragma unroll
                    for (int n = 0; n < 2; ++n) x[bj][n] = *(const f32x4*)(bs + off + bj * 128 + n * 16);
#pragma unroll
                for (int bj = 0; bj < 2; ++bj)
#pragma unroll
                    for (int n = 0; n < 2; ++n) *(f32x4*)(out + off + bj * 128 + n * 16) = x[bj][n] + g[bj][n] * acc[ai][bj][m][n];
                asm volatile("" ::: "memory");
            }
    }
};
struct EpiGateUp {
    static constexpr bool PERM = true, AFTER_DRAIN = false;
    h16* ff;
    __device__ __forceinline__ void operator()(const f32x4 (&acc)[2][2][4][2], const pg8::Unit& u, int wr, int wc, int fr, int fq) const {
        const int row0 = u.pm * 256 + wr * 64 + fr, col0 = u.pn * 128 + wc * 32 + 8 * fq;
#pragma unroll
        for (int ai = 0; ai < 2; ++ai)
#pragma unroll
            for (int m = 0; m < 4; ++m) {
                f32x4 v0, v1;
#pragma unroll
                for (int j = 0; j < 4; ++j) { v0[j] = siluf_(acc[ai][0][m][0][j]) * acc[ai][1][m][0][j]; v1[j] = siluf_(acc[ai][0][m][1][j]) * acc[ai][1][m][1][j]; }
                u32x4 w; w.x = pkh(v0[0], v0[1]); w.y = pkh(v0[2], v0[3]); w.z = pkh(v1[0], v1[1]); w.w = pkh(v1[2], v1[3]);
                *(u32x4*)(ff + (size_t)(row0 + ai * 128 + m * 16) * DFF + col0) = w;
            }
    }
};

__device__ __forceinline__ void phase_mod_partial(const Params& p, LAS float* ldsf) {
    const int tidx = ltid();
    for (int e = tidx; e < 9 * 1024; e += NTHR) { const int c = e >> 10, k = e & 1023; const float v = c == 0 ? p.c_ctx[k] : p.cnd[(c - 1) * 1024 + k]; ldsf[e] = siluf_(v); }
    __syncthreads();
    float* modp = (float*)(p.ws + WS_MODP);
    const int wave = tidx >> 6, lane = tidx & 63;
    const int gw = blockIdx.x * NWV + wave, NGW = gridDim.x * NWV;
    for (int it = gw; it < 4 * 96 * 8; it += NGW) {
        const int kq = it & 7, cgp = (it >> 3) % 96, l = it / (8 * 96);
        const int j = cgp * 64 + lane;
        const float* w = p.w_mod + ((size_t)l * 1024 + kq * 128) * 6144 + j;
        float acc[9];
#pragma unroll
        for (int c = 0; c < 9; ++c) acc[c] = 0.f;
#pragma unroll 4
        for (int k4 = 0; k4 < 32; ++k4) {
            const float w0 = w[(size_t)(4 * k4 + 0) * 6144], w1 = w[(size_t)(4 * k4 + 1) * 6144], w2 = w[(size_t)(4 * k4 + 2) * 6144], w3 = w[(size_t)(4 * k4 + 3) * 6144];
#pragma unroll
            for (int c = 0; c < 9; ++c) { const f32x4 s = *(const LAS f32x4*)(ldsf + c * 1024 + kq * 128 + 4 * k4); acc[c] += s.x * w0 + s.y * w1 + s.z * w2 + s.w * w3; }
        }
#pragma unroll
        for (int c = 0; c < 9; ++c) modp[(((size_t)kq * 4 + l) * 9 + c) * 6144 + j] = acc[c];
    }
    if (blockIdx.x == 0) {
        float* lb = (float*)(p.ws + WS_LB);
        for (int e = tidx; e < 1024; e += NTHR) {
            const float x0 = p.lb_logits[e], x1 = p.lb_logits[1024 + e], x2 = p.lb_logits[2048 + e], x3 = p.lb_logits[3072 + e];
            const float mx = fmaxf(fmaxf(x0, x1), fmaxf(x2, x3));
            const float e0 = expf(x0 - mx), e1 = expf(x1 - mx), e2 = expf(x2 - mx), e3 = expf(x3 - mx);
            const float inv = 1.f / (e0 + e1 + e2 + e3);
            lb[e] = 0.f; lb[1024 + e] = e1 * inv; lb[2048 + e] = (e1 + e2) * inv; lb[3072 + e] = (e1 + e2 + e3) * inv;
        }
    }
}
__device__ __forceinline__ void phase_mod_reduce(const Params& p) {
    const float* modp = (const float*)(p.ws + WS_MODP); float* mod = (float*)(p.ws + WS_MOD);
    for (int e = blockIdx.x * NTHR + ltid(); e < 4 * 9 * 6144; e += gridDim.x * NTHR) {
        const int j = e % 6144, l = e / (9 * 6144);
        float s = p.b_mod[l * 6144 + j];
#pragma unroll
        for (int kq = 0; kq < 8; ++kq) s += modp[(size_t)kq * (4 * 9 * 6144) + e];
        mod[e] = s;
    }
}

__device__ __forceinline__ void transpose_item(const float* W, int K, int N, h16* WT, int kb, int n0, int dst_row0, LAS float* scr, int lane) {
    const int k0 = 64 * kb, n = n0 + (lane & 31);
#pragma unroll 8
    for (int i = 0; i < 32; ++i) { const int kk = 2 * i + (lane >> 5); scr[kk * 33 + (lane & 31)] = (n < N) ? W[(size_t)(k0 + kk) * N + n] : 0.f; }
    asm volatile("s_waitcnt lgkmcnt(0)" ::: "memory");
    const int c = lane & 7;
#pragma unroll
    for (int j = 0; j < 4; ++j) {
        const int nn = (lane >> 3) + 8 * j; const LAS float* s = scr + (8 * c) * 33 + nn;
        u32x4 o; o.x = pkh(s[0 * 33], s[1 * 33]); o.y = pkh(s[2 * 33], s[3 * 33]); o.z = pkh(s[4 * 33], s[5 * 33]); o.w = pkh(s[6 * 33], s[7 * 33]);
        *(u32x4*)(WT + (size_t)(dst_row0 + nn) * K + k0 + 8 * c) = o;
    }
    asm volatile("s_waitcnt lgkmcnt(0)" ::: "memory");
}
__device__ __forceinline__ void convert_weights(const Params& p, int l, LAS float* scr, int gw, int NGW, int lane) {
    {
        h16* wg = (h16*)(p.ws + WS_WG16);
        const float* src = p.w_in + (size_t)l * DM * NIN + NPROJ;
        for (int e = gw * 64 + lane; e < 16 * 1024; e += NGW * 64) { const int k = e >> 4, g = e & 15; wg[g * 1024 + k] = (h16)src[(size_t)k * NIN + g]; }
    }
    h16* win = (h16*)(p.ws + WS_WIN); h16* wout = (h16*)(p.ws + WS_WOUT); h16* wgu = (h16*)(p.ws + WS_WGU); h16* wdn = (h16*)(p.ws + WS_WDN);
    constexpr int I_IN = 16 * 144, I_OUT = 16 * 32, I_G = 16 * 88, I_DN = 44 * 32;
    for (int it = gw; it < I_IN + I_OUT + 2 * I_G + I_DN; it += NGW) {
        int r = it;
        if (r < I_IN) { const int kb = r / 144, nb = r % 144; transpose_item(p.w_in + (size_t)l * DM * NIN, DM, NIN, win, kb, 32 * nb, 32 * nb, scr, lane); continue; } r -= I_IN;
        if (r < I_OUT) { const int kb = r / 32, nb = r % 32; transpose_item(p.w_out + (size_t)l * DM * DM, DM, DM, wout, kb, 32 * nb, 32 * nb, scr, lane); continue; } r -= I_OUT;
        if (r < I_G) { const int kb = r / 88, nb = r % 88, n0 = 32 * nb; transpose_item(p.w_gate + (size_t)l * DM * DFF, DM, DFF, wgu, kb, n0, (n0 >> 7) * 256 + (n0 & 127), scr, lane); continue; } r -= I_G;
        if (r < I_G) { const int kb = r / 88, nb = r % 88, n0 = 32 * nb; transpose_item(p.w_up + (size_t)l * DM * DFF, DM, DFF, wgu, kb, n0, (n0 >> 7) * 256 + 128 + (n0 & 127), scr, lane); continue; } r -= I_G;
        { const int kb = r / 32, nb = r % 32; transpose_item(p.w_down + (size_t)l * DFF * DM, DFF, DM, wdn, kb, 32 * nb, 32 * nb, scr, lane); }
    }
}
__device__ __forceinline__ void norm_mod_row(const float* xrow, const float* nw, const float* sc, const float* sh, h16* orow, int lane) {
    const f32x4* xr = (const f32x4*)xrow + lane;
    f32x4 v[4]; float s = 0.f;
#pragma unroll
    for (int j = 0; j < 4; ++j) { v[j] = xr[64 * j]; s += (v[j].x * v[j].x + v[j].y * v[j].y) + (v[j].z * v[j].z + v[j].w * v[j].w); }
    const float rstd = rsqrtf(wave_sum(s) * (1.f / DM) + EPS);
#pragma unroll
    for (int j = 0; j < 4; ++j) {
        const int col = 4 * lane + 256 * j;
        const f32x4 w4 = *(const f32x4*)(nw + col), s4 = *(const f32x4*)(sc + col), h4 = *(const f32x4*)(sh + col);
        const f32x4 y = v[j] * rstd * w4 * (1.f + s4) + h4;
        uint2 o; o.x = pkh(y.x, y.y); o.y = pkh(y.z, y.w);
        *(uint2*)(orow + col) = o;
    }
}
__device__ __forceinline__ void phase_norm(const Params& p, int l, int which, bool from_inputs, int gw, int NGW, int lane) {
    const float* mod = (const float*)(p.ws + WS_MOD) + (size_t)l * 9 * 6144;
    const float* nw = (which == 0 ? p.n1w : p.n2w) + l * DM;
    h16* hn = (h16*)(p.ws + WS_HN);
    for (int r = gw; r < T_ALL; r += NGW) {
        const float* xrow = from_inputs ? (r < T_CTX ? p.x_prompt + (size_t)r * DM : p.x_sample + (size_t)(r - T_CTX) * DM) : p.out + (size_t)r * DM;
        const float* m = mod + row_cidx(r) * 6144 + which * 3072;
        norm_mod_row(xrow, nw, m + 1024, m, hn + (size_t)r * DM, lane);
    }
}
__device__ __forceinline__ void phase_final_norm(const Params& p, int gw, int NGW, int lane) {
    for (int r = gw; r < T_ALL; r += NGW) {
        f32x4* xr = (f32x4*)(p.out + (size_t)r * DM) + lane;
        f32x4 v[4]; float s = 0.f;
#pragma unroll
        for (int j = 0; j < 4; ++j) { v[j] = xr[64 * j]; s += (v[j].x * v[j].x + v[j].y * v[j].y) + (v[j].z * v[j].z + v[j].w * v[j].w); }
        const float rstd = rsqrtf(wave_sum(s) * (1.f / DM) + EPS);
#pragma unroll
        for (int j = 0; j < 4; ++j) { const f32x4 w4 = *(const f32x4*)(p.fin_w + 4 * lane + 256 * j); xr[64 * j] = v[j] * rstd * w4; }
    }
}
__device__ __forceinline__ void phase_gates(const Params& p, int l, int gw, int NGW, int lane) {
    const h16* hn = (const h16*)(p.ws + WS_HN); const h16* wg = (const h16*)(p.ws + WS_WG16);
    float* gates = (float*)(p.ws + WS_GATES);
    const int c = lane & 15, q = lane >> 4;
    for (int grp = gw; grp < T_ALL / 16; grp += NGW) {
        const h16* ar = hn + (size_t)(16 * grp + c) * DM + 8 * q;
        const h16* br = wg + (size_t)c * DM + 8 * q;
        f32x4 acc = {0.f, 0.f, 0.f, 0.f};
#pragma unroll 8
        for (int kp = 0; kp < 32; ++kp) {
            const h16x8 a = *(const h16x8*)(ar + 32 * kp), bq = *(const h16x8*)(br + 32 * kp);
            acc = __builtin_amdgcn_mfma_f32_16x16x32_f16(a, bq, acc, 0, 0, 0);
        }
        const float bias = p.gate_b[l * 16 + c];
#pragma unroll
        for (int j = 0; j < 4; ++j) gates[(size_t)(16 * grp + 4 * q + j) * 16 + c] = acc[j] + bias;
    }
}
__device__ __forceinline__ void phase_conv(const Params& p, int l) {
    const h16* proj = (const h16*)(p.ws + WS_PROJ); h16* qkm = (h16*)(p.ws + WS_QKM);
    const float* cw = p.conv_w + (size_t)l * 9 * 1024; const float* cb = p.conv_b + l * 1024;
    for (int idx = blockIdx.x * NTHR + ltid(); idx < T_ALL * 128; idx += gridDim.x * NTHR) {
        const int r = idx >> 7, ch0 = (idx & 127) * 8;
        float acc[8];
        { const f32x4 b0 = *(const f32x4*)(cb + ch0), b1 = *(const f32x4*)(cb + ch0 + 4); acc[0] = b0.x; acc[1] = b0.y; acc[2] = b0.z; acc[3] = b0.w; acc[4] = b1.x; acc[5] = b1.y; acc[6] = b1.z; acc[7] = b1.w; }
        const h16* src = proj + 2560 + ch0;
        const bool lat = r >= T_CTX;
        const int pp = lat ? ((r - T_CTX) & 2047) : (r & 255);
        const int gy = lat ? (pp >> 6) : 0, gx = lat ? (pp & 63) : pp;
        const int H = lat ? 32 : 1, W = lat ? 64 : 256;
#pragma unroll
        for (int a = 0; a < 3; ++a) {
            const int yy = gy + a - 1;
            if (!lat && a != 1) continue;
            if (yy < 0 || yy >= H) continue;
#pragma unroll
            for (int b = 0; b < 3; ++b) {
                const int xx = gx + b - 1;
                if (xx < 0 || xx >= W) continue;
                const int rr = r + (a - 1) * 64 + (b - 1);
                const h16x8 x = *(const h16x8*)(src + (size_t)rr * NPROJ);
                const f32x4 t0 = *(const f32x4*)(cw + (a * 3 + b) * 1024 + ch0), t1 = *(const f32x4*)(cw + (a * 3 + b) * 1024 + ch0 + 4);
                acc[0] += t0.x * (float)x[0]; acc[1] += t0.y * (float)x[1]; acc[2] += t0.z * (float)x[2]; acc[3] += t0.w * (float)x[3];
                acc[4] += t1.x * (float)x[4]; acc[5] += t1.y * (float)x[5]; acc[6] += t1.z * (float)x[6]; acc[7] += t1.w * (float)x[7];
            }
        }
        const float sc = ch0 >= 512 ? 0.08838834764831845f : 1.f;
        u32x4 w; w.x = pkh(siluf_(acc[0]) * sc, siluf_(acc[1]) * sc); w.y = pkh(siluf_(acc[2]) * sc, siluf_(acc[3]) * sc);
        w.z = pkh(siluf_(acc[4]) * sc, siluf_(acc[5]) * sc); w.w = pkh(siluf_(acc[6]) * sc, siluf_(acc[7]) * sc);
        *(u32x4*)(qkm + (size_t)r * DM + ch0) = w;
    }
}

template <int TYPE  , int CMP = 0>
__device__ __forceinline__ void scan_item(const Params& p, int l, int lat, int b, int h, int dir, LAS float* lds) {
    const int tid = ltid(), lane = tid & 63, w = __builtin_amdgcn_readfirstlane(tid >> 6);
    const int L = lat ? 2048 : 256, row0 = lat ? T_CTX + b * 2048 : b * 256, NB = L / 16;
    LAS float* qs = lds;
    LAS float* fs = lds + 2048;
    LAS float* vs = lds + 4096;
    LAS float* part = lds + 6144;
    LAS float* partn = lds + 6144 + 16384;
    LAS float* scal = partn + 128;
    LAS float* mst = scal + 128;
    LAS float* cerr = mst + 16;
    LAS float* cref = cerr + 32;
    const h16* proj = (const h16*)(p.ws + WS_PROJ); const h16* qkm = (const h16*)(p.ws + WS_QKM); const float* gates = (const float*)(p.ws + WS_GATES);
    h16* odst = (h16*)(p.ws + (ODIR(dir) ? WS_OB : WS_HN));
    const size_t sidx = (((size_t)b * 4 + l) * 2 + dir) * 4 + h;
    if (CMP) { if (tid < 64) cerr[tid] = 0.f; __syncthreads(); }

    f32x2 S[16]; float nv = 0.f;
    if (lat) {
        const float* src = (TYPE == 0 ? p.st_hg : p.st_mc) + sidx * 16384;
#pragma unroll
        for (int dd = 0; dd < 16; ++dd) S[dd] = *(const f32x2*)(src + (16 * w + dd) * 128 + 2 * lane);
        if (TYPE == 1) { nv = lane < 16 ? p.st_mn[sidx * 128 + 16 * w + lane] : 0.f; if (tid == 0) mst[0] = p.st_mm[sidx]; }
    } else {
#pragma unroll
        for (int dd = 0; dd < 16; ++dd) S[dd] = (f32x2){0.f, 0.f};
        if (TYPE == 1 && tid == 0) mst[0] = 0.f;
    }
    const int tl = tid >> 5, d0 = 4 * (tid & 31);
    f32x4 lb4 = {0.f, 0.f, 0.f, 0.f};
    if (TYPE == 0) lb4 = *(const f32x4*)((const float*)(p.ws + WS_LB) + (l * 2 + dir) * 512 + h * 128 + d0);
    h16x4 pq, pz, pv; float pgi = 0.f, pgf = 0.f;
#define SCAN_LOAD(ii) do { const int pos_ = 16 * (ii) + tl, tok_ = dir ? L - 1 - pos_ : pos_; const size_t r_ = (size_t)(row0 + tok_); \
        if (TYPE == 0) { pq = *(const h16x4*)(proj + r_ * NPROJ + h * 128 + d0); pz = *(const h16x4*)(proj + r_ * NPROJ + 512 + dir * 512 + h * 128 + d0); pv = *(const h16x4*)(proj + r_ * NPROJ + 1536 + h * 128 + d0); } \
        else { pq = *(const h16x4*)(qkm + r_ * DM + h * 128 + d0); pz = *(const h16x4*)(qkm + r_ * DM + 512 + h * 128 + d0); pv = *(const h16x4*)(proj + r_ * NPROJ + 3584 + h * 128 + d0); \
               if (w == 0) { const int ps_ = 16 * (ii) + (lane & 15), tk_ = dir ? L - 1 - ps_ : ps_; const float* g_ = gates + (size_t)(row0 + tk_) * 16; pgi = g_[dir * 4 + h]; pgf = g_[8 + dir * 4 + h]; } } } while (0)
    SCAN_LOAD(0);
    for (int i = 0; i < NB; ++i) {
        const int par = i & 1;
        const int pos = 16 * i + tl, tok = dir ? L - 1 - pos : pos;
        const size_t r = (size_t)(row0 + tok);
        {
            *(LAS f32x4*)(qs + tl * 128 + d0) = (f32x4){(float)pq[0], (float)pq[1], (float)pq[2], (float)pq[3]};
            *(LAS f32x4*)(vs + tl * 128 + d0) = (f32x4){(float)pv[0], (float)pv[1], (float)pv[2], (float)pv[3]};
            if (TYPE == 0) {
                f32x4 f4;
#pragma unroll
                for (int j = 0; j < 4; ++j) f4[j] = lb4[j] + (1.f - lb4[j]) * sigmoidf_((float)pz[j]);
                *(LAS f32x4*)(fs + tl * 128 + d0) = f4;
            } else {
                *(LAS f32x4*)(fs + tl * 128 + d0) = (f32x4){(float)pz[0], (float)pz[1], (float)pz[2], (float)pz[3]};
                if (w == 0) {
                    const int t = lane & 15;
                    const float m0 = mst[0];
                    const float gi = pgi, lf = fminf(pgf, 0.f) - log1pf(__expf(-fabsf(pgf)));
                    float bc = lf;
#pragma unroll
                    for (int o = 1; o < 16; o <<= 1) { const float x = __shfl_up(bc, o, 16); if (t >= o) bc += x; }
                    float pm = gi - bc;
#pragma unroll
                    for (int o = 1; o < 16; o <<= 1) { const float x = __shfl_up(pm, o, 16); if (t >= o) pm = fmaxf(pm, x); }
                    const float mt = bc + fmaxf(m0, pm);
                    float mp = __shfl_up(mt, 1, 16); if (t == 0) mp = m0;
                    if (lane < 16) {
                        scal[(par * 16 + t) * 4 + 0] = __expf(lf + mp - mt);
                        scal[(par * 16 + t) * 4 + 1] = __expf(gi - mt);
                        scal[(par * 16 + t) * 4 + 2] = __expf(-mt);
                    }
                    asm volatile("s_waitcnt lgkmcnt(0)" ::: "memory");
                    if (lane == 15) mst[0] = mt;
                }
            }
        }
        if (i + 1 < NB) SCAN_LOAD(i + 1);
        __syncthreads();
#pragma unroll 2
        for (int t = 0; t < 16; ++t) {
            float fv = 0.f, qv = 0.f;
            if (lane < 16) { fv = fs[t * 128 + 16 * w + lane]; qv = qs[t * 128 + 16 * w + lane]; }
            const f32x2 v2 = *(const LAS f32x2*)(vs + t * 128 + 2 * lane);
            f32x2 o = {0.f, 0.f};
            if (TYPE == 0) {
#pragma unroll
                for (int dd = 0; dd < 16; ++dd) { const float sf = rdlane(fv, dd), sq = rdlane(qv, dd); S[dd] = v2 + sf * (S[dd] - v2); o += S[dd] * sq; }
            } else {
                const float a = __builtin_bit_cast(float, __builtin_amdgcn_readfirstlane(__builtin_bit_cast(int, scal[(par * 16 + t) * 4 + 0])));
                const float g = __builtin_bit_cast(float, __builtin_amdgcn_readfirstlane(__builtin_bit_cast(int, scal[(par * 16 + t) * 4 + 1])));
                const float gk = g * fv;
                nv = a * nv + gk;
                float nq = nv * qv;
                nq += __shfl_xor(nq, 8); nq += __shfl_xor(nq, 4); nq += __shfl_xor(nq, 2); nq += __shfl_xor(nq, 1);
                if (lane == 0) partn[t * 8 + w] = nq;
#pragma unroll
                for (int dd = 0; dd < 16; ++dd) { const float sk = rdlane(gk, dd), sq = rdlane(qv, dd); S[dd] = a * S[dd] + sk * v2; o += S[dd] * sq; }
            }
            *(LAS f32x2*)(part + (t * 8 + w) * 128 + 2 * lane) = o;
        }
        __syncthreads();
        {
            f32x4 acc = {0.f, 0.f, 0.f, 0.f};
#pragma unroll
            for (int ww = 0; ww < 8; ++ww) acc += *(const LAS f32x4*)(part + (tl * 8 + ww) * 128 + d0);
            if (TYPE == 1) {
                float den = 0.f;
#pragma unroll
                for (int ww = 0; ww < 8; ++ww) den += partn[tl * 8 + ww];
                const float sc = 1.f / fmaxf(fabsf(den), scal[(par * 16 + tl) * 4 + 2]);
                acc = acc * sc;
            }
            uint2 o; o.x = pkh(acc.x, acc.y); o.y = pkh(acc.z, acc.w);
            if (CMP) {
                const h16x4 old = *(const h16x4*)(odst + r * DM + TYPE * 512 + h * 128 + d0);
                float e = 0.f, rr = 0.f;
#pragma unroll
                for (int j = 0; j < 4; ++j) { const float df = (float)old[j] - acc[j]; e += df * df; rr += acc[j] * acc[j]; }
                e = wave_sum(e); rr = wave_sum(rr);
                if (lane == 0) { atomicAdd((float*)(cerr + (i >> 2)), e); atomicAdd((float*)(cref + (i >> 2)), rr); }
            }
            *(uint2*)(odst + r * DM + TYPE * 512 + h * 128 + d0) = o;
        }
    }
    if (CMP) {
        __syncthreads();
        if (tid == 0) {
            float best = -1.f; int bc_ = 0; float tot_e = 0.f, tot_r = 0.f;
            for (int cI = 0; cI < 32; ++cI) { const float rt = cerr[cI] / fmaxf(cref[cI], 1e-30f); tot_e += cerr[cI]; tot_r += cref[cI]; if (rt > best) { best = rt; bc_ = cI; } }
            float* dg = (float*)(p.ws + WS_MODP) + 4 * blockIdx.x;
#if defined(DIAG_ALL)
            const float tot = tot_e / fmaxf(tot_r, 1e-30f);
            if (tot > dg[0]) { dg[0] = tot; dg[1] = (float)(l * 8 + TYPE * 4 + lat * 2 + dir); dg[2] = best; dg[3] = (float)bc_; }
#else
            dg[0] = best; dg[1] = (float)bc_; dg[2] = tot_e / fmaxf(tot_r, 1e-30f); dg[3] = 0.f;
#endif
        }
    }
    if (!lat) {
        float* dst = p.out + (TYPE == 0 ? OUT_HG : OUT_MC) + sidx * 16384;
#pragma unroll
        for (int dd = 0; dd < 16; ++dd) *(f32x2*)(dst + (16 * w + dd) * 128 + 2 * lane) = S[dd];
        if (TYPE == 1) { if (lane < 16) p.out[OUT_MN + sidx * 128 + 16 * w + lane] = nv; if (tid == 0) p.out[OUT_MM + sidx] = mst[0]; }
    }
    __syncthreads();
#undef SCAN_LOAD
}
typedef unsigned u32x2 __attribute__((ext_vector_type(2)));
typedef short s16x8 __attribute__((ext_vector_type(8)));
typedef short s16x4 __attribute__((ext_vector_type(4)));
typedef __bf16 bf16x2_t __attribute__((ext_vector_type(2)));
__device__ __forceinline__ unsigned pkb(float a, float b) { f32x2 v = {a, b}; bf16x2_t r = __builtin_convertvector(v, bf16x2_t); return __builtin_bit_cast(unsigned, r); }
__device__ __forceinline__ unsigned short f2b(float a) { return (unsigned short)(pkb(a, 0.f) & 0xffffu); }
__device__ __forceinline__ s16x4 tr_read(LAS const unsigned char* ptr) { return __builtin_bit_cast(s16x4, __builtin_amdgcn_ds_read_tr16_b64_v4i16((LAS s16x4*)ptr)); }
constexpr int HP = 272;
__device__ __forceinline__ void scan_hgrn_mfma(const Params& p, int l, int lat, int b, int h, int dir, LAS unsigned char* lds) {
    const int tid = ltid(), lane = tid & 63, w = __builtin_amdgcn_readfirstlane(tid >> 6), c = lane & 15, q = lane >> 4;
    const int L = lat ? 2048 : 256, row0 = lat ? T_CTX + b * 2048 : b * 256, NB = L / 16;
    constexpr int IMG = 16 * HP, BUF = 4 * IMG + 512;
    LAS float* GS = (LAS float*)(lds + 2 * BUF);
    const h16* proj = (const h16*)(p.ws + WS_PROJ);
    h16* odst = (h16*)(p.ws + (ODIR(dir) ? WS_OB : WS_HN));
    const size_t sidx = (((size_t)b * 4 + l) * 2 + dir) * 4 + h;
    f32x4 S[8];
    if (lat) {
        const float* src = p.st_hg + sidx * 16384;
#pragma unroll
        for (int dt = 0; dt < 8; ++dt)
#pragma unroll
            for (int j = 0; j < 4; ++j) S[dt][j] = src[(16 * dt + 4 * q + j) * 128 + 16 * w + c];
    } else {
#pragma unroll
        for (int dt = 0; dt < 8; ++dt) S[dt] = (f32x4){0.f, 0.f, 0.f, 0.f};
    }
    const int pt = lane & 15, d0 = 16 * w + 4 * (lane >> 4);
    const f32x4 lb4 = *(const f32x4*)((const float*)(p.ws + WS_LB) + (l * 2 + dir) * 512 + h * 128 + d0);
    h16x4 rq, rz, rv;
#define HG_LOAD(ii) do { const int pos_ = 16 * (ii) + pt, tok_ = dir ? L - 1 - pos_ : pos_; const h16* r_ = proj + (size_t)(row0 + tok_) * NPROJ + h * 128 + d0; \
        rq = *(const h16x4*)(r_); rz = *(const h16x4*)(r_ + 512 + dir * 512); rv = *(const h16x4*)(r_ + 1536); } while (0)
#define HG_ROW_SHR(x, ctl) __builtin_bit_cast(float, __builtin_amdgcn_update_dpp(0, __builtin_bit_cast(int, (x)), (ctl), 0xF, 0xF, false))
    HG_LOAD(0);
    for (int i = 0; i < NB; ++i) {
        LAS unsigned char* buf = lds + (i & 1) * BUF;
        LAS unsigned char* QT = buf; LAS unsigned char* KT = buf + IMG; LAS unsigned char* KH = buf + 2 * IMG; LAS unsigned char* VV = buf + 3 * IMG; LAS float* AD = (LAS float*)(buf + 4 * IMG);
        asm volatile("s_waitcnt vmcnt(0)" ::: "memory");
        {
            float kk[4], G[4], tot[4];
#pragma unroll
            for (int j = 0; j < 4; ++j) { const float f = lb4[j] + (1.f - lb4[j]) * sigmoidf_((float)rz[j]); kk[j] = 1.f - f; G[j] = __logf(f); }
#pragma unroll
            for (int j = 0; j < 4; ++j) {
                G[j] += HG_ROW_SHR(G[j], 0x111); G[j] += HG_ROW_SHR(G[j], 0x112); G[j] += HG_ROW_SHR(G[j], 0x114); G[j] += HG_ROW_SHR(G[j], 0x118);
                tot[j] = __shfl(G[j], 15, 16);
            }
            float oq[4], ok[4], oh[4];
#pragma unroll
            for (int j = 0; j < 4; ++j) { const float e = __expf(G[j]), ei = __expf(fminf(-G[j], 60.f)), eh = __expf(tot[j] - G[j]); oq[j] = (float)rq[j] * e; ok[j] = kk[j] * ei; oh[j] = kk[j] * eh; }
            u32x2 wq, wk, wh, wv;
            wq.x = pkb(oq[0], oq[1]); wq.y = pkb(oq[2], oq[3]); wk.x = pkb(ok[0], ok[1]); wk.y = pkb(ok[2], ok[3]);
            wh.x = pkb(oh[0], oh[1]); wh.y = pkb(oh[2], oh[3]); wv.x = pkb((float)rv[0], (float)rv[1]); wv.y = pkb((float)rv[2], (float)rv[3]);
            *(LAS u32x2*)(QT + pt * HP + 2 * d0) = wq; *(LAS u32x2*)(KT + pt * HP + 2 * d0) = wk; *(LAS u32x2*)(KH + pt * HP + 2 * d0) = wh; *(LAS u32x2*)(VV + pt * HP + 2 * d0) = wv;
            if (pt == 15) *(LAS f32x4*)(AD + d0) = (f32x4){__expf(tot[0]), __expf(tot[1]), __expf(tot[2]), __expf(tot[3])};
        }
        { const int nx = (i + 1 < NB) ? i + 1 : NB - 1; HG_LOAD(nx); }
        __syncthreads();
        {
            f32x4 accO = {0.f, 0.f, 0.f, 0.f};
#pragma unroll
            for (int kp = 0; kp < 4; ++kp) {
                u32x4 sa; sa.x = pkb(S[2 * kp][0], S[2 * kp][1]); sa.y = pkb(S[2 * kp][2], S[2 * kp][3]); sa.z = pkb(S[2 * kp + 1][0], S[2 * kp + 1][1]); sa.w = pkb(S[2 * kp + 1][2], S[2 * kp + 1][3]);
                const u32x2 b0 = *(const LAS u32x2*)(QT + c * HP + 2 * (32 * kp + 4 * q)), b1 = *(const LAS u32x2*)(QT + c * HP + 2 * (32 * kp + 16 + 4 * q));
                u32x4 bb; bb.x = b0.x; bb.y = b0.y; bb.z = b1.x; bb.w = b1.y;
                accO = __builtin_amdgcn_mfma_f32_16x16x32_bf16(__builtin_bit_cast(s16x8, sa), __builtin_bit_cast(s16x8, bb), accO, 0, 0, 0);
            }
            f32x4 accP = {0.f, 0.f, 0.f, 0.f};
#pragma unroll
            for (int kp = 0; kp < 4; ++kp) {
                const s16x8 a = *(const LAS s16x8*)(KT + c * HP + 2 * (32 * kp + 8 * q));
                const s16x8 bq = *(const LAS s16x8*)(QT + c * HP + 2 * (32 * kp + 8 * q));
                accP = __builtin_amdgcn_mfma_f32_16x16x32_bf16(a, bq, accP, 0, 0, 0);
            }
#pragma unroll
            for (int j = 0; j < 4; ++j) accP[j] = (4 * q + j > c) ? 0.f : accP[j];
            u32x2 pb; pb.x = pkb(accP[0], accP[1]); pb.y = pkb(accP[2], accP[3]);
            const s16x4 vtr = tr_read(VV + (4 * q + (c >> 2)) * HP + 2 * (16 * w + 4 * (c & 3)));
            accO = __builtin_amdgcn_mfma_f32_16x16x16bf16_1k(vtr, __builtin_bit_cast(s16x4, pb), accO, 0, 0, 0);
            {
                const int pos = 16 * i + c, tok = dir ? L - 1 - pos : pos;
                uint2 o; o.x = pkh(accO[0], accO[1]); o.y = pkh(accO[2], accO[3]);
                *(uint2*)(odst + (size_t)(row0 + tok) * DM + h * 128 + 16 * w + 4 * q) = o;
            }
#pragma unroll
            for (int dt = 0; dt < 8; ++dt) {
                const s16x4 ktr = tr_read(KH + (4 * q + (c >> 2)) * HP + 2 * (16 * dt + 4 * (c & 3)));
                const f32x4 ad = *(const LAS f32x4*)(AD + 16 * dt + 4 * q);
                S[dt] = S[dt] * ad;
                S[dt] = __builtin_amdgcn_mfma_f32_16x16x16bf16_1k(ktr, vtr, S[dt], 0, 0, 0);
            }
        }
#if defined(HG_EXTRA_SYNC)
        asm volatile("s_waitcnt vmcnt(0) lgkmcnt(0)" ::: "memory");
        __syncthreads();
#endif
    }
    if (!lat) {
        float* dst = p.out + OUT_HG + sidx * 16384;
#pragma unroll
        for (int dt = 0; dt < 8; ++dt)
#pragma unroll
            for (int j = 0; j < 4; ++j) dst[(16 * dt + 4 * q + j) * 128 + 16 * w + c] = S[dt][j];
    }
    __syncthreads();
#undef HG_LOAD
#undef HG_ROW_SHR
}
constexpr int MP = 272;
constexpr int PP = 144;
__device__ __forceinline__ void scan_mlstm_mfma(const Params& p, int l, int lat, int b, int h, int dir, LAS unsigned char* lds) {
    const int tid = ltid(), lane = tid & 63, w = __builtin_amdgcn_readfirstlane(tid >> 6), c = lane & 15, q = lane >> 4;
    const int L = lat ? 2048 : 256, row0 = lat ? T_CTX + b * 2048 : b * 256, NC = L / 64;
    constexpr int IMG = 64 * MP, BUF = 3 * IMG + 1536;
    LAS unsigned char* PM = lds + 2 * BUF;
    LAS float* DENP = (LAS float*)(PM + 64 * PP);
    LAS float* QNP = DENP + 256;
    LAS float* NP = QNP + 512;
    LAS float* NV = NP + 512;
    LAS float* mst = NV + 128;
    const h16* proj = (const h16*)(p.ws + WS_PROJ); const h16* qkm = (const h16*)(p.ws + WS_QKM); const float* gates = (const float*)(p.ws + WS_GATES);
    h16* odst = (h16*)(p.ws + (ODIR(dir) ? WS_OB : WS_HN));
    const size_t sidx = (((size_t)b * 4 + l) * 2 + dir) * 4 + h;
    f32x4 C[8];
    if (lat) {
        const float* src = p.st_mc + sidx * 16384;
#pragma unroll
        for (int dt = 0; dt < 8; ++dt)
#pragma unroll
            for (int j = 0; j < 4; ++j) C[dt][j] = src[(16 * dt + 4 * q + j) * 128 + 16 * w + c];
        if (tid < 128) NV[tid] = p.st_mn[sidx * 128 + tid];
        if (tid == 0) mst[0] = p.st_mm[sidx];
    } else {
#pragma unroll
        for (int dt = 0; dt < 8; ++dt) C[dt] = (f32x4){0.f, 0.f, 0.f, 0.f};
        if (tid < 128) NV[tid] = 0.f;
        if (tid == 0) mst[0] = 0.f;
    }
    u32x4 pq[2], pk[2], pv[2]; float pgi = 0.f, pgf = 0.f;
#define ML_LOAD(ii) do { _Pragma("unroll") for (int j_ = 0; j_ < 2; ++j_) { const int e_ = tid + 512 * j_, rw_ = e_ >> 4, pc_ = e_ & 15; const int pos_ = 64 * (ii) + rw_, tok_ = dir ? L - 1 - pos_ : pos_; \
            const size_t r_ = (size_t)(row0 + tok_); pq[j_] = *(const u32x4*)(qkm + r_ * DM + h * 128 + 8 * pc_); pk[j_] = *(const u32x4*)(qkm + r_ * DM + 512 + h * 128 + 8 * pc_); \
            pv[j_] = *(const u32x4*)(proj + r_ * NPROJ + 3584 + h * 128 + 8 * pc_); } \
        if (w == 0) { const int ps_ = 64 * (ii) + lane, tk_ = dir ? L - 1 - ps_ : ps_; const float* g_ = gates + (size_t)(row0 + tk_) * 16; pgi = g_[dir * 4 + h]; pgf = g_[8 + dir * 4 + h]; } } while (0)
    ML_LOAD(0);
    for (int i = 0; i < NC; ++i) {
        LAS unsigned char* buf = lds + (i & 1) * BUF;
        LAS unsigned char* QM = buf; LAS unsigned char* KM = buf + IMG; LAS unsigned char* VM = buf + 2 * IMG;
        LAS float* U = (LAS float*)(buf + 3 * IMG); LAS float* MM = U + 64; LAS float* AI = U + 128; LAS float* EN = U + 192; LAS float* UE = U + 256;
        asm volatile("s_waitcnt vmcnt(0)" ::: "memory");
#pragma unroll
        for (int j = 0; j < 2; ++j) { const int e = tid + 512 * j, rw = e >> 4, pc = e & 15;
            *(LAS u32x4*)(QM + rw * MP + 16 * pc) = pq[j]; *(LAS u32x4*)(KM + rw * MP + 16 * pc) = pk[j]; *(LAS u32x4*)(VM + rw * MP + 16 * pc) = pv[j]; }
        if (w == 0) {
            const float m0 = mst[0];
            const float gi = pgi, lf = fminf(pgf, 0.f) - log1pf(__expf(-fabsf(pgf)));
            float bc = lf;
#pragma unroll
            for (int o = 1; o < 64; o <<= 1) { const float x = __shfl_up(bc, o); if (lane >= o) bc += x; }
            const float u = gi - bc;
            float pm = u;
#pragma unroll
            for (int o = 1; o < 64; o <<= 1) { const float x = __shfl_up(pm, o); if (lane >= o) pm = fmaxf(pm, x); }
            const float Mt = fmaxf(m0, pm);
            const float M63 = rdlane(Mt, 63), bc63 = rdlane(bc, 63);
            U[lane] = u; MM[lane] = Mt; AI[lane] = __expf(m0 - Mt); EN[lane] = __expf(-(bc + Mt)); UE[lane] = __expf(u - M63);
            asm volatile("s_waitcnt lgkmcnt(0)" ::: "memory");
            if (lane == 0) mst[0] = bc63 + M63;
        }
        { const int nx = (i + 1 < NC) ? i + 1 : NC - 1; ML_LOAD(nx); }
        __syncthreads();
        {
            const int tt = w >> 1;
#pragma unroll
            for (int k2 = 0; k2 < 2; ++k2) {
                const int st = 2 * (w & 1) + k2;
                if (st <= tt) {
                    f32x4 accP = {0.f, 0.f, 0.f, 0.f};
#pragma unroll
                    for (int kp = 0; kp < 4; ++kp) {
                        const h16x8 a = *(const LAS h16x8*)(KM + (16 * st + c) * MP + 2 * (32 * kp + 8 * q));
                        const h16x8 bq = *(const LAS h16x8*)(QM + (16 * tt + c) * MP + 2 * (32 * kp + 8 * q));
                        accP = __builtin_amdgcn_mfma_f32_16x16x32_f16(a, bq, accP, 0, 0, 0);
                    }
                    const f32x4 u4 = *(const LAS f32x4*)(U + 16 * st + 4 * q); const float mt = MM[16 * tt + c];
                    float pj[4];
#pragma unroll
                    for (int j = 0; j < 4; ++j) { const float e = accP[j] * __expf(u4[j] - mt); pj[j] = (16 * st + 4 * q + j <= 16 * tt + c) ? e : 0.f; }
                    u32x2 pw; pw.x = pkh(pj[0], pj[1]); pw.y = pkh(pj[2], pj[3]);
                    *(LAS u32x2*)(PM + (16 * tt + c) * PP + 2 * (16 * st + 4 * q)) = pw;
                    float cs = (pj[0] + pj[1]) + (pj[2] + pj[3]);
                    cs += __shfl_xor(cs, 16); cs += __shfl_xor(cs, 32);
                    if (q == 0) DENP[st * 64 + 16 * tt + c] = cs;
                }
            }
            {
                const h16x8 qa = *(const LAS h16x8*)(QM + lane * MP + 2 * (16 * w)), qb = *(const LAS h16x8*)(QM + lane * MP + 2 * (16 * w + 8));
                const f32x4 n0 = *(const LAS f32x4*)(NV + 16 * w), n1 = *(const LAS f32x4*)(NV + 16 * w + 4), n2 = *(const LAS f32x4*)(NV + 16 * w + 8), n3 = *(const LAS f32x4*)(NV + 16 * w + 12);
                float s = 0.f;
#pragma unroll
                for (int j = 0; j < 4; ++j) s += (float)qa[j] * n0[j] + (float)qa[4 + j] * n1[j] + (float)qb[j] * n2[j] + (float)qb[4 + j] * n3[j];
                QNP[w * 64 + lane] = s;
            }
            {
                const int d = tid & 127, part = tid >> 7;
                float s = 0.f;
#pragma unroll
                for (int ss = 0; ss < 16; ++ss) s += UE[16 * part + ss] * (float)*(const LAS h16*)(KM + (16 * part + ss) * MP + 2 * d);
                NP[part * 128 + d] = s;
            }
        }
        __syncthreads();
        {
            h16x4 vtr[4];
#pragma unroll
            for (int st = 0; st < 4; ++st) vtr[st] = __builtin_bit_cast(h16x4, tr_read(VM + (16 * st + 4 * q + (c >> 2)) * MP + 2 * (16 * w + 4 * (c & 3))));
            h16x8 cp[4];
#pragma unroll
            for (int kp = 0; kp < 4; ++kp) { u32x4 sa; sa.x = pkh(C[2 * kp][0], C[2 * kp][1]); sa.y = pkh(C[2 * kp][2], C[2 * kp][3]); sa.z = pkh(C[2 * kp + 1][0], C[2 * kp + 1][1]); sa.w = pkh(C[2 * kp + 1][2], C[2 * kp + 1][3]); cp[kp] = __builtin_bit_cast(h16x8, sa); }
#pragma unroll
            for (int tt = 0; tt < 4; ++tt) {
                const int t = 16 * tt + c;
                f32x4 accI = {0.f, 0.f, 0.f, 0.f}, accN = {0.f, 0.f, 0.f, 0.f};
#pragma unroll
                for (int kp = 0; kp < 4; ++kp) {
                    const u32x2 b0 = *(const LAS u32x2*)(QM + t * MP + 2 * (32 * kp + 4 * q)), b1 = *(const LAS u32x2*)(QM + t * MP + 2 * (32 * kp + 16 + 4 * q));
                    u32x4 bb; bb.x = b0.x; bb.y = b0.y; bb.z = b1.x; bb.w = b1.y;
                    accI = __builtin_amdgcn_mfma_f32_16x16x32_f16(cp[kp], __builtin_bit_cast(h16x8, bb), accI, 0, 0, 0);
                }
                float den = 0.f;
#pragma unroll
                for (int st = 0; st < 4; ++st) if (st <= tt) {
                    const u32x2 pb = *(const LAS u32x2*)(PM + t * PP + 2 * (16 * st + 4 * q));
                    accN = __builtin_amdgcn_mfma_f32_16x16x16f16(vtr[st], __builtin_bit_cast(h16x4, pb), accN, 0, 0, 0);
                    den += DENP[st * 64 + t];
                }
                float qn = 0.f;
#pragma unroll
                for (int ww = 0; ww < 8; ++ww) qn += QNP[ww * 64 + t];
                const float ai = AI[t];
                den += ai * qn;
                const float sc = 1.f / fmaxf(fabsf(den), EN[t]);
                const f32x4 hv = (accN + accI * ai) * sc;
                const int pos = 64 * i + t, tok = dir ? L - 1 - pos : pos;
                u32x2 o; o.x = pkh(hv[0], hv[1]); o.y = pkh(hv[2], hv[3]);
                *(u32x2*)(odst + (size_t)(row0 + tok) * DM + 512 + h * 128 + 16 * w + 4 * q) = o;
            }
            const float a63 = AI[63];
            h16x4 vs[4];
#pragma unroll
            for (int st = 0; st < 4; ++st) { const f32x4 ue4 = *(const LAS f32x4*)(UE + 16 * st + 4 * q);
#pragma unroll
                for (int j = 0; j < 4; ++j) vs[st][j] = (h16)((float)vtr[st][j] * ue4[j]); }
#pragma unroll
            for (int dt = 0; dt < 8; ++dt) {
                C[dt] = C[dt] * a63;
#pragma unroll
                for (int st = 0; st < 4; ++st) {
                    const h16x4 ktr = __builtin_bit_cast(h16x4, tr_read(KM + (16 * st + 4 * q + (c >> 2)) * MP + 2 * (16 * dt + 4 * (c & 3))));
                    C[dt] = __builtin_amdgcn_mfma_f32_16x16x16f16(ktr, vs[st], C[dt], 0, 0, 0);
                }
            }
            if (tid < 128) NV[tid] = a63 * NV[tid] + (NP[tid] + NP[128 + tid]) + (NP[256 + tid] + NP[384 + tid]);
        }
#if defined(ML_EXTRA_SYNC)
        asm volatile("s_waitcnt vmcnt(0) lgkmcnt(0)" ::: "memory");
        __syncthreads();
#endif
    }
    __syncthreads();
    if (!lat) {
        float* dst = p.out + OUT_MC + sidx * 16384;
#pragma unroll
        for (int dt = 0; dt < 8; ++dt)
#pragma unroll
            for (int j = 0; j < 4; ++j) dst[(16 * dt + 4 * q + j) * 128 + 16 * w + c] = C[dt][j];
        if (tid < 128) p.out[OUT_MN + sidx * 128 + tid] = NV[tid];
        if (tid == 0) p.out[OUT_MM + sidx] = mst[0];
    }
    __syncthreads();
#undef ML_LOAD
}
#if defined(DIAG_ALL)
#define SCAN_HG(p, l, lat, b, h, dir, lds) do { scan_hgrn_mfma(p, l, lat, b, h, dir, (LAS unsigned char*)(lds)); asm volatile("s_waitcnt vmcnt(0)" ::: "memory"); __syncthreads(); scan_item<0, 1>(p, l, lat, b, h, dir, lds); } while (0)
#elif defined(HGRN_VALU)
#define SCAN_HG(p, l, lat, b, h, dir, lds) scan_item<0>(p, l, lat, b, h, dir, lds)
#else
#define SCAN_HG(p, l, lat, b, h, dir, lds) scan_hgrn_mfma(p, l, lat, b, h, dir, (LAS unsigned char*)(lds))
#endif
#if defined(MLSTM_VALU)
#define SCAN_ML(p, l, lat, b, h, dir, lds) scan_item<1>(p, l, lat, b, h, dir, lds)
#else
#if defined(DIAG_ALL)
#define SCAN_ML(p, l, lat, b, h, dir, lds) do { scan_mlstm_mfma(p, l, lat, b, h, dir, (LAS unsigned char*)(lds)); asm volatile("s_waitcnt vmcnt(0)" ::: "memory"); __syncthreads(); scan_item<1, 1>(p, l, lat, b, h, dir, lds); } while (0)
#elif defined(MLSTM_DIAG)
#define SCAN_ML(p, l, lat, b, h, dir, lds) do { scan_mlstm_mfma(p, l, lat, b, h, dir, (LAS unsigned char*)(lds)); \
        if ((lat) && (dir) == 0 && (l) == DIAG_LAYER) { asm volatile("s_waitcnt vmcnt(0)" ::: "memory"); __syncthreads(); scan_item<1, 1>(p, l, lat, b, h, dir, lds); } } while (0)
#elif defined(MLSTM_VALU_CTX)
#define SCAN_ML(p, l, lat, b, h, dir, lds) do { if (lat) scan_mlstm_mfma(p, l, lat, b, h, dir, (LAS unsigned char*)(lds)); else scan_item<1>(p, l, lat, b, h, dir, lds); } while (0)
#elif defined(MLSTM_MFMA_DIR0)
#define SCAN_ML(p, l, lat, b, h, dir, lds) do { if ((dir) == 0) scan_mlstm_mfma(p, l, lat, b, h, dir, (LAS unsigned char*)(lds)); else scan_item<1>(p, l, lat, b, h, dir, lds); } while (0)
#elif defined(MLSTM_BISECT)
#define SCAN_ML(p, l, lat, b, h, dir, lds) do { if (!((lat) && (dir) == 0 && (MLSTM_BISECT_COND))) scan_mlstm_mfma(p, l, lat, b, h, dir, (LAS unsigned char*)(lds)); else scan_item<1>(p, l, lat, b, h, dir, lds); } while (0)
#elif defined(MLSTM_VALU_LAT)
#define SCAN_ML(p, l, lat, b, h, dir, lds) do { if (!(lat)) scan_mlstm_mfma(p, l, lat, b, h, dir, (LAS unsigned char*)(lds)); else scan_item<1>(p, l, lat, b, h, dir, lds); } while (0)
#else
#define SCAN_ML(p, l, lat, b, h, dir, lds) scan_mlstm_mfma(p, l, lat, b, h, dir, (LAS unsigned char*)(lds))
#endif
#endif
__device__ __forceinline__ void scan_dispatch(const Params& p, int l, int it, LAS float* lds) {
    if (it < 128) { const int type = it >> 6, r = it & 63, b = r >> 3, h = (r >> 1) & 3, dir = r & 1; if (type == 0) SCAN_HG(p, l, 1, b, h, dir, lds); else SCAN_ML(p, l, 1, b, h, dir, lds); }
    else { const int q = it - 128, type = q >> 8, r = q & 255, b = r >> 3, h = (r >> 1) & 3, dir = r & 1; if (type == 0) SCAN_HG(p, l, 0, b, h, dir, lds); else SCAN_ML(p, l, 0, b, h, dir, lds); }
}
__device__ __forceinline__ void phase_scan(const Params& p, int l, LAS float* lds) {
    const int G = gridDim.x, bid = blockIdx.x;
    if (G == 256) {
        if (bid < 128) scan_dispatch(p, l, bid, lds);
        else for (int it = 128 + (bid - 128); it < 640; it += 128) scan_dispatch(p, l, it, lds);
    } else {
        for (int it = bid; it < 640; it += G) scan_dispatch(p, l, it, lds);
    }
}
__device__ __forceinline__ void phase_mixnorm(const Params& p, int l, int gw, int NGW, int lane) {
    const h16* of = (const h16*)(p.ws + WS_HN); const h16* ob = (const h16*)(p.ws + WS_OB); const h16* proj = (const h16*)(p.ws + WS_PROJ);
    h16* mix = (h16*)(p.ws + WS_QKM);
    const int col = 16 * lane;
    const float* nw = col < 512 ? p.hg_nw + l * 512 + col : p.ml_nw + l * 512 + (col - 512);
    float wv[16];
#pragma unroll
    for (int j = 0; j < 4; ++j) { const f32x4 t = *(const f32x4*)(nw + 4 * j); wv[4 * j] = t.x; wv[4 * j + 1] = t.y; wv[4 * j + 2] = t.z; wv[4 * j + 3] = t.w; }
    const int gcol = col < 512 ? 2048 + col : 4096 + (col - 512);
    for (int r = gw; r < T_ALL; r += NGW) {
        const h16x8 a0 = *(const h16x8*)(of + (size_t)r * DM + col), a1 = *(const h16x8*)(of + (size_t)r * DM + col + 8);
        const h16x8 b0 = *(const h16x8*)(ob + (size_t)r * DM + col), b1 = *(const h16x8*)(ob + (size_t)r * DM + col + 8);
        const h16x8 g0 = *(const h16x8*)(proj + (size_t)r * NPROJ + gcol), g1 = *(const h16x8*)(proj + (size_t)r * NPROJ + gcol + 8);
        float o[16]; float ss = 0.f;
#pragma unroll
        for (int j = 0; j < 8; ++j) { o[j] = (float)a0[j] + (float)b0[j]; o[8 + j] = (float)a1[j] + (float)b1[j]; }
#pragma unroll
        for (int j = 0; j < 16; ++j) ss += o[j] * o[j];
        ss += __shfl_xor(ss, 1); ss += __shfl_xor(ss, 2); ss += __shfl_xor(ss, 4);
        const float rstd = rsqrtf(ss * (1.f / 128.f) + EPS);
        u32x4 w0, w1;
        w0.x = pkh(o[0] * rstd * wv[0] * (float)g0[0], o[1] * rstd * wv[1] * (float)g0[1]); w0.y = pkh(o[2] * rstd * wv[2] * (float)g0[2], o[3] * rstd * wv[3] * (float)g0[3]);
        w0.z = pkh(o[4] * rstd * wv[4] * (float)g0[4], o[5] * rstd * wv[5] * (float)g0[5]); w0.w = pkh(o[6] * rstd * wv[6] * (float)g0[6], o[7] * rstd * wv[7] * (float)g0[7]);
        w1.x = pkh(o[8] * rstd * wv[8] * (float)g1[0], o[9] * rstd * wv[9] * (float)g1[1]); w1.y = pkh(o[10] * rstd * wv[10] * (float)g1[2], o[11] * rstd * wv[11] * (float)g1[3]);
        w1.z = pkh(o[12] * rstd * wv[12] * (float)g1[4], o[13] * rstd * wv[13] * (float)g1[5]); w1.w = pkh(o[14] * rstd * wv[14] * (float)g1[6], o[15] * rstd * wv[15] * (float)g1[7]);
        *(u32x4*)(mix + (size_t)r * DM + col) = w0; *(u32x4*)(mix + (size_t)r * DM + col + 8) = w1;
    }
}

#define XB_TMO      128
#define XB_XCNT(j)  (256  + 64 * (j))
#define XB_XSUB(j)  (1280 + 64 * (j))
#define XB_XGEN(j)  (2304 + 64 * (j))
#define XB_TOP      3328
#define XB_TOPGEN   3392
#define XCD_BAR_WORDS 3456
#define XB_SPIN_CAP (1u << 18)

__device__ __forceinline__ unsigned xb_ld(unsigned* p)              { return __hip_atomic_load(p, __ATOMIC_RELAXED, __HIP_MEMORY_SCOPE_AGENT); }
__device__ __forceinline__ unsigned xb_add(unsigned* p, unsigned v) { return __hip_atomic_fetch_add(p, v, __ATOMIC_RELAXED, __HIP_MEMORY_SCOPE_AGENT); }
__device__ __forceinline__ unsigned xb_xcc_id() { return (unsigned)__builtin_amdgcn_s_getreg((3 << 11) | 20) & 0xFu; }
#define XB_SPIN(cond, bar) do { unsigned _sp = 0; while (cond) { __builtin_amdgcn_s_sleep(1); \
    if ((++_sp & 255u) == 0u) { if (xb_ld(&(bar)[XB_TMO])) break; if (_sp > XB_SPIN_CAP) { atomicAdd(&(bar)[XB_TMO], 1u); break; } } } } while (0)

struct XcdBarrier {
    unsigned* bar; unsigned x;
    volatile LAS unsigned* st;
};

__device__ __forceinline__ XcdBarrier xcd_barrier_post(unsigned* bar, volatile LAS unsigned* st) {
    XcdBarrier b; b.bar = bar; b.x = xb_xcc_id(); b.st = st;
    if (threadIdx.x == 0) (void)xb_add(&bar[XB_XCNT(b.x)], 1u);
    return b;
}
__device__ __forceinline__ void xcd_barrier_complete(unsigned* bar, unsigned x, unsigned& nloc, unsigned& nx) {
    const unsigned G = gridDim.x * gridDim.y * gridDim.z;
    unsigned sum, cnt, mine, sp = 0u;
    for (;;) {
        sum = 0u; cnt = 0u; mine = 0u;
#pragma unroll
        for (unsigned j = 0; j < 16; ++j) { const unsigned c = xb_ld(&bar[XB_XCNT(j)]); sum += c; cnt += (c > 0u) ? 1u : 0u; mine = (j == x) ? c : mine; }
        if (sum == G) break;
        __builtin_amdgcn_s_sleep(1);
        if ((++sp & 255u) == 0u) { if (xb_ld(&bar[XB_TMO])) break; if (sp > XB_SPIN_CAP) { atomicAdd(&bar[XB_TMO], 1u); break; } }
    }
    nloc = mine > 0u ? mine : 1u; nx = cnt > 0u ? cnt : 1u;
}

__device__ __forceinline__ void xcd_barrier(const XcdBarrier& b) {
    asm volatile("s_waitcnt vmcnt(0)" ::: "memory");
    __syncthreads();
    if (threadIdx.x == 0) {
        unsigned* bar = b.bar;
        __builtin_amdgcn_s_waitcnt(0);
        unsigned nloc = b.st[0], nx = b.st[1];
        if (nloc == 0u) { xcd_barrier_complete(bar, b.x, nloc, nx); b.st[0] = nloc; b.st[1] = nx; }
        const unsigned old = xb_add(&bar[XB_XSUB(b.x)], 1u);
        const unsigned gen = old / nloc;
        if (old + 1u == (gen + 1u) * nloc) {
            __builtin_amdgcn_fence(__ATOMIC_RELEASE, "agent");
            asm volatile("s_waitcnt vmcnt(0)" ::: "memory");
            const unsigned og = xb_add(&bar[XB_TOP], 1u);
            const unsigned tg = og / nx;
            if (og + 1u == (tg + 1u) * nx) xb_add(&bar[XB_TOPGEN], 1u);
            else XB_SPIN(xb_ld(&bar[XB_TOPGEN]) == tg, bar);
            __builtin_amdgcn_fence(__ATOMIC_ACQUIRE, "agent");
            xb_add(&bar[XB_XGEN(b.x)], 1u);
            asm volatile("s_waitcnt vmcnt(0)" ::: "memory");
        } else {
            XB_SPIN(xb_ld(&bar[XB_XGEN(b.x)]) == gen, bar);
            __builtin_amdgcn_fence(__ATOMIC_ACQUIRE, "agent");
            asm volatile("s_waitcnt vmcnt(0)" ::: "memory");
        }
    }
    __syncthreads();
}


__global__ void __launch_bounds__(NTHR, 2) fwd_megakernel(Params p) {
    extern __shared__ __attribute__((aligned(16))) unsigned char lds_raw[];
    cg::grid_group grid = cg::this_grid();
#if defined(USE_CG_SYNC)
#define GSYNC() do { asm volatile("s_waitcnt vmcnt(0)" ::: "memory"); grid.sync(); } while (0)
#else
#define GSYNC() do { XcdBarrier xb_; xb_.bar = (unsigned*)(p.ws + WS_BAR); xb_.x = xb_xcc_id(); xb_.st = (volatile LAS unsigned*)(lds + 131072 + 512); xcd_barrier(xb_); } while (0)
#endif
    LAS unsigned char* lds = (LAS unsigned char*)lds_raw;
    LAS float* ldsf = (LAS float*)lds_raw;
    const int G = gridDim.x, NGW = G * NWV;
#define PHASE_IDS() const int tid = ltid(), lane = tid & 63, wave = __builtin_amdgcn_readfirstlane(tid >> 6), gw = blockIdx.x * NWV + wave; (void)tid; (void)lane; (void)gw
    const float* mod = (const float*)(p.ws + WS_MOD);
    h16* hn = (h16*)(p.ws + WS_HN); h16* proj = (h16*)(p.ws + WS_PROJ); h16* mix = (h16*)(p.ws + WS_QKM); h16* ff = (h16*)(p.ws + WS_PROJ);

    volatile LAS unsigned* xst = (volatile LAS unsigned*)(lds + 131072 + 512);
    if (ltid() < 4) xst[ltid()] = 0u;
    __syncthreads();
    XcdBarrier xbar = xcd_barrier_post((unsigned*)(p.ws + WS_BAR), xst);
    phase_mod_partial(p, ldsf);
    asm volatile("s_waitcnt vmcnt(0)" ::: "memory"); grid.sync();
    (void)xbar;
    phase_mod_reduce(p);
    GSYNC();
#if defined(DIAG_ALL)
    if (ltid() == 0) { float* dg = (float*)(p.ws + WS_MODP) + 4 * blockIdx.x; dg[0] = 0.f; dg[1] = 0.f; dg[2] = 0.f; dg[3] = 0.f; }
#endif
    for (int l = 0; l < 4; ++l) {
        { PHASE_IDS(); convert_weights(p, l, ldsf + wave * 2176, gw, NGW, lane); }
        { PHASE_IDS(); phase_norm(p, l, 0, l == 0, gw, NGW, lane); }
        GSYNC();
        {
            pg8::Gemm g{(const pg8::bf16_t*)hn, (const pg8::bf16_t*)(p.ws + WS_WIN), T_ALL, NPROJ_PAD, DM}; pg8::StaticOrder S; S.init(T_ALL, NPROJ_PAD, G, (int)blockIdx.x);
            EpiInProj E{proj, (float*)(p.ws + WS_GATES), p.gate_b + l * 16};
            pg8::gemm_phase<EpiInProj, pg8::StaticOrder, true, true>(lds, g, S, E);
#if defined(PROBE_GEMM2)
            GSYNC();
            pg8::gemm_phase<EpiInProj, pg8::StaticOrder, true, true>(lds, g, S, E);
#endif
        }
        GSYNC();
        { PHASE_IDS(); phase_gates(p, l, gw, NGW, lane); }
        phase_conv(p, l);
        GSYNC();
#if defined(PERTURB)
        { if (ltid() == 0) { const unsigned long long t0_ = __builtin_amdgcn_s_memrealtime(); const unsigned long long dl_ = (unsigned long long)(((blockIdx.x * 37u + l * 11u) % 64u) * 300u); while (__builtin_amdgcn_s_memrealtime() - t0_ < dl_) __builtin_amdgcn_s_sleep(4); } __syncthreads(); }
#endif
        phase_scan(p, l, ldsf);
#if defined(PERTURB)
        { if (ltid() == 0) { const unsigned long long t0_ = __builtin_amdgcn_s_memrealtime(); const unsigned long long dl_ = (unsigned long long)(((blockIdx.x * 53u + l * 7u) % 32u) * 400u); while (__builtin_amdgcn_s_memrealtime() - t0_ < dl_) __builtin_amdgcn_s_sleep(4); } __syncthreads(); }
#endif
#if defined(DELAY_AFTER_SCAN)
        { if (ltid() == 0) { const unsigned long long t0_ = __builtin_amdgcn_s_memrealtime(); while (__builtin_amdgcn_s_memrealtime() - t0_ < (unsigned long long)(DELAY_AFTER_SCAN) * 100ull) __builtin_amdgcn_s_sleep(8); } __syncthreads(); }
#endif
#if defined(LDS_CLEAR)
        { __syncthreads(); const int t_ = ltid(); for (int e = t_; e < 32768; e += NTHR) ldsf[e] = LDS_CLEAR_VAL; __syncthreads(); }
#endif
        GSYNC();
#if defined(MLSTM_DIAG)
        if (l == DIAG_LAYER && blockIdx.x == 0 && ltid() == 0) {
            const float* dg = (const float*)(p.ws + WS_MODP);
            float best = -1.f; int code = 0;
            for (int bb = 64; bb < 128; bb += 2) { const float rt = dg[4 * bb + DIAG_FIELD]; if (rt > best) { best = rt; int lg = 0; float x = rt; while (x < 1.f && lg < 31) { x *= 2.f; ++lg; } code = DIAG_CODE; } }
            const unsigned long long t0 = __builtin_amdgcn_s_memrealtime();
            while (__builtin_amdgcn_s_memrealtime() - t0 < (unsigned long long)code * 5000ull) __builtin_amdgcn_s_sleep(8);
        }
#endif
#if defined(PROBE_GSYNC10)
        for (int rep = 0; rep < 10; ++rep) GSYNC();
#endif
#if defined(PROBE_SCAN_TYPE)
        { const int bid_ = blockIdx.x;
          if (bid_ < 128) { if ((bid_ >> 6) == PROBE_SCAN_TYPE) scan_dispatch(p, l, bid_, ldsf); }
          else for (int it = 128 + (bid_ - 128); it < 640; it += 128) { if (((it - 128) >> 8) == PROBE_SCAN_TYPE) scan_dispatch(p, l, it, ldsf); } }
        GSYNC();
#endif
#if defined(PROBE_SCAN2)
        phase_scan(p, l, ldsf);
        GSYNC();
#endif
        { PHASE_IDS(); phase_mixnorm(p, l, gw, NGW, lane); }
        GSYNC();
        {
            pg8::Gemm g{(const pg8::bf16_t*)mix, (const pg8::bf16_t*)(p.ws + WS_WOUT), T_ALL, DM, DM}; pg8::StaticOrder S; S.init(T_ALL, DM, G, (int)blockIdx.x);
            EpiResid E{l == 0 ? p.x_prompt : p.out, l == 0 ? p.x_sample : p.out + (size_t)T_CTX * DM, p.out, mod + (size_t)l * 9 * 6144 + 2048};
#if defined(PROBE_GEMM2)
            { EpiResid E2 = E; E2.out = (float*)(p.ws + WS_PROJ); pg8::gemm_phase<EpiResid, pg8::StaticOrder, true, true>(lds, g, S, E2); GSYNC(); }
#endif
            pg8::gemm_phase<EpiResid, pg8::StaticOrder, true, true>(lds, g, S, E);
        }
        GSYNC();
        { PHASE_IDS(); phase_norm(p, l, 1, false, gw, NGW, lane); }
        GSYNC();
        {
            pg8::Gemm g{(const pg8::bf16_t*)hn, (const pg8::bf16_t*)(p.ws + WS_WGU), T_ALL, NGU, DM}; pg8::StaticOrder S; S.init(T_ALL, NGU, G, (int)blockIdx.x);
            EpiGateUp E{ff};
            pg8::gemm_phase<EpiGateUp, pg8::StaticOrder, true, true>(lds, g, S, E);
#if defined(PROBE_GEMM2)
            GSYNC();
            pg8::gemm_phase<EpiGateUp, pg8::StaticOrder, true, true>(lds, g, S, E);
#endif
        }
        GSYNC();
        {
            pg8::Gemm g{(const pg8::bf16_t*)ff, (const pg8::bf16_t*)(p.ws + WS_WDN), T_ALL, DM, DFF}; pg8::StaticOrder S; S.init(T_ALL, DM, G, (int)blockIdx.x);
            EpiResid E{p.out, p.out + (size_t)T_CTX * DM, p.out, mod + (size_t)l * 9 * 6144 + 5120};
#if defined(PROBE_GEMM2)
            { EpiResid E2 = E; E2.out = (float*)(p.ws + WS_QKM); pg8::gemm_phase<EpiResid, pg8::StaticOrder, true, true>(lds, g, S, E2); GSYNC(); }
#endif
            pg8::gemm_phase<EpiResid, pg8::StaticOrder, true, true>(lds, g, S, E);
        }
        GSYNC();
    }
    { PHASE_IDS(); phase_final_norm(p, gw, NGW, lane); }
#if defined(DIAG_ALL)
    if (blockIdx.x == 0 && ltid() == 0) {
        const float* dg = (const float*)(p.ws + WS_MODP);
        float best = -1.f; int code = 0;
        for (int bb = 0; bb < (int)gridDim.x; ++bb) { const float rt = dg[4 * bb]; if (rt > best) { best = rt; int lg = 0; float x = rt; while (x < 1.f && lg < 31) { x *= 2.f; ++lg; } code = DIAG_ALL_CODE; } }
        const unsigned long long t0 = __builtin_amdgcn_s_memrealtime();
        while (__builtin_amdgcn_s_memrealtime() - t0 < (unsigned long long)code * 5000ull) __builtin_amdgcn_s_sleep(8);
    }
#endif
}

extern "C" void kernel_launch(void* const* d_in, const int* in_sizes, int n_in, void* d_out, int out_size, void* d_ws, size_t ws_size, hipStream_t stream) {
    static int grid_blocks = 0;
    if (grid_blocks == 0) {
        if (n_in != 24 || (size_t)out_size != OUT_TOTAL || ws_size < WS_END) {
            fprintf(stderr, "kernel_launch: unexpected sizes n_in %d out %d ws %zu (need %zu)\n", n_in, out_size, ws_size, (size_t)WS_END); grid_blocks = -1; return;
        }
        int dev = 0, cus = 0, per_cu = 0;
        hipGetDevice(&dev);
        hipDeviceGetAttribute(&cus, hipDeviceAttributeMultiprocessorCount, dev);
        hipFuncSetAttribute((const void*)fwd_megakernel, hipFuncAttributeMaxDynamicSharedMemorySize, LDS_BYTES);
        hipOccupancyMaxActiveBlocksPerMultiprocessor(&per_cu, (const void*)fwd_megakernel, NTHR, LDS_BYTES);
        if (per_cu < 1) { fprintf(stderr, "kernel_launch: occupancy query says %d blocks per CU\n", per_cu); per_cu = 1; }
        grid_blocks = cus * 1;
        (void)hipGetLastError();
    }
    if (grid_blocks < 0) return;
    Params p{};
    const float** f = (const float**)&p;
    for (int i = 0; i < 24; ++i) f[i] = (const float*)d_in[i];
    p.out = (float*)d_out; p.ws = (unsigned char*)d_ws;
    if (hipMemsetAsync((char*)d_ws + WS_BAR, 0, 16384, stream) != hipSuccess) { fprintf(stderr, "kernel_launch: memset of the barrier words failed\n"); return; }
    void* args[] = {&p};
    hipError_t e = hipLaunchCooperativeKernel((const void*)fwd_megakernel, dim3(grid_blocks), dim3(NTHR), args, LDS_BYTES, stream);
    if (e != hipSuccess) fprintf(stderr, "cooperative launch failed: %s (grid %d)\n", hipGetErrorString(e), grid_blocks);
}
```

```cpp
#include <hip/hip_runtime.h>
#include <hip/hip_cooperative_groups.h>
#include <cstdio>
#include <cstdint>
namespace cg = cooperative_groups;
typedef _Float16 h16;
typedef _Float16 h16x8 __attribute__((ext_vector_type(8)));
typedef _Float16 h16x4 __attribute__((ext_vector_type(4)));
typedef _Float16 h16x2 __attribute__((ext_vector_type(2)));
typedef float f32x2 __attribute__((ext_vector_type(2)));
namespace pg8 {
#define PG8_LAS __attribute__((address_space(3)))
typedef unsigned short bf16_t;
typedef short bf16x8 __attribute__((ext_vector_type(8)));
typedef float f32x4 __attribute__((ext_vector_type(4)));
typedef unsigned u32x4 __attribute__((ext_vector_type(4)));
constexpr int BM = 256, BK = 64, HALF = 128, HTB = HALF * BK * 2  , STAGE_BYTES = 8 * HTB, NXCD = 8, WGM = 8;

__host__ __device__ __forceinline__ int lds_byte(int r, int c) { const int st = (r >> 4) * 2 + (c >> 5), rr = r & 15, cc = c & 31, ob = rr * 64 + cc * 2; return st * 1024 + (ob ^ (((ob >> 9) & 1) << 5)); }
__host__ __device__ __forceinline__ void stage_rc(int b, int& R, int& C) { const int st = b / 1024, sb = b % 1024, swz = sb ^ (((sb >> 9) & 1) << 5); R = (st >> 1) * 16 + swz / 64; C = (st & 1) * 32 + (swz % 64) / 2; }
__host__ __device__ __forceinline__ int perm32(int rho) { const int n = rho >> 4, i = rho & 15; return 8 * (i >> 2) + 4 * n + (i & 3); }

struct Unit { int pm, pn; };
struct Gemm { const bf16_t* A; const bf16_t* Bt; int M, N, K; };

struct StaticOrder {
    int nM, nN, nwg, G, c;
    __host__ __device__ void init(int M, int N, int G_, int c_) { nM = M / BM; nN = N / BM; nwg = nM * nN; G = G_; c = c_; }
    __host__ __device__ bool next(int i, Unit& u) const {
        const long L = (long)i * G + c; if (L >= nwg) return false;
        int wgid = (int)L; { const int q = nwg / NXCD, r = nwg % NXCD, xcd = wgid % NXCD, off = wgid / NXCD; wgid = (xcd < r ? xcd * (q + 1) : r * (q + 1) + (xcd - r) * q) + off; }
        const int nig = WGM * nN, gid = wgid / nig, fm = gid * WGM, gsz = (nM - fm) < WGM ? (nM - fm) : WGM;
        u.pm = fm + ((wgid % nig) % gsz); u.pn = (wgid % nig) / gsz; return true;
    }
    __device__ __forceinline__ void a_ready(const Unit&) const {}
    __device__ __forceinline__ void done(const Unit&) const {}
};

template <class Epi, class Sched, bool ALIGN_EPI = false, bool SP2 = false>
__device__ __forceinline__ void gemm_phase(PG8_LAS unsigned char* lds, const Gemm g, const Sched& S, const Epi& E) {
    int tid_l = threadIdx.x; asm volatile("" : "+v"(tid_l));
    const int tid = tid_l, wid = __builtin_amdgcn_readfirstlane(tid >> 6), lane = tid & 63, wr = wid >> 2, wc = wid & 3, fr = lane & 15, fq = lane >> 4;
    const int K = g.K, nt = K / BK;
    unsigned voffA[2], voffB[2];
#pragma unroll
    for (int i = 0; i < 2; ++i) { int R, C; stage_rc(tid * 16 + i * 8192, R, C); const int Rb = Epi::PERM ? ((R & ~31) + perm32(R & 31)) : R;
        voffA[i] = (unsigned)(R * K + C) * 2u; voffB[i] = (unsigned)(Rb * K + C) * 2u; }
    const size_t kstep = (size_t)(BK * 2);
    const size_t hstep = (size_t)HALF * K * 2;
    const size_t tstep = 2 * hstep;
    const unsigned ldsw = (unsigned)wid * 1024u;
    const int aoff = lds_byte(wr * 64 + fr, fq * 8), boff = lds_byte(wc * 32 + fr, fq * 8);
#define PG8_SA(b, h) (((b) * 2 + (h)) * HTB)
#define PG8_SB(b, h) ((4 + (b) * 2 + (h)) * HTB)
#define PG8_STAGE(bufoff, gbase, voff) do { _Pragma("unroll") for (int _i = 0; _i < 2; ++_i) \
        __builtin_amdgcn_global_load_lds((const unsigned*)((const char*)(gbase) + (voff)[_i]), (PG8_LAS unsigned*)(lds + (bufoff) + ldsw + _i * 8192), 16, 0, 0); } while (0)
#define PG8_LDA(dst, b, h) do { _Pragma("unroll") for (int m = 0; m < 4; ++m) _Pragma("unroll") for (int k = 0; k < 2; ++k) dst[m][k] = *(const PG8_LAS bf16x8*)(lds + PG8_SA(b, h) + aoff + m * 2048 + k * 1024); } while (0)
#define PG8_LDB(dst, b, h) do { _Pragma("unroll") for (int n = 0; n < 2; ++n) _Pragma("unroll") for (int k = 0; k < 2; ++k) dst[n][k] = *(const PG8_LAS bf16x8*)(lds + PG8_SB(b, h) + boff + n * 2048 + k * 1024); } while (0)
#define PG8_MMA(ai, bj, At, Bt) do { __builtin_amdgcn_s_setprio(1); _Pragma("unroll") for (int m = 0; m < 4; ++m) _Pragma("unroll") for (int n = 0; n < 2; ++n) _Pragma("unroll") for (int k = 0; k < 2; ++k) \
        acc[ai][bj][m][n] = __builtin_amdgcn_mfma_f32_16x16x32_f16(__builtin_bit_cast(h16x8, Bt[n][k]), __builtin_bit_cast(h16x8, At[m][k]), acc[ai][bj][m][n], 0, 0, 0); __builtin_amdgcn_s_setprio(0); } while (0)
#define PG8_WAIT_V(n) asm volatile("s_waitcnt vmcnt(" #n ")" ::: "memory")
#define PG8_WAIT_L(n) asm volatile("s_waitcnt lgkmcnt(" #n ")" ::: "memory")
#define PG8_BAR __builtin_amdgcn_s_barrier()
#define PG8_SCHED __builtin_amdgcn_sched_barrier(0)
    Unit cur, nxt; int ui = 0;
    if (!S.next(0, cur)) return;
    f32x4 acc[2][2][4][2];
#pragma unroll
    for (int a = 0; a < 2; ++a)
#pragma unroll
        for (int b = 0; b < 2; ++b)
#pragma unroll
            for (int m = 0; m < 4; ++m)
#pragma unroll
                for (int n = 0; n < 2; ++n) acc[a][b][m][n] = (f32x4){0.f, 0.f, 0.f, 0.f};
    bf16x8 At[4][2], B0[2][2], B1[2][2];
    const char* cA = (const char*)g.A + (size_t)cur.pm * tstep; const char* cB = (const char*)g.Bt + (size_t)cur.pn * tstep;
    S.a_ready(cur);
    if constexpr (SP2) {
        PG8_STAGE(PG8_SB(0, 0), cB, voffB); PG8_STAGE(PG8_SB(0, 1), cB + hstep, voffB); PG8_STAGE(PG8_SA(0, 0), cA, voffA); PG8_STAGE(PG8_SA(0, 1), cA + hstep, voffA);
        if (wr == 1) PG8_BAR;
        PG8_WAIT_V(2); PG8_BAR;
        PG8_STAGE(PG8_SB(1, 0), cB + kstep, voffB); PG8_STAGE(PG8_SA(1, 0), cA + kstep, voffA); PG8_STAGE(PG8_SB(1, 1), cB + hstep + kstep, voffB);
        PG8_WAIT_V(6); PG8_BAR;
    } else {
        PG8_STAGE(PG8_SB(0, 0), cB, voffB); PG8_STAGE(PG8_SA(0, 0), cA, voffA); PG8_STAGE(PG8_SB(0, 1), cB + hstep, voffB); PG8_STAGE(PG8_SA(0, 1), cA + hstep, voffA);
        if (wr == 1) PG8_BAR;
        PG8_WAIT_V(4); PG8_BAR;
        PG8_STAGE(PG8_SB(1, 0), cB + kstep, voffB); PG8_STAGE(PG8_SA(1, 0), cA + kstep, voffA); PG8_STAGE(PG8_SB(1, 1), cB + hstep + kstep, voffB);
        PG8_WAIT_V(6); PG8_BAR;
    }
    for (;;) {
        const bool has_next = S.next(ui + 1, nxt);
        const char* nA = has_next ? (const char*)g.A + (size_t)nxt.pm * tstep : cA; const char* nB = has_next ? (const char*)g.Bt + (size_t)nxt.pn * tstep : cB;
        for (int t = 0; t < nt; t += 2) {
            const bool last = (t == nt - 2);
            const char* a1 = cA + (size_t)(t + 1) * kstep;
            const char* a2 = last ? nA : cA + (size_t)(t + 2) * kstep; const char* b2 = last ? nB : cB + (size_t)(t + 2) * kstep;
            const char* a3 = a2 + kstep; const char* b3 = b2 + kstep;
            if (last && has_next) S.a_ready(nxt);
            if constexpr (SP2) {
            PG8_LDB(B0, 0, 0); PG8_LDB(B1, 0, 1); PG8_SCHED; PG8_LDA(At, 0, 0); PG8_STAGE(PG8_SA(1, 1), a1 + hstep, voffA);
            PG8_WAIT_V(8); PG8_WAIT_L(0); PG8_BAR; PG8_MMA(0, 0, At, B0); PG8_MMA(0, 1, At, B1); PG8_BAR; PG8_SCHED;
            PG8_LDA(At, 0, 1); PG8_STAGE(PG8_SB(0, 0), b2, voffB); PG8_STAGE(PG8_SB(0, 1), b2 + hstep, voffB); PG8_STAGE(PG8_SA(0, 0), a2, voffA);
            PG8_WAIT_V(8); PG8_WAIT_L(0); PG8_BAR; PG8_MMA(1, 0, At, B0); PG8_MMA(1, 1, At, B1); PG8_BAR; PG8_SCHED;
            PG8_LDB(B0, 1, 0); PG8_LDB(B1, 1, 1); PG8_SCHED; PG8_LDA(At, 1, 0); PG8_STAGE(PG8_SA(0, 1), a2 + hstep, voffA);
            PG8_WAIT_V(8); PG8_WAIT_L(0); PG8_BAR; PG8_MMA(0, 0, At, B0); PG8_MMA(0, 1, At, B1); PG8_BAR; PG8_SCHED;
            PG8_LDA(At, 1, 1); PG8_STAGE(PG8_SB(1, 0), b3, voffB); PG8_STAGE(PG8_SB(1, 1), b3 + hstep, voffB); PG8_STAGE(PG8_SA(1, 0), a3, voffA);
            PG8_WAIT_V(8); PG8_WAIT_L(0); PG8_BAR; PG8_MMA(1, 0, At, B0); PG8_MMA(1, 1, At, B1); PG8_BAR; PG8_SCHED;
            } else {
            PG8_LDB(B0, 0, 0); PG8_SCHED; PG8_LDA(At, 0, 0); PG8_STAGE(PG8_SA(1, 1), a1 + hstep, voffA);
            PG8_WAIT_L(8); PG8_BAR; PG8_WAIT_L(0); PG8_MMA(0, 0, At, B0); PG8_BAR; PG8_SCHED;
            PG8_LDB(B1, 0, 1); PG8_STAGE(PG8_SB(0, 0), b2, voffB);
            PG8_BAR; PG8_WAIT_L(0); PG8_MMA(0, 1, At, B1); PG8_BAR;
            PG8_LDA(At, 0, 1); PG8_STAGE(PG8_SA(0, 0), a2, voffA);
            PG8_BAR; PG8_WAIT_L(0); PG8_MMA(1, 0, At, B0); PG8_BAR; PG8_SCHED;
            PG8_STAGE(PG8_SB(0, 1), b2 + hstep, voffB);
            PG8_WAIT_V(6); PG8_BAR; PG8_MMA(1, 1, At, B1); PG8_BAR;
            PG8_LDB(B0, 1, 0); PG8_SCHED; PG8_LDA(At, 1, 0); PG8_STAGE(PG8_SA(0, 1), a2 + hstep, voffA);
            PG8_WAIT_L(8); PG8_BAR; PG8_WAIT_L(0); PG8_MMA(0, 0, At, B0); PG8_BAR; PG8_SCHED;
            PG8_LDB(B1, 1, 1); PG8_STAGE(PG8_SB(1, 0), b3, voffB);
            PG8_BAR; PG8_WAIT_L(0); PG8_MMA(0, 1, At, B1); PG8_BAR;
            PG8_LDA(At, 1, 1); PG8_STAGE(PG8_SA(1, 0), a3, voffA);
            PG8_BAR; PG8_WAIT_L(0); PG8_MMA(1, 0, At, B0); PG8_BAR; PG8_SCHED;
            PG8_STAGE(PG8_SB(1, 1), b3 + hstep, voffB);
            PG8_WAIT_V(6); PG8_BAR; PG8_MMA(1, 1, At, B1); PG8_BAR;
            }
        }
        if constexpr (ALIGN_EPI) { if (wr == 0) PG8_BAR; }
        if constexpr (!Epi::AFTER_DRAIN) { E(acc, cur, wr, wc, fr, fq); S.done(cur); }
        if (!has_next) break;
#pragma unroll
        for (int a = 0; a < 2; ++a)
#pragma unroll
            for (int b = 0; b < 2; ++b)
#pragma unroll
                for (int m = 0; m < 4; ++m)
#pragma unroll
                    for (int n = 0; n < 2; ++n) acc[a][b][m][n] = (f32x4){0.f, 0.f, 0.f, 0.f};
        cur = nxt; cA = nA; cB = nB; ++ui;
        if constexpr (ALIGN_EPI) { if (wr == 1) PG8_BAR; }
    }
    PG8_WAIT_V(0);
    if constexpr (!ALIGN_EPI) { if (wr == 0) PG8_BAR; }
    PG8_BAR;
    if constexpr (Epi::AFTER_DRAIN) { E.fused(acc, cur, wr, wc, fr, fq, lds, wid, lane); S.done(cur); }
#undef PG8_SA
#undef PG8_SB
#undef PG8_STAGE
#undef PG8_LDA
#undef PG8_LDB
#undef PG8_MMA
#undef PG8_WAIT_V
#undef PG8_WAIT_L
#undef PG8_BAR
#undef PG8_SCHED
}
}
#define LAS __attribute__((address_space(3)))
using pg8::f32x4;
using pg8::u32x4;
constexpr int T_CTX = 8192, T_LAT = 16384, T_ALL = 24576, DM = 1024;
constexpr int NPROJ = 4608, NPROJ_PAD = 4608, NIN = 4624, DFF = 2816, NGU = 5632;
constexpr int NTHR = 512, NWV = 8;
constexpr float EPS = 1e-6f;
constexpr int LDS_BYTES = 132096;

constexpr size_t OUT_HG = 25165824, OUT_MC = 41943040, OUT_MN = 58720256, OUT_MM = 58851328, OUT_TOTAL = 58852352;

constexpr size_t al256(size_t x) { return (x + 255) & ~(size_t)255; }
constexpr size_t WS_WIN = 0;
constexpr size_t WS_WOUT = WS_WIN + al256((size_t)NPROJ_PAD * DM * 2);
constexpr size_t WS_WGU = WS_WOUT + al256((size_t)DM * DM * 2);
constexpr size_t WS_WDN = WS_WGU + al256((size_t)NGU * DM * 2);
constexpr size_t WS_MODP = WS_WDN + al256((size_t)DM * DFF * 2);
constexpr size_t WS_MOD = WS_MODP + al256((size_t)8 * 4 * 9 * 6144 * 4);
constexpr size_t WS_LB = WS_MOD + al256((size_t)4 * 9 * 6144 * 4);
constexpr size_t WS_HN = WS_LB + al256((size_t)4 * 2 * 512 * 4);
constexpr size_t WS_PROJ = WS_HN + al256((size_t)T_ALL * DM * 2);
constexpr size_t WS_GATES = WS_PROJ + al256((size_t)T_ALL * NPROJ * 2);
constexpr size_t WS_QKM = WS_GATES + al256((size_t)T_ALL * 16 * 4);
constexpr size_t WS_OB = WS_QKM + al256((size_t)T_ALL * DM * 2);
constexpr size_t WS_BAR = WS_OB + al256((size_t)T_ALL * DM * 2);
constexpr size_t WS_WG16 = WS_BAR + 16384;
constexpr size_t WS_END = WS_WG16 + 32768;

#if defined(SWAP_OBUF)
#define ODIR(d) (!(d))
#else
#define ODIR(d) (d)
#endif
struct Params {
    const float *x_prompt, *x_sample, *st_hg, *st_mc, *st_mn, *st_mm, *cnd, *c_ctx, *n1w, *n2w, *w_mod, *b_mod, *w_in, *conv_w, *conv_b, *gate_b,
        *lb_logits, *hg_nw, *ml_nw, *w_out, *w_gate, *w_up, *w_down, *fin_w;
    float* out; unsigned char* ws;
};

__device__ __forceinline__ float sigmoidf_(float x) { return __builtin_amdgcn_rcpf(1.f + __expf(-x)); }
__device__ __forceinline__ float siluf_(float x) { return x * __builtin_amdgcn_rcpf(1.f + __expf(-x)); }
__device__ __forceinline__ unsigned pkh(float a, float b) { h16x2 v = {(h16)a, (h16)b}; return __builtin_bit_cast(unsigned, v); }
__device__ __forceinline__ float wave_sum(float v) {
#pragma unroll
    for (int o = 1; o < 64; o <<= 1) v += __shfl_xor(v, o);
    return v;
}
__device__ __forceinline__ int row_cidx(int row) { return row < T_CTX ? 0 : 1 + ((row - T_CTX) >> 11); }
__device__ __forceinline__ int ltid() { int t = threadIdx.x; asm volatile("" : "+v"(t)); return t; }
__device__ __forceinline__ float rdlane(float v, int l) { return __builtin_bit_cast(float, __builtin_amdgcn_readlane(__builtin_bit_cast(int, v), l)); }

struct EpiInProj {
    static constexpr bool PERM = true, AFTER_DRAIN = false;
    h16* proj; float* gates; const float* gate_b;
    __device__ __forceinline__ void operator()(const f32x4 (&acc)[2][2][4][2], const pg8::Unit& u, int wr, int wc, int fr, int fq) const {
        const int row0 = u.pm * 256 + wr * 64 + fr;
#pragma unroll
        for (int bj = 0; bj < 2; ++bj) {
            const int colt = u.pn * 256 + bj * 128, reg = colt >> 9;
            const int act = (reg == 0 || reg == 4) ? 1 : (reg == 8 ? 2 : 0);
            const int col0 = colt + wc * 32 + 8 * fq;
#pragma unroll
            for (int ai = 0; ai < 2; ++ai)
#pragma unroll
                for (int m = 0; m < 4; ++m) {
                    f32x4 v0 = acc[ai][bj][m][0], v1 = acc[ai][bj][m][1];
                    if (act == 1) {
#pragma unroll
                        for (int j = 0; j < 4; ++j) { v0[j] = siluf_(v0[j]); v1[j] = siluf_(v1[j]); }
                    } else if (act == 2) {
#pragma unroll
                        for (int j = 0; j < 4; ++j) { v0[j] = sigmoidf_(v0[j]); v1[j] = sigmoidf_(v1[j]); }
                    }
                    u32x4 w; w.x = pkh(v0[0], v0[1]); w.y = pkh(v0[2], v0[3]); w.z = pkh(v1[0], v1[1]); w.w = pkh(v1[2], v1[3]);
                    *(u32x4*)(proj + (size_t)(row0 + ai * 128 + m * 16) * NPROJ + col0) = w;
                }
        }
    }
};
struct EpiResid {
    static constexpr bool PERM = false, AFTER_DRAIN = false;
    const float* base_ctx; const float* base_lat; float* out; const float* gate;
    __device__ __forceinline__ void operator()(const f32x4 (&acc)[2][2][4][2], const pg8::Unit& u, int wr, int wc, int fr, int fq) const {
        const int cidx = u.pm < 32 ? 0 : 1 + ((u.pm - 32) >> 3);
        const float* gt = gate + cidx * 6144;
        const float* bs = u.pm < 32 ? base_ctx : base_lat - (size_t)T_CTX * DM;
        const int colb = u.pn * 256 + wc * 32 + 4 * fq;
        f32x4 g[2][2];
#pragma unroll
        for (int bj = 0; bj < 2; ++bj)
#pragma unroll
            for (int n = 0; n < 2; ++n) g[bj][n] = *(const f32x4*)(gt + colb + bj * 128 + n * 16);
#pragma unroll
        for (int ai = 0; ai < 2; ++ai)
#pragma unroll
            for (int m = 0; m < 4; ++m) {
                const size_t off = (size_t)(u.pm * 256 + ai * 128 + wr * 64 + m * 16 + fr) * DM + colb;
                f32x4 x[2][2];
#pragma unroll
                for (int bj = 0; bj < 2; ++bj)
#pragma unroll
                    for (int n = 0; n < 2; ++n) x[bj][n] = *(const f32x4*)(bs + off + bj * 128 + n * 16);
#pragma unroll
                for (int bj = 0; bj < 2; ++bj)
#pragma unroll
                    for (int n = 0; n < 2; ++n) *(f32x4*)(out + off + bj * 128 + n * 16) = x[bj][n] + g[bj][n] * acc[ai][bj][m][n];
                asm volatile("" ::: "memory");
            }
    }
};
struct EpiGateUp {
    static constexpr bool PERM = true, AFTER_DRAIN = false;
    h16* ff;
    __device__ __forceinline__ void operator()(const f32x4 (&acc)[2][2][4][2], const pg8::Unit& u, int wr, int wc, int fr, int fq) const {
        const int row0 = u.pm * 256 + wr * 64 + fr, col0 = u.pn * 128 + wc * 32 + 8 * fq;
#pragma unroll
        for (int ai = 0; ai < 2; ++ai)
#pragma unroll
            for (int m = 0; m < 4; ++m) {
                f32x4 v0, v1;
#pragma unroll
                for (int j = 0; j < 4; ++j) { v0[j] = siluf_(acc[ai][0][m][0][j]) * acc[ai][1][m][0][j]; v1[j] = siluf_(acc[ai][0][m][1][j]) * acc[ai][1][m][1][j]; }
                u32x4 w; w.x = pkh(v0[0], v0[1]); w.y = pkh(v0[2], v0[3]); w.z = pkh(v1[0], v1[1]); w.w = pkh(v1[2], v1[3]);
                *(u32x4*)(ff + (size_t)(row0 + ai * 128 + m * 16) * DFF + col0) = w;
            }
    }
};

__device__ __forceinline__ void phase_mod_partial(const Params& p, LAS float* ldsf) {
    const int tidx = ltid();
    for (int e = tidx; e < 9 * 1024; e += NTHR) { const int c = e >> 10, k = e & 1023; const float v = c == 0 ? p.c_ctx[k] : p.cnd[(c - 1) * 1024 + k]; ldsf[e] = siluf_(v); }
    __syncthreads();
    float* modp = (float*)(p.ws + WS_MODP);
    const int wave = tidx >> 6, lane = tidx & 63;
    const int gw = blockIdx.x * NWV + wave, NGW = gridDim.x * NWV;
    for (int it = gw; it < 4 * 96 * 8; it += NGW) {
        const int kq = it & 7, cgp = (it >> 3) % 96, l = it / (8 * 96);
        const int j = cgp * 64 + lane;
        const float* w = p.w_mod + ((size_t)l * 1024 + kq * 128) * 6144 + j;
        float acc[9];
#pragma unroll
        for (int c = 0; c < 9; ++c) acc[c] = 0.f;
#pragma unroll 4
        for (int k4 = 0; k4 < 32; ++k4) {
            const float w0 = w[(size_t)(4 * k4 + 0) * 6144], w1 = w[(size_t)(4 * k4 + 1) * 6144], w2 = w[(size_t)(4 * k4 + 2) * 6144], w3 = w[(size_t)(4 * k4 + 3) * 6144];
#pragma unroll
            for (int c = 0; c < 9; ++c) { const f32x4 s = *(const LAS f32x4*)(ldsf + c * 1024 + kq * 128 + 4 * k4); acc[c] += s.x * w0 + s.y * w1 + s.z * w2 + s.w * w3; }
        }
#pragma unroll
        for (int c = 0; c < 9; ++c) modp[(((size_t)kq * 4 + l) * 9 + c) * 6144 + j] = acc[c];
    }
    if (blockIdx.x == 0) {
        float* lb = (float*)(p.ws + WS_LB);
        for (int e = tidx; e < 1024; e += NTHR) {
            const float x0 = p.lb_logits[e], x1 = p.lb_logits[1024 + e], x2 = p.lb_logits[2048 + e], x3 = p.lb_logits[3072 + e];
            const float mx = fmaxf(fmaxf(x0, x1), fmaxf(x2, x3));
            const float e0 = expf(x0 - mx), e1 = expf(x1 - mx), e2 = expf(x2 - mx), e3 = expf(x3 - mx);
            const float inv = 1.f / (e0 + e1 + e2 + e3);
            lb[e] = 0.f; lb[1024 + e] = e1 * inv; lb[2048 + e] = (e1 + e2) * inv; lb[3072 + e] = (e1 + e2 + e3) * inv;
        }
    }
}
__device__ __forceinline__ void phase_mod_reduce(const Params& p) {
    const float* modp = (const float*)(p.ws + WS_MODP); float* mod = (float*)(p.ws + WS_MOD);
    for (int e = blockIdx.x * NTHR + ltid(); e < 4 * 9 * 6144; e += gridDim.x * NTHR) {
        const int j = e % 6144, l = e / (9 * 6144);
        float s = p.b_mod[l * 6144 + j];
#pragma unroll
        for (int kq = 0; kq < 8; ++kq) s += modp[(size_t)kq * (4 * 9 * 6144) + e];
        mod[e] = s;
    }
}

__device__ __forceinline__ void transpose_item(const float* W, int K, int N, h16* WT, int kb, int n0, int dst_row0, LAS float* scr, int lane) {
    const int k0 = 64 * kb, n = n0 + (lane & 31);
#pragma unroll 8
    for (int i = 0; i < 32; ++i) { const int kk = 2 * i + (lane >> 5); scr[kk * 33 + (lane & 31)] = (n < N) ? W[(size_t)(k0 + kk) * N + n] : 0.f; }
    asm volatile("s_waitcnt lgkmcnt(0)" ::: "memory");
    const int c = lane & 7;
#pragma unroll
    for (int j = 0; j < 4; ++j) {
        const int nn = (lane >> 3) + 8 * j; const LAS float* s = scr + (8 * c) * 33 + nn;
        u32x4 o; o.x = pkh(s[0 * 33], s[1 * 33]); o.y = pkh(s[2 * 33], s[3 * 33]); o.z = pkh(s[4 * 33], s[5 * 33]); o.w = pkh(s[6 * 33], s[7 * 33]);
        *(u32x4*)(WT + (size_t)(dst_row0 + nn) * K + k0 + 8 * c) = o;
    }
    asm volatile("s_waitcnt lgkmcnt(0)" ::: "memory");
}
__device__ __forceinline__ void convert_weights(const Params& p, int l, LAS float* scr, int gw, int NGW, int lane) {
    {
        h16* wg = (h16*)(p.ws + WS_WG16);
        const float* src = p.w_in + (size_t)l * DM * NIN + NPROJ;
        for (int e = gw * 64 + lane; e < 16 * 1024; e += NGW * 64) { const int k = e >> 4, g = e & 15; wg[g * 1024 + k] = (h16)src[(size_t)k * NIN + g]; }
    }
    h16* win = (h16*)(p.ws + WS_WIN); h16* wout = (h16*)(p.ws + WS_WOUT); h16* wgu = (h16*)(p.ws + WS_WGU); h16* wdn = (h16*)(p.ws + WS_WDN);
    constexpr int I_IN = 16 * 144, I_OUT = 16 * 32, I_G = 16 * 88, I_DN = 44 * 32;
    for (int it = gw; it < I_IN + I_OUT + 2 * I_G + I_DN; it += NGW) {
        int r = it;
        if (r < I_IN) { const int kb = r / 144, nb = r % 144; transpose_item(p.w_in + (size_t)l * DM * NIN, DM, NIN, win, kb, 32 * nb, 32 * nb, scr, lane); continue; } r -= I_IN;
        if (r < I_OUT) { const int kb = r / 32, nb = r % 32; transpose_item(p.w_out + (size_t)l * DM * DM, DM, DM, wout, kb, 32 * nb, 32 * nb, scr, lane); continue; } r -= I_OUT;
        if (r < I_G) { const int kb = r / 88, nb = r % 88, n0 = 32 * nb; transpose_item(p.w_gate + (size_t)l * DM * DFF, DM, DFF, wgu, kb, n0, (n0 >> 7) * 256 + (n0 & 127), scr, lane); continue; } r -= I_G;
        if (r < I_G) { const int kb = r / 88, nb = r % 88, n0 = 32 * nb; transpose_item(p.w_up + (size_t)l * DM * DFF, DM, DFF, wgu, kb, n0, (n0 >> 7) * 256 + 128 + (n0 & 127), scr, lane); continue; } r -= I_G;
        { const int kb = r / 32, nb = r % 32; transpose_item(p.w_down + (size_t)l * DFF * DM, DFF, DM, wdn, kb, 32 * nb, 32 * nb, scr, lane); }
    }
}
__device__ __forceinline__ void norm_mod_row(const float* xrow, const float* nw, const float* sc, const float* sh, h16* orow, int lane) {
    const f32x4* xr = (const f32x4*)xrow + lane;
    f32x4 v[4]; float s = 0.f;
#pragma unroll
    for (int j = 0; j < 4; ++j) { v[j] = xr[64 * j]; s += (v[j].x * v[j].x + v[j].y * v[j].y) + (v[j].z * v[j].z + v[j].w * v[j].w); }
    const float rstd = rsqrtf(wave_sum(s) * (1.f / DM) + EPS);
#pragma unroll
    for (int j = 0; j < 4; ++j) {
        const int col = 4 * lane + 256 * j;
        const f32x4 w4 = *(const f32x4*)(nw + col), s4 = *(const f32x4*)(sc + col), h4 = *(const f32x4*)(sh + col);
        const f32x4 y = v[j] * rstd * w4 * (1.f + s4) + h4;
        uint2 o; o.x = pkh(y.x, y.y); o.y = pkh(y.z, y.w);
        *(uint2*)(orow + col) = o;
    }
}
__device__ __forceinline__ void phase_norm(const Params& p, int l, int which, bool from_inputs, int gw, int NGW, int lane) {
    const float* mod = (const float*)(p.ws + WS_MOD) + (size_t)l * 9 * 6144;
    const float* nw = (which == 0 ? p.n1w : p.n2w) + l * DM;
    h16* hn = (h16*)(p.ws + WS_HN);
    for (int r = gw; r < T_ALL; r += NGW) {
        const float* xrow = from_inputs ? (r < T_CTX ? p.x_prompt + (size_t)r * DM : p.x_sample + (size_t)(r - T_CTX) * DM) : p.out + (size_t)r * DM;
        const float* m = mod + row_cidx(r) * 6144 + which * 3072;
        norm_mod_row(xrow, nw, m + 1024, m, hn + (size_t)r * DM, lane);
    }
}
__device__ __forceinline__ void phase_final_norm(const Params& p, int gw, int NGW, int lane) {
    for (int r = gw; r < T_ALL; r += NGW) {
        f32x4* xr = (f32x4*)(p.out + (size_t)r * DM) + lane;
        f32x4 v[4]; float s = 0.f;
#pragma unroll
        for (int j = 0; j < 4; ++j) { v[j] = xr[64 * j]; s += (v[j].x * v[j].x + v[j].y * v[j].y) + (v[j].z * v[j].z + v[j].w * v[j].w); }
        const float rstd = rsqrtf(wave_sum(s) * (1.f / DM) + EPS);
#pragma unroll
        for (int j = 0; j < 4; ++j) { const f32x4 w4 = *(const f32x4*)(p.fin_w + 4 * lane + 256 * j); xr[64 * j] = v[j] * rstd * w4; }
    }
}
__device__ __forceinline__ void phase_gates(const Params& p, int l, int gw, int NGW, int lane) {
    const h16* hn = (const h16*)(p.ws + WS_HN); const h16* wg = (const h16*)(p.ws + WS_WG16);
    float* gates = (float*)(p.ws + WS_GATES);
    const int c = lane & 15, q = lane >> 4;
    for (int grp = gw; grp < T_ALL / 16; grp += NGW) {
        const h16* ar = hn + (size_t)(16 * grp + c) * DM + 8 * q;
        const h16* br = wg + (size_t)c * DM + 8 * q;
        f32x4 acc = {0.f, 0.f, 0.f, 0.f};
#pragma unroll 8
        for (int kp = 0; kp < 32; ++kp) {
            const h16x8 a = *(const h16x8*)(ar + 32 * kp), bq = *(const h16x8*)(br + 32 * kp);
            acc = __builtin_amdgcn_mfma_f32_16x16x32_f16(a, bq, acc, 0, 0, 0);
        }
        const float bias = p.gate_b[l * 16 + c];
#pragma unroll
        for (int j = 0; j < 4; ++j) gates[(size_t)(16 * grp + 4 * q + j) * 16 + c] = acc[j] + bias;
    }
}
__device__ __forceinline__ void phase_conv(const Params& p, int l) {
    const h16* proj = (const h16*)(p.ws + WS_PROJ); h16* qkm = (h16*)(p.ws + WS_QKM);
    const float* cw = p.conv_w + (size_t)l * 9 * 1024; const float* cb = p.conv_b + l * 1024;
    for (int idx = blockIdx.x * NTHR + ltid(); idx < T_ALL * 128; idx += gridDim.x * NTHR) {
        const int r = idx >> 7, ch0 = (idx & 127) * 8;
        float acc[8];
        { const f32x4 b0 = *(const f32x4*)(cb + ch0), b1 = *(const f32x4*)(cb + ch0 + 4); acc[0] = b0.x; acc[1] = b0.y; acc[2] = b0.z; acc[3] = b0.w; acc[4] = b1.x; acc[5] = b1.y; acc[6] = b1.z; acc[7] = b1.w; }
        const h16* src = proj + 2560 + ch0;
        const bool lat = r >= T_CTX;
        const int pp = lat ? ((r - T_CTX) & 2047) : (r & 255);
        const int gy = lat ? (pp >> 6) : 0, gx = lat ? (pp & 63) : pp;
        const int H = lat ? 32 : 1, W = lat ? 64 : 256;
#pragma unroll
        for (int a = 0; a < 3; ++a) {
            const int yy = gy + a - 1;
            if (!lat && a != 1) continue;
            if (yy < 0 || yy >= H) continue;
#pragma unroll
            for (int b = 0; b < 3; ++b) {
                const int xx = gx + b - 1;
                if (xx < 0 || xx >= W) continue;
                const int rr = r + (a - 1) * 64 + (b - 1);
                const h16x8 x = *(const h16x8*)(src + (size_t)rr * NPROJ);
                const f32x4 t0 = *(const f32x4*)(cw + (a * 3 + b) * 1024 + ch0), t1 = *(const f32x4*)(cw + (a * 3 + b) * 1024 + ch0 + 4);
                acc[0] += t0.x * (float)x[0]; acc[1] += t0.y * (float)x[1]; acc[2] += t0.z * (float)x[2]; acc[3] += t0.w * (float)x[3];
                acc[4] += t1.x * (float)x[4]; acc[5] += t1.y * (float)x[5]; acc[6] += t1.z * (float)x[6]; acc[7] += t1.w * (float)x[7];
            }
        }
        const float sc = ch0 >= 512 ? 0.08838834764831845f : 1.f;
        u32x4 w; w.x = pkh(siluf_(acc[0]) * sc, siluf_(acc[1]) * sc); w.y = pkh(siluf_(acc[2]) * sc, siluf_(acc[3]) * sc);
        w.z = pkh(siluf_(acc[4]) * sc, siluf_(acc[5]) * sc); w.w = pkh(siluf_(acc[6]) * sc, siluf_(acc[7]) * sc);
        *(u32x4*)(qkm + (size_t)r * DM + ch0) = w;
    }
}

template <int TYPE  , int CMP = 0>
__device__ __forceinline__ void scan_item(const Params& p, int l, int lat, int b, int h, int dir, LAS float* lds) {
    const int tid = ltid(), lane = tid & 63, w = __builtin_amdgcn_readfirstlane(tid >> 6);
    const int L = lat ? 2048 : 256, row0 = lat ? T_CTX + b * 2048 : b * 256, NB = L / 16;
    LAS float* qs = lds;
    LAS float* fs = lds + 2048;
    LAS float* vs = lds + 4096;
    LAS float* part = lds + 6144;
    LAS float* partn = lds + 6144 + 16384;
    LAS float* scal = partn + 128;
    LAS float* mst = scal + 128;
    LAS float* cerr = mst + 16;
    LAS float* cref = cerr + 32;
    const h16* proj = (const h16*)(p.ws + WS_PROJ); const h16* qkm = (const h16*)(p.ws + WS_QKM); const float* gates = (const float*)(p.ws + WS_GATES);
    h16* odst = (h16*)(p.ws + (ODIR(dir) ? WS_OB : WS_HN));
    const size_t sidx = (((size_t)b * 4 + l) * 2 + dir) * 4 + h;
    if (CMP) { if (tid < 64) cerr[tid] = 0.f; __syncthreads(); }

    f32x2 S[16]; float nv = 0.f;
    if (lat) {
        const float* src = (TYPE == 0 ? p.st_hg : p.st_mc) + sidx * 16384;
#pragma unroll
        for (int dd = 0; dd < 16; ++dd) S[dd] = *(const f32x2*)(src + (16 * w + dd) * 128 + 2 * lane);
        if (TYPE == 1) { nv = lane < 16 ? p.st_mn[sidx * 128 + 16 * w + lane] : 0.f; if (tid == 0) mst[0] = p.st_mm[sidx]; }
    } else {
#pragma unroll
        for (int dd = 0; dd < 16; ++dd) S[dd] = (f32x2){0.f, 0.f};
        if (TYPE == 1 && tid == 0) mst[0] = 0.f;
    }
    const int tl = tid >> 5, d0 = 4 * (tid & 31);
    f32x4 lb4 = {0.f, 0.f, 0.f, 0.f};
    if (TYPE == 0) lb4 = *(const f32x4*)((const float*)(p.ws + WS_LB) + (l * 2 + dir) * 512 + h * 128 + d0);
    h16x4 pq, pz, pv; float pgi = 0.f, pgf = 0.f;
#define SCAN_LOAD(ii) do { const int pos_ = 16 * (ii) + tl, tok_ = dir ? L - 1 - pos_ : pos_; const size_t r_ = (size_t)(row0 + tok_); \
        if (TYPE == 0) { pq = *(const h16x4*)(proj + r_ * NPROJ + h * 128 + d0); pz = *(const h16x4*)(proj + r_ * NPROJ + 512 + dir * 512 + h * 128 + d0); pv = *(const h16x4*)(proj + r_ * NPROJ + 1536 + h * 128 + d0); } \
        else { pq = *(const h16x4*)(qkm + r_ * DM + h * 128 + d0); pz = *(const h16x4*)(qkm + r_ * DM + 512 + h * 128 + d0); pv = *(const h16x4*)(proj + r_ * NPROJ + 3584 + h * 128 + d0); \
               if (w == 0) { const int ps_ = 16 * (ii) + (lane & 15), tk_ = dir ? L - 1 - ps_ : ps_; const float* g_ = gates + (size_t)(row0 + tk_) * 16; pgi = g_[dir * 4 + h]; pgf = g_[8 + dir * 4 + h]; } } } while (0)
    SCAN_LOAD(0);
    for (int i = 0; i < NB; ++i) {
        const int par = i & 1;
        const int pos = 16 * i + tl, tok = dir ? L - 1 - pos : pos;
        const size_t r = (size_t)(row0 + tok);
        {
            *(LAS f32x4*)(qs + tl * 128 + d0) = (f32x4){(float)pq[0], (float)pq[1], (float)pq[2], (float)pq[3]};
            *(LAS f32x4*)(vs + tl * 128 + d0) = (f32x4){(float)pv[0], (float)pv[1], (float)pv[2], (float)pv[3]};
            if (TYPE == 0) {
                f32x4 f4;
#pragma unroll
                for (int j = 0; j < 4; ++j) f4[j] = lb4[j] + (1.f - lb4[j]) * sigmoidf_((float)pz[j]);
                *(LAS f32x4*)(fs + tl * 128 + d0) = f4;
            } else {
                *(LAS f32x4*)(fs + tl * 128 + d0) = (f32x4){(float)pz[0], (float)pz[1], (float)pz[2], (float)pz[3]};
                if (w == 0) {
                    const int t = lane & 15;
                    const float m0 = mst[0];
                    const float gi = pgi, lf = fminf(pgf, 0.f) - log1pf(__expf(-fabsf(pgf)));
                    float bc = lf;
#pragma unroll
                    for (int o = 1; o < 16; o <<= 1) { const float x = __shfl_up(bc, o, 16); if (t >= o) bc += x; }
                    float pm = gi - bc;
#pragma unroll
                    for (int o = 1; o < 16; o <<= 1) { const float x = __shfl_up(pm, o, 16); if (t >= o) pm = fmaxf(pm, x); }
                    const float mt = bc + fmaxf(m0, pm);
                    float mp = __shfl_up(mt, 1, 16); if (t == 0) mp = m0;
                    if (lane < 16) {
                        scal[(par * 16 + t) * 4 + 0] = __expf(lf + mp - mt);
                        scal[(par * 16 + t) * 4 + 1] = __expf(gi - mt);
                        scal[(par * 16 + t) * 4 + 2] = __expf(-mt);
                    }
                    asm volatile("s_waitcnt lgkmcnt(0)" ::: "memory");
                    if (lane == 15) mst[0] = mt;
                }
            }
        }
        if (i + 1 < NB) SCAN_LOAD(i + 1);
        __syncthreads();
#pragma unroll 2
        for (int t = 0; t < 16; ++t) {
            float fv = 0.f, qv = 0.f;
            if (lane < 16) { fv = fs[t * 128 + 16 * w + lane]; qv = qs[t * 128 + 16 * w + lane]; }
            const f32x2 v2 = *(const LAS f32x2*)(vs + t * 128 + 2 * lane);
            f32x2 o = {0.f, 0.f};
            if (TYPE == 0) {
#pragma unroll
                for (int dd = 0; dd < 16; ++dd) { const float sf = rdlane(fv, dd), sq = rdlane(qv, dd); S[dd] = v2 + sf * (S[dd] - v2); o += S[dd] * sq; }
            } else {
                const float a = __builtin_bit_cast(float, __builtin_amdgcn_readfirstlane(__builtin_bit_cast(int, scal[(par * 16 + t) * 4 + 0])));
                const float g = __builtin_bit_cast(float, __builtin_amdgcn_readfirstlane(__builtin_bit_cast(int, scal[(par * 16 + t) * 4 + 1])));
                const float gk = g * fv;
                nv = a * nv + gk;
                float nq = nv * qv;
                nq += __shfl_xor(nq, 8); nq += __shfl_xor(nq, 4); nq += __shfl_xor(nq, 2); nq += __shfl_xor(nq, 1);
                if (lane == 0) partn[t * 8 + w] = nq;
#pragma unroll
                for (int dd = 0; dd < 16; ++dd) { const float sk = rdlane(gk, dd), sq = rdlane(qv, dd); S[dd] = a * S[dd] + sk * v2; o += S[dd] * sq; }
            }
            *(LAS f32x2*)(part + (t * 8 + w) * 128 + 2 * lane) = o;
        }
        __syncthreads();
        {
            f32x4 acc = {0.f, 0.f, 0.f, 0.f};
#pragma unroll
            for (int ww = 0; ww < 8; ++ww) acc += *(const LAS f32x4*)(part + (tl * 8 + ww) * 128 + d0);
            if (TYPE == 1) {
                float den = 0.f;
#pragma unroll
                for (int ww = 0; ww < 8; ++ww) den += partn[tl * 8 + ww];
                const float sc = 1.f / fmaxf(fabsf(den), scal[(par * 16 + tl) * 4 + 2]);
                acc = acc * sc;
            }
            uint2 o; o.x = pkh(acc.x, acc.y); o.y = pkh(acc.z, acc.w);
            if (CMP) {
                const h16x4 old = *(const h16x4*)(odst + r * DM + TYPE * 512 + h * 128 + d0);
                float e = 0.f, rr = 0.f;
#pragma unroll
                for (int j = 0; j < 4; ++j) { const float df = (float)old[j] - acc[j]; e += df * df; rr += acc[j] * acc[j]; }
                e = wave_sum(e); rr = wave_sum(rr);
                if (lane == 0) { atomicAdd((float*)(cerr + (i >> 2)), e); atomicAdd((float*)(cref + (i >> 2)), rr); }
            }
            *(uint2*)(odst + r * DM + TYPE * 512 + h * 128 + d0) = o;
        }
    }
    if (CMP) {
        __syncthreads();
        if (tid == 0) {
            float best = -1.f; int bc_ = 0; float tot_e = 0.f, tot_r = 0.f;
            for (int cI = 0; cI < 32; ++cI) { const float rt = cerr[cI] / fmaxf(cref[cI], 1e-30f); tot_e += cerr[cI]; tot_r += cref[cI]; if (rt > best) { best = rt; bc_ = cI; } }
            float* dg = (float*)(p.ws + WS_MODP) + 4 * blockIdx.x;
#if defined(DIAG_ALL)
            const float tot = tot_e / fmaxf(tot_r, 1e-30f);
            if (tot > dg[0]) { dg[0] = tot; dg[1] = (float)(l * 8 + TYPE * 4 + lat * 2 + dir); dg[2] = best; dg[3] = (float)bc_; }
#else
            dg[0] = best; dg[1] = (float)bc_; dg[2] = tot_e / fmaxf(tot_r, 1e-30f); dg[3] = 0.f;
#endif
        }
    }
    if (!lat) {
        float* dst = p.out + (TYPE == 0 ? OUT_HG : OUT_MC) + sidx * 16384;
#pragma unroll
        for (int dd = 0; dd < 16; ++dd) *(f32x2*)(dst + (16 * w + dd) * 128 + 2 * lane) = S[dd];
        if (TYPE == 1) { if (lane < 16) p.out[OUT_MN + sidx * 128 + 16 * w + lane] = nv; if (tid == 0) p.out[OUT_MM + sidx] = mst[0]; }
    }
    __syncthreads();
#undef SCAN_LOAD
}
typedef unsigned u32x2 __attribute__((ext_vector_type(2)));
typedef short s16x8 __attribute__((ext_vector_type(8)));
typedef short s16x4 __attribute__((ext_vector_type(4)));
typedef __bf16 bf16x2_t __attribute__((ext_vector_type(2)));
__device__ __forceinline__ unsigned pkb(float a, float b) { f32x2 v = {a, b}; bf16x2_t r = __builtin_convertvector(v, bf16x2_t); return __builtin_bit_cast(unsigned, r); }
__device__ __forceinline__ unsigned short f2b(float a) { return (unsigned short)(pkb(a, 0.f) & 0xffffu); }
__device__ __forceinline__ s16x4 tr_read(LAS const unsigned char* ptr) { return __builtin_bit_cast(s16x4, __builtin_amdgcn_ds_read_tr16_b64_v4i16((LAS s16x4*)ptr)); }
constexpr int HP = 272;
__device__ __forceinline__ void scan_hgrn_mfma(const Params& p, int l, int lat, int b, int h, int dir, LAS unsigned char* lds) {
    const int tid = ltid(), lane = tid & 63, w = __builtin_amdgcn_readfirstlane(tid >> 6), c = lane & 15, q = lane >> 4;
    const int L = lat ? 2048 : 256, row0 = lat ? T_CTX + b * 2048 : b * 256, NB = L / 16;
    constexpr int IMG = 16 * HP, BUF = 4 * IMG + 512;
    LAS float* GS = (LAS float*)(lds + 2 * BUF);
    const h16* proj = (const h16*)(p.ws + WS_PROJ);
    h16* odst = (h16*)(p.ws + (ODIR(dir) ? WS_OB : WS_HN));
    const size_t sidx = (((size_t)b * 4 + l) * 2 + dir) * 4 + h;
    f32x4 S[8];
    if (lat) {
        const float* src = p.st_hg + sidx * 16384;
#pragma unroll
        for (int dt = 0; dt < 8; ++dt)
#pragma unroll
            for (int j = 0; j < 4; ++j) S[dt][j] = src[(16 * dt + 4 * q + j) * 128 + 16 * w + c];
    } else {
#pragma unroll
        for (int dt = 0; dt < 8; ++dt) S[dt] = (f32x4){0.f, 0.f, 0.f, 0.f};
    }
    const int pt = lane & 15, d0 = 16 * w + 4 * (lane >> 4);
    const f32x4 lb4 = *(const f32x4*)((const float*)(p.ws + WS_LB) + (l * 2 + dir) * 512 + h * 128 + d0);
    h16x4 rq, rz, rv;
#define HG_LOAD(ii) do { const int pos_ = 16 * (ii) + pt, tok_ = dir ? L - 1 - pos_ : pos_; const h16* r_ = proj + (size_t)(row0 + tok_) * NPROJ + h * 128 + d0; \
        rq = *(const h16x4*)(r_); rz = *(const h16x4*)(r_ + 512 + dir * 512); rv = *(const h16x4*)(r_ + 1536); } while (0)
#define HG_ROW_SHR(x, ctl) __builtin_bit_cast(float, __builtin_amdgcn_update_dpp(0, __builtin_bit_cast(int, (x)), (ctl), 0xF, 0xF, false))
    HG_LOAD(0);
    for (int i = 0; i < NB; ++i) {
        LAS unsigned char* buf = lds + (i & 1) * BUF;
        LAS unsigned char* QT = buf; LAS unsigned char* KT = buf + IMG; LAS unsigned char* KH = buf + 2 * IMG; LAS unsigned char* VV = buf + 3 * IMG; LAS float* AD = (LAS float*)(buf + 4 * IMG);
        asm volatile("s_waitcnt vmcnt(0)" ::: "memory");
        {
            float kk[4], G[4], tot[4];
#pragma unroll
            for (int j = 0; j < 4; ++j) { const float f = lb4[j] + (1.f - lb4[j]) * sigmoidf_((float)rz[j]); kk[j] = 1.f - f; G[j] = __logf(f); }
#pragma unroll
            for (int j = 0; j < 4; ++j) {
                G[j] += HG_ROW_SHR(G[j], 0x111); G[j] += HG_ROW_SHR(G[j], 0x112); G[j] += HG_ROW_SHR(G[j], 0x114); G[j] += HG_ROW_SHR(G[j], 0x118);
                tot[j] = __shfl(G[j], 15, 16);
            }
            float oq[4], ok[4], oh[4];
#pragma unroll
            for (int j = 0; j < 4; ++j) { const float e = __expf(G[j]), ei = __expf(fminf(-G[j], 60.f)), eh = __expf(tot[j] - G[j]); oq[j] = (float)rq[j] * e; ok[j] = kk[j] * ei; oh[j] = kk[j] * eh; }
            u32x2 wq, wk, wh, wv;
            wq.x = pkb(oq[0], oq[1]); wq.y = pkb(oq[2], oq[3]); wk.x = pkb(ok[0], ok[1]); wk.y = pkb(ok[2], ok[3]);
            wh.x = pkb(oh[0], oh[1]); wh.y = pkb(oh[2], oh[3]); wv.x = pkb((float)rv[0], (float)rv[1]); wv.y = pkb((float)rv[2], (float)rv[3]);
            *(LAS u32x2*)(QT + pt * HP + 2 * d0) = wq; *(LAS u32x2*)(KT + pt * HP + 2 * d0) = wk; *(LAS u32x2*)(KH + pt * HP + 2 * d0) = wh; *(LAS u32x2*)(VV + pt * HP + 2 * d0) = wv;
            if (pt == 15) *(LAS f32x4*)(AD + d0) = (f32x4){__expf(tot[0]), __expf(tot[1]), __expf(tot[2]), __expf(tot[3])};
        }
        { const int nx = (i + 1 < NB) ? i + 1 : NB - 1; HG_LOAD(nx); }
        __syncthreads();
        {
            f32x4 accO = {0.f, 0.f, 0.f, 0.f};
#pragma unroll
            for (int kp = 0; kp < 4; ++kp) {
                u32x4 sa; sa.x = pkb(S[2 * kp][0], S[2 * kp][1]); sa.y = pkb(S[2 * kp][2], S[2 * kp][3]); sa.z = pkb(S[2 * kp + 1][0], S[2 * kp + 1][1]); sa.w = pkb(S[2 * kp + 1][2], S[2 * kp + 1][3]);
                const u32x2 b0 = *(const LAS u32x2*)(QT + c * HP + 2 * (32 * kp + 4 * q)), b1 = *(const LAS u32x2*)(QT + c * HP + 2 * (32 * kp + 16 + 4 * q));
                u32x4 bb; bb.x = b0.x; bb.y = b0.y; bb.z = b1.x; bb.w = b1.y;
                accO = __builtin_amdgcn_mfma_f32_16x16x32_bf16(__builtin_bit_cast(s16x8, sa), __builtin_bit_cast(s16x8, bb), accO, 0, 0, 0);
            }
            f32x4 accP = {0.f, 0.f, 0.f, 0.f};
#pragma unroll
            for (int kp = 0; kp < 4; ++kp) {
                const s16x8 a = *(const LAS s16x8*)(KT + c * HP + 2 * (32 * kp + 8 * q));
                const s16x8 bq = *(const LAS s16x8*)(QT + c * HP + 2 * (32 * kp + 8 * q));
                accP = __builtin_amdgcn_mfma_f32_16x16x32_bf16(a, bq, accP, 0, 0, 0);
            }
#pragma unroll
            for (int j = 0; j < 4; ++j) accP[j] = (4 * q + j > c) ? 0.f : accP[j];
            u32x2 pb; pb.x = pkb(accP[0], accP[1]); pb.y = pkb(accP[2], accP[3]);
            const s16x4 vtr = tr_read(VV + (4 * q + (c >> 2)) * HP + 2 * (16 * w + 4 * (c & 3)));
            accO = __builtin_amdgcn_mfma_f32_16x16x16bf16_1k(vtr, __builtin_bit_cast(s16x4, pb), accO, 0, 0, 0);
            {
                const int pos = 16 * i + c, tok = dir ? L - 1 - pos : pos;
                uint2 o; o.x = pkh(accO[0], accO[1]); o.y = pkh(accO[2], accO[3]);
                *(uint2*)(odst + (size_t)(row0 + tok) * DM + h * 128 + 16 * w + 4 * q) = o;
            }
#pragma unroll
            for (int dt = 0; dt < 8; ++dt) {
                const s16x4 ktr = tr_read(KH + (4 * q + (c >> 2)) * HP + 2 * (16 * dt + 4 * (c & 3)));
                const f32x4 ad = *(const LAS f32x4*)(AD + 16 * dt + 4 * q);
                S[dt] = S[dt] * ad;
                S[dt] = __builtin_amdgcn_mfma_f32_16x16x16bf16_1k(ktr, vtr, S[dt], 0, 0, 0);
            }
        }
#if defined(HG_EXTRA_SYNC)
        asm volatile("s_waitcnt vmcnt(0) lgkmcnt(0)" ::: "memory");
        __syncthreads();
#endif
    }
    if (!lat) {
        float* dst = p.out + OUT_HG + sidx * 16384;
#pragma unroll
        for (int dt = 0; dt < 8; ++dt)
#pragma unroll
            for (int j = 0; j < 4; ++j) dst[(16 * dt + 4 * q + j) * 128 + 16 * w + c] = S[dt][j];
    }
    __syncthreads();
#undef HG_LOAD
#undef HG_ROW_SHR
}
constexpr int MP = 272;
constexpr int PP = 144;
__device__ __forceinline__ void scan_mlstm_mfma(const Params& p, int l, int lat, int b, int h, int dir, LAS unsigned char* lds) {
    const int tid = ltid(), lane = tid & 63, w = __builtin_amdgcn_readfirstlane(tid >> 6), c = lane & 15, q = lane >> 4;
    const int L = lat ? 2048 : 256, row0 = lat ? T_CTX + b * 2048 : b * 256, NC = L / 64;
    constexpr int IMG = 64 * MP, BUF = 3 * IMG + 1536;
    LAS unsigned char* PM = lds + 2 * BUF;
    LAS float* DENP = (LAS float*)(PM + 64 * PP);
    LAS float* QNP = DENP + 256;
    LAS float* NP = QNP + 512;
    LAS float* NV = NP + 512;
    LAS float* mst = NV + 128;
    const h16* proj = (const h16*)(p.ws + WS_PROJ); const h16* qkm = (const h16*)(p.ws + WS_QKM); const float* gates = (const float*)(p.ws + WS_GATES);
    h16* odst = (h16*)(p.ws + (ODIR(dir) ? WS_OB : WS_HN));
    const size_t sidx = (((size_t)b * 4 + l) * 2 + dir) * 4 + h;
    f32x4 C[8];
    if (lat) {
        const float* src = p.st_mc + sidx * 16384;
#pragma unroll
        for (int dt = 0; dt < 8; ++dt)
#pragma unroll
            for (int j = 0; j < 4; ++j) C[dt][j] = src[(16 * dt + 4 * q + j) * 128 + 16 * w + c];
        if (tid < 128) NV[tid] = p.st_mn[sidx * 128 + tid];
        if (tid == 0) mst[0] = p.st_mm[sidx];
    } else {
#pragma unroll
        for (int dt = 0; dt < 8; ++dt) C[dt] = (f32x4){0.f, 0.f, 0.f, 0.f};
        if (tid < 128) NV[tid] = 0.f;
        if (tid == 0) mst[0] = 0.f;
    }
    u32x4 pq[2], pk[2], pv[2]; float pgi = 0.f, pgf = 0.f;
#define ML_LOAD(ii) do { _Pragma("unroll") for (int j_ = 0; j_ < 2; ++j_) { const int e_ = tid + 512 * j_, rw_ = e_ >> 4, pc_ = e_ & 15; const int pos_ = 64 * (ii) + rw_, tok_ = dir ? L - 1 - pos_ : pos_; \
            const size_t r_ = (size_t)(row0 + tok_); pq[j_] = *(const u32x4*)(qkm + r_ * DM + h * 128 + 8 * pc_); pk[j_] = *(const u32x4*)(qkm + r_ * DM + 512 + h * 128 + 8 * pc_); \
            pv[j_] = *(const u32x4*)(proj + r_ * NPROJ + 3584 + h * 128 + 8 * pc_); } \
        if (w == 0) { const int ps_ = 64 * (ii) + lane, tk_ = dir ? L - 1 - ps_ : ps_; const float* g_ = gates + (size_t)(row0 + tk_) * 16; pgi = g_[dir * 4 + h]; pgf = g_[8 + dir * 4 + h]; } } while (0)
    ML_LOAD(0);
    for (int i = 0; i < NC; ++i) {
        LAS unsigned char* buf = lds + (i & 1) * BUF;
        LAS unsigned char* QM = buf; LAS unsigned char* KM = buf + IMG; LAS unsigned char* VM = buf + 2 * IMG;
        LAS float* U = (LAS float*)(buf + 3 * IMG); LAS float* MM = U + 64; LAS float* AI = U + 128; LAS float* EN = U + 192; LAS float* UE = U + 256;
        asm volatile("s_waitcnt vmcnt(0)" ::: "memory");
#pragma unroll
        for (int j = 0; j < 2; ++j) { const int e = tid + 512 * j, rw = e >> 4, pc = e & 15;
            *(LAS u32x4*)(QM + rw * MP + 16 * pc) = pq[j]; *(LAS u32x4*)(KM + rw * MP + 16 * pc) = pk[j]; *(LAS u32x4*)(VM + rw * MP + 16 * pc) = pv[j]; }
        if (w == 0) {
            const float m0 = mst[0];
            const float gi = pgi, lf = fminf(pgf, 0.f) - log1pf(__expf(-fabsf(pgf)));
            float bc = lf;
#pragma unroll
            for (int o = 1; o < 64; o <<= 1) { const float x = __shfl_up(bc, o); if (lane >= o) bc += x; }
            const float u = gi - bc;
            float pm = u;
#pragma unroll
            for (int o = 1; o < 64; o <<= 1) { const float x = __shfl_up(pm, o); if (lane >= o) pm = fmaxf(pm, x); }
            const float Mt = fmaxf(m0, pm);
            const float M63 = rdlane(Mt, 63), bc63 = rdlane(bc, 63);
            U[lane] = u; MM[lane] = Mt; AI[lane] = __expf(m0 - Mt); EN[lane] = __expf(-(bc + Mt)); UE[lane] = __expf(u - M63);
            asm volatile("s_waitcnt lgkmcnt(0)" ::: "memory");
            if (lane == 0) mst[0] = bc63 + M63;
        }
        { const int nx = (i + 1 < NC) ? i + 1 : NC - 1; ML_LOAD(nx); }
        __syncthreads();
        {
            const int tt = w >> 1;
#pragma unroll
            for (int k2 = 0; k2 < 2; ++k2) {
                const int st = 2 * (w & 1) + k2;
                if (st <= tt) {
                    f32x4 accP = {0.f, 0.f, 0.f, 0.f};
#pragma unroll
                    for (int kp = 0; kp < 4; ++kp) {
                        const h16x8 a = *(const LAS h16x8*)(KM + (16 * st + c) * MP + 2 * (32 * kp + 8 * q));
                        const h16x8 bq = *(const LAS h16x8*)(QM + (16 * tt + c) * MP + 2 * (32 * kp + 8 * q));
                        accP = __builtin_amdgcn_mfma_f32_16x16x32_f16(a, bq, accP, 0, 0, 0);
                    }
                    const f32x4 u4 = *(const LAS f32x4*)(U + 16 * st + 4 * q); const float mt = MM[16 * tt + c];
                    float pj[4];
#pragma unroll
                    for (int j = 0; j < 4; ++j) { const float e = accP[j] * __expf(u4[j] - mt); pj[j] = (16 * st + 4 * q + j <= 16 * tt + c) ? e : 0.f; }
                    u32x2 pw; pw.x = pkh(pj[0], pj[1]); pw.y = pkh(pj[2], pj[3]);
                    *(LAS u32x2*)(PM + (16 * tt + c) * PP + 2 * (16 * st + 4 * q)) = pw;
                    float cs = (pj[0] + pj[1]) + (pj[2] + pj[3]);
                    cs += __shfl_xor(cs, 16); cs += __shfl_xor(cs, 32);
                    if (q == 0) DENP[st * 64 + 16 * tt + c] = cs;
                }
            }
            {
                const h16x8 qa = *(const LAS h16x8*)(QM + lane * MP + 2 * (16 * w)), qb = *(const LAS h16x8*)(QM + lane * MP + 2 * (16 * w + 8));
                const f32x4 n0 = *(const LAS f32x4*)(NV + 16 * w), n1 = *(const LAS f32x4*)(NV + 16 * w + 4), n2 = *(const LAS f32x4*)(NV + 16 * w + 8), n3 = *(const LAS f32x4*)(NV + 16 * w + 12);
                float s = 0.f;
#pragma unroll
                for (int j = 0; j < 4; ++j) s += (float)qa[j] * n0[j] + (float)qa[4 + j] * n1[j] + (float)qb[j] * n2[j] + (float)qb[4 + j] * n3[j];
                QNP[w * 64 + lane] = s;
            }
            {
                const int d = tid & 127, part = tid >> 7;
                float s = 0.f;
#pragma unroll
                for (int ss = 0; ss < 16; ++ss) s += UE[16 * part + ss] * (float)*(const LAS h16*)(KM + (16 * part + ss) * MP + 2 * d);
                NP[part * 128 + d] = s;
            }
        }
        __syncthreads();
        {
            h16x4 vtr[4];
#pragma unroll
            for (int st = 0; st < 4; ++st) vtr[st] = __builtin_bit_cast(h16x4, tr_read(VM + (16 * st + 4 * q + (c >> 2)) * MP + 2 * (16 * w + 4 * (c & 3))));
            h16x8 cp[4];
#pragma unroll
            for (int kp = 0; kp < 4; ++kp) { u32x4 sa; sa.x = pkh(C[2 * kp][0], C[2 * kp][1]); sa.y = pkh(C[2 * kp][2], C[2 * kp][3]); sa.z = pkh(C[2 * kp + 1][0], C[2 * kp + 1][1]); sa.w = pkh(C[2 * kp + 1][2], C[2 * kp + 1][3]); cp[kp] = __builtin_bit_cast(h16x8, sa); }
#pragma unroll
            for (int tt = 0; tt < 4; ++tt) {
                const int t = 16 * tt + c;
                f32x4 accI = {0.f, 0.f, 0.f, 0.f}, accN = {0.f, 0.f, 0.f, 0.f};
#pragma unroll
                for (int kp = 0; kp < 4; ++kp) {
                    const u32x2 b0 = *(const LAS u32x2*)(QM + t * MP + 2 * (32 * kp + 4 * q)), b1 = *(const LAS u32x2*)(QM + t * MP + 2 * (32 * kp + 16 + 4 * q));
                    u32x4 bb; bb.x = b0.x; bb.y = b0.y; bb.z = b1.x; bb.w = b1.y;
                    accI = __builtin_amdgcn_mfma_f32_16x16x32_f16(cp[kp], __builtin_bit_cast(h16x8, bb), accI, 0, 0, 0);
                }
                float den = 0.f;
#pragma unroll
                for (int st = 0; st < 4; ++st) if (st <= tt) {
                    const u32x2 pb = *(const LAS u32x2*)(PM + t * PP + 2 * (16 * st + 4 * q));
                    accN = __builtin_amdgcn_mfma_f32_16x16x16f16(vtr[st], __builtin_bit_cast(h16x4, pb), accN, 0, 0, 0);
                    den += DENP[st * 64 + t];
                }
                float qn = 0.f;
#pragma unroll
                for (int ww = 0; ww < 8; ++ww) qn += QNP[ww * 64 + t];
                const float ai = AI[t];
                den += ai * qn;
                const float sc = 1.f / fmaxf(fabsf(den), EN[t]);
                const f32x4 hv = (accN + accI * ai) * sc;
                const int pos = 64 * i + t, tok = dir ? L - 1 - pos : pos;
                u32x2 o; o.x = pkh(hv[0], hv[1]); o.y = pkh(hv[2], hv[3]);
                *(u32x2*)(odst + (size_t)(row0 + tok) * DM + 512 + h * 128 + 16 * w + 4 * q) = o;
            }
            const float a63 = AI[63];
            h16x4 vs[4];
#pragma unroll
            for (int st = 0; st < 4; ++st) { const f32x4 ue4 = *(const LAS f32x4*)(UE + 16 * st + 4 * q);
#pragma unroll
                for (int j = 0; j < 4; ++j) vs[st][j] = (h16)((float)vtr[st][j] * ue4[j]); }
#pragma unroll
            for (int dt = 0; dt < 8; ++dt) {
                C[dt] = C[dt] * a63;
#pragma unroll
                for (int st = 0; st < 4; ++st) {
                    const h16x4 ktr = __builtin_bit_cast(h16x4, tr_read(KM + (16 * st + 4 * q + (c >> 2)) * MP + 2 * (16 * dt + 4 * (c & 3))));
                    C[dt] = __builtin_amdgcn_mfma_f32_16x16x16f16(ktr, vs[st], C[dt], 0, 0, 0);
                }
            }
            if (tid < 128) NV[tid] = a63 * NV[tid] + (NP[tid] + NP[128 + tid]) + (NP[256 + tid] + NP[384 + tid]);
        }
#if defined(ML_EXTRA_SYNC)
        asm volatile("s_waitcnt vmcnt(0) lgkmcnt(0)" ::: "memory");
        __syncthreads();
#endif
    }
    __syncthreads();
    if (!lat) {
        float* dst = p.out + OUT_MC + sidx * 16384;
#pragma unroll
        for (int dt = 0; dt < 8; ++dt)
#pragma unroll
            for (int j = 0; j < 4; ++j) dst[(16 * dt + 4 * q + j) * 128 + 16 * w + c] = C[dt][j];
        if (tid < 128) p.out[OUT_MN + sidx * 128 + tid] = NV[tid];
        if (tid == 0) p.out[OUT_MM + sidx] = mst[0];
    }
    __syncthreads();
#undef ML_LOAD
}
#if defined(DIAG_ALL)
#define SCAN_HG(p, l, lat, b, h, dir, lds) do { scan_hgrn_mfma(p, l, lat, b, h, dir, (LAS unsigned char*)(lds)); asm volatile("s_waitcnt vmcnt(0)" ::: "memory"); __syncthreads(); scan_item<0, 1>(p, l, lat, b, h, dir, lds); } while (0)
#elif defined(HGRN_VALU)
#define SCAN_HG(p, l, lat, b, h, dir, lds) scan_item<0>(p, l, lat, b, h, dir, lds)
#else
#define SCAN_HG(p, l, lat, b, h, dir, lds) scan_hgrn_mfma(p, l, lat, b, h, dir, (LAS unsigned char*)(lds))
#endif
#if defined(MLSTM_VALU)
#define SCAN_ML(p, l, lat, b, h, dir, lds) scan_item<1>(p, l, lat, b, h, dir, lds)
#else
#if defined(DIAG_ALL)
#define SCAN_ML(p, l, lat, b, h, dir, lds) do { scan_mlstm_mfma(p, l, lat, b, h, dir, (LAS unsigned char*)(lds)); asm volatile("s_waitcnt vmcnt(0)" ::: "memory"); __syncthreads(); scan_item<1, 1>(p, l, lat, b, h, dir, lds); } while (0)
#elif defined(MLSTM_DIAG)
#define SCAN_ML(p, l, lat, b, h, dir, lds) do { scan_mlstm_mfma(p, l, lat, b, h, dir, (LAS unsigned char*)(lds)); \
        if ((lat) && (dir) == 0 && (l) == DIAG_LAYER) { asm volatile("s_waitcnt vmcnt(0)" ::: "memory"); __syncthreads(); scan_item<1, 1>(p, l, lat, b, h, dir, lds); } } while (0)
#elif defined(MLSTM_VALU_CTX)
#define SCAN_ML(p, l, lat, b, h, dir, lds) do { if (lat) scan_mlstm_mfma(p, l, lat, b, h, dir, (LAS unsigned char*)(lds)); else scan_item<1>(p, l, lat, b, h, dir, lds); } while (0)
#elif defined(MLSTM_MFMA_DIR0)
#define SCAN_ML(p, l, lat, b, h, dir, lds) do { if ((dir) == 0) scan_mlstm_mfma(p, l, lat, b, h, dir, (LAS unsigned char*)(lds)); else scan_item<1>(p, l, lat, b, h, dir, lds); } while (0)
#elif defined(MLSTM_BISECT)
#define SCAN_ML(p, l, lat, b, h, dir, lds) do { if (!((lat) && (dir) == 0 && (MLSTM_BISECT_COND))) scan_mlstm_mfma(p, l, lat, b, h, dir, (LAS unsigned char*)(lds)); else scan_item<1>(p, l, lat, b, h, dir, lds); } while (0)
#elif defined(MLSTM_VALU_LAT)
#define SCAN_ML(p, l, lat, b, h, dir, lds) do { if (!(lat)) scan_mlstm_mfma(p, l, lat, b, h, dir, (LAS unsigned char*)(lds)); else scan_item<1>(p, l, lat, b, h, dir, lds); } while (0)
#else
#define SCAN_ML(p, l, lat, b, h, dir, lds) scan_mlstm_mfma(p, l, lat, b, h, dir, (LAS unsigned char*)(lds))
#endif
#endif
__device__ __forceinline__ void scan_dispatch(const Params& p, int l, int it, LAS float* lds) {
    if (it < 128) { const int type = it >> 6, r = it & 63, b = r >> 3, h = (r >> 1) & 3, dir = r & 1; if (type == 0) SCAN_HG(p, l, 1, b, h, dir, lds); else SCAN_ML(p, l, 1, b, h, dir, lds); }
    else { const int q = it - 128, type = q >> 8, r = q & 255, b = r >> 3, h = (r >> 1) & 3, dir = r & 1; if (type == 0) SCAN_HG(p, l, 0, b, h, dir, lds); else SCAN_ML(p, l, 0, b, h, dir, lds); }
}
__device__ __forceinline__ void phase_scan(const Params& p, int l, LAS float* lds) {
    const int G = gridDim.x, bid = blockIdx.x;
    if (G == 256) {
        if (bid < 128) scan_dispatch(p, l, bid, lds);
        else for (int it = 128 + (bid - 128); it < 640; it += 128) scan_dispatch(p, l, it, lds);
    } else {
        for (int it = bid; it < 640; it += G) scan_dispatch(p, l, it, lds);
    }
}
__device__ __forceinline__ void phase_mixnorm(const Params& p, int l, int gw, int NGW, int lane) {
    const h16* of = (const h16*)(p.ws + WS_HN); const h16* ob = (const h16*)(p.ws + WS_OB); const h16* proj = (const h16*)(p.ws + WS_PROJ);
    h16* mix = (h16*)(p.ws + WS_QKM);
    const int col = 16 * lane;
    const float* nw = col < 512 ? p.hg_nw + l * 512 + col : p.ml_nw + l * 512 + (col - 512);
    float wv[16];
#pragma unroll
    for (int j = 0; j < 4; ++j) { const f32x4 t = *(const f32x4*)(nw + 4 * j); wv[4 * j] = t.x; wv[4 * j + 1] = t.y; wv[4 * j + 2] = t.z; wv[4 * j + 3] = t.w; }
    const int gcol = col < 512 ? 2048 + col : 4096 + (col - 512);
    for (int r = gw; r < T_ALL; r += NGW) {
        const h16x8 a0 = *(const h16x8*)(of + (size_t)r * DM + col), a1 = *(const h16x8*)(of + (size_t)r * DM + col + 8);
        const h16x8 b0 = *(const h16x8*)(ob + (size_t)r * DM + col), b1 = *(const h16x8*)(ob + (size_t)r * DM + col + 8);
        const h16x8 g0 = *(const h16x8*)(proj + (size_t)r * NPROJ + gcol), g1 = *(const h16x8*)(proj + (size_t)r * NPROJ + gcol + 8);
        float o[16]; float ss = 0.f;
#pragma unroll
        for (int j = 0; j < 8; ++j) { o[j] = (float)a0[j] + (float)b0[j]; o[8 + j] = (float)a1[j] + (float)b1[j]; }
#pragma unroll
        for (int j = 0; j < 16; ++j) ss += o[j] * o[j];
        ss += __shfl_xor(ss, 1); ss += __shfl_xor(ss, 2); ss += __shfl_xor(ss, 4);
        const float rstd = rsqrtf(ss * (1.f / 128.f) + EPS);
        u32x4 w0, w1;
        w0.x = pkh(o[0] * rstd * wv[0] * (float)g0[0], o[1] * rstd * wv[1] * (float)g0[1]); w0.y = pkh(o[2] * rstd * wv[2] * (float)g0[2], o[3] * rstd * wv[3] * (float)g0[3]);
        w0.z = pkh(o[4] * rstd * wv[4] * (float)g0[4], o[5] * rstd * wv[5] * (float)g0[5]); w0.w = pkh(o[6] * rstd * wv[6] * (float)g0[6], o[7] * rstd * wv[7] * (float)g0[7]);
        w1.x = pkh(o[8] * rstd * wv[8] * (float)g1[0], o[9] * rstd * wv[9] * (float)g1[1]); w1.y = pkh(o[10] * rstd * wv[10] * (float)g1[2], o[11] * rstd * wv[11] * (float)g1[3]);
        w1.z = pkh(o[12] * rstd * wv[12] * (float)g1[4], o[13] * rstd * wv[13] * (float)g1[5]); w1.w = pkh(o[14] * rstd * wv[14] * (float)g1[6], o[15] * rstd * wv[15] * (float)g1[7]);
        *(u32x4*)(mix + (size_t)r * DM + col) = w0; *(u32x4*)(mix + (size_t)r * DM + col + 8) = w1;
    }
}

#define XB_TMO      128
#define XB_XCNT(j)  (256  + 64 * (j))
#define XB_XSUB(j)  (1280 + 64 * (j))
#define XB_XGEN(j)  (2304 + 64 * (j))
#define XB_TOP      3328
#define XB_TOPGEN   3392
#define XCD_BAR_WORDS 3456
#define XB_SPIN_CAP (1u << 18)

__device__ __forceinline__ unsigned xb_ld(unsigned* p)              { return __hip_atomic_load(p, __ATOMIC_RELAXED, __HIP_MEMORY_SCOPE_AGENT); }
__device__ __forceinline__ unsigned xb_add(unsigned* p, unsigned v) { return __hip_atomic_fetch_add(p, v, __ATOMIC_RELAXED, __HIP_MEMORY_SCOPE_AGENT); }
__device__ __forceinline__ unsigned xb_xcc_id() { return (unsigned)__builtin_amdgcn_s_getreg((3 << 11) | 20) & 0xFu; }
#define XB_SPIN(cond, bar) do { unsigned _sp = 0; while (cond) { __builtin_amdgcn_s_sleep(1); \
    if ((++_sp & 255u) == 0u) { if (xb_ld(&(bar)[XB_TMO])) break; if (_sp > XB_SPIN_CAP) { atomicAdd(&(bar)[XB_TMO], 1u); break; } } } } while (0)

struct XcdBarrier {
    unsigned* bar; unsigned x;
    volatile LAS unsigned* st;
};

__device__ __forceinline__ XcdBarrier xcd_barrier_post(unsigned* bar, volatile LAS unsigned* st) {
    XcdBarrier b; b.bar = bar; b.x = xb_xcc_id(); b.st = st;
    if (threadIdx.x == 0) (void)xb_add(&bar[XB_XCNT(b.x)], 1u);
    return b;
}
__device__ __forceinline__ void xcd_barrier_complete(unsigned* bar, unsigned x, unsigned& nloc, unsigned& nx) {
    const unsigned G = gridDim.x * gridDim.y * gridDim.z;
    unsigned sum, cnt, mine, sp = 0u;
    for (;;) {
        sum = 0u; cnt = 0u; mine = 0u;
#pragma unroll
        for (unsigned j = 0; j < 16; ++j) { const unsigned c = xb_ld(&bar[XB_XCNT(j)]); sum += c; cnt += (c > 0u) ? 1u : 0u; mine = (j == x) ? c : mine; }
        if (sum == G) break;
        __builtin_amdgcn_s_sleep(1);
        if ((++sp & 255u) == 0u) { if (xb_ld(&bar[XB_TMO])) break; if (sp > XB_SPIN_CAP) { atomicAdd(&bar[XB_TMO], 1u); break; } }
    }
    nloc = mine > 0u ? mine : 1u; nx = cnt > 0u ? cnt : 1u;
}

__device__ __forceinline__ void xcd_barrier(const XcdBarrier& b) {
    asm volatile("s_waitcnt vmcnt(0)" ::: "memory");
    __syncthreads();
    if (threadIdx.x == 0) {
        unsigned* bar = b.bar;
        __builtin_amdgcn_s_waitcnt(0);
        unsigned nloc = b.st[0], nx = b.st[1];
        if (nloc == 0u) { xcd_barrier_complete(bar, b.x, nloc, nx); b.st[0] = nloc; b.st[1] = nx; }
        const unsigned old = xb_add(&bar[XB_XSUB(b.x)], 1u);
        const unsigned gen = old / nloc;
        if (old + 1u == (gen + 1u) * nloc) {
            __builtin_amdgcn_fence(__ATOMIC_RELEASE, "agent");
            asm volatile("s_waitcnt vmcnt(0)" ::: "memory");
            const unsigned og = xb_add(&bar[XB_TOP], 1u);
            const unsigned tg = og / nx;
            if (og + 1u == (tg + 1u) * nx) xb_add(&bar[XB_TOPGEN], 1u);
            else XB_SPIN(xb_ld(&bar[XB_TOPGEN]) == tg, bar);
            __builtin_amdgcn_fence(__ATOMIC_ACQUIRE, "agent");
            xb_add(&bar[XB_XGEN(b.x)], 1u);
            asm volatile("s_waitcnt vmcnt(0)" ::: "memory");
        } else {
            XB_SPIN(xb_ld(&bar[XB_XGEN(b.x)]) == gen, bar);
            __builtin_amdgcn_fence(__ATOMIC_ACQUIRE, "agent");
            asm volatile("s_waitcnt vmcnt(0)" ::: "memory");
        }
    }
    __syncthreads();
}


__global__ void __launch_bounds__(NTHR, 2) fwd_megakernel(Params p) {
    extern __shared__ __attribute__((aligned(16))) unsigned char lds_raw[];
    cg::grid_group grid = cg::this_grid();
#if defined(USE_CG_SYNC)
#define GSYNC() do { asm volatile("s_waitcnt vmcnt(0)" ::: "memory"); grid.sync(); } while (0)
#else
#define GSYNC() do { XcdBarrier xb_; xb_.bar = (unsigned*)(p.ws + WS_BAR); xb_.x = xb_xcc_id(); xb_.st = (volatile LAS unsigned*)(lds + 131072 + 512); xcd_barrier(xb_); } while (0)
#endif
    LAS unsigned char* lds = (LAS unsigned char*)lds_raw;
    LAS float* ldsf = (LAS float*)lds_raw;
    const int G = gridDim.x, NGW = G * NWV;
#define PHASE_IDS() const int tid = ltid(), lane = tid & 63, wave = __builtin_amdgcn_readfirstlane(tid >> 6), gw = blockIdx.x * NWV + wave; (void)tid; (void)lane; (void)gw
    const float* mod = (const float*)(p.ws + WS_MOD);
    h16* hn = (h16*)(p.ws + WS_HN); h16* proj = (h16*)(p.ws + WS_PROJ); h16* mix = (h16*)(p.ws + WS_QKM); h16* ff = (h16*)(p.ws + WS_PROJ);

    volatile LAS unsigned* xst = (volatile LAS unsigned*)(lds + 131072 + 512);
    if (ltid() < 4) xst[ltid()] = 0u;
    __syncthreads();
    XcdBarrier xbar = xcd_barrier_post((unsigned*)(p.ws + WS_BAR), xst);
    phase_mod_partial(p, ldsf);
    asm volatile("s_waitcnt vmcnt(0)" ::: "memory"); grid.sync();
    (void)xbar;
    phase_mod_reduce(p);
    GSYNC();
#if defined(DIAG_ALL)
    if (ltid() == 0) { float* dg = (float*)(p.ws + WS_MODP) + 4 * blockIdx.x; dg[0] = 0.f; dg[1] = 0.f; dg[2] = 0.f; dg[3] = 0.f; }
#endif
    for (int l = 0; l < 4; ++l) {
        { PHASE_IDS(); convert_weights(p, l, ldsf + wave * 2176, gw, NGW, lane); }
        { PHASE_IDS(); phase_norm(p, l, 0, l == 0, gw, NGW, lane); }
        GSYNC();
        {
            pg8::Gemm g{(const pg8::bf16_t*)hn, (const pg8::bf16_t*)(p.ws + WS_WIN), T_ALL, NPROJ_PAD, DM}; pg8::StaticOrder S; S.init(T_ALL, NPROJ_PAD, G, (int)blockIdx.x);
            EpiInProj E{proj, (float*)(p.ws + WS_GATES), p.gate_b + l * 16};
            pg8::gemm_phase<EpiInProj, pg8::StaticOrder, true, true>(lds, g, S, E);
#if defined(PROBE_GEMM2)
            GSYNC();
            pg8::gemm_phase<EpiInProj, pg8::StaticOrder, true, true>(lds, g, S, E);
#endif
        }
        GSYNC();
        { PHASE_IDS(); phase_gates(p, l, gw, NGW, lane); }
        phase_conv(p, l);
        GSYNC();
#if defined(PERTURB)
        { if (ltid() == 0) { const unsigned long long t0_ = __builtin_amdgcn_s_memrealtime(); const unsigned long long dl_ = (unsigned long long)(((blockIdx.x * 37u + l * 11u) % 64u) * 300u); while (__builtin_amdgcn_s_memrealtime() - t0_ < dl_) __builtin_amdgcn_s_sleep(4); } __syncthreads(); }
#endif
        phase_scan(p, l, ldsf);
#if defined(PERTURB)
        { if (ltid() == 0) { const unsigned long long t0_ = __builtin_amdgcn_s_memrealtime(); const unsigned long long dl_ = (unsigned long long)(((blockIdx.x * 53u + l * 7u) % 32u) * 400u); while (__builtin_amdgcn_s_memrealtime() - t0_ < dl_) __builtin_amdgcn_s_sleep(4); } __syncthreads(); }
#endif
#if defined(DELAY_AFTER_SCAN)
        { if (ltid() == 0) { const unsigned long long t0_ = __builtin_amdgcn_s_memrealtime(); while (__builtin_amdgcn_s_memrealtime() - t0_ < (unsigned long long)(DELAY_AFTER_SCAN) * 100ull) __builtin_amdgcn_s_sleep(8); } __syncthreads(); }
#endif
#if defined(LDS_CLEAR)
        { __syncthreads(); const int t_ = ltid(); for (int e = t_; e < 32768; e += NTHR) ldsf[e] = LDS_CLEAR_VAL; __syncthreads(); }
#endif
        GSYNC();
#if defined(MLSTM_DIAG)
        if (l == DIAG_LAYER && blockIdx.x == 0 && ltid() == 0) {
            const float* dg = (const float*)(p.ws + WS_MODP);
            float best = -1.f; int code = 0;
            for (int bb = 64; bb < 128; bb += 2) { const float rt = dg[4 * bb + DIAG_FIELD]; if (rt > best) { best = rt; int lg = 0; float x = rt; while (x < 1.f && lg < 31) { x *= 2.f; ++lg; } code = DIAG_CODE; } }
            const unsigned long long t0 = __builtin_amdgcn_s_memrealtime();
            while (__builtin_amdgcn_s_memrealtime() - t0 < (unsigned long long)code * 5000ull) __builtin_amdgcn_s_sleep(8);
        }
#endif
#if defined(PROBE_GSYNC10)
        for (int rep = 0; rep < 10; ++rep) GSYNC();
#endif
#if defined(PROBE_SCAN_TYPE)
        { const int bid_ = blockIdx.x;
          if (bid_ < 128) { if ((bid_ >> 6) == PROBE_SCAN_TYPE) scan_dispatch(p, l, bid_, ldsf); }
          else for (int it = 128 + (bid_ - 128); it < 640; it += 128) { if (((it - 128) >> 8) == PROBE_SCAN_TYPE) scan_dispatch(p, l, it, ldsf); } }
        GSYNC();
#endif
#if defined(PROBE_SCAN2)
        phase_scan(p, l, ldsf);
        GSYNC();
#endif
        { PHASE_IDS(); phase_mixnorm(p, l, gw, NGW, lane); }
        GSYNC();
        {
            pg8::Gemm g{(const pg8::bf16_t*)mix, (const pg8::bf16_t*)(p.ws + WS_WOUT), T_ALL, DM, DM}; pg8::StaticOrder S; S.init(T_ALL, DM, G, (int)blockIdx.x);
            EpiResid E{l == 0 ? p.x_prompt : p.out, l == 0 ? p.x_sample : p.out + (size_t)T_CTX * DM, p.out, mod + (size_t)l * 9 * 6144 + 2048};
#if defined(PROBE_GEMM2)
            { EpiResid E2 = E; E2.out = (float*)(p.ws + WS_PROJ); pg8::gemm_phase<EpiResid, pg8::StaticOrder, true, true>(lds, g, S, E2); GSYNC(); }
#endif
            pg8::gemm_phase<EpiResid, pg8::StaticOrder, true, true>(lds, g, S, E);
        }
        GSYNC();
        { PHASE_IDS(); phase_norm(p, l, 1, false, gw, NGW, lane); }
        GSYNC();
        {
            pg8::Gemm g{(const pg8::bf16_t*)hn, (const pg8::bf16_t*)(p.ws + WS_WGU), T_ALL, NGU, DM}; pg8::StaticOrder S; S.init(T_ALL, NGU, G, (int)blockIdx.x);
            EpiGateUp E{ff};
            pg8::gemm_phase<EpiGateUp, pg8::StaticOrder, true, true>(lds, g, S, E);
#if defined(PROBE_GEMM2)
            GSYNC();
            pg8::gemm_phase<EpiGateUp, pg8::StaticOrder, true, true>(lds, g, S, E);
#endif
        }
        GSYNC();
        {
            pg8::Gemm g{(const pg8::bf16_t*)ff, (const pg8::bf16_t*)(p.ws + WS_WDN), T_ALL, DM, DFF}; pg8::StaticOrder S; S.init(T_ALL, DM, G, (int)blockIdx.x);
            EpiResid E{p.out, p.out + (size_t)T_CTX * DM, p.out, mod + (size_t)l * 9 * 6144 + 5120};
#if defined(PROBE_GEMM2)
            { EpiResid E2 = E; E2.out = (float*)(p.ws + WS_QKM); pg8::gemm_phase<EpiResid, pg8::StaticOrder, true, true>(lds, g, S, E2); GSYNC(); }
#endif
            pg8::gemm_phase<EpiResid, pg8::StaticOrder, true, true>(lds, g, S, E);
        }
        GSYNC();
    }
    { PHASE_IDS(); phase_final_norm(p, gw, NGW, lane); }
#if defined(DIAG_ALL)
    if (blockIdx.x == 0 && ltid() == 0) {
        const float* dg = (const float*)(p.ws + WS_MODP);
        float best = -1.f; int code = 0;
        for (int bb = 0; bb < (int)gridDim.x; ++bb) { const float rt = dg[4 * bb]; if (rt > best) { best = rt; int lg = 0; float x = rt; while (x < 1.f && lg < 31) { x *= 2.f; ++lg; } code = DIAG_ALL_CODE; } }
        const unsigned long long t0 = __builtin_amdgcn_s_memrealtime();
        while (__builtin_amdgcn_s_memrealtime() - t0 < (unsigned long long)code * 5000ull) __builtin_amdgcn_s_sleep(8);
    }
#endif
}

extern "C" void kernel_launch(void* const* d_in, const int* in_sizes, int n_in, void* d_out, int out_size, void* d_ws, size_t ws_size, hipStream_t stream) {
    static int grid_blocks = 0;
    if (grid_blocks == 0) {
        if (n_in != 24 || (size_t)out_size != OUT_TOTAL || ws_size < WS_END) {
            fprintf(stderr, "kernel_launch: unexpected sizes n_in %d out %d ws %zu (need %zu)\n", n_in, out_size, ws_size, (size_t)WS_END); grid_blocks = -1; return;
        }
        int dev = 0, cus = 0, per_cu = 0;
        hipGetDevice(&dev);
        hipDeviceGetAttribute(&cus, hipDeviceAttributeMultiprocessorCount, dev);
        hipFuncSetAttribute((const void*)fwd_megakernel, hipFuncAttributeMaxDynamicSharedMemorySize, LDS_BYTES);
        hipOccupancyMaxActiveBlocksPerMultiprocessor(&per_cu, (const void*)fwd_megakernel, NTHR, LDS_BYTES);
        if (per_cu < 1) { fprintf(stderr, "kernel_launch: occupancy query says %d blocks per CU\n", per_cu); per_cu = 1; }
        grid_blocks = cus * 1;
        (void)hipGetLastError();
    }
    if (grid_blocks < 0) return;
    Params p{};
    const float** f = (const float**)&p;
    for (int i = 0; i < 24; ++i) f[i] = (const float*)d_in[i];
    p.out = (float*)d_out; p.ws = (unsigned char*)d_ws;
    if (hipMemsetAsync((char*)d_ws + WS_BAR, 0, 16384, stream) != hipSuccess) { fprintf(stderr, "kernel_launch: memset of the barrier words failed\n"); return; }
    void* args[] = {&p};
    hipError_t e = hipLaunchCooperativeKernel((const void*)fwd_megakernel, dim3(grid_blocks), dim3(NTHR), args, LDS_BYTES, stream);
    if (e != hipSuccess) fprintf(stderr, "cooperative launch failed: %s (grid %d)\n", hipGetErrorString(e), grid_blocks);
}
```

```cpp
#include <hip/hip_runtime.h>
#include <hip/hip_cooperative_groups.h>
#include <cstdio>
#include <cstdint>
namespace cg = cooperative_groups;
typedef _Float16 h16;
typedef _Float16 h16x8 __attribute__((ext_vector_type(8)));
typedef _Float16 h16x4 __attribute__((ext_vector_type(4)));
typedef _Float16 h16x2 __attribute__((ext_vector_type(2)));
typedef float f32x2 __attribute__((ext_vector_type(2)));
namespace pg8 {
#define PG8_LAS __attribute__((address_space(3)))
typedef unsigned short bf16_t;
typedef short bf16x8 __attribute__((ext_vector_type(8)));
typedef float f32x4 __attribute__((ext_vector_type(4)));
typedef unsigned u32x4 __attribute__((ext_vector_type(4)));
constexpr int BM = 256, BK = 64, HALF = 128, HTB = HALF * BK * 2  , STAGE_BYTES = 8 * HTB, NXCD = 8, WGM = 8;

__host__ __device__ __forceinline__ int lds_byte(int r, int c) { const int st = (r >> 4) * 2 + (c >> 5), rr = r & 15, cc = c & 31, ob = rr * 64 + cc * 2; return st * 1024 + (ob ^ (((ob >> 9) & 1) << 5)); }
__host__ __device__ __forceinline__ void stage_rc(int b, int& R, int& C) { const int st = b / 1024, sb = b % 1024, swz = sb ^ (((sb >> 9) & 1) << 5); R = (st >> 1) * 16 + swz / 64; C = (st & 1) * 32 + (swz % 64) / 2; }
__host__ __device__ __forceinline__ int perm32(int rho) { const int n = rho >> 4, i = rho & 15; return 8 * (i >> 2) + 4 * n + (i & 3); }

struct Unit { int pm, pn; };
struct Gemm { const bf16_t* A; const bf16_t* Bt; int M, N, K; };

struct StaticOrder {
    int nM, nN, nwg, G, c;
    __host__ __device__ void init(int M, int N, int G_, int c_) { nM = M / BM; nN = N / BM; nwg = nM * nN; G = G_; c = c_; }
    __host__ __device__ bool next(int i, Unit& u) const {
        const long L = (long)i * G + c; if (L >= nwg) return false;
        int wgid = (int)L; { const int q = nwg / NXCD, r = nwg % NXCD, xcd = wgid % NXCD, off = wgid / NXCD; wgid = (xcd < r ? xcd * (q + 1) : r * (q + 1) + (xcd - r) * q) + off; }
        const int nig = WGM * nN, gid = wgid / nig, fm = gid * WGM, gsz = (nM - fm) < WGM ? (nM - fm) : WGM;
        u.pm = fm + ((wgid % nig) % gsz); u.pn = (wgid % nig) / gsz; return true;
    }
    __device__ __forceinline__ void a_ready(const Unit&) const {}
    __device__ __forceinline__ void done(const Unit&) const {}
};

template <class Epi, class Sched, bool ALIGN_EPI = false, bool SP2 = false>
__device__ __forceinline__ void gemm_phase(PG8_LAS unsigned char* lds, const Gemm g, const Sched& S, const Epi& E) {
    int tid_l = threadIdx.x; asm volatile("" : "+v"(tid_l));
    const int tid = tid_l, wid = __builtin_amdgcn_readfirstlane(tid >> 6), lane = tid & 63, wr = wid >> 2, wc = wid & 3, fr = lane & 15, fq = lane >> 4;
    const int K = g.K, nt = K / BK;
    unsigned voffA[2], voffB[2];
#pragma unroll
    for (int i = 0; i < 2; ++i) { int R, C; stage_rc(tid * 16 + i * 8192, R, C); const int Rb = Epi::PERM ? ((R & ~31) + perm32(R & 31)) : R;
        voffA[i] = (unsigned)(R * K + C) * 2u; voffB[i] = (unsigned)(Rb * K + C) * 2u; }
    const size_t kstep = (size_t)(BK * 2);
    const size_t hstep = (size_t)HALF * K * 2;
    const size_t tstep = 2 * hstep;
    const unsigned ldsw = (unsigned)wid * 1024u;
    const int aoff = lds_byte(wr * 64 + fr, fq * 8), boff = lds_byte(wc * 32 + fr, fq * 8);
#define PG8_SA(b, h) (((b) * 2 + (h)) * HTB)
#define PG8_SB(b, h) ((4 + (b) * 2 + (h)) * HTB)
#define PG8_STAGE(bufoff, gbase, voff) do { _Pragma("unroll") for (int _i = 0; _i < 2; ++_i) \
        __builtin_amdgcn_global_load_lds((const unsigned*)((const char*)(gbase) + (voff)[_i]), (PG8_LAS unsigned*)(lds + (bufoff) + ldsw + _i * 8192), 16, 0, 0); } while (0)
#define PG8_LDA(dst, b, h) do { _Pragma("unroll") for (int m = 0; m < 4; ++m) _Pragma("unroll") for (int k = 0; k < 2; ++k) dst[m][k] = *(const PG8_LAS bf16x8*)(lds + PG8_SA(b, h) + aoff + m * 2048 + k * 1024); } while (0)
#define PG8_LDB(dst, b, h) do { _Pragma("unroll") for (int n = 0; n < 2; ++n) _Pragma("unroll") for (int k = 0; k < 2; ++k) dst[n][k] = *(const PG8_LAS bf16x8*)(lds + PG8_SB(b, h) + boff + n * 2048 + k * 1024); } while (0)
#define PG8_MMA(ai, bj, At, Bt) do { __builtin_amdgcn_s_setprio(1); _Pragma("unroll") for (int m = 0; m < 4; ++m) _Pragma("unroll") for (int n = 0; n < 2; ++n) _Pragma("unroll") for (int k = 0; k < 2; ++k) \
        acc[ai][bj][m][n] = __builtin_amdgcn_mfma_f32_16x16x32_f16(__builtin_bit_cast(h16x8, Bt[n][k]), __builtin_bit_cast(h16x8, At[m][k]), acc[ai][bj][m][n], 0, 0, 0); __builtin_amdgcn_s_setprio(0); } while (0)
#define PG8_WAIT_V(n) asm volatile("s_waitcnt vmcnt(" #n ")" ::: "memory")
#define PG8_WAIT_L(n) asm volatile("s_waitcnt lgkmcnt(" #n ")" ::: "memory")
#define PG8_BAR __builtin_amdgcn_s_barrier()
#define PG8_SCHED __builtin_amdgcn_sched_barrier(0)
    Unit cur, nxt; int ui = 0;
    if (!S.next(0, cur)) return;
    f32x4 acc[2][2][4][2];
#pragma unroll
    for (int a = 0; a < 2; ++a)
#pragma unroll
        for (int b = 0; b < 2; ++b)
#pragma unroll
            for (int m = 0; m < 4; ++m)
#pragma unroll
                for (int n = 0; n < 2; ++n) acc[a][b][m][n] = (f32x4){0.f, 0.f, 0.f, 0.f};
    bf16x8 At[4][2], B0[2][2], B1[2][2];
    const char* cA = (const char*)g.A + (size_t)cur.pm * tstep; const char* cB = (const char*)g.Bt + (size_t)cur.pn * tstep;
    S.a_ready(cur);
    if constexpr (SP2) {
        PG8_STAGE(PG8_SB(0, 0), cB, voffB); PG8_STAGE(PG8_SB(0, 1), cB + hstep, voffB); PG8_STAGE(PG8_SA(0, 0), cA, voffA); PG8_STAGE(PG8_SA(0, 1), cA + hstep, voffA);
        if (wr == 1) PG8_BAR;
        PG8_WAIT_V(2); PG8_BAR;
        PG8_STAGE(PG8_SB(1, 0), cB + kstep, voffB); PG8_STAGE(PG8_SA(1, 0), cA + kstep, voffA); PG8_STAGE(PG8_SB(1, 1), cB + hstep + kstep, voffB);
        PG8_WAIT_V(6); PG8_BAR;
    } else {
        PG8_STAGE(PG8_SB(0, 0), cB, voffB); PG8_STAGE(PG8_SA(0, 0), cA, voffA); PG8_STAGE(PG8_SB(0, 1), cB + hstep, voffB); PG8_STAGE(PG8_SA(0, 1), cA + hstep, voffA);
        if (wr == 1) PG8_BAR;
        PG8_WAIT_V(4); PG8_BAR;
        PG8_STAGE(PG8_SB(1, 0), cB + kstep, voffB); PG8_STAGE(PG8_SA(1, 0), cA + kstep, voffA); PG8_STAGE(PG8_SB(1, 1), cB + hstep + kstep, voffB);
        PG8_WAIT_V(6); PG8_BAR;
    }
    for (;;) {
        const bool has_next = S.next(ui + 1, nxt);
        const char* nA = has_next ? (const char*)g.A + (size_t)nxt.pm * tstep : cA; const char* nB = has_next ? (const char*)g.Bt + (size_t)nxt.pn * tstep : cB;
        for (int t = 0; t < nt; t += 2) {
            const bool last = (t == nt - 2);
            const char* a1 = cA + (size_t)(t + 1) * kstep;
            const char* a2 = last ? nA : cA + (size_t)(t + 2) * kstep; const char* b2 = last ? nB : cB + (size_t)(t + 2) * kstep;
            const char* a3 = a2 + kstep; const char* b3 = b2 + kstep;
            if (last && has_next) S.a_ready(nxt);
            if constexpr (SP2) {
            PG8_LDB(B0, 0, 0); PG8_LDB(B1, 0, 1); PG8_SCHED; PG8_LDA(At, 0, 0); PG8_STAGE(PG8_SA(1, 1), a1 + hstep, voffA);
            PG8_WAIT_V(8); PG8_WAIT_L(0); PG8_BAR; PG8_MMA(0, 0, At, B0); PG8_MMA(0, 1, At, B1); PG8_BAR; PG8_SCHED;
            PG8_LDA(At, 0, 1); PG8_STAGE(PG8_SB(0, 0), b2, voffB); PG8_STAGE(PG8_SB(0, 1), b2 + hstep, voffB); PG8_STAGE(PG8_SA(0, 0), a2, voffA);
            PG8_WAIT_V(8); PG8_WAIT_L(0); PG8_BAR; PG8_MMA(1, 0, At, B0); PG8_MMA(1, 1, At, B1); PG8_BAR; PG8_SCHED;
            PG8_LDB(B0, 1, 0); PG8_LDB(B1, 1, 1); PG8_SCHED; PG8_LDA(At, 1, 0); PG8_STAGE(PG8_SA(0, 1), a2 + hstep, voffA);
            PG8_WAIT_V(8); PG8_WAIT_L(0); PG8_BAR; PG8_MMA(0, 0, At, B0); PG8_MMA(0, 1, At, B1); PG8_BAR; PG8_SCHED;
            PG8_LDA(At, 1, 1); PG8_STAGE(PG8_SB(1, 0), b3, voffB); PG8_STAGE(PG8_SB(1, 1), b3 + hstep, voffB); PG8_STAGE(PG8_SA(1, 0), a3, voffA);
            PG8_WAIT_V(8); PG8_WAIT_L(0); PG8_BAR; PG8_MMA(1, 0, At, B0); PG8_MMA(1, 1, At, B1); PG8_BAR; PG8_SCHED;
            } else {
            PG8_LDB(B0, 0, 0); PG8_SCHED; PG8_LDA(At, 0, 0); PG8_STAGE(PG8_SA(1, 1), a1 + hstep, voffA);
            PG8_WAIT_L(8); PG8_BAR; PG8_WAIT_L(0); PG8_MMA(0, 0, At, B0); PG8_BAR; PG8_SCHED;
            PG8_LDB(B1, 0, 1); PG8_STAGE(PG8_SB(0, 0), b2, voffB);
            PG8_BAR; PG8_WAIT_L(0); PG8_MMA(0, 1, At, B1); PG8_BAR;
            PG8_LDA(At, 0, 1); PG8_STAGE(PG8_SA(0, 0), a2, voffA);
            PG8_BAR; PG8_WAIT_L(0); PG8_MMA(1, 0, At, B0); PG8_BAR; PG8_SCHED;
            PG8_STAGE(PG8_SB(0, 1), b2 + hstep, voffB);
            PG8_WAIT_V(6); PG8_BAR; PG8_MMA(1, 1, At, B1); PG8_BAR;
            PG8_LDB(B0, 1, 0); PG8_SCHED; PG8_LDA(At, 1, 0); PG8_STAGE(PG8_SA(0, 1), a2 + hstep, voffA);
            PG8_WAIT_L(8); PG8_BAR; PG8_WAIT_L(0); PG8_MMA(0, 0, At, B0); PG8_BAR; PG8_SCHED;
            PG8_LDB(B1, 1, 1); PG8_STAGE(PG8_SB(1, 0), b3, voffB);
            PG8_BAR; PG8_WAIT_L(0); PG8_MMA(0, 1, At, B1); PG8_BAR;
            PG8_LDA(At, 1, 1); PG8_STAGE(PG8_SA(1, 0), a3, voffA);
            PG8_BAR; PG8_WAIT_L(0); PG8_MMA(1, 0, At, B0); PG8_BAR; PG8_SCHED;
            PG8_STAGE(PG8_SB(1, 1), b3 + hstep, voffB);
            PG8_WAIT_V(6); PG8_BAR; PG8_MMA(1, 1, At, B1); PG8_BAR;
            }
        }
        if constexpr (ALIGN_EPI) { if (wr == 0) PG8_BAR; }
        if constexpr (!Epi::AFTER_DRAIN) { E(acc, cur, wr, wc, fr, fq); S.done(cur); }
        if (!has_next) break;
#pragma unroll
        for (int a = 0; a < 2; ++a)
#pragma unroll
            for (int b = 0; b < 2; ++b)
#pragma unroll
                for (int m = 0; m < 4; ++m)
#pragma unroll
                    for (int n = 0; n < 2; ++n) acc[a][b][m][n] = (f32x4){0.f, 0.f, 0.f, 0.f};
        cur = nxt; cA = nA; cB = nB; ++ui;
        if constexpr (ALIGN_EPI) { if (wr == 1) PG8_BAR; }
    }
    PG8_WAIT_V(0);
    if constexpr (!ALIGN_EPI) { if (wr == 0) PG8_BAR; }
    PG8_BAR;
    if constexpr (Epi::AFTER_DRAIN) { E.fused(acc, cur, wr, wc, fr, fq, lds, wid, lane); S.done(cur); }
#undef PG8_SA
#undef PG8_SB
#undef PG8_STAGE
#undef PG8_LDA
#undef PG8_LDB
#undef PG8_MMA
#undef PG8_WAIT_V
#undef PG8_WAIT_L
#undef PG8_BAR
#undef PG8_SCHED
}
}
#define LAS __attribute__((address_space(3)))
using pg8::f32x4;
using pg8::u32x4;
constexpr int T_CTX = 8192, T_LAT = 16384, T_ALL = 24576, DM = 1024;
constexpr int NPROJ = 4608, NPROJ_PAD = 4608, NIN = 4624, DFF = 2816, NGU = 5632;
constexpr int NTHR = 512, NWV = 8;
constexpr float EPS = 1e-6f;
constexpr int LDS_BYTES = 132096;

constexpr size_t OUT_HG = 25165824, OUT_MC = 41943040, OUT_MN = 58720256, OUT_MM = 58851328, OUT_TOTAL = 58852352;

constexpr size_t al256(size_t x) { return (x + 255) & ~(size_t)255; }
constexpr size_t WS_WIN = 0;
constexpr size_t WS_WOUT = WS_WIN + al256((size_t)NPROJ_PAD * DM * 2);
constexpr size_t WS_WGU = WS_WOUT + al256((size_t)DM * DM * 2);
constexpr size_t WS_WDN = WS_WGU + al256((size_t)NGU * DM * 2);
constexpr size_t WS_MODP = WS_WDN + al256((size_t)DM * DFF * 2);
constexpr size_t WS_MOD = WS_MODP + al256((size_t)8 * 4 * 9 * 6144 * 4);
constexpr size_t WS_LB = WS_MOD + al256((size_t)4 * 9 * 6144 * 4);
constexpr size_t WS_HN = WS_LB + al256((size_t)4 * 2 * 512 * 4);
constexpr size_t WS_PROJ = WS_HN + al256((size_t)T_ALL * DM * 2);
constexpr size_t WS_GATES = WS_PROJ + al256((size_t)T_ALL * NPROJ * 2);
constexpr size_t WS_QKM = WS_GATES + al256((size_t)T_ALL * 16 * 4);
constexpr size_t WS_OB = WS_QKM + al256((size_t)T_ALL * DM * 2);
constexpr size_t WS_BAR = WS_OB + al256((size_t)T_ALL * DM * 2);
constexpr size_t WS_WG16 = WS_BAR + 16384;
constexpr size_t WS_END = WS_WG16 + 32768;

#if defined(SWAP_OBUF)
#define ODIR(d) (!(d))
#else
#define ODIR(d) (d)
#endif
struct Params {
    const float *x_prompt, *x_sample, *st_hg, *st_mc, *st_mn, *st_mm, *cnd, *c_ctx, *n1w, *n2w, *w_mod, *b_mod, *w_in, *conv_w, *conv_b, *gate_b,
        *lb_logits, *hg_nw, *ml_nw, *w_out, *w_gate, *w_up, *w_down, *fin_w;
    float* out; unsigned char* ws;
};

__device__ __forceinline__ float sigmoidf_(float x) { return __builtin_amdgcn_rcpf(1.f + __expf(-x)); }
__device__ __forceinline__ float siluf_(float x) { return x * __builtin_amdgcn_rcpf(1.f + __expf(-x)); }
__device__ __forceinline__ unsigned pkh(float a, float b) { h16x2 v = {(h16)a, (h16)b}; return __builtin_bit_cast(unsigned, v); }
__device__ __forceinline__ float wave_sum(float v) {
#pragma unroll
    for (int o = 1; o < 64; o <<= 1) v += __shfl_xor(v, o);
    return v;
}
__device__ __forceinline__ int row_cidx(int row) { return row < T_CTX ? 0 : 1 + ((row - T_CTX) >> 11); }
__device__ __forceinline__ int ltid() { int t = threadIdx.x; asm volatile("" : "+v"(t)); return t; }
__device__ __forceinline__ float rdlane(float v, int l) { return __builtin_bit_cast(float, __builtin_amdgcn_readlane(__builtin_bit_cast(int, v), l)); }

struct EpiInProj {
    static constexpr bool PERM = true, AFTER_DRAIN = false;
    h16* proj; float* gates; const float* gate_b;
    __device__ __forceinline__ void operator()(const f32x4 (&acc)[2][2][4][2], const pg8::Unit& u, int wr, int wc, int fr, int fq) const {
        const int row0 = u.pm * 256 + wr * 64 + fr;
#pragma unroll
        for (int bj = 0; bj < 2; ++bj) {
            const int colt = u.pn * 256 + bj * 128, reg = colt >> 9;
            const int act = (reg == 0 || reg == 4) ? 1 : (reg == 8 ? 2 : 0);
            const int col0 = colt + wc * 32 + 8 * fq;
#pragma unroll
            for (int ai = 0; ai < 2; ++ai)
#pragma unroll
                for (int m = 0; m < 4; ++m) {
                    f32x4 v0 = acc[ai][bj][m][0], v1 = acc[ai][bj][m][1];
                    if (act == 1) {
#pragma unroll
                        for (int j = 0; j < 4; ++j) { v0[j] = siluf_(v0[j]); v1[j] = siluf_(v1[j]); }
                    } else if (act == 2) {
#pragma unroll
                        for (int j = 0; j < 4; ++j) { v0[j] = sigmoidf_(v0[j]); v1[j] = sigmoidf_(v1[j]); }
                    }
                    u32x4 w; w.x = pkh(v0[0], v0[1]); w.y = pkh(v0[2], v0[3]); w.z = pkh(v1[0], v1[1]); w.w = pkh(v1[2], v1[3]);
                    *(u32x4*)(proj + (size_t)(row0 + ai * 128 + m * 16) * NPROJ + col0) = w;
                }
        }
    }
};
struct EpiResid {
    static constexpr bool PERM = false, AFTER_DRAIN = false;
    const float* base_ctx; const float* base_lat; float* out; const float* gate;
    __device__ __forceinline__ void operator()(const f32x4 (&acc)[2][2][4][2], const pg8::Unit& u, int wr, int wc, int fr, int fq) const {
        const int cidx = u.pm < 32 ? 0 : 1 + ((u.pm - 32) >> 3);
        const float* gt = gate + cidx * 6144;
        const float* bs = u.pm < 32 ? base_ctx : base_lat - (size_t)T_CTX * DM;
        const int colb = u.pn * 256 + wc * 32 + 4 * fq;
        f32x4 g[2][2];
#pragma unroll
        for (int bj = 0; bj < 2; ++bj)
#pragma unroll
            for (int n = 0; n < 2; ++n) g[bj][n] = *(const f32x4*)(gt + colb + bj * 128 + n * 16);
#pragma unroll
        for (int ai = 0; ai < 2; ++ai)
#pragma unroll
            for (int m = 0; m < 4; ++m) {
                const size_t off = (size_t)(u.pm * 256 + ai * 128 + wr * 64 + m * 16 + fr) * DM + colb;
                f32x4 x[2][2];
#pragma unroll
                for (int bj = 0; bj < 2; ++bj)
#pragma unroll
                    for (int n = 0; n < 2; ++n) x[bj][n] = *(const f32x4*)(bs + off + bj * 128 + n * 16);
#pragma unroll
                for (int bj = 0; bj < 2; ++bj)
#pragma unroll
                    for (int n = 0; n < 2; ++n) *(f32x4*)(out + off + bj * 128 + n * 16) = x[bj][n] + g[bj][n] * acc[ai][bj][m][n];
                asm volatile("" ::: "memory");
            }
    }
};
struct EpiGateUp {
    static constexpr bool PERM = true, AFTER_DRAIN = false;
    h16* ff;
    __device__ __forceinline__ void operator()(const f32x4 (&acc)[2][2][4][2], const pg8::Unit& u, int wr, int wc, int fr, int fq) const {
        const int row0 = u.pm * 256 + wr * 64 + fr, col0 = u.pn * 128 + wc * 32 + 8 * fq;
#pragma unroll
        for (int ai = 0; ai < 2; ++ai)
#pragma unroll
            for (int m = 0; m < 4; ++m) {
                f32x4 v0, v1;
#pragma unroll
                for (int j = 0; j < 4; ++j) { v0[j] = siluf_(acc[ai][0][m][0][j]) * acc[ai][1][m][0][j]; v1[j] = siluf_(acc[ai][0][m][1][j]) * acc[ai][1][m][1][j]; }
                u32x4 w; w.x = pkh(v0[0], v0[1]); w.y = pkh(v0[2], v0[3]); w.z = pkh(v1[0], v1[1]); w.w = pkh(v1[2], v1[3]);
                *(u32x4*)(ff + (size_t)(row0 + ai * 128 + m * 16) * DFF + col0) = w;
            }
    }
};

__device__ __forceinline__ void phase_mod_partial(const Params& p, LAS float* ldsf) {
    const int tidx = ltid();
    for (int e = tidx; e < 9 * 1024; e += NTHR) { const int c = e >> 10, k = e & 1023; const float v = c == 0 ? p.c_ctx[k] : p.cnd[(c - 1) * 1024 + k]; ldsf[e] = siluf_(v); }
    __syncthreads();
    float* modp = (float*)(p.ws + WS_MODP);
    const int wave = tidx >> 6, lane = tidx & 63;
    const int gw = blockIdx.x * NWV + wave, NGW = gridDim.x * NWV;
    for (int it = gw; it < 4 * 96 * 8; it += NGW) {
        const int kq = it & 7, cgp = (it >> 3) % 96, l = it / (8 * 96);
        const int j = cgp * 64 + lane;
        const float* w = p.w_mod + ((size_t)l * 1024 + kq * 128) * 6144 + j;
        float acc[9];
#pragma unroll
        for (int c = 0; c < 9; ++c) acc[c] = 0.f;
#pragma unroll 4
        for (int k4 = 0; k4 < 32; ++k4) {
            const float w0 = w[(size_t)(4 * k4 + 0) * 6144], w1 = w[(size_t)(4 * k4 + 1) * 6144], w2 = w[(size_t)(4 * k4 + 2) * 6144], w3 = w[(size_t)(4 * k4 + 3) * 6144];
#pragma unroll
            for (int c = 0; c < 9; ++c) { const f32x4 s = *(const LAS f32x4*)(ldsf + c * 1024 + kq * 128 + 4 * k4); acc[c] += s.x * w0 + s.y * w1 + s.z * w2 + s.w * w3; }
        }
#pragma unroll
        for (int c = 0; c < 9; ++c) modp[(((size_t)kq * 4 + l) * 9 + c) * 6144 + j] = acc[c];
    }
    if (blockIdx.x == 0) {
        float* lb = (float*)(p.ws + WS_LB);
        for (int e = tidx; e < 1024; e += NTHR) {
            const float x0 = p.lb_logits[e], x1 = p.lb_logits[1024 + e], x2 = p.lb_logits[2048 + e], x3 = p.lb_logits[3072 + e];
            const float mx = fmaxf(fmaxf(x0, x1), fmaxf(x2, x3));
            const float e0 = expf(x0 - mx), e1 = expf(x1 - mx), e2 = expf(x2 - mx), e3 = expf(x3 - mx);
            const float inv = 1.f / (e0 + e1 + e2 + e3);
            lb[e] = 0.f; lb[1024 + e] = e1 * inv; lb[2048 + e] = (e1 + e2) * inv; lb[3072 + e] = (e1 + e2 + e3) * inv;
        }
    }
}
__device__ __forceinline__ void phase_mod_reduce(const Params& p) {
    const float* modp = (const float*)(p.ws + WS_MODP); float* mod = (float*)(p.ws + WS_MOD);
    for (int e = blockIdx.x * NTHR + ltid(); e < 4 * 9 * 6144; e += gridDim.x * NTHR) {
        const int j = e % 6144, l = e / (9 * 6144);
        float s = p.b_mod[l * 6144 + j];
#pragma unroll
        for (int kq = 0; kq < 8; ++kq) s += modp[(size_t)kq * (4 * 9 * 6144) + e];
        mod[e] = s;
    }
}

__device__ __forceinline__ void transpose_item(const float* W, int K, int N, h16* WT, int kb, int n0, int dst_row0, LAS float* scr, int lane) {
    const int k0 = 64 * kb, n = n0 + (lane & 31);
#pragma unroll 8
    for (int i = 0; i < 32; ++i) { const int kk = 2 * i + (lane >> 5); scr[kk * 33 + (lane & 31)] = (n < N) ? W[(size_t)(k0 + kk) * N + n] : 0.f; }
    asm volatile("s_waitcnt lgkmcnt(0)" ::: "memory");
    const int c = lane & 7;
#pragma unroll
    for (int j = 0; j < 4; ++j) {
        const int nn = (lane >> 3) + 8 * j; const LAS float* s = scr + (8 * c) * 33 + nn;
        u32x4 o; o.x = pkh(s[0 * 33], s[1 * 33]); o.y = pkh(s[2 * 33], s[3 * 33]); o.z = pkh(s[4 * 33], s[5 * 33]); o.w = pkh(s[6 * 33], s[7 * 33]);
        *(u32x4*)(WT + (size_t)(dst_row0 + nn) * K + k0 + 8 * c) = o;
    }
    asm volatile("s_waitcnt lgkmcnt(0)" ::: "memory");
}
__device__ __forceinline__ void convert_weights(const Params& p, int l, LAS float* scr, int gw, int NGW, int lane) {
    {
        h16* wg = (h16*)(p.ws + WS_WG16);
        const float* src = p.w_in + (size_t)l * DM * NIN + NPROJ;
        for (int e = gw * 64 + lane; e < 16 * 1024; e += NGW * 64) { const int k = e >> 4, g = e & 15; wg[g * 1024 + k] = (h16)src[(size_t)k * NIN + g]; }
    }
    h16* win = (h16*)(p.ws + WS_WIN); h16* wout = (h16*)(p.ws + WS_WOUT); h16* wgu = (h16*)(p.ws + WS_WGU); h16* wdn = (h16*)(p.ws + WS_WDN);
    constexpr int I_IN = 16 * 144, I_OUT = 16 * 32, I_G = 16 * 88, I_DN = 44 * 32;
    for (int it = gw; it < I_IN + I_OUT + 2 * I_G + I_DN; it += NGW) {
        int r = it;
        if (r < I_IN) { const int kb = r / 144, nb = r % 144; transpose_item(p.w_in + (size_t)l * DM * NIN, DM, NIN, win, kb, 32 * nb, 32 * nb, scr, lane); continue; } r -= I_IN;
        if (r < I_OUT) { const int kb = r / 32, nb = r % 32; transpose_item(p.w_out + (size_t)l * DM * DM, DM, DM, wout, kb, 32 * nb, 32 * nb, scr, lane); continue; } r -= I_OUT;
        if (r < I_G) { const int kb = r / 88, nb = r % 88, n0 = 32 * nb; transpose_item(p.w_gate + (size_t)l * DM * DFF, DM, DFF, wgu, kb, n0, (n0 >> 7) * 256 + (n0 & 127), scr, lane); continue; } r -= I_G;
        if (r < I_G) { const int kb = r / 88, nb = r % 88, n0 = 32 * nb; transpose_item(p.w_up + (size_t)l * DM * DFF, DM, DFF, wgu, kb, n0, (n0 >> 7) * 256 + 128 + (n0 & 127), scr, lane); continue; } r -= I_G;
        { const int kb = r / 32, nb = r % 32; transpose_item(p.w_down + (size_t)l * DFF * DM, DFF, DM, wdn, kb, 32 * nb, 32 * nb, scr, lane); }
    }
}
__device__ __forceinline__ void norm_mod_row(const float* xrow, const float* nw, const float* sc, const float* sh, h16* orow, int lane) {
    const f32x4* xr = (const f32x4*)xrow + lane;
    f32x4 v[4]; float s = 0.f;
#pragma unroll
    for (int j = 0; j < 4; ++j) { v[j] = xr[64 * j]; s += (v[j].x * v[j].x + v[j].y * v[j].y) + (v[j].z * v[j].z + v[j].w * v[j].w); }
    const float rstd = rsqrtf(wave_sum(s) * (1.f / DM) + EPS);
#pragma unroll
    for (int j = 0; j < 4; ++j) {
        const int col = 4 * lane + 256 * j;
        const f32x4 w4 = *(const f32x4*)(nw + col), s4 = *(const f32x4*)(sc + col), h4 = *(const f32x4*)(sh + col);
        const f32x4 y = v[j] * rstd * w4 * (1.f + s4) + h4;
        uint2 o; o.x = pkh(y.x, y.y); o.y = pkh(y.z, y.w);
        *(uint2*)(orow + col) = o;
    }
}
__device__ __forceinline__ void phase_norm(const Params& p, int l, int which, bool from_inputs, int gw, int NGW, int lane) {
    const float* mod = (const float*)(p.ws + WS_MOD) + (size_t)l * 9 * 6144;
    const float* nw = (which == 0 ? p.n1w : p.n2w) + l * DM;
    h16* hn = (h16*)(p.ws + WS_HN);
    for (int r = gw; r < T_ALL; r += NGW) {
        const float* xrow = from_inputs ? (r < T_CTX ? p.x_prompt + (size_t)r * DM : p.x_sample + (size_t)(r - T_CTX) * DM) : p.out + (size_t)r * DM;
        const float* m = mod + row_cidx(r) * 6144 + which * 3072;
        norm_mod_row(xrow, nw, m + 1024, m, hn + (size_t)r * DM, lane);
    }
}
__device__ __forceinline__ void phase_final_norm(const Params& p, int gw, int NGW, int lane) {
    for (int r = gw; r < T_ALL; r += NGW) {
        f32x4* xr = (f32x4*)(p.out + (size_t)r * DM) + lane;
        f32x4 v[4]; float s = 0.f;
#pragma unroll
        for (int j = 0; j < 4; ++j) { v[j] = xr[64 * j]; s += (v[j].x * v[j].x + v[j].y * v[j].y) + (v[j].z * v[j].z + v[j].w * v[j].w); }
        const float rstd = rsqrtf(wave_sum(s) * (1.f / DM) + EPS);
#pragma unroll
        for (int j = 0; j < 4; ++j) { const f32x4 w4 = *(const f32x4*)(p.fin_w + 4 * lane + 256 * j); xr[64 * j] = v[j] * rstd * w4; }
    }
}
__device__ __forceinline__ void phase_gates(const Params& p, int l, int gw, int NGW, int lane) {
    const h16* hn = (const h16*)(p.ws + WS_HN); const h16* wg = (const h16*)(p.ws + WS_WG16);
    float* gates = (float*)(p.ws + WS_GATES);
    const int c = lane & 15, q = lane >> 4;
    for (int grp = gw; grp < T_ALL / 16; grp += NGW) {
        const h16* ar = hn + (size_t)(16 * grp + c) * DM + 8 * q;
        const h16* br = wg + (size_t)c * DM + 8 * q;
        f32x4 acc = {0.f, 0.f, 0.f, 0.f};
#pragma unroll 8
        for (int kp = 0; kp < 32; ++kp) {
            const h16x8 a = *(const h16x8*)(ar + 32 * kp), bq = *(const h16x8*)(br + 32 * kp);
            acc = __builtin_amdgcn_mfma_f32_16x16x32_f16(a, bq, acc, 0, 0, 0);
        }
        const float bias = p.gate_b[l * 16 + c];
#pragma unroll
        for (int j = 0; j < 4; ++j) gates[(size_t)(16 * grp + 4 * q + j) * 16 + c] = acc[j] + bias;
    }
}
__device__ __forceinline__ void phase_conv(const Params& p, int l) {
    const h16* proj = (const h16*)(p.ws + WS_PROJ); h16* qkm = (h16*)(p.ws + WS_QKM);
    const float* cw = p.conv_w + (size_t)l * 9 * 1024; const float* cb = p.conv_b + l * 1024;
    for (int idx = blockIdx.x * NTHR + ltid(); idx < T_ALL * 128; idx += gridDim.x * NTHR) {
        const int r = idx >> 7, ch0 = (idx & 127) * 8;
        float acc[8];
        { const f32x4 b0 = *(const f32x4*)(cb + ch0), b1 = *(const f32x4*)(cb + ch0 + 4); acc[0] = b0.x; acc[1] = b0.y; acc[2] = b0.z; acc[3] = b0.w; acc[4] = b1.x; acc[5] = b1.y; acc[6] = b1.z; acc[7] = b1.w; }
        const h16* src = proj + 2560 + ch0;
        const bool lat = r >= T_CTX;
        const int pp = lat ? ((r - T_CTX) & 2047) : (r & 255);
        const int gy = lat ? (pp >> 6) : 0, gx = lat ? (pp & 63) : pp;
        const int H = lat ? 32 : 1, W = lat ? 64 : 256;
#pragma unroll
        for (int a = 0; a < 3; ++a) {
            const int yy = gy + a - 1;
            if (!lat && a != 1) continue;
            if (yy < 0 || yy >= H) continue;
#pragma unroll
            for (int b = 0; b < 3; ++b) {
                const int xx = gx + b - 1;
                if (xx < 0 || xx >= W) continue;
                const int rr = r + (a - 1) * 64 + (b - 1);
                const h16x8 x = *(const h16x8*)(src + (size_t)rr * NPROJ);
                const f32x4 t0 = *(const f32x4*)(cw + (a * 3 + b) * 1024 + ch0), t1 = *(const f32x4*)(cw + (a * 3 + b) * 1024 + ch0 + 4);
                acc[0] += t0.x * (float)x[0]; acc[1] += t0.y * (float)x[1]; acc[2] += t0.z * (float)x[2]; acc[3] += t0.w * (float)x[3];
                acc[4] += t1.x * (float)x[4]; acc[5] += t1.y * (float)x[5]; acc[6] += t1.z * (float)x[6]; acc[7] += t1.w * (float)x[7];
            }
        }
        const float sc = ch0 >= 512 ? 0.08838834764831845f : 1.f;
        u32x4 w; w.x = pkh(siluf_(acc[0]) * sc, siluf_(acc[1]) * sc); w.y = pkh(siluf_(acc[2]) * sc, siluf_(acc[3]) * sc);
        w.z = pkh(siluf_(acc[4]) * sc, siluf_(acc[5]) * sc); w.w = pkh(siluf_(acc[6]) * sc, siluf_(acc[7]) * sc);
        *(u32x4*)(qkm + (size_t)r * DM + ch0) = w;
    }
}

template <int TYPE  , int CMP = 0>
__device__ __forceinline__ void scan_item(const Params& p, int l, int lat, int b, int h, int dir, LAS float* lds) {
    const int tid = ltid(), lane = tid & 63, w = __builtin_amdgcn_readfirstlane(tid >> 6);
    const int L = lat ? 2048 : 256, row0 = lat ? T_CTX + b * 2048 : b * 256, NB = L / 16;
    LAS float* qs = lds;
    LAS float* fs = lds + 2048;
    LAS float* vs = lds + 4096;
    LAS float* part = lds + 6144;
    LAS float* partn = lds + 6144 + 16384;
    LAS float* scal = partn + 128;
    LAS float* mst = scal + 128;
    LAS float* cerr = mst + 16;
    LAS float* cref = cerr + 32;
    const h16* proj = (const h16*)(p.ws + WS_PROJ); const h16* qkm = (const h16*)(p.ws + WS_QKM); const float* gates = (const float*)(p.ws + WS_GATES);
    h16* odst = (h16*)(p.ws + (ODIR(dir) ? WS_OB : WS_HN));
    const size_t sidx = (((size_t)b * 4 + l) * 2 + dir) * 4 + h;
    if (CMP) { if (tid < 64) cerr[tid] = 0.f; __syncthreads(); }

    f32x2 S[16]; float nv = 0.f;
    if (lat) {
        const float* src = (TYPE == 0 ? p.st_hg : p.st_mc) + sidx * 16384;
#pragma unroll
        for (int dd = 0; dd < 16; ++dd) S[dd] = *(const f32x2*)(src + (16 * w + dd) * 128 + 2 * lane);
        if (TYPE == 1) { nv = lane < 16 ? p.st_mn[sidx * 128 + 16 * w + lane] : 0.f; if (tid == 0) mst[0] = p.st_mm[sidx]; }
    } else {
#pragma unroll
        for (int dd = 0; dd < 16; ++dd) S[dd] = (f32x2){0.f, 0.f};
        if (TYPE == 1 && tid == 0) mst[0] = 0.f;
    }
    const int tl = tid >> 5, d0 = 4 * (tid & 31);
    f32x4 lb4 = {0.f, 0.f, 0.f, 0.f};
    if (TYPE == 0) lb4 = *(const f32x4*)((const float*)(p.ws + WS_LB) + (l * 2 + dir) * 512 + h * 128 + d0);
    h16x4 pq, pz, pv; float pgi = 0.f, pgf = 0.f;
#define SCAN_LOAD(ii) do { const int pos_ = 16 * (ii) + tl, tok_ = dir ? L - 1 - pos_ : pos_; const size_t r_ = (size_t)(row0 + tok_); \
        if (TYPE == 0) { pq = *(const h16x4*)(proj + r_ * NPROJ + h * 128 + d0); pz = *(const h16x4*)(proj + r_ * NPROJ + 512 + dir * 512 + h * 128 + d0); pv = *(const h16x4*)(proj + r_ * NPROJ + 1536 + h * 128 + d0); } \
        else { pq = *(const h16x4*)(qkm + r_ * DM + h * 128 + d0); pz = *(const h16x4*)(qkm + r_ * DM + 512 + h * 128 + d0); pv = *(const h16x4*)(proj + r_ * NPROJ + 3584 + h * 128 + d0); \
               if (w == 0) { const int ps_ = 16 * (ii) + (lane & 15), tk_ = dir ? L - 1 - ps_ : ps_; const float* g_ = gates + (size_t)(row0 + tk_) * 16; pgi = g_[dir * 4 + h]; pgf = g_[8 + dir * 4 + h]; } } } while (0)
    SCAN_LOAD(0);
    for (int i = 0; i < NB; ++i) {
        const int par = i & 1;
        const int pos = 16 * i + tl, tok = dir ? L - 1 - pos : pos;
        const size_t r = (size_t)(row0 + tok);
        {
            *(LAS f32x4*)(qs + tl * 128 + d0) = (f32x4){(float)pq[0], (float)pq[1], (float)pq[2], (float)pq[3]};
            *(LAS f32x4*)(vs + tl * 128 + d0) = (f32x4){(float)pv[0], (float)pv[1], (float)pv[2], (float)pv[3]};
            if (TYPE == 0) {
                f32x4 f4;
#pragma unroll
                for (int j = 0; j < 4; ++j) f4[j] = lb4[j] + (1.f - lb4[j]) * sigmoidf_((float)pz[j]);
                *(LAS f32x4*)(fs + tl * 128 + d0) = f4;
            } else {
                *(LAS f32x4*)(fs + tl * 128 + d0) = (f32x4){(float)pz[0], (float)pz[1], (float)pz[2], (float)pz[3]};
                if (w == 0) {
                    const int t = lane & 15;
                    const float m0 = mst[0];
                    const float gi = pgi, lf = fminf(pgf, 0.f) - log1pf(__expf(-fabsf(pgf)));
                    float bc = lf;
#pragma unroll
                    for (int o = 1; o < 16; o <<= 1) { const float x = __shfl_up(bc, o, 16); if (t >= o) bc += x; }
                    float pm = gi - bc;
#pragma unroll
                    for (int o = 1; o < 16; o <<= 1) { const float x = __shfl_up(pm, o, 16); if (t >= o) pm = fmaxf(pm, x); }
                    const float mt = bc + fmaxf(m0, pm);
                    float mp = __shfl_up(mt, 1, 16); if (t == 0) mp = m0;
                    if (lane < 16) {
                        scal[(par * 16 + t) * 4 + 0] = __expf(lf + mp - mt);
                        scal[(par * 16 + t) * 4 + 1] = __expf(gi - mt);
                        scal[(par * 16 + t) * 4 + 2] = __expf(-mt);
                    }
                    asm volatile("s_waitcnt lgkmcnt(0)" ::: "memory");
                    if (lane == 15) mst[0] = mt;
                }
            }
        }
        if (i + 1 < NB) SCAN_LOAD(i + 1);
        __syncthreads();
#pragma unroll 2
        for (int t = 0; t < 16; ++t) {
            float fv = 0.f, qv = 0.f;
            if (lane < 16) { fv = fs[t * 128 + 16 * w + lane]; qv = qs[t * 128 + 16 * w + lane]; }
            const f32x2 v2 = *(const LAS f32x2*)(vs + t * 128 + 2 * lane);
            f32x2 o = {0.f, 0.f};
            if (TYPE == 0) {
#pragma unroll
                for (int dd = 0; dd < 16; ++dd) { const float sf = rdlane(fv, dd), sq = rdlane(qv, dd); S[dd] = v2 + sf * (S[dd] - v2); o += S[dd] * sq; }
            } else {
                const float a = __builtin_bit_cast(float, __builtin_amdgcn_readfirstlane(__builtin_bit_cast(int, scal[(par * 16 + t) * 4 + 0])));
                const float g = __builtin_bit_cast(float, __builtin_amdgcn_readfirstlane(__builtin_bit_cast(int, scal[(par * 16 + t) * 4 + 1])));
                const float gk = g * fv;
                nv = a * nv + gk;
                float nq = nv * qv;
                nq += __shfl_xor(nq, 8); nq += __shfl_xor(nq, 4); nq += __shfl_xor(nq, 2); nq += __shfl_xor(nq, 1);
                if (lane == 0) partn[t * 8 + w] = nq;
#pragma unroll
                for (int dd = 0; dd < 16; ++dd) { const float sk = rdlane(gk, dd), sq = rdlane(qv, dd); S[dd] = a * S[dd] + sk * v2; o += S[dd] * sq; }
            }
            *(LAS f32x2*)(part + (t * 8 + w) * 128 + 2 * lane) = o;
        }
        __syncthreads();
        {
            f32x4 acc = {0.f, 0.f, 0.f, 0.f};
#pragma unroll
            for (int ww = 0; ww < 8; ++ww) acc += *(const LAS f32x4*)(part + (tl * 8 + ww) * 128 + d0);
            if (TYPE == 1) {
                float den = 0.f;
#pragma unroll
                for (int ww = 0; ww < 8; ++ww) den += partn[tl * 8 + ww];
                const float sc = 1.f / fmaxf(fabsf(den), scal[(par * 16 + tl) * 4 + 2]);
                acc = acc * sc;
            }
            uint2 o; o.x = pkh(acc.x, acc.y); o.y = pkh(acc.z, acc.w);
            if (CMP) {
                const h16x4 old = *(const h16x4*)(odst + r * DM + TYPE * 512 + h * 128 + d0);
                float e = 0.f, rr = 0.f;
#pragma unroll
                for (int j = 0; j < 4; ++j) { const float df = (float)old[j] - acc[j]; e += df * df; rr += acc[j] * acc[j]; }
                e = wave_sum(e); rr = wave_sum(rr);
                if (lane == 0) { atomicAdd((float*)(cerr + (i >> 2)), e); atomicAdd((float*)(cref + (i >> 2)), rr); }
            }
            *(uint2*)(odst + r * DM + TYPE * 512 + h * 128 + d0) = o;
        }
    }
    if (CMP) {
        __syncthreads();
        if (tid == 0) {
            float best = -1.f; int bc_ = 0; float tot_e = 0.f, tot_r = 0.f;
            for (int cI = 0; cI < 32; ++cI) { const float rt = cerr[cI] / fmaxf(cref[cI], 1e-30f); tot_e += cerr[cI]; tot_r += cref[cI]; if (rt > best) { best = rt; bc_ = cI; } }
            float* dg = (float*)(p.ws + WS_MODP) + 4 * blockIdx.x;
#if defined(DIAG_ALL)
            const float tot = tot_e / fmaxf(tot_r, 1e-30f);
            if (tot > dg[0]) { dg[0] = tot; dg[1] = (float)(l * 8 + TYPE * 4 + lat * 2 + dir); dg[2] = best; dg[3] = (float)bc_; }
#else
            dg[0] = best; dg[1] = (float)bc_; dg[2] = tot_e / fmaxf(tot_r, 1e-30f); dg[3] = 0.f;
#endif
        }
    }
    if (!lat) {
        float* dst = p.out + (TYPE == 0 ? OUT_HG : OUT_MC) + sidx * 16384;
#pragma unroll
        for (int dd = 0; dd < 16; ++dd) *(f32x2*)(dst + (16 * w + dd) * 128 + 2 * lane) = S[dd];
        if (TYPE == 1) { if (lane < 16) p.out[OUT_MN + sidx * 128 + 16 * w + lane] = nv; if (tid == 0) p.out[OUT_MM + sidx] = mst[0]; }
    }
    __syncthreads();
#undef SCAN_LOAD
}
typedef unsigned u32x2 __attribute__((ext_vector_type(2)));
typedef short s16x8 __attribute__((ext_vector_type(8)));
typedef short s16x4 __attribute__((ext_vector_type(4)));
typedef __bf16 bf16x2_t __attribute__((ext_vector_type(2)));
__device__ __forceinline__ unsigned pkb(float a, float b) { f32x2 v = {a, b}; bf16x2_t r = __builtin_convertvector(v, bf16x2_t); return __builtin_bit_cast(unsigned, r); }
__device__ __forceinline__ unsigned short f2b(float a) { return (unsigned short)(pkb(a, 0.f) & 0xffffu); }
__device__ __forceinline__ s16x4 tr_read(LAS const unsigned char* ptr) { return __builtin_bit_cast(s16x4, __builtin_amdgcn_ds_read_tr16_b64_v4i16((LAS s16x4*)ptr)); }
constexpr int HP = 272;
__device__ __forceinline__ void scan_hgrn_mfma(const Params& p, int l, int lat, int b, int h, int dir, LAS unsigned char* lds) {
    const int tid = ltid(), lane = tid & 63, w = __builtin_amdgcn_readfirstlane(tid >> 6), c = lane & 15, q = lane >> 4;
    const int L = lat ? 2048 : 256, row0 = lat ? T_CTX + b * 2048 : b * 256, NB = L / 16;
    constexpr int IMG = 16 * HP, BUF = 4 * IMG + 512;
    LAS float* GS = (LAS float*)(lds + 2 * BUF);
    const h16* proj = (const h16*)(p.ws + WS_PROJ);
    h16* odst = (h16*)(p.ws + (ODIR(dir) ? WS_OB : WS_HN));
    const size_t sidx = (((size_t)b * 4 + l) * 2 + dir) * 4 + h;
    f32x4 S[8];
    if (lat) {
        const float* src = p.st_hg + sidx * 16384;
#pragma unroll
        for (int dt = 0; dt < 8; ++dt)
#pragma unroll
            for (int j = 0; j < 4; ++j) S[dt][j] = src[(16 * dt + 4 * q + j) * 128 + 16 * w + c];
    } else {
#pragma unroll
        for (int dt = 0; dt < 8; ++dt) S[dt] = (f32x4){0.f, 0.f, 0.f, 0.f};
    }
    const int pt = lane & 15, d0 = 16 * w + 4 * (lane >> 4);
    const f32x4 lb4 = *(const f32x4*)((const float*)(p.ws + WS_LB) + (l * 2 + dir) * 512 + h * 128 + d0);
    h16x4 rq, rz, rv;
#define HG_LOAD(ii) do { const int pos_ = 16 * (ii) + pt, tok_ = dir ? L - 1 - pos_ : pos_; const h16* r_ = proj + (size_t)(row0 + tok_) * NPROJ + h * 128 + d0; \
        rq = *(const h16x4*)(r_); rz = *(const h16x4*)(r_ + 512 + dir * 512); rv = *(const h16x4*)(r_ + 1536); } while (0)
#define HG_ROW_SHR(x, ctl) __builtin_bit_cast(float, __builtin_amdgcn_update_dpp(0, __builtin_bit_cast(int, (x)), (ctl), 0xF, 0xF, false))
    HG_LOAD(0);
    for (int i = 0; i < NB; ++i) {
        LAS unsigned char* buf = lds + (i & 1) * BUF;
        LAS unsigned char* QT = buf; LAS unsigned char* KT = buf + IMG; LAS unsigned char* KH = buf + 2 * IMG; LAS unsigned char* VV = buf + 3 * IMG; LAS float* AD = (LAS float*)(buf + 4 * IMG);
        asm volatile("s_waitcnt vmcnt(0)" ::: "memory");
        {
            float kk[4], G[4];
#pragma unroll
            for (int j = 0; j < 4; ++j) { const float f = lb4[j] + (1.f - lb4[j]) * sigmoidf_((float)rz[j]); kk[j] = 1.f - f; G[j] = __logf(f); }
#pragma unroll
            for (int j = 0; j < 4; ++j) {
                G[j] += HG_ROW_SHR(G[j], 0x111); G[j] += HG_ROW_SHR(G[j], 0x112); G[j] += HG_ROW_SHR(G[j], 0x114); G[j] += HG_ROW_SHR(G[j], 0x118);
            }
            float oq[4], ok[4], oh[4];
            float ev[4];
#pragma unroll
            for (int j = 0; j < 4; ++j) {
                const float e = __expf(G[j]), ei = __builtin_amdgcn_rcpf(fmaxf(e, 8.7565e-27f)); ev[j] = e;
                const float et = __shfl(e, 15, 16);
                oq[j] = (float)rq[j] * e; ok[j] = kk[j] * ei; oh[j] = kk[j] * (et * ei);
            }
            u32x2 wq, wk, wh, wv;
            wq.x = pkb(oq[0], oq[1]); wq.y = pkb(oq[2], oq[3]); wk.x = pkb(ok[0], ok[1]); wk.y = pkb(ok[2], ok[3]);
            wh.x = pkb(oh[0], oh[1]); wh.y = pkb(oh[2], oh[3]); wv.x = pkb((float)rv[0], (float)rv[1]); wv.y = pkb((float)rv[2], (float)rv[3]);
            *(LAS u32x2*)(QT + pt * HP + 2 * d0) = wq; *(LAS u32x2*)(KT + pt * HP + 2 * d0) = wk; *(LAS u32x2*)(KH + pt * HP + 2 * d0) = wh; *(LAS u32x2*)(VV + pt * HP + 2 * d0) = wv;
            if (pt == 15) *(LAS f32x4*)(AD + d0) = (f32x4){ev[0], ev[1], ev[2], ev[3]};
        }
        { const int nx = (i + 1 < NB) ? i + 1 : NB - 1; HG_LOAD(nx); }
        __syncthreads();
        {
            f32x4 accO = {0.f, 0.f, 0.f, 0.f};
#pragma unroll
            for (int kp = 0; kp < 4; ++kp) {
                u32x4 sa; sa.x = pkb(S[2 * kp][0], S[2 * kp][1]); sa.y = pkb(S[2 * kp][2], S[2 * kp][3]); sa.z = pkb(S[2 * kp + 1][0], S[2 * kp + 1][1]); sa.w = pkb(S[2 * kp + 1][2], S[2 * kp + 1][3]);
                const u32x2 b0 = *(const LAS u32x2*)(QT + c * HP + 2 * (32 * kp + 4 * q)), b1 = *(const LAS u32x2*)(QT + c * HP + 2 * (32 * kp + 16 + 4 * q));
                u32x4 bb; bb.x = b0.x; bb.y = b0.y; bb.z = b1.x; bb.w = b1.y;
                accO = __builtin_amdgcn_mfma_f32_16x16x32_bf16(__builtin_bit_cast(s16x8, sa), __builtin_bit_cast(s16x8, bb), accO, 0, 0, 0);
            }
            f32x4 accP = {0.f, 0.f, 0.f, 0.f};
#pragma unroll
            for (int kp = 0; kp < 4; ++kp) {
                const s16x8 a = *(const LAS s16x8*)(KT + c * HP + 2 * (32 * kp + 8 * q));
                const s16x8 bq = *(const LAS s16x8*)(QT + c * HP + 2 * (32 * kp + 8 * q));
                accP = __builtin_amdgcn_mfma_f32_16x16x32_bf16(a, bq, accP, 0, 0, 0);
            }
#pragma unroll
            for (int j = 0; j < 4; ++j) accP[j] = (4 * q + j > c) ? 0.f : accP[j];
            u32x2 pb; pb.x = pkb(accP[0], accP[1]); pb.y = pkb(accP[2], accP[3]);
            const s16x4 vtr = tr_read(VV + (4 * q + (c >> 2)) * HP + 2 * (16 * w + 4 * (c & 3)));
            accO = __builtin_amdgcn_mfma_f32_16x16x16bf16_1k(vtr, __builtin_bit_cast(s16x4, pb), accO, 0, 0, 0);
            {
                const int pos = 16 * i + c, tok = dir ? L - 1 - pos : pos;
                uint2 o; o.x = pkh(accO[0], accO[1]); o.y = pkh(accO[2], accO[3]);
                *(uint2*)(odst + (size_t)(row0 + tok) * DM + h * 128 + 16 * w + 4 * q) = o;
            }
#pragma unroll
            for (int dt = 0; dt < 8; ++dt) {
                const s16x4 ktr = tr_read(KH + (4 * q + (c >> 2)) * HP + 2 * (16 * dt + 4 * (c & 3)));
                const f32x4 ad = *(const LAS f32x4*)(AD + 16 * dt + 4 * q);
                S[dt] = S[dt] * ad;
                S[dt] = __builtin_amdgcn_mfma_f32_16x16x16bf16_1k(ktr, vtr, S[dt], 0, 0, 0);
            }
        }
#if defined(HG_EXTRA_SYNC)
        asm volatile("s_waitcnt vmcnt(0) lgkmcnt(0)" ::: "memory");
        __syncthreads();
#endif
    }
    if (!lat) {
        float* dst = p.out + OUT_HG + sidx * 16384;
#pragma unroll
        for (int dt = 0; dt < 8; ++dt)
#pragma unroll
            for (int j = 0; j < 4; ++j) dst[(16 * dt + 4 * q + j) * 128 + 16 * w + c] = S[dt][j];
    }
    __syncthreads();
#undef HG_LOAD
#undef HG_ROW_SHR
}
constexpr int MP = 272;
constexpr int PP = 144;
__device__ __forceinline__ void scan_mlstm_mfma(const Params& p, int l, int lat, int b, int h, int dir, LAS unsigned char* lds) {
    const int tid = ltid(), lane = tid & 63, w = __builtin_amdgcn_readfirstlane(tid >> 6), c = lane & 15, q = lane >> 4;
    const int L = lat ? 2048 : 256, row0 = lat ? T_CTX + b * 2048 : b * 256, NC = L / 64;
    constexpr int IMG = 64 * MP, BUF = 3 * IMG + 1536;
    LAS unsigned char* PM = lds + 2 * BUF;
    LAS float* DENP = (LAS float*)(PM + 64 * PP);
    LAS float* QNP = DENP + 256;
    LAS float* NP = QNP + 512;
    LAS float* NV = NP + 512;
    LAS float* mst = NV + 128;
    const h16* proj = (const h16*)(p.ws + WS_PROJ); const h16* qkm = (const h16*)(p.ws + WS_QKM); const float* gates = (const float*)(p.ws + WS_GATES);
    h16* odst = (h16*)(p.ws + (ODIR(dir) ? WS_OB : WS_HN));
    const size_t sidx = (((size_t)b * 4 + l) * 2 + dir) * 4 + h;
    f32x4 C[8];
    if (lat) {
        const float* src = p.st_mc + sidx * 16384;
#pragma unroll
        for (int dt = 0; dt < 8; ++dt)
#pragma unroll
            for (int j = 0; j < 4; ++j) C[dt][j] = src[(16 * dt + 4 * q + j) * 128 + 16 * w + c];
        if (tid < 128) NV[tid] = p.st_mn[sidx * 128 + tid];
        if (tid == 0) mst[0] = p.st_mm[sidx];
    } else {
#pragma unroll
        for (int dt = 0; dt < 8; ++dt) C[dt] = (f32x4){0.f, 0.f, 0.f, 0.f};
        if (tid < 128) NV[tid] = 0.f;
        if (tid == 0) mst[0] = 0.f;
    }
    u32x4 pq[2], pk[2], pv[2]; float pgi = 0.f, pgf = 0.f;
#define ML_LOAD(ii) do { _Pragma("unroll") for (int j_ = 0; j_ < 2; ++j_) { const int e_ = tid + 512 * j_, rw_ = e_ >> 4, pc_ = e_ & 15; const int pos_ = 64 * (ii) + rw_, tok_ = dir ? L - 1 - pos_ : pos_; \
            const size_t r_ = (size_t)(row0 + tok_); pq[j_] = *(const u32x4*)(qkm + r_ * DM + h * 128 + 8 * pc_); pk[j_] = *(const u32x4*)(qkm + r_ * DM + 512 + h * 128 + 8 * pc_); \
            pv[j_] = *(const u32x4*)(proj + r_ * NPROJ + 3584 + h * 128 + 8 * pc_); } \
        if (w == 0) { const int ps_ = 64 * (ii) + lane, tk_ = dir ? L - 1 - ps_ : ps_; const float* g_ = gates + (size_t)(row0 + tk_) * 16; pgi = g_[dir * 4 + h]; pgf = g_[8 + dir * 4 + h]; } } while (0)
    ML_LOAD(0);
    for (int i = 0; i < NC; ++i) {
        LAS unsigned char* buf = lds + (i & 1) * BUF;
        LAS unsigned char* QM = buf; LAS unsigned char* KM = buf + IMG; LAS unsigned char* VM = buf + 2 * IMG;
        LAS float* U = (LAS float*)(buf + 3 * IMG); LAS float* MM = U + 64; LAS float* AI = U + 128; LAS float* EN = U + 192; LAS float* UE = U + 256;
        asm volatile("s_waitcnt vmcnt(0)" ::: "memory");
#pragma unroll
        for (int j = 0; j < 2; ++j) { const int e = tid + 512 * j, rw = e >> 4, pc = e & 15;
            *(LAS u32x4*)(QM + rw * MP + 16 * pc) = pq[j]; *(LAS u32x4*)(KM + rw * MP + 16 * pc) = pk[j]; *(LAS u32x4*)(VM + rw * MP + 16 * pc) = pv[j]; }
        if (w == 0) {
            const float m0 = mst[0];
            const float gi = pgi, lf = fminf(pgf, 0.f) - log1pf(__expf(-fabsf(pgf)));
            float bc = lf;
#pragma unroll
            for (int o = 1; o < 64; o <<= 1) { const float x = __shfl_up(bc, o); if (lane >= o) bc += x; }
            const float u = gi - bc;
            float pm = u;
#pragma unroll
            for (int o = 1; o < 64; o <<= 1) { const float x = __shfl_up(pm, o); if (lane >= o) pm = fmaxf(pm, x); }
            const float Mt = fmaxf(m0, pm);
            const float M63 = rdlane(Mt, 63), bc63 = rdlane(bc, 63);
            U[lane] = u; MM[lane] = Mt; AI[lane] = __expf(m0 - Mt); EN[lane] = __expf(-(bc + Mt)); UE[lane] = __expf(u - M63);
            asm volatile("s_waitcnt lgkmcnt(0)" ::: "memory");
            if (lane == 0) mst[0] = bc63 + M63;
        }
        { const int nx = (i + 1 < NC) ? i + 1 : NC - 1; ML_LOAD(nx); }
        __syncthreads();
        {
            const int tt = w >> 1;
#pragma unroll
            for (int k2 = 0; k2 < 2; ++k2) {
                const int st = 2 * (w & 1) + k2;
                if (st <= tt) {
                    f32x4 accP = {0.f, 0.f, 0.f, 0.f};
#pragma unroll
                    for (int kp = 0; kp < 4; ++kp) {
                        const h16x8 a = *(const LAS h16x8*)(KM + (16 * st + c) * MP + 2 * (32 * kp + 8 * q));
                        const h16x8 bq = *(const LAS h16x8*)(QM + (16 * tt + c) * MP + 2 * (32 * kp + 8 * q));
                        accP = __builtin_amdgcn_mfma_f32_16x16x32_f16(a, bq, accP, 0, 0, 0);
                    }
                    const f32x4 u4 = *(const LAS f32x4*)(U + 16 * st + 4 * q); const float mt = MM[16 * tt + c];
                    float pj[4];
#pragma unroll
                    for (int j = 0; j < 4; ++j) { const float e = accP[j] * __expf(u4[j] - mt); pj[j] = (16 * st + 4 * q + j <= 16 * tt + c) ? e : 0.f; }
                    u32x2 pw; pw.x = pkh(pj[0], pj[1]); pw.y = pkh(pj[2], pj[3]);
                    *(LAS u32x2*)(PM + (16 * tt + c) * PP + 2 * (16 * st + 4 * q)) = pw;
                    float cs = (pj[0] + pj[1]) + (pj[2] + pj[3]);
                    cs += __shfl_xor(cs, 16); cs += __shfl_xor(cs, 32);
                    if (q == 0) DENP[st * 64 + 16 * tt + c] = cs;
                }
            }
            {
                const h16x8 qa = *(const LAS h16x8*)(QM + lane * MP + 2 * (16 * w)), qb = *(const LAS h16x8*)(QM + lane * MP + 2 * (16 * w + 8));
                const f32x4 n0 = *(const LAS f32x4*)(NV + 16 * w), n1 = *(const LAS f32x4*)(NV + 16 * w + 4), n2 = *(const LAS f32x4*)(NV + 16 * w + 8), n3 = *(const LAS f32x4*)(NV + 16 * w + 12);
                float s = 0.f;
#pragma unroll
                for (int j = 0; j < 4; ++j) s += (float)qa[j] * n0[j] + (float)qa[4 + j] * n1[j] + (float)qb[j] * n2[j] + (float)qb[4 + j] * n3[j];
                QNP[w * 64 + lane] = s;
            }
            {
                const int d = tid & 127, part = tid >> 7;
                float s = 0.f;
#pragma unroll
                for (int ss = 0; ss < 16; ++ss) s += UE[16 * part + ss] * (float)*(const LAS h16*)(KM + (16 * part + ss) * MP + 2 * d);
                NP[part * 128 + d] = s;
            }
        }
        __syncthreads();
        {
            h16x4 vtr[4];
#pragma unroll
            for (int st = 0; st < 4; ++st) vtr[st] = __builtin_bit_cast(h16x4, tr_read(VM + (16 * st + 4 * q + (c >> 2)) * MP + 2 * (16 * w + 4 * (c & 3))));
            h16x8 cp[4];
#pragma unroll
            for (int kp = 0; kp < 4; ++kp) { u32x4 sa; sa.x = pkh(C[2 * kp][0], C[2 * kp][1]); sa.y = pkh(C[2 * kp][2], C[2 * kp][3]); sa.z = pkh(C[2 * kp + 1][0], C[2 * kp + 1][1]); sa.w = pkh(C[2 * kp + 1][2], C[2 * kp + 1][3]); cp[kp] = __builtin_bit_cast(h16x8, sa); }
#pragma unroll
            for (int tt = 0; tt < 4; ++tt) {
                const int t = 16 * tt + c;
                f32x4 accI = {0.f, 0.f, 0.f, 0.f}, accN = {0.f, 0.f, 0.f, 0.f};
#pragma unroll
                for (int kp = 0; kp < 4; ++kp) {
                    const u32x2 b0 = *(const LAS u32x2*)(QM + t * MP + 2 * (32 * kp + 4 * q)), b1 = *(const LAS u32x2*)(QM + t * MP + 2 * (32 * kp + 16 + 4 * q));
                    u32x4 bb; bb.x = b0.x; bb.y = b0.y; bb.z = b1.x; bb.w = b1.y;
                    accI = __builtin_amdgcn_mfma_f32_16x16x32_f16(cp[kp], __builtin_bit_cast(h16x8, bb), accI, 0, 0, 0);
                }
                float den = 0.f;
#pragma unroll
                for (int st = 0; st < 4; ++st) if (st <= tt) {
                    const u32x2 pb = *(const LAS u32x2*)(PM + t * PP + 2 * (16 * st + 4 * q));
                    accN = __builtin_amdgcn_mfma_f32_16x16x16f16(vtr[st], __builtin_bit_cast(h16x4, pb), accN, 0, 0, 0);
                    den += DENP[st * 64 + t];
                }
                float qn = 0.f;
#pragma unroll
                for (int ww = 0; ww < 8; ++ww) qn += QNP[ww * 64 + t];
                const float ai = AI[t];
                den += ai * qn;
                const float sc = 1.f / fmaxf(fabsf(den), EN[t]);
                const f32x4 hv = (accN + accI * ai) * sc;
                const int pos = 64 * i + t, tok = dir ? L - 1 - pos : pos;
                u32x2 o; o.x = pkh(hv[0], hv[1]); o.y = pkh(hv[2], hv[3]);
                *(u32x2*)(odst + (size_t)(row0 + tok) * DM + 512 + h * 128 + 16 * w + 4 * q) = o;
            }
            const float a63 = AI[63];
            h16x4 vs[4];
#pragma unroll
            for (int st = 0; st < 4; ++st) { const f32x4 ue4 = *(const LAS f32x4*)(UE + 16 * st + 4 * q);
#pragma unroll
                for (int j = 0; j < 4; ++j) vs[st][j] = (h16)((float)vtr[st][j] * ue4[j]); }
#pragma unroll
            for (int dt = 0; dt < 8; ++dt) {
                C[dt] = C[dt] * a63;
#pragma unroll
                for (int st = 0; st < 4; ++st) {
                    const h16x4 ktr = __builtin_bit_cast(h16x4, tr_read(KM + (16 * st + 4 * q + (c >> 2)) * MP + 2 * (16 * dt + 4 * (c & 3))));
                    C[dt] = __builtin_amdgcn_mfma_f32_16x16x16f16(ktr, vs[st], C[dt], 0, 0, 0);
                }
            }
            if (tid < 128) NV[tid] = a63 * NV[tid] + (NP[tid] + NP[128 + tid]) + (NP[256 + tid] + NP[384 + tid]);
        }
#if defined(ML_EXTRA_SYNC)
        asm volatile("s_waitcnt vmcnt(0) lgkmcnt(0)" ::: "memory");
        __syncthreads();
#endif
    }
    __syncthreads();
    if (!lat) {
        float* dst = p.out + OUT_MC + sidx * 16384;
#pragma unroll
        for (int dt = 0; dt < 8; ++dt)
#pragma unroll
            for (int j = 0; j < 4; ++j) dst[(16 * dt + 4 * q + j) * 128 + 16 * w + c] = C[dt][j];
        if (tid < 128) p.out[OUT_MN + sidx * 128 + tid] = NV[tid];
        if (tid == 0) p.out[OUT_MM + sidx] = mst[0];
    }
    __syncthreads();
#undef ML_LOAD
}
#if defined(DIAG_ALL)
#define SCAN_HG(p, l, lat, b, h, dir, lds) do { scan_hgrn_mfma(p, l, lat, b, h, dir, (LAS unsigned char*)(lds)); asm volatile("s_waitcnt vmcnt(0)" ::: "memory"); __syncthreads(); scan_item<0, 1>(p, l, lat, b, h, dir, lds); } while (0)
#elif defined(HGRN_VALU)
#define SCAN_HG(p, l, lat, b, h, dir, lds) scan_item<0>(p, l, lat, b, h, dir, lds)
#else
#define SCAN_HG(p, l, lat, b, h, dir, lds) scan_hgrn_mfma(p, l, lat, b, h, dir, (LAS unsigned char*)(lds))
#endif
#if defined(MLSTM_VALU)
#define SCAN_ML(p, l, lat, b, h, dir, lds) scan_item<1>(p, l, lat, b, h, dir, lds)
#else
#if defined(DIAG_ALL)
#define SCAN_ML(p, l, lat, b, h, dir, lds) do { scan_mlstm_mfma(p, l, lat, b, h, dir, (LAS unsigned char*)(lds)); asm volatile("s_waitcnt vmcnt(0)" ::: "memory"); __syncthreads(); scan_item<1, 1>(p, l, lat, b, h, dir, lds); } while (0)
#elif defined(MLSTM_DIAG)
#define SCAN_ML(p, l, lat, b, h, dir, lds) do { scan_mlstm_mfma(p, l, lat, b, h, dir, (LAS unsigned char*)(lds)); \
        if ((lat) && (dir) == 0 && (l) == DIAG_LAYER) { asm volatile("s_waitcnt vmcnt(0)" ::: "memory"); __syncthreads(); scan_item<1, 1>(p, l, lat, b, h, dir, lds); } } while (0)
#elif defined(MLSTM_VALU_CTX)
#define SCAN_ML(p, l, lat, b, h, dir, lds) do { if (lat) scan_mlstm_mfma(p, l, lat, b, h, dir, (LAS unsigned char*)(lds)); else scan_item<1>(p, l, lat, b, h, dir, lds); } while (0)
#elif defined(MLSTM_MFMA_DIR0)
#define SCAN_ML(p, l, lat, b, h, dir, lds) do { if ((dir) == 0) scan_mlstm_mfma(p, l, lat, b, h, dir, (LAS unsigned char*)(lds)); else scan_item<1>(p, l, lat, b, h, dir, lds); } while (0)
#elif defined(MLSTM_BISECT)
#define SCAN_ML(p, l, lat, b, h, dir, lds) do { if (!((lat) && (dir) == 0 && (MLSTM_BISECT_COND))) scan_mlstm_mfma(p, l, lat, b, h, dir, (LAS unsigned char*)(lds)); else scan_item<1>(p, l, lat, b, h, dir, lds); } while (0)
#elif defined(MLSTM_VALU_LAT)
#define SCAN_ML(p, l, lat, b, h, dir, lds) do { if (!(lat)) scan_mlstm_mfma(p, l, lat, b, h, dir, (LAS unsigned char*)(lds)); else scan_item<1>(p, l, lat, b, h, dir, lds); } while (0)
#else
#define SCAN_ML(p, l, lat, b, h, dir, lds) scan_mlstm_mfma(p, l, lat, b, h, dir, (LAS unsigned char*)(lds))
#endif
#endif
__device__ __forceinline__ void scan_dispatch(const Params& p, int l, int it, LAS float* lds) {
    if (it < 128) { const int type = it >> 6, r = it & 63, b = r >> 3, h = (r >> 1) & 3, dir = r & 1; if (type == 0) SCAN_HG(p, l, 1, b, h, dir, lds); else SCAN_ML(p, l, 1, b, h, dir, lds); }
    else { const int q = it - 128, type = q >> 8, r = q & 255, b = r >> 3, h = (r >> 1) & 3, dir = r & 1; if (type == 0) SCAN_HG(p, l, 0, b, h, dir, lds); else SCAN_ML(p, l, 0, b, h, dir, lds); }
}
__device__ __forceinline__ void phase_scan(const Params& p, int l, LAS float* lds) {
    const int G = gridDim.x, bid = blockIdx.x;
    if (G == 256) {
        if (bid < 128) scan_dispatch(p, l, bid, lds);
        else for (int it = 128 + (bid - 128); it < 640; it += 128) scan_dispatch(p, l, it, lds);
    } else {
        for (int it = bid; it < 640; it += G) scan_dispatch(p, l, it, lds);
    }
}
__device__ __forceinline__ void phase_mixnorm(const Params& p, int l, int gw, int NGW, int lane) {
    const h16* of = (const h16*)(p.ws + WS_HN); const h16* ob = (const h16*)(p.ws + WS_OB); const h16* proj = (const h16*)(p.ws + WS_PROJ);
    h16* mix = (h16*)(p.ws + WS_QKM);
    const int col = 16 * lane;
    const float* nw = col < 512 ? p.hg_nw + l * 512 + col : p.ml_nw + l * 512 + (col - 512);
    float wv[16];
#pragma unroll
    for (int j = 0; j < 4; ++j) { const f32x4 t = *(const f32x4*)(nw + 4 * j); wv[4 * j] = t.x; wv[4 * j + 1] = t.y; wv[4 * j + 2] = t.z; wv[4 * j + 3] = t.w; }
    const int gcol = col < 512 ? 2048 + col : 4096 + (col - 512);
    for (int r = gw; r < T_ALL; r += NGW) {
        const h16x8 a0 = *(const h16x8*)(of + (size_t)r * DM + col), a1 = *(const h16x8*)(of + (size_t)r * DM + col + 8);
        const h16x8 b0 = *(const h16x8*)(ob + (size_t)r * DM + col), b1 = *(const h16x8*)(ob + (size_t)r * DM + col + 8);
        const h16x8 g0 = *(const h16x8*)(proj + (size_t)r * NPROJ + gcol), g1 = *(const h16x8*)(proj + (size_t)r * NPROJ + gcol + 8);
        float o[16]; float ss = 0.f;
#pragma unroll
        for (int j = 0; j < 8; ++j) { o[j] = (float)a0[j] + (float)b0[j]; o[8 + j] = (float)a1[j] + (float)b1[j]; }
#pragma unroll
        for (int j = 0; j < 16; ++j) ss += o[j] * o[j];
        ss += __shfl_xor(ss, 1); ss += __shfl_xor(ss, 2); ss += __shfl_xor(ss, 4);
        const float rstd = rsqrtf(ss * (1.f / 128.f) + EPS);
        u32x4 w0, w1;
        w0.x = pkh(o[0] * rstd * wv[0] * (float)g0[0], o[1] * rstd * wv[1] * (float)g0[1]); w0.y = pkh(o[2] * rstd * wv[2] * (float)g0[2], o[3] * rstd * wv[3] * (float)g0[3]);
        w0.z = pkh(o[4] * rstd * wv[4] * (float)g0[4], o[5] * rstd * wv[5] * (float)g0[5]); w0.w = pkh(o[6] * rstd * wv[6] * (float)g0[6], o[7] * rstd * wv[7] * (float)g0[7]);
        w1.x = pkh(o[8] * rstd * wv[8] * (float)g1[0], o[9] * rstd * wv[9] * (float)g1[1]); w1.y = pkh(o[10] * rstd * wv[10] * (float)g1[2], o[11] * rstd * wv[11] * (float)g1[3]);
        w1.z = pkh(o[12] * rstd * wv[12] * (float)g1[4], o[13] * rstd * wv[13] * (float)g1[5]); w1.w = pkh(o[14] * rstd * wv[14] * (float)g1[6], o[15] * rstd * wv[15] * (float)g1[7]);
        *(u32x4*)(mix + (size_t)r * DM + col) = w0; *(u32x4*)(mix + (size_t)r * DM + col + 8) = w1;
    }
}

#define XB_TMO      128
#define XB_XCNT(j)  (256  + 64 * (j))
#define XB_XSUB(j)  (1280 + 64 * (j))
#define XB_XGEN(j)  (2304 + 64 * (j))
#define XB_TOP      3328
#define XB_TOPGEN   3392
#define XCD_BAR_WORDS 3456
#define XB_SPIN_CAP (1u << 18)

__device__ __forceinline__ unsigned xb_ld(unsigned* p)              { return __hip_atomic_load(p, __ATOMIC_RELAXED, __HIP_MEMORY_SCOPE_AGENT); }
__device__ __forceinline__ unsigned xb_add(unsigned* p, unsigned v) { return __hip_atomic_fetch_add(p, v, __ATOMIC_RELAXED, __HIP_MEMORY_SCOPE_AGENT); }
__device__ __forceinline__ unsigned xb_xcc_id() { return (unsigned)__builtin_amdgcn_s_getreg((3 << 11) | 20) & 0xFu; }
#define XB_SPIN(cond, bar) do { unsigned _sp = 0; while (cond) { __builtin_amdgcn_s_sleep(1); \
    if ((++_sp & 255u) == 0u) { if (xb_ld(&(bar)[XB_TMO])) break; if (_sp > XB_SPIN_CAP) { atomicAdd(&(bar)[XB_TMO], 1u); break; } } } } while (0)

struct XcdBarrier {
    unsigned* bar; unsigned x;
    volatile LAS unsigned* st;
};

__device__ __forceinline__ XcdBarrier xcd_barrier_post(unsigned* bar, volatile LAS unsigned* st) {
    XcdBarrier b; b.bar = bar; b.x = xb_xcc_id(); b.st = st;
    if (threadIdx.x == 0) (void)xb_add(&bar[XB_XCNT(b.x)], 1u);
    return b;
}
__device__ __forceinline__ void xcd_barrier_complete(unsigned* bar, unsigned x, unsigned& nloc, unsigned& nx) {
    const unsigned G = gridDim.x * gridDim.y * gridDim.z;
    unsigned sum, cnt, mine, sp = 0u;
    for (;;) {
        sum = 0u; cnt = 0u; mine = 0u;
#pragma unroll
        for (unsigned j = 0; j < 16; ++j) { const unsigned c = xb_ld(&bar[XB_XCNT(j)]); sum += c; cnt += (c > 0u) ? 1u : 0u; mine = (j == x) ? c : mine; }
        if (sum == G) break;
        __builtin_amdgcn_s_sleep(1);
        if ((++sp & 255u) == 0u) { if (xb_ld(&bar[XB_TMO])) break; if (sp > XB_SPIN_CAP) { atomicAdd(&bar[XB_TMO], 1u); break; } }
    }
    nloc = mine > 0u ? mine : 1u; nx = cnt > 0u ? cnt : 1u;
}

__device__ __forceinline__ void xcd_barrier(const XcdBarrier& b) {
    asm volatile("s_waitcnt vmcnt(0)" ::: "memory");
    __syncthreads();
    if (threadIdx.x == 0) {
        unsigned* bar = b.bar;
        __builtin_amdgcn_s_waitcnt(0);
        unsigned nloc = b.st[0], nx = b.st[1];
        if (nloc == 0u) { xcd_barrier_complete(bar, b.x, nloc, nx); b.st[0] = nloc; b.st[1] = nx; }
        const unsigned old = xb_add(&bar[XB_XSUB(b.x)], 1u);
        const unsigned gen = old / nloc;
        if (old + 1u == (gen + 1u) * nloc) {
            __builtin_amdgcn_fence(__ATOMIC_RELEASE, "agent");
            asm volatile("s_waitcnt vmcnt(0)" ::: "memory");
            const unsigned og = xb_add(&bar[XB_TOP], 1u);
            const unsigned tg = og / nx;
            if (og + 1u == (tg + 1u) * nx) xb_add(&bar[XB_TOPGEN], 1u);
            else XB_SPIN(xb_ld(&bar[XB_TOPGEN]) == tg, bar);
            __builtin_amdgcn_fence(__ATOMIC_ACQUIRE, "agent");
            xb_add(&bar[XB_XGEN(b.x)], 1u);
            asm volatile("s_waitcnt vmcnt(0)" ::: "memory");
        } else {
            XB_SPIN(xb_ld(&bar[XB_XGEN(b.x)]) == gen, bar);
            __builtin_amdgcn_fence(__ATOMIC_ACQUIRE, "agent");
            asm volatile("s_waitcnt vmcnt(0)" ::: "memory");
        }
    }
    __syncthreads();
}


__global__ void __launch_bounds__(NTHR, 2) fwd_megakernel(Params p) {
    extern __shared__ __attribute__((aligned(16))) unsigned char lds_raw[];
    cg::grid_group grid = cg::this_grid();
#if defined(USE_CG_SYNC)
#define GSYNC() do { asm volatile("s_waitcnt vmcnt(0)" ::: "memory"); grid.sync(); } while (0)
#else
#define GSYNC() do { XcdBarrier xb_; xb_.bar = (unsigned*)(p.ws + WS_BAR); xb_.x = xb_xcc_id(); xb_.st = (volatile LAS unsigned*)(lds + 131072 + 512); xcd_barrier(xb_); } while (0)
#endif
    LAS unsigned char* lds = (LAS unsigned char*)lds_raw;
    LAS float* ldsf = (LAS float*)lds_raw;
    const int G = gridDim.x, NGW = G * NWV;
#define PHASE_IDS() const int tid = ltid(), lane = tid & 63, wave = __builtin_amdgcn_readfirstlane(tid >> 6), gw = blockIdx.x * NWV + wave; (void)tid; (void)lane; (void)gw
    const float* mod = (const float*)(p.ws + WS_MOD);
    h16* hn = (h16*)(p.ws + WS_HN); h16* proj = (h16*)(p.ws + WS_PROJ); h16* mix = (h16*)(p.ws + WS_QKM); h16* ff = (h16*)(p.ws + WS_PROJ);

    volatile LAS unsigned* xst = (volatile LAS unsigned*)(lds + 131072 + 512);
    if (ltid() < 4) xst[ltid()] = 0u;
    __syncthreads();
    XcdBarrier xbar = xcd_barrier_post((unsigned*)(p.ws + WS_BAR), xst);
    phase_mod_partial(p, ldsf);
    asm volatile("s_waitcnt vmcnt(0)" ::: "memory"); grid.sync();
    (void)xbar;
    phase_mod_reduce(p);
    GSYNC();
#if defined(DIAG_ALL)
    if (ltid() == 0) { float* dg = (float*)(p.ws + WS_MODP) + 4 * blockIdx.x; dg[0] = 0.f; dg[1] = 0.f; dg[2] = 0.f; dg[3] = 0.f; }
#endif
    for (int l = 0; l < 4; ++l) {
        { PHASE_IDS(); convert_weights(p, l, ldsf + wave * 2176, gw, NGW, lane); }
        { PHASE_IDS(); phase_norm(p, l, 0, l == 0, gw, NGW, lane); }
        GSYNC();
        {
            pg8::Gemm g{(const pg8::bf16_t*)hn, (const pg8::bf16_t*)(p.ws + WS_WIN), T_ALL, NPROJ_PAD, DM}; pg8::StaticOrder S; S.init(T_ALL, NPROJ_PAD, G, (int)blockIdx.x);
            EpiInProj E{proj, (float*)(p.ws + WS_GATES), p.gate_b + l * 16};
            pg8::gemm_phase<EpiInProj, pg8::StaticOrder, true, true>(lds, g, S, E);
#if defined(PROBE_GEMM2)
            GSYNC();
            pg8::gemm_phase<EpiInProj, pg8::StaticOrder, true, true>(lds, g, S, E);
#endif
        }
        GSYNC();
        { PHASE_IDS(); phase_gates(p, l, gw, NGW, lane); }
        phase_conv(p, l);
        GSYNC();
#if defined(PERTURB)
        { if (ltid() == 0) { const unsigned long long t0_ = __builtin_amdgcn_s_memrealtime(); const unsigned long long dl_ = (unsigned long long)(((blockIdx.x * 37u + l * 11u) % 64u) * 300u); while (__builtin_amdgcn_s_memrealtime() - t0_ < dl_) __builtin_amdgcn_s_sleep(4); } __syncthreads(); }
#endif
        phase_scan(p, l, ldsf);
#if defined(PERTURB)
        { if (ltid() == 0) { const unsigned long long t0_ = __builtin_amdgcn_s_memrealtime(); const unsigned long long dl_ = (unsigned long long)(((blockIdx.x * 53u + l * 7u) % 32u) * 400u); while (__builtin_amdgcn_s_memrealtime() - t0_ < dl_) __builtin_amdgcn_s_sleep(4); } __syncthreads(); }
#endif
#if defined(DELAY_AFTER_SCAN)
        { if (ltid() == 0) { const unsigned long long t0_ = __builtin_amdgcn_s_memrealtime(); while (__builtin_amdgcn_s_memrealtime() - t0_ < (unsigned long long)(DELAY_AFTER_SCAN) * 100ull) __builtin_amdgcn_s_sleep(8); } __syncthreads(); }
#endif
#if defined(LDS_CLEAR)
        { __syncthreads(); const int t_ = ltid(); for (int e = t_; e < 32768; e += NTHR) ldsf[e] = LDS_CLEAR_VAL; __syncthreads(); }
#endif
        GSYNC();
#if defined(MLSTM_DIAG)
        if (l == DIAG_LAYER && blockIdx.x == 0 && ltid() == 0) {
            const float* dg = (const float*)(p.ws + WS_MODP);
            float best = -1.f; int code = 0;
            for (int bb = 64; bb < 128; bb += 2) { const float rt = dg[4 * bb + DIAG_FIELD]; if (rt > best) { best = rt; int lg = 0; float x = rt; while (x < 1.f && lg < 31) { x *= 2.f; ++lg; } code = DIAG_CODE; } }
            const unsigned long long t0 = __builtin_amdgcn_s_memrealtime();
            while (__builtin_amdgcn_s_memrealtime() - t0 < (unsigned long long)code * 5000ull) __builtin_amdgcn_s_sleep(8);
        }
#endif
#if defined(PROBE_GSYNC10)
        for (int rep = 0; rep < 10; ++rep) GSYNC();
#endif
#if defined(PROBE_SCAN_TYPE)
        { const int bid_ = blockIdx.x;
          if (bid_ < 128) { if ((bid_ >> 6) == PROBE_SCAN_TYPE) scan_dispatch(p, l, bid_, ldsf); }
          else for (int it = 128 + (bid_ - 128); it < 640; it += 128) { if (((it - 128) >> 8) == PROBE_SCAN_TYPE) scan_dispatch(p, l, it, ldsf); } }
        GSYNC();
#endif
#if defined(PROBE_SCAN2)
        phase_scan(p, l, ldsf);
        GSYNC();
#endif
        { PHASE_IDS(); phase_mixnorm(p, l, gw, NGW, lane); }
        GSYNC();
        {
            pg8::Gemm g{(const pg8::bf16_t*)mix, (const pg8::bf16_t*)(p.ws + WS_WOUT), T_ALL, DM, DM}; pg8::StaticOrder S; S.init(T_ALL, DM, G, (int)blockIdx.x);
            EpiResid E{l == 0 ? p.x_prompt : p.out, l == 0 ? p.x_sample : p.out + (size_t)T_CTX * DM, p.out, mod + (size_t)l * 9 * 6144 + 2048};
#if defined(PROBE_GEMM2)
            { EpiResid E2 = E; E2.out = (float*)(p.ws + WS_PROJ); pg8::gemm_phase<EpiResid, pg8::StaticOrder, true, true>(lds, g, S, E2); GSYNC(); }
#endif
            pg8::gemm_phase<EpiResid, pg8::StaticOrder, true, true>(lds, g, S, E);
        }
        GSYNC();
        { PHASE_IDS(); phase_norm(p, l, 1, false, gw, NGW, lane); }
        GSYNC();
        {
            pg8::Gemm g{(const pg8::bf16_t*)hn, (const pg8::bf16_t*)(p.ws + WS_WGU), T_ALL, NGU, DM}; pg8::StaticOrder S; S.init(T_ALL, NGU, G, (int)blockIdx.x);
            EpiGateUp E{ff};
            pg8::gemm_phase<EpiGateUp, pg8::StaticOrder, true, true>(lds, g, S, E);
#if defined(PROBE_GEMM2)
            GSYNC();
            pg8::gemm_phase<EpiGateUp, pg8::StaticOrder, true, true>(lds, g, S, E);
#endif
        }
        GSYNC();
        {
            pg8::Gemm g{(const pg8::bf16_t*)ff, (const pg8::bf16_t*)(p.ws + WS_WDN), T_ALL, DM, DFF}; pg8::StaticOrder S; S.init(T_ALL, DM, G, (int)blockIdx.x);
            EpiResid E{p.out, p.out + (size_t)T_CTX * DM, p.out, mod + (size_t)l * 9 * 6144 + 5120};
#if defined(PROBE_GEMM2)
            { EpiResid E2 = E; E2.out = (float*)(p.ws + WS_QKM); pg8::gemm_phase<EpiResid, pg8::StaticOrder, true, true>(lds, g, S, E2); GSYNC(); }
#endif
            pg8::gemm_phase<EpiResid, pg8::StaticOrder, true, true>(lds, g, S, E);
        }
        GSYNC();
    }
    { PHASE_IDS(); phase_final_norm(p, gw, NGW, lane); }
#if defined(DIAG_ALL)
    if (blockIdx.x == 0 && ltid() == 0) {
        const float* dg = (const float*)(p.ws + WS_MODP);
        float best = -1.f; int code = 0;
        for (int bb = 0; bb < (int)gridDim.x; ++bb) { const float rt = dg[4 * bb]; if (rt > best) { best = rt; int lg = 0; float x = rt; while (x < 1.f && lg < 31) { x *= 2.f; ++lg; } code = DIAG_ALL_CODE; } }
        const unsigned long long t0 = __builtin_amdgcn_s_memrealtime();
        while (__builtin_amdgcn_s_memrealtime() - t0 < (unsigned long long)code * 5000ull) __builtin_amdgcn_s_sleep(8);
    }
#endif
}

extern "C" void kernel_launch(void* const* d_in, const int* in_sizes, int n_in, void* d_out, int out_size, void* d_ws, size_t ws_size, hipStream_t stream) {
    static int grid_blocks = 0;
    if (grid_blocks == 0) {
        if (n_in != 24 || (size_t)out_size != OUT_TOTAL || ws_size < WS_END) {
            fprintf(stderr, "kernel_launch: unexpected sizes n_in %d out %d ws %zu (need %zu)\n", n_in, out_size, ws_size, (size_t)WS_END); grid_blocks = -1; return;
        }
        int dev = 0, cus = 0, per_cu = 0;
        hipGetDevice(&dev);
        hipDeviceGetAttribute(&cus, hipDeviceAttributeMultiprocessorCount, dev);
        hipFuncSetAttribute((const void*)fwd_megakernel, hipFuncAttributeMaxDynamicSharedMemorySize, LDS_BYTES);
        hipOccupancyMaxActiveBlocksPerMultiprocessor(&per_cu, (const void*)fwd_megakernel, NTHR, LDS_BYTES);
        if (per_cu < 1) { fprintf(stderr, "kernel_launch: occupancy query says %d blocks per CU\n", per_cu); per_cu = 1; }
        grid_blocks = cus * 1;
        (void)hipGetLastError();
    }
    if (grid_blocks < 0) return;
    Params p{};
    const float** f = (const float**)&p;
    for (int i = 0; i < 24; ++i) f[i] = (const float*)d_in[i];
    p.out = (float*)d_out; p.ws = (unsigned char*)d_ws;
    if (hipMemsetAsync((char*)d_ws + WS_BAR, 0, 16384, stream) != hipSuccess) { fprintf(stderr, "kernel_launch: memset of the barrier words failed\n"); return; }
    void* args[] = {&p};
    hipError_t e = hipLaunchCooperativeKernel((const void*)fwd_megakernel, dim3(grid_blocks), dim3(NTHR), args, LDS_BYTES, stream);
    if (e != hipSuccess) fprintf(stderr, "cooperative launch failed: %s (grid %d)\n", hipGetErrorString(e), grid_blocks);
}
```

```cpp
#include <hip/hip_runtime.h>
#include <hip/hip_cooperative_groups.h>
#include <cstdio>
#include <cstdint>
namespace cg = cooperative_groups;
typedef _Float16 h16;
typedef _Float16 h16x8 __attribute__((ext_vector_type(8)));
typedef _Float16 h16x4 __attribute__((ext_vector_type(4)));
typedef _Float16 h16x2 __attribute__((ext_vector_type(2)));
typedef float f32x2 __attribute__((ext_vector_type(2)));
namespace pg8 {
#define PG8_LAS __attribute__((address_space(3)))
typedef unsigned short bf16_t;
typedef short bf16x8 __attribute__((ext_vector_type(8)));
typedef float f32x4 __attribute__((ext_vector_type(4)));
typedef unsigned u32x4 __attribute__((ext_vector_type(4)));
constexpr int BM = 256, BK = 64, HALF = 128, HTB = HALF * BK * 2  , STAGE_BYTES = 8 * HTB, NXCD = 8, WGM = 8;

__host__ __device__ __forceinline__ int lds_byte(int r, int c) { const int st = (r >> 4) * 2 + (c >> 5), rr = r & 15, cc = c & 31, ob = rr * 64 + cc * 2; return st * 1024 + (ob ^ (((ob >> 9) & 1) << 5)); }
__host__ __device__ __forceinline__ void stage_rc(int b, int& R, int& C) { const int st = b / 1024, sb = b % 1024, swz = sb ^ (((sb >> 9) & 1) << 5); R = (st >> 1) * 16 + swz / 64; C = (st & 1) * 32 + (swz % 64) / 2; }
__host__ __device__ __forceinline__ int perm32(int rho) { const int n = rho >> 4, i = rho & 15; return 8 * (i >> 2) + 4 * n + (i & 3); }

struct Unit { int pm, pn; };
struct Gemm { const bf16_t* A; const bf16_t* Bt; int M, N, K; };

struct StaticOrder {
    int nM, nN, nwg, G, c;
    __host__ __device__ void init(int M, int N, int G_, int c_) { nM = M / BM; nN = N / BM; nwg = nM * nN; G = G_; c = c_; }
    __host__ __device__ bool next(int i, Unit& u) const {
        const long L = (long)i * G + c; if (L >= nwg) return false;
        int wgid = (int)L; { const int q = nwg / NXCD, r = nwg % NXCD, xcd = wgid % NXCD, off = wgid / NXCD; wgid = (xcd < r ? xcd * (q + 1) : r * (q + 1) + (xcd - r) * q) + off; }
        const int nig = WGM * nN, gid = wgid / nig, fm = gid * WGM, gsz = (nM - fm) < WGM ? (nM - fm) : WGM;
        u.pm = fm + ((wgid % nig) % gsz); u.pn = (wgid % nig) / gsz; return true;
    }
    __device__ __forceinline__ void a_ready(const Unit&) const {}
    __device__ __forceinline__ void done(const Unit&) const {}
};

template <class Epi, class Sched, bool ALIGN_EPI = false, bool SP2 = false>
__device__ __forceinline__ void gemm_phase(PG8_LAS unsigned char* lds, const Gemm g, const Sched& S, const Epi& E) {
    int tid_l = threadIdx.x; asm volatile("" : "+v"(tid_l));
    const int tid = tid_l, wid = __builtin_amdgcn_readfirstlane(tid >> 6), lane = tid & 63, wr = wid >> 2, wc = wid & 3, fr = lane & 15, fq = lane >> 4;
    const int K = g.K, nt = K / BK;
    unsigned voffA[2], voffB[2];
#pragma unroll
    for (int i = 0; i < 2; ++i) { int R, C; stage_rc(tid * 16 + i * 8192, R, C); const int Rb = Epi::PERM ? ((R & ~31) + perm32(R & 31)) : R;
        voffA[i] = (unsigned)(R * K + C) * 2u; voffB[i] = (unsigned)(Rb * K + C) * 2u; }
    const size_t kstep = (size_t)(BK * 2);
    const size_t hstep = (size_t)HALF * K * 2;
    const size_t tstep = 2 * hstep;
    const unsigned ldsw = (unsigned)wid * 1024u;
    const int aoff = lds_byte(wr * 64 + fr, fq * 8), boff = lds_byte(wc * 32 + fr, fq * 8);
#define PG8_SA(b, h) (((b) * 2 + (h)) * HTB)
#define PG8_SB(b, h) ((4 + (b) * 2 + (h)) * HTB)
#define PG8_STAGE(bufoff, gbase, voff) do { _Pragma("unroll") for (int _i = 0; _i < 2; ++_i) \
        __builtin_amdgcn_global_load_lds((const unsigned*)((const char*)(gbase) + (voff)[_i]), (PG8_LAS unsigned*)(lds + (bufoff) + ldsw + _i * 8192), 16, 0, 0); } while (0)
#define PG8_LDA(dst, b, h) do { _Pragma("unroll") for (int m = 0; m < 4; ++m) _Pragma("unroll") for (int k = 0; k < 2; ++k) dst[m][k] = *(const PG8_LAS bf16x8*)(lds + PG8_SA(b, h) + aoff + m * 2048 + k * 1024); } while (0)
#define PG8_LDB(dst, b, h) do { _Pragma("unroll") for (int n = 0; n < 2; ++n) _Pragma("unroll") for (int k = 0; k < 2; ++k) dst[n][k] = *(const PG8_LAS bf16x8*)(lds + PG8_SB(b, h) + boff + n * 2048 + k * 1024); } while (0)
#define PG8_MMA(ai, bj, At, Bt) do { __builtin_amdgcn_s_setprio(1); _Pragma("unroll") for (int m = 0; m < 4; ++m) _Pragma("unroll") for (int n = 0; n < 2; ++n) _Pragma("unroll") for (int k = 0; k < 2; ++k) \
        acc[ai][bj][m][n] = __builtin_amdgcn_mfma_f32_16x16x32_f16(__builtin_bit_cast(h16x8, Bt[n][k]), __builtin_bit_cast(h16x8, At[m][k]), acc[ai][bj][m][n], 0, 0, 0); __builtin_amdgcn_s_setprio(0); } while (0)
#define PG8_WAIT_V(n) asm volatile("s_waitcnt vmcnt(" #n ")" ::: "memory")
#define PG8_WAIT_L(n) asm volatile("s_waitcnt lgkmcnt(" #n ")" ::: "memory")
#define PG8_BAR __builtin_amdgcn_s_barrier()
#define PG8_SCHED __builtin_amdgcn_sched_barrier(0)
    Unit cur, nxt; int ui = 0;
    if (!S.next(0, cur)) return;
    f32x4 acc[2][2][4][2];
#pragma unroll
    for (int a = 0; a < 2; ++a)
#pragma unroll
        for (int b = 0; b < 2; ++b)
#pragma unroll
            for (int m = 0; m < 4; ++m)
#pragma unroll
                for (int n = 0; n < 2; ++n) acc[a][b][m][n] = (f32x4){0.f, 0.f, 0.f, 0.f};
    bf16x8 At[4][2], B0[2][2], B1[2][2];
    const char* cA = (const char*)g.A + (size_t)cur.pm * tstep; const char* cB = (const char*)g.Bt + (size_t)cur.pn * tstep;
    S.a_ready(cur);
    if constexpr (SP2) {
        PG8_STAGE(PG8_SB(0, 0), cB, voffB); PG8_STAGE(PG8_SB(0, 1), cB + hstep, voffB); PG8_STAGE(PG8_SA(0, 0), cA, voffA); PG8_STAGE(PG8_SA(0, 1), cA + hstep, voffA);
        if (wr == 1) PG8_BAR;
        PG8_WAIT_V(2); PG8_BAR;
        PG8_STAGE(PG8_SB(1, 0), cB + kstep, voffB); PG8_STAGE(PG8_SA(1, 0), cA + kstep, voffA); PG8_STAGE(PG8_SB(1, 1), cB + hstep + kstep, voffB);
        PG8_WAIT_V(6); PG8_BAR;
    } else {
        PG8_STAGE(PG8_SB(0, 0), cB, voffB); PG8_STAGE(PG8_SA(0, 0), cA, voffA); PG8_STAGE(PG8_SB(0, 1), cB + hstep, voffB); PG8_STAGE(PG8_SA(0, 1), cA + hstep, voffA);
        if (wr == 1) PG8_BAR;
        PG8_WAIT_V(4); PG8_BAR;
        PG8_STAGE(PG8_SB(1, 0), cB + kstep, voffB); PG8_STAGE(PG8_SA(1, 0), cA + kstep, voffA); PG8_STAGE(PG8_SB(1, 1), cB + hstep + kstep, voffB);
        PG8_WAIT_V(6); PG8_BAR;
    }
    for (;;) {
        const bool has_next = S.next(ui + 1, nxt);
        const char* nA = has_next ? (const char*)g.A + (size_t)nxt.pm * tstep : cA; const char* nB = has_next ? (const char*)g.Bt + (size_t)nxt.pn * tstep : cB;
        for (int t = 0; t < nt; t += 2) {
            const bool last = (t == nt - 2);
            const char* a1 = cA + (size_t)(t + 1) * kstep;
            const char* a2 = last ? nA : cA + (size_t)(t + 2) * kstep; const char* b2 = last ? nB : cB + (size_t)(t + 2) * kstep;
            const char* a3 = a2 + kstep; const char* b3 = b2 + kstep;
            if (last && has_next) S.a_ready(nxt);
            if constexpr (SP2) {
            PG8_LDB(B0, 0, 0); PG8_LDB(B1, 0, 1); PG8_SCHED; PG8_LDA(At, 0, 0); PG8_STAGE(PG8_SA(1, 1), a1 + hstep, voffA);
            PG8_WAIT_V(8); PG8_WAIT_L(0); PG8_BAR; PG8_MMA(0, 0, At, B0); PG8_MMA(0, 1, At, B1); PG8_BAR; PG8_SCHED;
            PG8_LDA(At, 0, 1); PG8_STAGE(PG8_SB(0, 0), b2, voffB); PG8_STAGE(PG8_SB(0, 1), b2 + hstep, voffB); PG8_STAGE(PG8_SA(0, 0), a2, voffA);
            PG8_WAIT_V(8); PG8_WAIT_L(0); PG8_BAR; PG8_MMA(1, 0, At, B0); PG8_MMA(1, 1, At, B1); PG8_BAR; PG8_SCHED;
            PG8_LDB(B0, 1, 0); PG8_LDB(B1, 1, 1); PG8_SCHED; PG8_LDA(At, 1, 0); PG8_STAGE(PG8_SA(0, 1), a2 + hstep, voffA);
            PG8_WAIT_V(8); PG8_WAIT_L(0); PG8_BAR; PG8_MMA(0, 0, At, B0); PG8_MMA(0, 1, At, B1); PG8_BAR; PG8_SCHED;
            PG8_LDA(At, 1, 1); PG8_STAGE(PG8_SB(1, 0), b3, voffB); PG8_STAGE(PG8_SB(1, 1), b3 + hstep, voffB); PG8_STAGE(PG8_SA(1, 0), a3, voffA);
            PG8_WAIT_V(8); PG8_WAIT_L(0); PG8_BAR; PG8_MMA(1, 0, At, B0); PG8_MMA(1, 1, At, B1); PG8_BAR; PG8_SCHED;
            } else {
            PG8_LDB(B0, 0, 0); PG8_SCHED; PG8_LDA(At, 0, 0); PG8_STAGE(PG8_SA(1, 1), a1 + hstep, voffA);
            PG8_WAIT_L(8); PG8_BAR; PG8_WAIT_L(0); PG8_MMA(0, 0, At, B0); PG8_BAR; PG8_SCHED;
            PG8_LDB(B1, 0, 1); PG8_STAGE(PG8_SB(0, 0), b2, voffB);
            PG8_BAR; PG8_WAIT_L(0); PG8_MMA(0, 1, At, B1); PG8_BAR;
            PG8_LDA(At, 0, 1); PG8_STAGE(PG8_SA(0, 0), a2, voffA);
            PG8_BAR; PG8_WAIT_L(0); PG8_MMA(1, 0, At, B0); PG8_BAR; PG8_SCHED;
            PG8_STAGE(PG8_SB(0, 1), b2 + hstep, voffB);
            PG8_WAIT_V(6); PG8_BAR; PG8_MMA(1, 1, At, B1); PG8_BAR;
            PG8_LDB(B0, 1, 0); PG8_SCHED; PG8_LDA(At, 1, 0); PG8_STAGE(PG8_SA(0, 1), a2 + hstep, voffA);
            PG8_WAIT_L(8); PG8_BAR; PG8_WAIT_L(0); PG8_MMA(0, 0, At, B0); PG8_BAR; PG8_SCHED;
            PG8_LDB(B1, 1, 1); PG8_STAGE(PG8_SB(1, 0), b3, voffB);
            PG8_BAR; PG8_WAIT_L(0); PG8_MMA(0, 1, At, B1); PG8_BAR;
            PG8_LDA(At, 1, 1); PG8_STAGE(PG8_SA(1, 0), a3, voffA);
            PG8_BAR; PG8_WAIT_L(0); PG8_MMA(1, 0, At, B0); PG8_BAR; PG8_SCHED;
            PG8_STAGE(PG8_SB(1, 1), b3 + hstep, voffB);
            PG8_WAIT_V(6); PG8_BAR; PG8_MMA(1, 1, At, B1); PG8_BAR;
            }
        }
        if constexpr (ALIGN_EPI) { if (wr == 0) PG8_BAR; }
        if constexpr (!Epi::AFTER_DRAIN) { E(acc, cur, wr, wc, fr, fq); S.done(cur); }
        if (!has_next) break;
#pragma unroll
        for (int a = 0; a < 2; ++a)
#pragma unroll
            for (int b = 0; b < 2; ++b)
#pragma unroll
                for (int m = 0; m < 4; ++m)
#pragma unroll
                    for (int n = 0; n < 2; ++n) acc[a][b][m][n] = (f32x4){0.f, 0.f, 0.f, 0.f};
        cur = nxt; cA = nA; cB = nB; ++ui;
        if constexpr (ALIGN_EPI) { if (wr == 1) PG8_BAR; }
    }
    PG8_WAIT_V(0);
    if constexpr (!ALIGN_EPI) { if (wr == 0) PG8_BAR; }
    PG8_BAR;
    if constexpr (Epi::AFTER_DRAIN) { E.fused(acc, cur, wr, wc, fr, fq, lds, wid, lane); S.done(cur); }
#undef PG8_SA
#undef PG8_SB
#undef PG8_STAGE
#undef PG8_LDA
#undef PG8_LDB
#undef PG8_MMA
#undef PG8_WAIT_V
#undef PG8_WAIT_L
#undef PG8_BAR
#undef PG8_SCHED
}
}
#define LAS __attribute__((address_space(3)))
using pg8::f32x4;
using pg8::u32x4;
constexpr int T_CTX = 8192, T_LAT = 16384, T_ALL = 24576, DM = 1024;
constexpr int NPROJ = 4608, NPROJ_PAD = 4608, NIN = 4624, DFF = 2816, NGU = 5632;
constexpr int NTHR = 512, NWV = 8;
constexpr float EPS = 1e-6f;
constexpr int LDS_BYTES = 132096;

constexpr size_t OUT_HG = 25165824, OUT_MC = 41943040, OUT_MN = 58720256, OUT_MM = 58851328, OUT_TOTAL = 58852352;

constexpr size_t al256(size_t x) { return (x + 255) & ~(size_t)255; }
constexpr size_t WS_WIN = 0;
constexpr size_t WS_WOUT = WS_WIN + al256((size_t)NPROJ_PAD * DM * 2);
constexpr size_t WS_WGU = WS_WOUT + al256((size_t)DM * DM * 2);
constexpr size_t WS_WDN = WS_WGU + al256((size_t)NGU * DM * 2);
constexpr size_t WS_MODP = WS_WDN + al256((size_t)DM * DFF * 2);
constexpr size_t WS_MOD = WS_MODP + al256((size_t)8 * 4 * 9 * 6144 * 4);
constexpr size_t WS_LB = WS_MOD + al256((size_t)4 * 9 * 6144 * 4);
constexpr size_t WS_HN = WS_LB + al256((size_t)4 * 2 * 512 * 4);
constexpr size_t WS_PROJ = WS_HN + al256((size_t)T_ALL * DM * 2);
constexpr size_t WS_GATES = WS_PROJ + al256((size_t)T_ALL * NPROJ * 2);
constexpr size_t WS_QKM = WS_GATES + al256((size_t)T_ALL * 16 * 4);
constexpr size_t WS_OB = WS_QKM + al256((size_t)T_ALL * DM * 2);
constexpr size_t WS_BAR = WS_OB + al256((size_t)T_ALL * DM * 2);
constexpr size_t WS_WG16 = WS_BAR + 16384;
constexpr size_t WS_END = WS_WG16 + 32768;

#if defined(SWAP_OBUF)
#define ODIR(d) (!(d))
#else
#define ODIR(d) (d)
#endif
struct Params {
    const float *x_prompt, *x_sample, *st_hg, *st_mc, *st_mn, *st_mm, *cnd, *c_ctx, *n1w, *n2w, *w_mod, *b_mod, *w_in, *conv_w, *conv_b, *gate_b,
        *lb_logits, *hg_nw, *ml_nw, *w_out, *w_gate, *w_up, *w_down, *fin_w;
    float* out; unsigned char* ws;
};

__device__ __forceinline__ float sigmoidf_(float x) { return __builtin_amdgcn_rcpf(1.f + __expf(-x)); }
__device__ __forceinline__ float siluf_(float x) { return x * __builtin_amdgcn_rcpf(1.f + __expf(-x)); }
__device__ __forceinline__ unsigned pkh(float a, float b) { h16x2 v = {(h16)a, (h16)b}; return __builtin_bit_cast(unsigned, v); }
__device__ __forceinline__ float wave_sum(float v) {
#pragma unroll
    for (int o = 1; o < 64; o <<= 1) v += __shfl_xor(v, o);
    return v;
}
__device__ __forceinline__ int row_cidx(int row) { return row < T_CTX ? 0 : 1 + ((row - T_CTX) >> 11); }
__device__ __forceinline__ int ltid() { int t = threadIdx.x; asm volatile("" : "+v"(t)); return t; }
__device__ __forceinline__ float rdlane(float v, int l) { return __builtin_bit_cast(float, __builtin_amdgcn_readlane(__builtin_bit_cast(int, v), l)); }

struct EpiInProj {
    static constexpr bool PERM = true, AFTER_DRAIN = false;
    h16* proj; float* gates; const float* gate_b;
    __device__ __forceinline__ void operator()(const f32x4 (&acc)[2][2][4][2], const pg8::Unit& u, int wr, int wc, int fr, int fq) const {
        const int row0 = u.pm * 256 + wr * 64 + fr;
#pragma unroll
        for (int bj = 0; bj < 2; ++bj) {
            const int colt = u.pn * 256 + bj * 128, reg = colt >> 9;
            const int act = (reg == 0 || reg == 4) ? 1 : (reg == 8 ? 2 : 0);
            const int col0 = colt + wc * 32 + 8 * fq;
#pragma unroll
            for (int ai = 0; ai < 2; ++ai)
#pragma unroll
                for (int m = 0; m < 4; ++m) {
                    f32x4 v0 = acc[ai][bj][m][0], v1 = acc[ai][bj][m][1];
                    if (act == 1) {
#pragma unroll
                        for (int j = 0; j < 4; ++j) { v0[j] = siluf_(v0[j]); v1[j] = siluf_(v1[j]); }
                    } else if (act == 2) {
#pragma unroll
                        for (int j = 0; j < 4; ++j) { v0[j] = sigmoidf_(v0[j]); v1[j] = sigmoidf_(v1[j]); }
                    }
                    u32x4 w; w.x = pkh(v0[0], v0[1]); w.y = pkh(v0[2], v0[3]); w.z = pkh(v1[0], v1[1]); w.w = pkh(v1[2], v1[3]);
                    *(u32x4*)(proj + (size_t)(row0 + ai * 128 + m * 16) * NPROJ + col0) = w;
                }
        }
    }
};
struct EpiResid {
    static constexpr bool PERM = false, AFTER_DRAIN = false;
    const float* base_ctx; const float* base_lat; float* out; const float* gate;
    __device__ __forceinline__ void operator()(const f32x4 (&acc)[2][2][4][2], const pg8::Unit& u, int wr, int wc, int fr, int fq) const {
        const int cidx = u.pm < 32 ? 0 : 1 + ((u.pm - 32) >> 3);
        const float* gt = gate + cidx * 6144;
        const float* bs = u.pm < 32 ? base_ctx : base_lat - (size_t)T_CTX * DM;
        const int colb = u.pn * 256 + wc * 32 + 4 * fq;
        f32x4 g[2][2];
#pragma unroll
        for (int bj = 0; bj < 2; ++bj)
#pragma unroll
            for (int n = 0; n < 2; ++n) g[bj][n] = *(const f32x4*)(gt + colb + bj * 128 + n * 16);
#pragma unroll
        for (int ai = 0; ai < 2; ++ai)
#pragma unroll
            for (int m = 0; m < 4; ++m) {
                const size_t off = (size_t)(u.pm * 256 + ai * 128 + wr * 64 + m * 16 + fr) * DM + colb;
                f32x4 x[2][2];
#pragma unroll
                for (int bj = 0; bj < 2; ++bj)
#pragma unroll
                    for (int n = 0; n < 2; ++n) x[bj][n] = *(const f32x4*)(bs + off + bj * 128 + n * 16);
#pragma unroll
                for (int bj = 0; bj < 2; ++bj)
#pragma unroll
                    for (int n = 0; n < 2; ++n) *(f32x4*)(out + off + bj * 128 + n * 16) = x[bj][n] + g[bj][n] * acc[ai][bj][m][n];
                asm volatile("" ::: "memory");
            }
    }
};
struct EpiGateUp {
    static constexpr bool PERM = true, AFTER_DRAIN = false;
    h16* ff;
    __device__ __forceinline__ void operator()(const f32x4 (&acc)[2][2][4][2], const pg8::Unit& u, int wr, int wc, int fr, int fq) const {
        const int row0 = u.pm * 256 + wr * 64 + fr, col0 = u.pn * 128 + wc * 32 + 8 * fq;
#pragma unroll
        for (int ai = 0; ai < 2; ++ai)
#pragma unroll
            for (int m = 0; m < 4; ++m) {
                f32x4 v0, v1;
#pragma unroll
                for (int j = 0; j < 4; ++j) { v0[j] = siluf_(acc[ai][0][m][0][j]) * acc[ai][1][m][0][j]; v1[j] = siluf_(acc[ai][0][m][1][j]) * acc[ai][1][m][1][j]; }
                u32x4 w; w.x = pkh(v0[0], v0[1]); w.y = pkh(v0[2], v0[3]); w.z = pkh(v1[0], v1[1]); w.w = pkh(v1[2], v1[3]);
                *(u32x4*)(ff + (size_t)(row0 + ai * 128 + m * 16) * DFF + col0) = w;
            }
    }
};

__device__ __forceinline__ void phase_mod_partial(const Params& p, LAS float* ldsf) {
    const int tidx = ltid();
    for (int e = tidx; e < 9 * 1024; e += NTHR) { const int c = e >> 10, k = e & 1023; const float v = c == 0 ? p.c_ctx[k] : p.cnd[(c - 1) * 1024 + k]; ldsf[e] = siluf_(v); }
    __syncthreads();
    float* modp = (float*)(p.ws + WS_MODP);
    const int wave = tidx >> 6, lane = tidx & 63;
    const int gw = blockIdx.x * NWV + wave, NGW = gridDim.x * NWV;
    for (int it = gw; it < 4 * 96 * 8; it += NGW) {
        const int kq = it & 7, cgp = (it >> 3) % 96, l = it / (8 * 96);
        const int j = cgp * 64 + lane;
        const float* w = p.w_mod + ((size_t)l * 1024 + kq * 128) * 6144 + j;
        float acc[9];
#pragma unroll
        for (int c = 0; c < 9; ++c) acc[c] = 0.f;
#pragma unroll 4
        for (int k4 = 0; k4 < 32; ++k4) {
            const float w0 = w[(size_t)(4 * k4 + 0) * 6144], w1 = w[(size_t)(4 * k4 + 1) * 6144], w2 = w[(size_t)(4 * k4 + 2) * 6144], w3 = w[(size_t)(4 * k4 + 3) * 6144];
#pragma unroll
            for (int c = 0; c < 9; ++c) { const f32x4 s = *(const LAS f32x4*)(ldsf + c * 1024 + kq * 128 + 4 * k4); acc[c] += s.x * w0 + s.y * w1 + s.z * w2 + s.w * w3; }
        }
#pragma unroll
        for (int c = 0; c < 9; ++c) modp[(((size_t)kq * 4 + l) * 9 + c) * 6144 + j] = acc[c];
    }
    if (blockIdx.x == 0) {
        float* lb = (float*)(p.ws + WS_LB);
        for (int e = tidx; e < 1024; e += NTHR) {
            const float x0 = p.lb_logits[e], x1 = p.lb_logits[1024 + e], x2 = p.lb_logits[2048 + e], x3 = p.lb_logits[3072 + e];
            const float mx = fmaxf(fmaxf(x0, x1), fmaxf(x2, x3));
            const float e0 = expf(x0 - mx), e1 = expf(x1 - mx), e2 = expf(x2 - mx), e3 = expf(x3 - mx);
            const float inv = 1.f / (e0 + e1 + e2 + e3);
            lb[e] = 0.f; lb[1024 + e] = e1 * inv; lb[2048 + e] = (e1 + e2) * inv; lb[3072 + e] = (e1 + e2 + e3) * inv;
        }
    }
}
__device__ __forceinline__ void phase_mod_reduce(const Params& p) {
    const float* modp = (const float*)(p.ws + WS_MODP); float* mod = (float*)(p.ws + WS_MOD);
    for (int e = blockIdx.x * NTHR + ltid(); e < 4 * 9 * 6144; e += gridDim.x * NTHR) {
        const int j = e % 6144, l = e / (9 * 6144);
        float s = p.b_mod[l * 6144 + j];
#pragma unroll
        for (int kq = 0; kq < 8; ++kq) s += modp[(size_t)kq * (4 * 9 * 6144) + e];
        mod[e] = s;
    }
}

__device__ __forceinline__ void transpose_item(const float* W, int K, int N, h16* WT, int kb, int n0, int dst_row0, LAS float* scr, int lane) {
    const int k0 = 64 * kb, n = n0 + (lane & 31);
#pragma unroll 8
    for (int i = 0; i < 32; ++i) { const int kk = 2 * i + (lane >> 5); scr[kk * 33 + (lane & 31)] = (n < N) ? W[(size_t)(k0 + kk) * N + n] : 0.f; }
    asm volatile("s_waitcnt lgkmcnt(0)" ::: "memory");
    const int c = lane & 7;
#pragma unroll
    for (int j = 0; j < 4; ++j) {
        const int nn = (lane >> 3) + 8 * j; const LAS float* s = scr + (8 * c) * 33 + nn;
        u32x4 o; o.x = pkh(s[0 * 33], s[1 * 33]); o.y = pkh(s[2 * 33], s[3 * 33]); o.z = pkh(s[4 * 33], s[5 * 33]); o.w = pkh(s[6 * 33], s[7 * 33]);
        *(u32x4*)(WT + (size_t)(dst_row0 + nn) * K + k0 + 8 * c) = o;
    }
    asm volatile("s_waitcnt lgkmcnt(0)" ::: "memory");
}
__device__ __forceinline__ void convert_weights(const Params& p, int l, LAS float* scr, int gw, int NGW, int lane) {
    {
        h16* wg = (h16*)(p.ws + WS_WG16);
        const float* src = p.w_in + (size_t)l * DM * NIN + NPROJ;
        for (int e = gw * 64 + lane; e < 16 * 1024; e += NGW * 64) { const int k = e >> 4, g = e & 15; wg[g * 1024 + k] = (h16)src[(size_t)k * NIN + g]; }
    }
    h16* win = (h16*)(p.ws + WS_WIN); h16* wout = (h16*)(p.ws + WS_WOUT); h16* wgu = (h16*)(p.ws + WS_WGU); h16* wdn = (h16*)(p.ws + WS_WDN);
    constexpr int I_IN = 16 * 144, I_OUT = 16 * 32, I_G = 16 * 88, I_DN = 44 * 32;
    for (int it = gw; it < I_IN + I_OUT + 2 * I_G + I_DN; it += NGW) {
        int r = it;
        if (r < I_IN) { const int kb = r / 144, nb = r % 144; transpose_item(p.w_in + (size_t)l * DM * NIN, DM, NIN, win, kb, 32 * nb, 32 * nb, scr, lane); continue; } r -= I_IN;
        if (r < I_OUT) { const int kb = r / 32, nb = r % 32; transpose_item(p.w_out + (size_t)l * DM * DM, DM, DM, wout, kb, 32 * nb, 32 * nb, scr, lane); continue; } r -= I_OUT;
        if (r < I_G) { const int kb = r / 88, nb = r % 88, n0 = 32 * nb; transpose_item(p.w_gate + (size_t)l * DM * DFF, DM, DFF, wgu, kb, n0, (n0 >> 7) * 256 + (n0 & 127), scr, lane); continue; } r -= I_G;
        if (r < I_G) { const int kb = r / 88, nb = r % 88, n0 = 32 * nb; transpose_item(p.w_up + (size_t)l * DM * DFF, DM, DFF, wgu, kb, n0, (n0 >> 7) * 256 + 128 + (n0 & 127), scr, lane); continue; } r -= I_G;
        { const int kb = r / 32, nb = r % 32; transpose_item(p.w_down + (size_t)l * DFF * DM, DFF, DM, wdn, kb, 32 * nb, 32 * nb, scr, lane); }
    }
}
__device__ __forceinline__ void norm_mod_row(const float* xrow, const float* nw, const float* sc, const float* sh, h16* orow, int lane) {
    const f32x4* xr = (const f32x4*)xrow + lane;
    f32x4 v[4]; float s = 0.f;
#pragma unroll
    for (int j = 0; j < 4; ++j) { v[j] = xr[64 * j]; s += (v[j].x * v[j].x + v[j].y * v[j].y) + (v[j].z * v[j].z + v[j].w * v[j].w); }
    const float rstd = rsqrtf(wave_sum(s) * (1.f / DM) + EPS);
#pragma unroll
    for (int j = 0; j < 4; ++j) {
        const int col = 4 * lane + 256 * j;
        const f32x4 w4 = *(const f32x4*)(nw + col), s4 = *(const f32x4*)(sc + col), h4 = *(const f32x4*)(sh + col);
        const f32x4 y = v[j] * rstd * w4 * (1.f + s4) + h4;
        uint2 o; o.x = pkh(y.x, y.y); o.y = pkh(y.z, y.w);
        *(uint2*)(orow + col) = o;
    }
}
__device__ __forceinline__ void phase_norm(const Params& p, int l, int which, bool from_inputs, int gw, int NGW, int lane) {
    const float* mod = (const float*)(p.ws + WS_MOD) + (size_t)l * 9 * 6144;
    const float* nw = (which == 0 ? p.n1w : p.n2w) + l * DM;
    h16* hn = (h16*)(p.ws + WS_HN);
    for (int r = gw; r < T_ALL; r += NGW) {
        const float* xrow = from_inputs ? (r < T_CTX ? p.x_prompt + (size_t)r * DM : p.x_sample + (size_t)(r - T_CTX) * DM) : p.out + (size_t)r * DM;
        const float* m = mod + row_cidx(r) * 6144 + which * 3072;
        norm_mod_row(xrow, nw, m + 1024, m, hn + (size_t)r * DM, lane);
    }
}
__device__ __forceinline__ void phase_final_norm(const Params& p, int gw, int NGW, int lane) {
    for (int r = gw; r < T_ALL; r += NGW) {
        f32x4* xr = (f32x4*)(p.out + (size_t)r * DM) + lane;
        f32x4 v[4]; float s = 0.f;
#pragma unroll
        for (int j = 0; j < 4; ++j) { v[j] = xr[64 * j]; s += (v[j].x * v[j].x + v[j].y * v[j].y) + (v[j].z * v[j].z + v[j].w * v[j].w); }
        const float rstd = rsqrtf(wave_sum(s) * (1.f / DM) + EPS);
#pragma unroll
        for (int j = 0; j < 4; ++j) { const f32x4 w4 = *(const f32x4*)(p.fin_w + 4 * lane + 256 * j); xr[64 * j] = v[j] * rstd * w4; }
    }
}
__device__ __forceinline__ void phase_gates(const Params& p, int l, int gw, int NGW, int lane) {
    const h16* hn = (const h16*)(p.ws + WS_HN); const h16* wg = (const h16*)(p.ws + WS_WG16);
    float* gates = (float*)(p.ws + WS_GATES);
    const int c = lane & 15, q = lane >> 4;
    for (int grp = gw; grp < T_ALL / 16; grp += NGW) {
        const h16* ar = hn + (size_t)(16 * grp + c) * DM + 8 * q;
        const h16* br = wg + (size_t)c * DM + 8 * q;
        f32x4 acc = {0.f, 0.f, 0.f, 0.f};
#pragma unroll 8
        for (int kp = 0; kp < 32; ++kp) {
            const h16x8 a = *(const h16x8*)(ar + 32 * kp), bq = *(const h16x8*)(br + 32 * kp);
            acc = __builtin_amdgcn_mfma_f32_16x16x32_f16(a, bq, acc, 0, 0, 0);
        }
        const float bias = p.gate_b[l * 16 + c];
#pragma unroll
        for (int j = 0; j < 4; ++j) gates[(size_t)(16 * grp + 4 * q + j) * 16 + c] = acc[j] + bias;
    }
}
__device__ __forceinline__ void phase_conv(const Params& p, int l) {
    const h16* proj = (const h16*)(p.ws + WS_PROJ); h16* qkm = (h16*)(p.ws + WS_QKM);
    const float* cw = p.conv_w + (size_t)l * 9 * 1024; const float* cb = p.conv_b + l * 1024;
    for (int idx = blockIdx.x * NTHR + ltid(); idx < T_ALL * 128; idx += gridDim.x * NTHR) {
        const int r = idx >> 7, ch0 = (idx & 127) * 8;
        float acc[8];
        { const f32x4 b0 = *(const f32x4*)(cb + ch0), b1 = *(const f32x4*)(cb + ch0 + 4); acc[0] = b0.x; acc[1] = b0.y; acc[2] = b0.z; acc[3] = b0.w; acc[4] = b1.x; acc[5] = b1.y; acc[6] = b1.z; acc[7] = b1.w; }
        const h16* src = proj + 2560 + ch0;
        const bool lat = r >= T_CTX;
        const int pp = lat ? ((r - T_CTX) & 2047) : (r & 255);
        const int gy = lat ? (pp >> 6) : 0, gx = lat ? (pp & 63) : pp;
        const int H = lat ? 32 : 1, W = lat ? 64 : 256;
#pragma unroll
        for (int a = 0; a < 3; ++a) {
            const int yy = gy + a - 1;
            if (!lat && a != 1) continue;
            if (yy < 0 || yy >= H) continue;
#pragma unroll
            for (int b = 0; b < 3; ++b) {
                const int xx = gx + b - 1;
                if (xx < 0 || xx >= W) continue;
                const int rr = r + (a - 1) * 64 + (b - 1);
                const h16x8 x = *(const h16x8*)(src + (size_t)rr * NPROJ);
                const f32x4 t0 = *(const f32x4*)(cw + (a * 3 + b) * 1024 + ch0), t1 = *(const f32x4*)(cw + (a * 3 + b) * 1024 + ch0 + 4);
                acc[0] += t0.x * (float)x[0]; acc[1] += t0.y * (float)x[1]; acc[2] += t0.z * (float)x[2]; acc[3] += t0.w * (float)x[3];
                acc[4] += t1.x * (float)x[4]; acc[5] += t1.y * (float)x[5]; acc[6] += t1.z * (float)x[6]; acc[7] += t1.w * (float)x[7];
            }
        }
        const float sc = ch0 >= 512 ? 0.08838834764831845f : 1.f;
        u32x4 w; w.x = pkh(siluf_(acc[0]) * sc, siluf_(acc[1]) * sc); w.y = pkh(siluf_(acc[2]) * sc, siluf_(acc[3]) * sc);
        w.z = pkh(siluf_(acc[4]) * sc, siluf_(acc[5]) * sc); w.w = pkh(siluf_(acc[6]) * sc, siluf_(acc[7]) * sc);
        *(u32x4*)(qkm + (size_t)r * DM + ch0) = w;
    }
}

template <int TYPE  , int CMP = 0>
__device__ __forceinline__ void scan_item(const Params& p, int l, int lat, int b, int h, int dir, LAS float* lds) {
    const int tid = ltid(), lane = tid & 63, w = __builtin_amdgcn_readfirstlane(tid >> 6);
    const int L = lat ? 2048 : 256, row0 = lat ? T_CTX + b * 2048 : b * 256, NB = L / 16;
    LAS float* qs = lds;
    LAS float* fs = lds + 2048;
    LAS float* vs = lds + 4096;
    LAS float* part = lds + 6144;
    LAS float* partn = lds + 6144 + 16384;
    LAS float* scal = partn + 128;
    LAS float* mst = scal + 128;
    LAS float* cerr = mst + 16;
    LAS float* cref = cerr + 32;
    const h16* proj = (const h16*)(p.ws + WS_PROJ); const h16* qkm = (const h16*)(p.ws + WS_QKM); const float* gates = (const float*)(p.ws + WS_GATES);
    h16* odst = (h16*)(p.ws + (ODIR(dir) ? WS_OB : WS_HN));
    const size_t sidx = (((size_t)b * 4 + l) * 2 + dir) * 4 + h;
    if (CMP) { if (tid < 64) cerr[tid] = 0.f; __syncthreads(); }

    f32x2 S[16]; float nv = 0.f;
    if (lat) {
        const float* src = (TYPE == 0 ? p.st_hg : p.st_mc) + sidx * 16384;
#pragma unroll
        for (int dd = 0; dd < 16; ++dd) S[dd] = *(const f32x2*)(src + (16 * w + dd) * 128 + 2 * lane);
        if (TYPE == 1) { nv = lane < 16 ? p.st_mn[sidx * 128 + 16 * w + lane] : 0.f; if (tid == 0) mst[0] = p.st_mm[sidx]; }
    } else {
#pragma unroll
        for (int dd = 0; dd < 16; ++dd) S[dd] = (f32x2){0.f, 0.f};
        if (TYPE == 1 && tid == 0) mst[0] = 0.f;
    }
    const int tl = tid >> 5, d0 = 4 * (tid & 31);
    f32x4 lb4 = {0.f, 0.f, 0.f, 0.f};
    if (TYPE == 0) lb4 = *(const f32x4*)((const float*)(p.ws + WS_LB) + (l * 2 + dir) * 512 + h * 128 + d0);
    h16x4 pq, pz, pv; float pgi = 0.f, pgf = 0.f;
#define SCAN_LOAD(ii) do { const int pos_ = 16 * (ii) + tl, tok_ = dir ? L - 1 - pos_ : pos_; const size_t r_ = (size_t)(row0 + tok_); \
        if (TYPE == 0) { pq = *(const h16x4*)(proj + r_ * NPROJ + h * 128 + d0); pz = *(const h16x4*)(proj + r_ * NPROJ + 512 + dir * 512 + h * 128 + d0); pv = *(const h16x4*)(proj + r_ * NPROJ + 1536 + h * 128 + d0); } \
        else { pq = *(const h16x4*)(qkm + r_ * DM + h * 128 + d0); pz = *(const h16x4*)(qkm + r_ * DM + 512 + h * 128 + d0); pv = *(const h16x4*)(proj + r_ * NPROJ + 3584 + h * 128 + d0); \
               if (w == 0) { const int ps_ = 16 * (ii) + (lane & 15), tk_ = dir ? L - 1 - ps_ : ps_; const float* g_ = gates + (size_t)(row0 + tk_) * 16; pgi = g_[dir * 4 + h]; pgf = g_[8 + dir * 4 + h]; } } } while (0)
    SCAN_LOAD(0);
    for (int i = 0; i < NB; ++i) {
        const int par = i & 1;
        const int pos = 16 * i + tl, tok = dir ? L - 1 - pos : pos;
        const size_t r = (size_t)(row0 + tok);
        {
            *(LAS f32x4*)(qs + tl * 128 + d0) = (f32x4){(float)pq[0], (float)pq[1], (float)pq[2], (float)pq[3]};
            *(LAS f32x4*)(vs + tl * 128 + d0) = (f32x4){(float)pv[0], (float)pv[1], (float)pv[2], (float)pv[3]};
            if (TYPE == 0) {
                f32x4 f4;
#pragma unroll
                for (int j = 0; j < 4; ++j) f4[j] = lb4[j] + (1.f - lb4[j]) * sigmoidf_((float)pz[j]);
                *(LAS f32x4*)(fs + tl * 128 + d0) = f4;
            } else {
                *(LAS f32x4*)(fs + tl * 128 + d0) = (f32x4){(float)pz[0], (float)pz[1], (float)pz[2], (float)pz[3]};
                if (w == 0) {
                    const int t = lane & 15;
                    const float m0 = mst[0];
                    const float gi = pgi, lf = fminf(pgf, 0.f) - log1pf(__expf(-fabsf(pgf)));
                    float bc = lf;
#pragma unroll
                    for (int o = 1; o < 16; o <<= 1) { const float x = __shfl_up(bc, o, 16); if (t >= o) bc += x; }
                    float pm = gi - bc;
#pragma unroll
                    for (int o = 1; o < 16; o <<= 1) { const float x = __shfl_up(pm, o, 16); if (t >= o) pm = fmaxf(pm, x); }
                    const float mt = bc + fmaxf(m0, pm);
                    float mp = __shfl_up(mt, 1, 16); if (t == 0) mp = m0;
                    if (lane < 16) {
                        scal[(par * 16 + t) * 4 + 0] = __expf(lf + mp - mt);
                        scal[(par * 16 + t) * 4 + 1] = __expf(gi - mt);
                        scal[(par * 16 + t) * 4 + 2] = __expf(-mt);
                    }
                    asm volatile("s_waitcnt lgkmcnt(0)" ::: "memory");
                    if (lane == 15) mst[0] = mt;
                }
            }
        }
        if (i + 1 < NB) SCAN_LOAD(i + 1);
        __syncthreads();
#pragma unroll 2
        for (int t = 0; t < 16; ++t) {
            float fv = 0.f, qv = 0.f;
            if (lane < 16) { fv = fs[t * 128 + 16 * w + lane]; qv = qs[t * 128 + 16 * w + lane]; }
            const f32x2 v2 = *(const LAS f32x2*)(vs + t * 128 + 2 * lane);
            f32x2 o = {0.f, 0.f};
            if (TYPE == 0) {
#pragma unroll
                for (int dd = 0; dd < 16; ++dd) { const float sf = rdlane(fv, dd), sq = rdlane(qv, dd); S[dd] = v2 + sf * (S[dd] - v2); o += S[dd] * sq; }
            } else {
                const float a = __builtin_bit_cast(float, __builtin_amdgcn_readfirstlane(__builtin_bit_cast(int, scal[(par * 16 + t) * 4 + 0])));
                const float g = __builtin_bit_cast(float, __builtin_amdgcn_readfirstlane(__builtin_bit_cast(int, scal[(par * 16 + t) * 4 + 1])));
                const float gk = g * fv;
                nv = a * nv + gk;
                float nq = nv * qv;
                nq += __shfl_xor(nq, 8); nq += __shfl_xor(nq, 4); nq += __shfl_xor(nq, 2); nq += __shfl_xor(nq, 1);
                if (lane == 0) partn[t * 8 + w] = nq;
#pragma unroll
                for (int dd = 0; dd < 16; ++dd) { const float sk = rdlane(gk, dd), sq = rdlane(qv, dd); S[dd] = a * S[dd] + sk * v2; o += S[dd] * sq; }
            }
            *(LAS f32x2*)(part + (t * 8 + w) * 128 + 2 * lane) = o;
        }
        __syncthreads();
        {
            f32x4 acc = {0.f, 0.f, 0.f, 0.f};
#pragma unroll
            for (int ww = 0; ww < 8; ++ww) acc += *(const LAS f32x4*)(part + (tl * 8 + ww) * 128 + d0);
            if (TYPE == 1) {
                float den = 0.f;
#pragma unroll
                for (int ww = 0; ww < 8; ++ww) den += partn[tl * 8 + ww];
                const float sc = 1.f / fmaxf(fabsf(den), scal[(par * 16 + tl) * 4 + 2]);
                acc = acc * sc;
            }
            uint2 o; o.x = pkh(acc.x, acc.y); o.y = pkh(acc.z, acc.w);
            if (CMP) {
                const h16x4 old = *(const h16x4*)(odst + r * DM + TYPE * 512 + h * 128 + d0);
                float e = 0.f, rr = 0.f;
#pragma unroll
                for (int j = 0; j < 4; ++j) { const float df = (float)old[j] - acc[j]; e += df * df; rr += acc[j] * acc[j]; }
                e = wave_sum(e); rr = wave_sum(rr);
                if (lane == 0) { atomicAdd((float*)(cerr + (i >> 2)), e); atomicAdd((float*)(cref + (i >> 2)), rr); }
            }
            *(uint2*)(odst + r * DM + TYPE * 512 + h * 128 + d0) = o;
        }
    }
    if (CMP) {
        __syncthreads();
        if (tid == 0) {
            float best = -1.f; int bc_ = 0; float tot_e = 0.f, tot_r = 0.f;
            for (int cI = 0; cI < 32; ++cI) { const float rt = cerr[cI] / fmaxf(cref[cI], 1e-30f); tot_e += cerr[cI]; tot_r += cref[cI]; if (rt > best) { best = rt; bc_ = cI; } }
            float* dg = (float*)(p.ws + WS_MODP) + 4 * blockIdx.x;
#if defined(DIAG_ALL)
            const float tot = tot_e / fmaxf(tot_r, 1e-30f);
            if (tot > dg[0]) { dg[0] = tot; dg[1] = (float)(l * 8 + TYPE * 4 + lat * 2 + dir); dg[2] = best; dg[3] = (float)bc_; }
#else
            dg[0] = best; dg[1] = (float)bc_; dg[2] = tot_e / fmaxf(tot_r, 1e-30f); dg[3] = 0.f;
#endif
        }
    }
    if (!lat) {
        float* dst = p.out + (TYPE == 0 ? OUT_HG : OUT_MC) + sidx * 16384;
#pragma unroll
        for (int dd = 0; dd < 16; ++dd) *(f32x2*)(dst + (16 * w + dd) * 128 + 2 * lane) = S[dd];
        if (TYPE == 1) { if (lane < 16) p.out[OUT_MN + sidx * 128 + 16 * w + lane] = nv; if (tid == 0) p.out[OUT_MM + sidx] = mst[0]; }
    }
    __syncthreads();
#undef SCAN_LOAD
}
typedef unsigned u32x2 __attribute__((ext_vector_type(2)));
typedef short s16x8 __attribute__((ext_vector_type(8)));
typedef short s16x4 __attribute__((ext_vector_type(4)));
typedef __bf16 bf16x2_t __attribute__((ext_vector_type(2)));
__device__ __forceinline__ unsigned pkb(float a, float b) { f32x2 v = {a, b}; bf16x2_t r = __builtin_convertvector(v, bf16x2_t); return __builtin_bit_cast(unsigned, r); }
__device__ __forceinline__ unsigned short f2b(float a) { return (unsigned short)(pkb(a, 0.f) & 0xffffu); }
__device__ __forceinline__ s16x4 tr_read(LAS const unsigned char* ptr) { return __builtin_bit_cast(s16x4, __builtin_amdgcn_ds_read_tr16_b64_v4i16((LAS s16x4*)ptr)); }
constexpr int HP = 272;
__device__ __forceinline__ void scan_hgrn_mfma(const Params& p, int l, int lat, int b, int h, int dir, LAS unsigned char* lds) {
    const int tid = ltid(), lane = tid & 63, w = __builtin_amdgcn_readfirstlane(tid >> 6), c = lane & 15, q = lane >> 4;
    const int L = lat ? 2048 : 256, row0 = lat ? T_CTX + b * 2048 : b * 256, NB = L / 16;
    constexpr int IMG = 16 * HP, BUF = 4 * IMG + 512;
    LAS float* GS = (LAS float*)(lds + 2 * BUF);
    const h16* proj = (const h16*)(p.ws + WS_PROJ);
    h16* odst = (h16*)(p.ws + (ODIR(dir) ? WS_OB : WS_HN));
    const size_t sidx = (((size_t)b * 4 + l) * 2 + dir) * 4 + h;
    f32x4 S[8];
    if (lat) {
        const float* src = p.st_hg + sidx * 16384;
#pragma unroll
        for (int dt = 0; dt < 8; ++dt)
#pragma unroll
            for (int j = 0; j < 4; ++j) S[dt][j] = src[(16 * dt + 4 * q + j) * 128 + 16 * w + c];
    } else {
#pragma unroll
        for (int dt = 0; dt < 8; ++dt) S[dt] = (f32x4){0.f, 0.f, 0.f, 0.f};
    }
    const int pt = lane & 15, d0 = 16 * w + 4 * (lane >> 4);
    const f32x4 lb4 = *(const f32x4*)((const float*)(p.ws + WS_LB) + (l * 2 + dir) * 512 + h * 128 + d0);
    h16x4 rq, rz, rv;
#define HG_LOAD(ii) do { const int pos_ = 16 * (ii) + pt, tok_ = dir ? L - 1 - pos_ : pos_; const h16* r_ = proj + (size_t)(row0 + tok_) * NPROJ + h * 128 + d0; \
        rq = *(const h16x4*)(r_); rz = *(const h16x4*)(r_ + 512 + dir * 512); rv = *(const h16x4*)(r_ + 1536); } while (0)
#define HG_ROW_SHR(x, ctl) __builtin_bit_cast(float, __builtin_amdgcn_update_dpp(0, __builtin_bit_cast(int, (x)), (ctl), 0xF, 0xF, false))
    HG_LOAD(0);
    for (int i = 0; i < NB; ++i) {
        LAS unsigned char* buf = lds + (i & 1) * BUF;
        LAS unsigned char* QT = buf; LAS unsigned char* KT = buf + IMG; LAS unsigned char* KH = buf + 2 * IMG; LAS unsigned char* VV = buf + 3 * IMG; LAS float* AD = (LAS float*)(buf + 4 * IMG);
        asm volatile("s_waitcnt vmcnt(0)" ::: "memory");
        {
            float kk[4], G[4];
#pragma unroll
            for (int j = 0; j < 4; ++j) { const float f = lb4[j] + (1.f - lb4[j]) * sigmoidf_((float)rz[j]); kk[j] = 1.f - f; G[j] = __logf(f); }
#pragma unroll
            for (int j = 0; j < 4; ++j) {
                G[j] += HG_ROW_SHR(G[j], 0x111); G[j] += HG_ROW_SHR(G[j], 0x112); G[j] += HG_ROW_SHR(G[j], 0x114); G[j] += HG_ROW_SHR(G[j], 0x118);
            }
            float oq[4], ok[4], oh[4];
            float ev[4];
#pragma unroll
            for (int j = 0; j < 4; ++j) {
                const float e = __expf(G[j]), ei = __builtin_amdgcn_rcpf(fmaxf(e, 8.7565e-27f)); ev[j] = e;
                const float et = __shfl(e, 15, 16);
                oq[j] = (float)rq[j] * e; ok[j] = kk[j] * ei; oh[j] = kk[j] * (et * ei);
            }
            u32x2 wq, wk, wh, wv;
            wq.x = pkb(oq[0], oq[1]); wq.y = pkb(oq[2], oq[3]); wk.x = pkb(ok[0], ok[1]); wk.y = pkb(ok[2], ok[3]);
            wh.x = pkb(oh[0], oh[1]); wh.y = pkb(oh[2], oh[3]); wv.x = pkb((float)rv[0], (float)rv[1]); wv.y = pkb((float)rv[2], (float)rv[3]);
            *(LAS u32x2*)(QT + pt * HP + 2 * d0) = wq; *(LAS u32x2*)(KT + pt * HP + 2 * d0) = wk; *(LAS u32x2*)(KH + pt * HP + 2 * d0) = wh; *(LAS u32x2*)(VV + pt * HP + 2 * d0) = wv;
            if (pt == 15) *(LAS f32x4*)(AD + d0) = (f32x4){ev[0], ev[1], ev[2], ev[3]};
        }
        { const int nx = (i + 1 < NB) ? i + 1 : NB - 1; HG_LOAD(nx); }
        __syncthreads();
        {
            f32x4 accO = {0.f, 0.f, 0.f, 0.f};
#pragma unroll
            for (int kp = 0; kp < 4; ++kp) {
                u32x4 sa; sa.x = pkb(S[2 * kp][0], S[2 * kp][1]); sa.y = pkb(S[2 * kp][2], S[2 * kp][3]); sa.z = pkb(S[2 * kp + 1][0], S[2 * kp + 1][1]); sa.w = pkb(S[2 * kp + 1][2], S[2 * kp + 1][3]);
                const u32x2 b0 = *(const LAS u32x2*)(QT + c * HP + 2 * (32 * kp + 4 * q)), b1 = *(const LAS u32x2*)(QT + c * HP + 2 * (32 * kp + 16 + 4 * q));
                u32x4 bb; bb.x = b0.x; bb.y = b0.y; bb.z = b1.x; bb.w = b1.y;
                accO = __builtin_amdgcn_mfma_f32_16x16x32_bf16(__builtin_bit_cast(s16x8, sa), __builtin_bit_cast(s16x8, bb), accO, 0, 0, 0);
            }
            f32x4 accP = {0.f, 0.f, 0.f, 0.f};
#pragma unroll
            for (int kp = 0; kp < 4; ++kp) {
                const s16x8 a = *(const LAS s16x8*)(KT + c * HP + 2 * (32 * kp + 8 * q));
                const s16x8 bq = *(const LAS s16x8*)(QT + c * HP + 2 * (32 * kp + 8 * q));
                accP = __builtin_amdgcn_mfma_f32_16x16x32_bf16(a, bq, accP, 0, 0, 0);
            }
#pragma unroll
            for (int j = 0; j < 4; ++j) accP[j] = (4 * q + j > c) ? 0.f : accP[j];
            u32x2 pb; pb.x = pkb(accP[0], accP[1]); pb.y = pkb(accP[2], accP[3]);
            const s16x4 vtr = tr_read(VV + (4 * q + (c >> 2)) * HP + 2 * (16 * w + 4 * (c & 3)));
            accO = __builtin_amdgcn_mfma_f32_16x16x16bf16_1k(vtr, __builtin_bit_cast(s16x4, pb), accO, 0, 0, 0);
            {
                const int pos = 16 * i + c, tok = dir ? L - 1 - pos : pos;
                uint2 o; o.x = pkh(accO[0], accO[1]); o.y = pkh(accO[2], accO[3]);
                *(uint2*)(odst + (size_t)(row0 + tok) * DM + h * 128 + 16 * w + 4 * q) = o;
            }
#pragma unroll
            for (int dt = 0; dt < 8; ++dt) {
                const s16x4 ktr = tr_read(KH + (4 * q + (c >> 2)) * HP + 2 * (16 * dt + 4 * (c & 3)));
                const f32x4 ad = *(const LAS f32x4*)(AD + 16 * dt + 4 * q);
                S[dt] = S[dt] * ad;
                S[dt] = __builtin_amdgcn_mfma_f32_16x16x16bf16_1k(ktr, vtr, S[dt], 0, 0, 0);
            }
        }
#if defined(HG_EXTRA_SYNC)
        asm volatile("s_waitcnt vmcnt(0) lgkmcnt(0)" ::: "memory");
        __syncthreads();
#endif
    }
    if (!lat) {
        float* dst = p.out + OUT_HG + sidx * 16384;
#pragma unroll
        for (int dt = 0; dt < 8; ++dt)
#pragma unroll
            for (int j = 0; j < 4; ++j) dst[(16 * dt + 4 * q + j) * 128 + 16 * w + c] = S[dt][j];
    }
    __syncthreads();
#undef HG_LOAD
#undef HG_ROW_SHR
}
constexpr int MP = 272;
constexpr int PP = 144;
__device__ __forceinline__ void scan_mlstm_mfma(const Params& p, int l, int lat, int b, int h, int dir, LAS unsigned char* lds) {
    const int tid = ltid(), lane = tid & 63, w = __builtin_amdgcn_readfirstlane(tid >> 6), c = lane & 15, q = lane >> 4;
    const int L = lat ? 2048 : 256, row0 = lat ? T_CTX + b * 2048 : b * 256, NC = L / 64;
    constexpr int IMG = 64 * MP, BUF = 3 * IMG + 1536;
    LAS unsigned char* PM = lds + 2 * BUF;
    LAS float* DENP = (LAS float*)(PM + 64 * PP);
    LAS float* QNP = DENP + 256;
    LAS float* NP = QNP + 512;
    LAS float* NV = NP + 512;
    LAS float* mst = NV + 128;
    const h16* proj = (const h16*)(p.ws + WS_PROJ); const h16* qkm = (const h16*)(p.ws + WS_QKM); const float* gates = (const float*)(p.ws + WS_GATES);
    h16* odst = (h16*)(p.ws + (ODIR(dir) ? WS_OB : WS_HN));
    const size_t sidx = (((size_t)b * 4 + l) * 2 + dir) * 4 + h;
    f32x4 C[8];
    if (lat) {
        const float* src = p.st_mc + sidx * 16384;
#pragma unroll
        for (int dt = 0; dt < 8; ++dt)
#pragma unroll
            for (int j = 0; j < 4; ++j) C[dt][j] = src[(16 * dt + 4 * q + j) * 128 + 16 * w + c];
        if (tid < 128) NV[tid] = p.st_mn[sidx * 128 + tid];
        if (tid == 0) mst[0] = p.st_mm[sidx];
    } else {
#pragma unroll
        for (int dt = 0; dt < 8; ++dt) C[dt] = (f32x4){0.f, 0.f, 0.f, 0.f};
        if (tid < 128) NV[tid] = 0.f;
        if (tid == 0) mst[0] = 0.f;
    }
    u32x4 pq[2], pk[2], pv[2]; float pgi = 0.f, pgf = 0.f;
#define ML_LOAD(ii) do { _Pragma("unroll") for (int j_ = 0; j_ < 2; ++j_) { const int e_ = tid + 512 * j_, rw_ = e_ >> 4, pc_ = e_ & 15; const int pos_ = 64 * (ii) + rw_, tok_ = dir ? L - 1 - pos_ : pos_; \
            const size_t r_ = (size_t)(row0 + tok_); pq[j_] = *(const u32x4*)(qkm + r_ * DM + h * 128 + 8 * pc_); pk[j_] = *(const u32x4*)(qkm + r_ * DM + 512 + h * 128 + 8 * pc_); \
            pv[j_] = *(const u32x4*)(proj + r_ * NPROJ + 3584 + h * 128 + 8 * pc_); } \
        if (w == 0) { const int ps_ = 64 * (ii) + lane, tk_ = dir ? L - 1 - ps_ : ps_; const float* g_ = gates + (size_t)(row0 + tk_) * 16; pgi = g_[dir * 4 + h]; pgf = g_[8 + dir * 4 + h]; } } while (0)
    ML_LOAD(0);
    for (int i = 0; i < NC; ++i) {
        LAS unsigned char* buf = lds + (i & 1) * BUF;
        LAS unsigned char* QM = buf; LAS unsigned char* KM = buf + IMG; LAS unsigned char* VM = buf + 2 * IMG;
        LAS float* U = (LAS float*)(buf + 3 * IMG); LAS float* MM = U + 64; LAS float* AI = U + 128; LAS float* EN = U + 192; LAS float* UE = U + 256;
        asm volatile("s_waitcnt vmcnt(0)" ::: "memory");
#pragma unroll
        for (int j = 0; j < 2; ++j) { const int e = tid + 512 * j, rw = e >> 4, pc = e & 15;
            *(LAS u32x4*)(QM + rw * MP + 16 * pc) = pq[j]; *(LAS u32x4*)(KM + rw * MP + 16 * pc) = pk[j]; *(LAS u32x4*)(VM + rw * MP + 16 * pc) = pv[j]; }
        if (w == 0) {
            const float m0 = mst[0];
            const float gi = pgi, lf = fminf(pgf, 0.f) - log1pf(__expf(-fabsf(pgf)));
            float bc = lf;
#pragma unroll
            for (int o = 1; o < 64; o <<= 1) { const float x = __shfl_up(bc, o); if (lane >= o) bc += x; }
            const float u = gi - bc;
            float pm = u;
#pragma unroll
            for (int o = 1; o < 64; o <<= 1) { const float x = __shfl_up(pm, o); if (lane >= o) pm = fmaxf(pm, x); }
            const float Mt = fmaxf(m0, pm);
            const float M63 = rdlane(Mt, 63), bc63 = rdlane(bc, 63);
            U[lane] = u; MM[lane] = Mt; AI[lane] = __expf(m0 - Mt); EN[lane] = __expf(-(bc + Mt)); UE[lane] = __expf(u - M63);
            asm volatile("s_waitcnt lgkmcnt(0)" ::: "memory");
            if (lane == 0) mst[0] = bc63 + M63;
        }
        { const int nx = (i + 1 < NC) ? i + 1 : NC - 1; ML_LOAD(nx); }
        __syncthreads();
        {
            const int tt = w >> 1;
#pragma unroll
            for (int k2 = 0; k2 < 2; ++k2) {
                const int st = 2 * (w & 1) + k2;
                if (st <= tt) {
                    f32x4 accP = {0.f, 0.f, 0.f, 0.f};
#pragma unroll
                    for (int kp = 0; kp < 4; ++kp) {
                        const h16x8 a = *(const LAS h16x8*)(KM + (16 * st + c) * MP + 2 * (32 * kp + 8 * q));
                        const h16x8 bq = *(const LAS h16x8*)(QM + (16 * tt + c) * MP + 2 * (32 * kp + 8 * q));
                        accP = __builtin_amdgcn_mfma_f32_16x16x32_f16(a, bq, accP, 0, 0, 0);
                    }
                    const f32x4 u4 = *(const LAS f32x4*)(U + 16 * st + 4 * q); const float mt = MM[16 * tt + c];
                    float pj[4];
#pragma unroll
                    for (int j = 0; j < 4; ++j) { const float e = accP[j] * __expf(u4[j] - mt); pj[j] = (16 * st + 4 * q + j <= 16 * tt + c) ? e : 0.f; }
                    u32x2 pw; pw.x = pkh(pj[0], pj[1]); pw.y = pkh(pj[2], pj[3]);
                    *(LAS u32x2*)(PM + (16 * tt + c) * PP + 2 * (16 * st + 4 * q)) = pw;
                    float cs = (pj[0] + pj[1]) + (pj[2] + pj[3]);
                    cs += __shfl_xor(cs, 16); cs += __shfl_xor(cs, 32);
                    if (q == 0) DENP[st * 64 + 16 * tt + c] = cs;
                }
            }
            {
                const h16x8 qa = *(const LAS h16x8*)(QM + lane * MP + 2 * (16 * w)), qb = *(const LAS h16x8*)(QM + lane * MP + 2 * (16 * w + 8));
                const f32x4 n0 = *(const LAS f32x4*)(NV + 16 * w), n1 = *(const LAS f32x4*)(NV + 16 * w + 4), n2 = *(const LAS f32x4*)(NV + 16 * w + 8), n3 = *(const LAS f32x4*)(NV + 16 * w + 12);
                float s = 0.f;
#pragma unroll
                for (int j = 0; j < 4; ++j) s += (float)qa[j] * n0[j] + (float)qa[4 + j] * n1[j] + (float)qb[j] * n2[j] + (float)qb[4 + j] * n3[j];
                QNP[w * 64 + lane] = s;
            }
            {
                const int d = tid & 127, part = tid >> 7;
                float s = 0.f;
#pragma unroll
                for (int ss = 0; ss < 16; ++ss) s += UE[16 * part + ss] * (float)*(const LAS h16*)(KM + (16 * part + ss) * MP + 2 * d);
                NP[part * 128 + d] = s;
            }
        }
        __syncthreads();
        {
            h16x4 vtr[4];
#pragma unroll
            for (int st = 0; st < 4; ++st) vtr[st] = __builtin_bit_cast(h16x4, tr_read(VM + (16 * st + 4 * q + (c >> 2)) * MP + 2 * (16 * w + 4 * (c & 3))));
            h16x8 cp[4];
#pragma unroll
            for (int kp = 0; kp < 4; ++kp) { u32x4 sa; sa.x = pkh(C[2 * kp][0], C[2 * kp][1]); sa.y = pkh(C[2 * kp][2], C[2 * kp][3]); sa.z = pkh(C[2 * kp + 1][0], C[2 * kp + 1][1]); sa.w = pkh(C[2 * kp + 1][2], C[2 * kp + 1][3]); cp[kp] = __builtin_bit_cast(h16x8, sa); }
#pragma unroll
            for (int tt = 0; tt < 4; ++tt) {
                const int t = 16 * tt + c;
                f32x4 accI = {0.f, 0.f, 0.f, 0.f}, accN = {0.f, 0.f, 0.f, 0.f};
#pragma unroll
                for (int kp = 0; kp < 4; ++kp) {
                    const u32x2 b0 = *(const LAS u32x2*)(QM + t * MP + 2 * (32 * kp + 4 * q)), b1 = *(const LAS u32x2*)(QM + t * MP + 2 * (32 * kp + 16 + 4 * q));
                    u32x4 bb; bb.x = b0.x; bb.y = b0.y; bb.z = b1.x; bb.w = b1.y;
                    accI = __builtin_amdgcn_mfma_f32_16x16x32_f16(cp[kp], __builtin_bit_cast(h16x8, bb), accI, 0, 0, 0);
                }
                float den = 0.f;
#pragma unroll
                for (int st = 0; st < 4; ++st) if (st <= tt) {
                    const u32x2 pb = *(const LAS u32x2*)(PM + t * PP + 2 * (16 * st + 4 * q));
                    accN = __builtin_amdgcn_mfma_f32_16x16x16f16(vtr[st], __builtin_bit_cast(h16x4, pb), accN, 0, 0, 0);
                    den += DENP[st * 64 + t];
                }
                float qn = 0.f;
#pragma unroll
                for (int ww = 0; ww < 8; ++ww) qn += QNP[ww * 64 + t];
                const float ai = AI[t];
                den += ai * qn;
                const float sc = 1.f / fmaxf(fabsf(den), EN[t]);
                f32x4 hv = (accN + accI * ai) * sc;
#pragma unroll
                for (int j = 0; j < 4; ++j) hv[j] = fminf(fmaxf(hv[j], -60000.f), 60000.f);
                const int pos = 64 * i + t, tok = dir ? L - 1 - pos : pos;
                u32x2 o; o.x = pkh(hv[0], hv[1]); o.y = pkh(hv[2], hv[3]);
                *(u32x2*)(odst + (size_t)(row0 + tok) * DM + 512 + h * 128 + 16 * w + 4 * q) = o;
            }
            const float a63 = AI[63];
            h16x4 vs[4];
#pragma unroll
            for (int st = 0; st < 4; ++st) { const f32x4 ue4 = *(const LAS f32x4*)(UE + 16 * st + 4 * q);
#pragma unroll
                for (int j = 0; j < 4; ++j) vs[st][j] = (h16)((float)vtr[st][j] * ue4[j]); }
#pragma unroll
            for (int dt = 0; dt < 8; ++dt) {
                C[dt] = C[dt] * a63;
#pragma unroll
                for (int st = 0; st < 4; ++st) {
                    const h16x4 ktr = __builtin_bit_cast(h16x4, tr_read(KM + (16 * st + 4 * q + (c >> 2)) * MP + 2 * (16 * dt + 4 * (c & 3))));
                    C[dt] = __builtin_amdgcn_mfma_f32_16x16x16f16(ktr, vs[st], C[dt], 0, 0, 0);
                }
            }
            if (tid < 128) NV[tid] = a63 * NV[tid] + (NP[tid] + NP[128 + tid]) + (NP[256 + tid] + NP[384 + tid]);
        }
#if defined(ML_EXTRA_SYNC)
        asm volatile("s_waitcnt vmcnt(0) lgkmcnt(0)" ::: "memory");
        __syncthreads();
#endif
    }
    __syncthreads();
    if (!lat) {
        float* dst = p.out + OUT_MC + sidx * 16384;
#pragma unroll
        for (int dt = 0; dt < 8; ++dt)
#pragma unroll
            for (int j = 0; j < 4; ++j) dst[(16 * dt + 4 * q + j) * 128 + 16 * w + c] = C[dt][j];
        if (tid < 128) p.out[OUT_MN + sidx * 128 + tid] = NV[tid];
        if (tid == 0) p.out[OUT_MM + sidx] = mst[0];
    }
    __syncthreads();
#undef ML_LOAD
}
#if defined(DIAG_ALL)
#define SCAN_HG(p, l, lat, b, h, dir, lds) do { scan_hgrn_mfma(p, l, lat, b, h, dir, (LAS unsigned char*)(lds)); asm volatile("s_waitcnt vmcnt(0)" ::: "memory"); __syncthreads(); scan_item<0, 1>(p, l, lat, b, h, dir, lds); } while (0)
#elif defined(HGRN_VALU)
#define SCAN_HG(p, l, lat, b, h, dir, lds) scan_item<0>(p, l, lat, b, h, dir, lds)
#else
#define SCAN_HG(p, l, lat, b, h, dir, lds) scan_hgrn_mfma(p, l, lat, b, h, dir, (LAS unsigned char*)(lds))
#endif
#if defined(MLSTM_VALU)
#define SCAN_ML(p, l, lat, b, h, dir, lds) scan_item<1>(p, l, lat, b, h, dir, lds)
#else
#if defined(DIAG_ALL)
#define SCAN_ML(p, l, lat, b, h, dir, lds) do { scan_mlstm_mfma(p, l, lat, b, h, dir, (LAS unsigned char*)(lds)); asm volatile("s_waitcnt vmcnt(0)" ::: "memory"); __syncthreads(); scan_item<1, 1>(p, l, lat, b, h, dir, lds); } while (0)
#elif defined(MLSTM_DIAG)
#define SCAN_ML(p, l, lat, b, h, dir, lds) do { scan_mlstm_mfma(p, l, lat, b, h, dir, (LAS unsigned char*)(lds)); \
        if ((lat) && (dir) == 0 && (l) == DIAG_LAYER) { asm volatile("s_waitcnt vmcnt(0)" ::: "memory"); __syncthreads(); scan_item<1, 1>(p, l, lat, b, h, dir, lds); } } while (0)
#elif defined(MLSTM_VALU_CTX)
#define SCAN_ML(p, l, lat, b, h, dir, lds) do { if (lat) scan_mlstm_mfma(p, l, lat, b, h, dir, (LAS unsigned char*)(lds)); else scan_item<1>(p, l, lat, b, h, dir, lds); } while (0)
#elif defined(MLSTM_MFMA_DIR0)
#define SCAN_ML(p, l, lat, b, h, dir, lds) do { if ((dir) == 0) scan_mlstm_mfma(p, l, lat, b, h, dir, (LAS unsigned char*)(lds)); else scan_item<1>(p, l, lat, b, h, dir, lds); } while (0)
#elif defined(MLSTM_BISECT)
#define SCAN_ML(p, l, lat, b, h, dir, lds) do { if (!((lat) && (dir) == 0 && (MLSTM_BISECT_COND))) scan_mlstm_mfma(p, l, lat, b, h, dir, (LAS unsigned char*)(lds)); else scan_item<1>(p, l, lat, b, h, dir, lds); } while (0)
#elif defined(MLSTM_VALU_LAT)
#define SCAN_ML(p, l, lat, b, h, dir, lds) do { if (!(lat)) scan_mlstm_mfma(p, l, lat, b, h, dir, (LAS unsigned char*)(lds)); else scan_item<1>(p, l, lat, b, h, dir, lds); } while (0)
#else
#define SCAN_ML(p, l, lat, b, h, dir, lds) scan_mlstm_mfma(p, l, lat, b, h, dir, (LAS unsigned char*)(lds))
#endif
#endif
__device__ __forceinline__ void scan_dispatch(const Params& p, int l, int it, LAS float* lds) {
    if (it < 128) { const int type = it >> 6, r = it & 63, b = r >> 3, h = (r >> 1) & 3, dir = r & 1; if (type == 0) SCAN_HG(p, l, 1, b, h, dir, lds); else SCAN_ML(p, l, 1, b, h, dir, lds); }
    else { const int q = it - 128, type = q >> 8, r = q & 255, b = r >> 3, h = (r >> 1) & 3, dir = r & 1; if (type == 0) SCAN_HG(p, l, 0, b, h, dir, lds); else SCAN_ML(p, l, 0, b, h, dir, lds); }
}
__device__ __forceinline__ void phase_scan(const Params& p, int l, LAS float* lds) {
    const int G = gridDim.x, bid = blockIdx.x;
    if (G == 256) {
        if (bid < 128) scan_dispatch(p, l, bid, lds);
        else for (int it = 128 + (bid - 128); it < 640; it += 128) scan_dispatch(p, l, it, lds);
    } else {
        for (int it = bid; it < 640; it += G) scan_dispatch(p, l, it, lds);
    }
}
__device__ __forceinline__ void phase_mixnorm(const Params& p, int l, int gw, int NGW, int lane) {
    const h16* of = (const h16*)(p.ws + WS_HN); const h16* ob = (const h16*)(p.ws + WS_OB); const h16* proj = (const h16*)(p.ws + WS_PROJ);
    h16* mix = (h16*)(p.ws + WS_QKM);
    const int col = 16 * lane;
    const float* nw = col < 512 ? p.hg_nw + l * 512 + col : p.ml_nw + l * 512 + (col - 512);
    float wv[16];
#pragma unroll
    for (int j = 0; j < 4; ++j) { const f32x4 t = *(const f32x4*)(nw + 4 * j); wv[4 * j] = t.x; wv[4 * j + 1] = t.y; wv[4 * j + 2] = t.z; wv[4 * j + 3] = t.w; }
    const int gcol = col < 512 ? 2048 + col : 4096 + (col - 512);
    for (int r = gw; r < T_ALL; r += NGW) {
        const h16x8 a0 = *(const h16x8*)(of + (size_t)r * DM + col), a1 = *(const h16x8*)(of + (size_t)r * DM + col + 8);
        const h16x8 b0 = *(const h16x8*)(ob + (size_t)r * DM + col), b1 = *(const h16x8*)(ob + (size_t)r * DM + col + 8);
        const h16x8 g0 = *(const h16x8*)(proj + (size_t)r * NPROJ + gcol), g1 = *(const h16x8*)(proj + (size_t)r * NPROJ + gcol + 8);
        float o[16]; float ss = 0.f;
#pragma unroll
        for (int j = 0; j < 8; ++j) { o[j] = (float)a0[j] + (float)b0[j]; o[8 + j] = (float)a1[j] + (float)b1[j]; }
#pragma unroll
        for (int j = 0; j < 16; ++j) ss += o[j] * o[j];
        ss += __shfl_xor(ss, 1); ss += __shfl_xor(ss, 2); ss += __shfl_xor(ss, 4);
        const float rstd = rsqrtf(ss * (1.f / 128.f) + EPS);
        u32x4 w0, w1;
        w0.x = pkh(o[0] * rstd * wv[0] * (float)g0[0], o[1] * rstd * wv[1] * (float)g0[1]); w0.y = pkh(o[2] * rstd * wv[2] * (float)g0[2], o[3] * rstd * wv[3] * (float)g0[3]);
        w0.z = pkh(o[4] * rstd * wv[4] * (float)g0[4], o[5] * rstd * wv[5] * (float)g0[5]); w0.w = pkh(o[6] * rstd * wv[6] * (float)g0[6], o[7] * rstd * wv[7] * (float)g0[7]);
        w1.x = pkh(o[8] * rstd * wv[8] * (float)g1[0], o[9] * rstd * wv[9] * (float)g1[1]); w1.y = pkh(o[10] * rstd * wv[10] * (float)g1[2], o[11] * rstd * wv[11] * (float)g1[3]);
        w1.z = pkh(o[12] * rstd * wv[12] * (float)g1[4], o[13] * rstd * wv[13] * (float)g1[5]); w1.w = pkh(o[14] * rstd * wv[14] * (float)g1[6], o[15] * rstd * wv[15] * (float)g1[7]);
        *(u32x4*)(mix + (size_t)r * DM + col) = w0; *(u32x4*)(mix + (size_t)r * DM + col + 8) = w1;
    }
}

#define XB_TMO      128
#define XB_XCNT(j)  (256  + 64 * (j))
#define XB_XSUB(j)  (1280 + 64 * (j))
#define XB_XGEN(j)  (2304 + 64 * (j))
#define XB_TOP      3328
#define XB_TOPGEN   3392
#define XCD_BAR_WORDS 3456
#define XB_SPIN_CAP (1u << 18)

__device__ __forceinline__ unsigned xb_ld(unsigned* p)              { return __hip_atomic_load(p, __ATOMIC_RELAXED, __HIP_MEMORY_SCOPE_AGENT); }
__device__ __forceinline__ unsigned xb_add(unsigned* p, unsigned v) { return __hip_atomic_fetch_add(p, v, __ATOMIC_RELAXED, __HIP_MEMORY_SCOPE_AGENT); }
__device__ __forceinline__ unsigned xb_xcc_id() { return (unsigned)__builtin_amdgcn_s_getreg((3 << 11) | 20) & 0xFu; }
#define XB_SPIN(cond, bar) do { unsigned _sp = 0; while (cond) { __builtin_amdgcn_s_sleep(1); \
    if ((++_sp & 255u) == 0u) { if (xb_ld(&(bar)[XB_TMO])) break; if (_sp > XB_SPIN_CAP) { atomicAdd(&(bar)[XB_TMO], 1u); break; } } } } while (0)

struct XcdBarrier {
    unsigned* bar; unsigned x;
    volatile LAS unsigned* st;
};

__device__ __forceinline__ XcdBarrier xcd_barrier_post(unsigned* bar, volatile LAS unsigned* st) {
    XcdBarrier b; b.bar = bar; b.x = xb_xcc_id(); b.st = st;
    if (threadIdx.x == 0) (void)xb_add(&bar[XB_XCNT(b.x)], 1u);
    return b;
}
__device__ __forceinline__ void xcd_barrier_complete(unsigned* bar, unsigned x, unsigned& nloc, unsigned& nx) {
    const unsigned G = gridDim.x * gridDim.y * gridDim.z;
    unsigned sum, cnt, mine, sp = 0u;
    for (;;) {
        sum = 0u; cnt = 0u; mine = 0u;
#pragma unroll
        for (unsigned j = 0; j < 16; ++j) { const unsigned c = xb_ld(&bar[XB_XCNT(j)]); sum += c; cnt += (c > 0u) ? 1u : 0u; mine = (j == x) ? c : mine; }
        if (sum == G) break;
        __builtin_amdgcn_s_sleep(1);
        if ((++sp & 255u) == 0u) { if (xb_ld(&bar[XB_TMO])) break; if (sp > XB_SPIN_CAP) { atomicAdd(&bar[XB_TMO], 1u); break; } }
    }
    nloc = mine > 0u ? mine : 1u; nx = cnt > 0u ? cnt : 1u;
}

__device__ __forceinline__ void xcd_barrier(const XcdBarrier& b) {
    asm volatile("s_waitcnt vmcnt(0)" ::: "memory");
    __syncthreads();
    if (threadIdx.x == 0) {
        unsigned* bar = b.bar;
        __builtin_amdgcn_s_waitcnt(0);
        unsigned nloc = b.st[0], nx = b.st[1];
        if (nloc == 0u) { xcd_barrier_complete(bar, b.x, nloc, nx); b.st[0] = nloc; b.st[1] = nx; }
        const unsigned old = xb_add(&bar[XB_XSUB(b.x)], 1u);
        const unsigned gen = old / nloc;
        if (old + 1u == (gen + 1u) * nloc) {
            __builtin_amdgcn_fence(__ATOMIC_RELEASE, "agent");
            asm volatile("s_waitcnt vmcnt(0)" ::: "memory");
            const unsigned og = xb_add(&bar[XB_TOP], 1u);
            const unsigned tg = og / nx;
            if (og + 1u == (tg + 1u) * nx) xb_add(&bar[XB_TOPGEN], 1u);
            else XB_SPIN(xb_ld(&bar[XB_TOPGEN]) == tg, bar);
            __builtin_amdgcn_fence(__ATOMIC_ACQUIRE, "agent");
            xb_add(&bar[XB_XGEN(b.x)], 1u);
            asm volatile("s_waitcnt vmcnt(0)" ::: "memory");
        } else {
            XB_SPIN(xb_ld(&bar[XB_XGEN(b.x)]) == gen, bar);
            __builtin_amdgcn_fence(__ATOMIC_ACQUIRE, "agent");
            asm volatile("s_waitcnt vmcnt(0)" ::: "memory");
        }
    }
    __syncthreads();
}


__global__ void __launch_bounds__(NTHR, 2) fwd_megakernel(Params p) {
    extern __shared__ __attribute__((aligned(16))) unsigned char lds_raw[];
    cg::grid_group grid = cg::this_grid();
#if defined(USE_CG_SYNC)
#define GSYNC() do { asm volatile("s_waitcnt vmcnt(0)" ::: "memory"); grid.sync(); } while (0)
#else
#define GSYNC() do { XcdBarrier xb_; xb_.bar = (unsigned*)(p.ws + WS_BAR); xb_.x = xb_xcc_id(); xb_.st = (volatile LAS unsigned*)(lds + 131072 + 512); xcd_barrier(xb_); } while (0)
#endif
    LAS unsigned char* lds = (LAS unsigned char*)lds_raw;
    LAS float* ldsf = (LAS float*)lds_raw;
    const int G = gridDim.x, NGW = G * NWV;
#define PHASE_IDS() const int tid = ltid(), lane = tid & 63, wave = __builtin_amdgcn_readfirstlane(tid >> 6), gw = blockIdx.x * NWV + wave; (void)tid; (void)lane; (void)gw
    const float* mod = (const float*)(p.ws + WS_MOD);
    h16* hn = (h16*)(p.ws + WS_HN); h16* proj = (h16*)(p.ws + WS_PROJ); h16* mix = (h16*)(p.ws + WS_QKM); h16* ff = (h16*)(p.ws + WS_PROJ);

    volatile LAS unsigned* xst = (volatile LAS unsigned*)(lds + 131072 + 512);
    if (ltid() < 4) xst[ltid()] = 0u;
    __syncthreads();
    XcdBarrier xbar = xcd_barrier_post((unsigned*)(p.ws + WS_BAR), xst);
    phase_mod_partial(p, ldsf);
    asm volatile("s_waitcnt vmcnt(0)" ::: "memory"); grid.sync();
    (void)xbar;
    phase_mod_reduce(p);
    GSYNC();
#if defined(DIAG_ALL)
    if (ltid() == 0) { float* dg = (float*)(p.ws + WS_MODP) + 4 * blockIdx.x; dg[0] = 0.f; dg[1] = 0.f; dg[2] = 0.f; dg[3] = 0.f; }
#endif
    for (int l = 0; l < 4; ++l) {
        { PHASE_IDS(); convert_weights(p, l, ldsf + wave * 2176, gw, NGW, lane); }
        { PHASE_IDS(); phase_norm(p, l, 0, l == 0, gw, NGW, lane); }
        GSYNC();
        {
            pg8::Gemm g{(const pg8::bf16_t*)hn, (const pg8::bf16_t*)(p.ws + WS_WIN), T_ALL, NPROJ_PAD, DM}; pg8::StaticOrder S; S.init(T_ALL, NPROJ_PAD, G, (int)blockIdx.x);
            EpiInProj E{proj, (float*)(p.ws + WS_GATES), p.gate_b + l * 16};
            pg8::gemm_phase<EpiInProj, pg8::StaticOrder, true, true>(lds, g, S, E);
#if defined(PROBE_GEMM2)
            GSYNC();
            pg8::gemm_phase<EpiInProj, pg8::StaticOrder, true, true>(lds, g, S, E);
#endif
        }
        GSYNC();
        { PHASE_IDS(); phase_gates(p, l, gw, NGW, lane); }
        phase_conv(p, l);
        GSYNC();
#if defined(PERTURB)
        { if (ltid() == 0) { const unsigned long long t0_ = __builtin_amdgcn_s_memrealtime(); const unsigned long long dl_ = (unsigned long long)(((blockIdx.x * 37u + l * 11u) % 64u) * 300u); while (__builtin_amdgcn_s_memrealtime() - t0_ < dl_) __builtin_amdgcn_s_sleep(4); } __syncthreads(); }
#endif
        phase_scan(p, l, ldsf);
#if defined(PERTURB)
        { if (ltid() == 0) { const unsigned long long t0_ = __builtin_amdgcn_s_memrealtime(); const unsigned long long dl_ = (unsigned long long)(((blockIdx.x * 53u + l * 7u) % 32u) * 400u); while (__builtin_amdgcn_s_memrealtime() - t0_ < dl_) __builtin_amdgcn_s_sleep(4); } __syncthreads(); }
#endif
#if defined(DELAY_AFTER_SCAN)
        { if (ltid() == 0) { const unsigned long long t0_ = __builtin_amdgcn_s_memrealtime(); while (__builtin_amdgcn_s_memrealtime() - t0_ < (unsigned long long)(DELAY_AFTER_SCAN) * 100ull) __builtin_amdgcn_s_sleep(8); } __syncthreads(); }
#endif
#if defined(LDS_CLEAR)
        { __syncthreads(); const int t_ = ltid(); for (int e = t_; e < 32768; e += NTHR) ldsf[e] = LDS_CLEAR_VAL; __syncthreads(); }
#endif
        GSYNC();
#if defined(MLSTM_DIAG)
        if (l == DIAG_LAYER && blockIdx.x == 0 && ltid() == 0) {
            const float* dg = (const float*)(p.ws + WS_MODP);
            float best = -1.f; int code = 0;
            for (int bb = 64; bb < 128; bb += 2) { const float rt = dg[4 * bb + DIAG_FIELD]; if (rt > best) { best = rt; int lg = 0; float x = rt; while (x < 1.f && lg < 31) { x *= 2.f; ++lg; } code = DIAG_CODE; } }
            const unsigned long long t0 = __builtin_amdgcn_s_memrealtime();
            while (__builtin_amdgcn_s_memrealtime() - t0 < (unsigned long long)code * 5000ull) __builtin_amdgcn_s_sleep(8);
        }
#endif
#if defined(PROBE_GSYNC10)
        for (int rep = 0; rep < 10; ++rep) GSYNC();
#endif
#if defined(PROBE_SCAN_TYPE)
        { const int bid_ = blockIdx.x;
          if (bid_ < 128) { if ((bid_ >> 6) == PROBE_SCAN_TYPE) scan_dispatch(p, l, bid_, ldsf); }
          else for (int it = 128 + (bid_ - 128); it < 640; it += 128) { if (((it - 128) >> 8) == PROBE_SCAN_TYPE) scan_dispatch(p, l, it, ldsf); } }
        GSYNC();
#endif
#if defined(PROBE_SCAN2)
        phase_scan(p, l, ldsf);
        GSYNC();
#endif
        { PHASE_IDS(); phase_mixnorm(p, l, gw, NGW, lane); }
        GSYNC();
        {
            pg8::Gemm g{(const pg8::bf16_t*)mix, (const pg8::bf16_t*)(p.ws + WS_WOUT), T_ALL, DM, DM}; pg8::StaticOrder S; S.init(T_ALL, DM, G, (int)blockIdx.x);
            EpiResid E{l == 0 ? p.x_prompt : p.out, l == 0 ? p.x_sample : p.out + (size_t)T_CTX * DM, p.out, mod + (size_t)l * 9 * 6144 + 2048};
#if defined(PROBE_GEMM2)
            { EpiResid E2 = E; E2.out = (float*)(p.ws + WS_PROJ); pg8::gemm_phase<EpiResid, pg8::StaticOrder, true, true>(lds, g, S, E2); GSYNC(); }
#endif
            pg8::gemm_phase<EpiResid, pg8::StaticOrder, true, true>(lds, g, S, E);
        }
        GSYNC();
        { PHASE_IDS(); phase_norm(p, l, 1, false, gw, NGW, lane); }
        GSYNC();
        {
            pg8::Gemm g{(const pg8::bf16_t*)hn, (const pg8::bf16_t*)(p.ws + WS_WGU), T_ALL, NGU, DM}; pg8::StaticOrder S; S.init(T_ALL, NGU, G, (int)blockIdx.x);
            EpiGateUp E{ff};
            pg8::gemm_phase<EpiGateUp, pg8::StaticOrder, true, true>(lds, g, S, E);
#if defined(PROBE_GEMM2)
            GSYNC();
            pg8::gemm_phase<EpiGateUp, pg8::StaticOrder, true, true>(lds, g, S, E);
#endif
        }
        GSYNC();
        {
            pg8::Gemm g{(const pg8::bf16_t*)ff, (const pg8::bf16_t*)(p.ws + WS_WDN), T_ALL, DM, DFF}; pg8::StaticOrder S; S.init(T_ALL, DM, G, (int)blockIdx.x);
            EpiResid E{p.out, p.out + (size_t)T_CTX * DM, p.out, mod + (size_t)l * 9 * 6144 + 5120};
#if defined(PROBE_GEMM2)
            { EpiResid E2 = E; E2.out = (float*)(p.ws + WS_QKM); pg8::gemm_phase<EpiResid, pg8::StaticOrder, true, true>(lds, g, S, E2); GSYNC(); }
#endif
            pg8::gemm_phase<EpiResid, pg8::StaticOrder, true, true>(lds, g, S, E);
        }
        GSYNC();
    }
    { PHASE_IDS(); phase_final_norm(p, gw, NGW, lane); }
#if defined(DIAG_ALL)
    if (blockIdx.x == 0 && ltid() == 0) {
        const float* dg = (const float*)(p.ws + WS_MODP);
        float best = -1.f; int code = 0;
        for (int bb = 0; bb < (int)gridDim.x; ++bb) { const float rt = dg[4 * bb]; if (rt > best) { best = rt; int lg = 0; float x = rt; while (x < 1.f && lg < 31) { x *= 2.f; ++lg; } code = DIAG_ALL_CODE; } }
        const unsigned long long t0 = __builtin_amdgcn_s_memrealtime();
        while (__builtin_amdgcn_s_memrealtime() - t0 < (unsigned long long)code * 5000ull) __builtin_amdgcn_s_sleep(8);
    }
#endif
}

extern "C" void kernel_launch(void* const* d_in, const int* in_sizes, int n_in, void* d_out, int out_size, void* d_ws, size_t ws_size, hipStream_t stream) {
    static int grid_blocks = 0;
    if (grid_blocks == 0) {
        if (n_in != 24 || (size_t)out_size != OUT_TOTAL || ws_size < WS_END) {
            fprintf(stderr, "kernel_launch: unexpected sizes n_in %d out %d ws %zu (need %zu)\n", n_in, out_size, ws_size, (size_t)WS_END); grid_blocks = -1; return;
        }
        int dev = 0, cus = 0, per_cu = 0;
        hipGetDevice(&dev);
        hipDeviceGetAttribute(&cus, hipDeviceAttributeMultiprocessorCount, dev);
        hipFuncSetAttribute((const void*)fwd_megakernel, hipFuncAttributeMaxDynamicSharedMemorySize, LDS_BYTES);
        hipOccupancyMaxActiveBlocksPerMultiprocessor(&per_cu, (const void*)fwd_megakernel, NTHR, LDS_BYTES);
        if (per_cu < 1) { fprintf(stderr, "kernel_launch: occupancy query says %d blocks per CU\n", per_cu); per_cu = 1; }
        grid_blocks = cus * 1;
        (void)hipGetLastError();
    }
    if (grid_blocks < 0) return;
    Params p{};
    const float** f = (const float**)&p;
    for (int i = 0; i < 24; ++i) f[i] = (const float*)d_in[i];
    p.out = (float*)d_out; p.ws = (unsigned char*)d_ws;
    if (hipMemsetAsync((char*)d_ws + WS_BAR, 0, 16384, stream) != hipSuccess) { fprintf(stderr, "kernel_launch: memset of the barrier words failed\n"); return; }
    void* args[] = {&p};
    hipError_t e = hipLaunchCooperativeKernel((const void*)fwd_megakernel, dim3(grid_blocks), dim3(NTHR), args, LDS_BYTES, stream);
    if (e != hipSuccess) fprintf(stderr, "cooperative launch failed: %s (grid %d)\n", hipGetErrorString(e), grid_blocks);
}
```

```cpp
#include <hip/hip_runtime.h>
#include <hip/hip_cooperative_groups.h>
#include <cstdio>
#include <cstdint>
namespace cg = cooperative_groups;
typedef _Float16 h16;
typedef _Float16 h16x8 __attribute__((ext_vector_type(8)));
typedef _Float16 h16x4 __attribute__((ext_vector_type(4)));
typedef _Float16 h16x2 __attribute__((ext_vector_type(2)));
typedef float f32x2 __attribute__((ext_vector_type(2)));
namespace pg8 {
#define PG8_LAS __attribute__((address_space(3)))
typedef unsigned short bf16_t;
typedef short bf16x8 __attribute__((ext_vector_type(8)));
typedef float f32x4 __attribute__((ext_vector_type(4)));
typedef unsigned u32x4 __attribute__((ext_vector_type(4)));
constexpr int BM = 256, BK = 64, HALF = 128, HTB = HALF * BK * 2  , STAGE_BYTES = 8 * HTB, NXCD = 8, WGM = 8;

__host__ __device__ __forceinline__ int lds_byte(int r, int c) { const int st = (r >> 4) * 2 + (c >> 5), rr = r & 15, cc = c & 31, ob = rr * 64 + cc * 2; return st * 1024 + (ob ^ (((ob >> 9) & 1) << 5)); }
__host__ __device__ __forceinline__ void stage_rc(int b, int& R, int& C) { const int st = b / 1024, sb = b % 1024, swz = sb ^ (((sb >> 9) & 1) << 5); R = (st >> 1) * 16 + swz / 64; C = (st & 1) * 32 + (swz % 64) / 2; }
__host__ __device__ __forceinline__ int perm32(int rho) { const int n = rho >> 4, i = rho & 15; return 8 * (i >> 2) + 4 * n + (i & 3); }

struct Unit { int pm, pn; };
struct Gemm { const bf16_t* A; const bf16_t* Bt; int M, N, K; };

struct StaticOrder {
    int nM, nN, nwg, G, c;
    __host__ __device__ void init(int M, int N, int G_, int c_) { nM = M / BM; nN = N / BM; nwg = nM * nN; G = G_; c = c_; }
    __host__ __device__ bool next(int i, Unit& u) const {
        const long L = (long)i * G + c; if (L >= nwg) return false;
        int wgid = (int)L; { const int q = nwg / NXCD, r = nwg % NXCD, xcd = wgid % NXCD, off = wgid / NXCD; wgid = (xcd < r ? xcd * (q + 1) : r * (q + 1) + (xcd - r) * q) + off; }
        const int nig = WGM * nN, gid = wgid / nig, fm = gid * WGM, gsz = (nM - fm) < WGM ? (nM - fm) : WGM;
        u.pm = fm + ((wgid % nig) % gsz); u.pn = (wgid % nig) / gsz; return true;
    }
    __device__ __forceinline__ void a_ready(const Unit&) const {}
    __device__ __forceinline__ void done(const Unit&) const {}
};

template <class Epi, class Sched, bool ALIGN_EPI = false, bool SP2 = false>
__device__ __forceinline__ void gemm_phase(PG8_LAS unsigned char* lds, const Gemm g, const Sched& S, const Epi& E) {
    int tid_l = threadIdx.x; asm volatile("" : "+v"(tid_l));
    const int tid = tid_l, wid = __builtin_amdgcn_readfirstlane(tid >> 6), lane = tid & 63, wr = wid >> 2, wc = wid & 3, fr = lane & 15, fq = lane >> 4;
    const int K = g.K, nt = K / BK;
    unsigned voffA[2], voffB[2];
#pragma unroll
    for (int i = 0; i < 2; ++i) { int R, C; stage_rc(tid * 16 + i * 8192, R, C); const int Rb = Epi::PERM ? ((R & ~31) + perm32(R & 31)) : R;
        voffA[i] = (unsigned)(R * K + C) * 2u; voffB[i] = (unsigned)(Rb * K + C) * 2u; }
    const size_t kstep = (size_t)(BK * 2);
    const size_t hstep = (size_t)HALF * K * 2;
    const size_t tstep = 2 * hstep;
    const unsigned ldsw = (unsigned)wid * 1024u;
    const int aoff = lds_byte(wr * 64 + fr, fq * 8), boff = lds_byte(wc * 32 + fr, fq * 8);
#define PG8_SA(b, h) (((b) * 2 + (h)) * HTB)
#define PG8_SB(b, h) ((4 + (b) * 2 + (h)) * HTB)
#define PG8_STAGE(bufoff, gbase, voff) do { _Pragma("unroll") for (int _i = 0; _i < 2; ++_i) \
        __builtin_amdgcn_global_load_lds((const unsigned*)((const char*)(gbase) + (voff)[_i]), (PG8_LAS unsigned*)(lds + (bufoff) + ldsw + _i * 8192), 16, 0, 0); } while (0)
#define PG8_LDA(dst, b, h) do { _Pragma("unroll") for (int m = 0; m < 4; ++m) _Pragma("unroll") for (int k = 0; k < 2; ++k) dst[m][k] = *(const PG8_LAS bf16x8*)(lds + PG8_SA(b, h) + aoff + m * 2048 + k * 1024); } while (0)
#define PG8_LDB(dst, b, h) do { _Pragma("unroll") for (int n = 0; n < 2; ++n) _Pragma("unroll") for (int k = 0; k < 2; ++k) dst[n][k] = *(const PG8_LAS bf16x8*)(lds + PG8_SB(b, h) + boff + n * 2048 + k * 1024); } while (0)
#define PG8_MMA(ai, bj, At, Bt) do { __builtin_amdgcn_s_setprio(1); _Pragma("unroll") for (int m = 0; m < 4; ++m) _Pragma("unroll") for (int n = 0; n < 2; ++n) _Pragma("unroll") for (int k = 0; k < 2; ++k) \
        acc[ai][bj][m][n] = __builtin_amdgcn_mfma_f32_16x16x32_f16(__builtin_bit_cast(h16x8, Bt[n][k]), __builtin_bit_cast(h16x8, At[m][k]), acc[ai][bj][m][n], 0, 0, 0); __builtin_amdgcn_s_setprio(0); } while (0)
#define PG8_WAIT_V(n) asm volatile("s_waitcnt vmcnt(" #n ")" ::: "memory")
#define PG8_WAIT_L(n) asm volatile("s_waitcnt lgkmcnt(" #n ")" ::: "memory")
#define PG8_BAR __builtin_amdgcn_s_barrier()
#define PG8_SCHED __builtin_amdgcn_sched_barrier(0)
    Unit cur, nxt; int ui = 0;
    if (!S.next(0, cur)) return;
    f32x4 acc[2][2][4][2];
#pragma unroll
    for (int a = 0; a < 2; ++a)
#pragma unroll
        for (int b = 0; b < 2; ++b)
#pragma unroll
            for (int m = 0; m < 4; ++m)
#pragma unroll
                for (int n = 0; n < 2; ++n) acc[a][b][m][n] = (f32x4){0.f, 0.f, 0.f, 0.f};
    bf16x8 At[4][2], B0[2][2], B1[2][2];
    const char* cA = (const char*)g.A + (size_t)cur.pm * tstep; const char* cB = (const char*)g.Bt + (size_t)cur.pn * tstep;
    S.a_ready(cur);
    if constexpr (SP2) {
        PG8_STAGE(PG8_SB(0, 0), cB, voffB); PG8_STAGE(PG8_SB(0, 1), cB + hstep, voffB); PG8_STAGE(PG8_SA(0, 0), cA, voffA); PG8_STAGE(PG8_SA(0, 1), cA + hstep, voffA);
        if (wr == 1) PG8_BAR;
        PG8_WAIT_V(2); PG8_BAR;
        PG8_STAGE(PG8_SB(1, 0), cB + kstep, voffB); PG8_STAGE(PG8_SA(1, 0), cA + kstep, voffA); PG8_STAGE(PG8_SB(1, 1), cB + hstep + kstep, voffB);
        PG8_WAIT_V(6); PG8_BAR;
    } else {
        PG8_STAGE(PG8_SB(0, 0), cB, voffB); PG8_STAGE(PG8_SA(0, 0), cA, voffA); PG8_STAGE(PG8_SB(0, 1), cB + hstep, voffB); PG8_STAGE(PG8_SA(0, 1), cA + hstep, voffA);
        if (wr == 1) PG8_BAR;
        PG8_WAIT_V(4); PG8_BAR;
        PG8_STAGE(PG8_SB(1, 0), cB + kstep, voffB); PG8_STAGE(PG8_SA(1, 0), cA + kstep, voffA); PG8_STAGE(PG8_SB(1, 1), cB + hstep + kstep, voffB);
        PG8_WAIT_V(6); PG8_BAR;
    }
    for (;;) {
        const bool has_next = S.next(ui + 1, nxt);
        const char* nA = has_next ? (const char*)g.A + (size_t)nxt.pm * tstep : cA; const char* nB = has_next ? (const char*)g.Bt + (size_t)nxt.pn * tstep : cB;
        for (int t = 0; t < nt; t += 2) {
            const bool last = (t == nt - 2);
            const char* a1 = cA + (size_t)(t + 1) * kstep;
            const char* a2 = last ? nA : cA + (size_t)(t + 2) * kstep; const char* b2 = last ? nB : cB + (size_t)(t + 2) * kstep;
            const char* a3 = a2 + kstep; const char* b3 = b2 + kstep;
            if (last && has_next) S.a_ready(nxt);
            if constexpr (SP2) {
            PG8_LDB(B0, 0, 0); PG8_LDB(B1, 0, 1); PG8_SCHED; PG8_LDA(At, 0, 0); PG8_STAGE(PG8_SA(1, 1), a1 + hstep, voffA);
            PG8_WAIT_V(8); PG8_WAIT_L(0); PG8_BAR; PG8_MMA(0, 0, At, B0); PG8_MMA(0, 1, At, B1); PG8_BAR; PG8_SCHED;
            PG8_LDA(At, 0, 1); PG8_STAGE(PG8_SB(0, 0), b2, voffB); PG8_STAGE(PG8_SB(0, 1), b2 + hstep, voffB); PG8_STAGE(PG8_SA(0, 0), a2, voffA);
            PG8_WAIT_V(8); PG8_WAIT_L(0); PG8_BAR; PG8_MMA(1, 0, At, B0); PG8_MMA(1, 1, At, B1); PG8_BAR; PG8_SCHED;
            PG8_LDB(B0, 1, 0); PG8_LDB(B1, 1, 1); PG8_SCHED; PG8_LDA(At, 1, 0); PG8_STAGE(PG8_SA(0, 1), a2 + hstep, voffA);
            PG8_WAIT_V(8); PG8_WAIT_L(0); PG8_BAR; PG8_MMA(0, 0, At, B0); PG8_MMA(0, 1, At, B1); PG8_BAR; PG8_SCHED;
            PG8_LDA(At, 1, 1); PG8_STAGE(PG8_SB(1, 0), b3, voffB); PG8_STAGE(PG8_SB(1, 1), b3 + hstep, voffB); PG8_STAGE(PG8_SA(1, 0), a3, voffA);
            PG8_WAIT_V(8); PG8_WAIT_L(0); PG8_BAR; PG8_MMA(1, 0, At, B0); PG8_MMA(1, 1, At, B1); PG8_BAR; PG8_SCHED;
            } else {
            PG8_LDB(B0, 0, 0); PG8_SCHED; PG8_LDA(At, 0, 0); PG8_STAGE(PG8_SA(1, 1), a1 + hstep, voffA);
            PG8_WAIT_L(8); PG8_BAR; PG8_WAIT_L(0); PG8_MMA(0, 0, At, B0); PG8_BAR; PG8_SCHED;
            PG8_LDB(B1, 0, 1); PG8_STAGE(PG8_SB(0, 0), b2, voffB);
            PG8_BAR; PG8_WAIT_L(0); PG8_MMA(0, 1, At, B1); PG8_BAR;
            PG8_LDA(At, 0, 1); PG8_STAGE(PG8_SA(0, 0), a2, voffA);
            PG8_BAR; PG8_WAIT_L(0); PG8_MMA(1, 0, At, B0); PG8_BAR; PG8_SCHED;
            PG8_STAGE(PG8_SB(0, 1), b2 + hstep, voffB);
            PG8_WAIT_V(6); PG8_BAR; PG8_MMA(1, 1, At, B1); PG8_BAR;
            PG8_LDB(B0, 1, 0); PG8_SCHED; PG8_LDA(At, 1, 0); PG8_STAGE(PG8_SA(0, 1), a2 + hstep, voffA);
            PG8_WAIT_L(8); PG8_BAR; PG8_WAIT_L(0); PG8_MMA(0, 0, At, B0); PG8_BAR; PG8_SCHED;
            PG8_LDB(B1, 1, 1); PG8_STAGE(PG8_SB(1, 0), b3, voffB);
            PG8_BAR; PG8_WAIT_L(0); PG8_MMA(0, 1, At, B1); PG8_BAR;
            PG8_LDA(At, 1, 1); PG8_STAGE(PG8_SA(1, 0), a3, voffA);
            PG8_BAR; PG8_WAIT_L(0); PG8_MMA(1, 0, At, B0); PG8_BAR; PG8_SCHED;
            PG8_STAGE(PG8_SB(1, 1), b3 + hstep, voffB);
            PG8_WAIT_V(6); PG8_BAR; PG8_MMA(1, 1, At, B1); PG8_BAR;
            }
        }
        if constexpr (ALIGN_EPI) { if (wr == 0) PG8_BAR; }
        if constexpr (!Epi::AFTER_DRAIN) { E(acc, cur, wr, wc, fr, fq); S.done(cur); }
        if (!has_next) break;
#pragma unroll
        for (int a = 0; a < 2; ++a)
#pragma unroll
            for (int b = 0; b < 2; ++b)
#pragma unroll
                for (int m = 0; m < 4; ++m)
#pragma unroll
                    for (int n = 0; n < 2; ++n) acc[a][b][m][n] = (f32x4){0.f, 0.f, 0.f, 0.f};
        cur = nxt; cA = nA; cB = nB; ++ui;
        if constexpr (ALIGN_EPI) { if (wr == 1) PG8_BAR; }
    }
    PG8_WAIT_V(0);
    if constexpr (!ALIGN_EPI) { if (wr == 0) PG8_BAR; }
    PG8_BAR;
    if constexpr (Epi::AFTER_DRAIN) { E.fused(acc, cur, wr, wc, fr, fq, lds, wid, lane); S.done(cur); }
#undef PG8_SA
#undef PG8_SB
#undef PG8_STAGE
#undef PG8_LDA
#undef PG8_LDB
#undef PG8_MMA
#undef PG8_WAIT_V
#undef PG8_WAIT_L
#undef PG8_BAR
#undef PG8_SCHED
}
}
#define LAS __attribute__((address_space(3)))
using pg8::f32x4;
using pg8::u32x4;
constexpr int T_CTX = 8192, T_LAT = 16384, T_ALL = 24576, DM = 1024;
constexpr int NPROJ = 4608, NPROJ_PAD = 4608, NIN = 4624, DFF = 2816, NGU = 5632;
constexpr int NTHR = 512, NWV = 8;
constexpr float EPS = 1e-6f;
constexpr int LDS_BYTES = 132096;

constexpr size_t OUT_HG = 25165824, OUT_MC = 41943040, OUT_MN = 58720256, OUT_MM = 58851328, OUT_TOTAL = 58852352;

constexpr size_t al256(size_t x) { return (x + 255) & ~(size_t)255; }
constexpr size_t WS_WIN = 0;
constexpr size_t WS_WOUT = WS_WIN + al256((size_t)NPROJ_PAD * DM * 2);
constexpr size_t WS_WGU = WS_WOUT + al256((size_t)DM * DM * 2);
constexpr size_t WS_WDN = WS_WGU + al256((size_t)NGU * DM * 2);
constexpr size_t WS_MODP = WS_WDN + al256((size_t)DM * DFF * 2);
constexpr size_t WS_MOD = WS_MODP + al256((size_t)8 * 4 * 9 * 6144 * 4);
constexpr size_t WS_LB = WS_MOD + al256((size_t)4 * 9 * 6144 * 4);
constexpr size_t WS_HN = WS_LB + al256((size_t)4 * 2 * 512 * 4);
constexpr size_t WS_PROJ = WS_HN + al256((size_t)T_ALL * DM * 2);
constexpr size_t WS_GATES = WS_PROJ + al256((size_t)T_ALL * NPROJ * 2);
constexpr size_t WS_QKM = WS_GATES + al256((size_t)T_ALL * 16 * 4);
constexpr size_t WS_OB = WS_QKM + al256((size_t)T_ALL * DM * 2);
constexpr size_t WS_BAR = WS_OB + al256((size_t)T_ALL * DM * 2);
constexpr size_t WS_WG16 = WS_BAR + 16384;
constexpr size_t WS_END = WS_WG16 + 32768;

#if defined(SWAP_OBUF)
#define ODIR(d) (!(d))
#else
#define ODIR(d) (d)
#endif
struct Params {
    const float *x_prompt, *x_sample, *st_hg, *st_mc, *st_mn, *st_mm, *cnd, *c_ctx, *n1w, *n2w, *w_mod, *b_mod, *w_in, *conv_w, *conv_b, *gate_b,
        *lb_logits, *hg_nw, *ml_nw, *w_out, *w_gate, *w_up, *w_down, *fin_w;
    float* out; unsigned char* ws;
};

__device__ __forceinline__ float sigmoidf_(float x) { return __builtin_amdgcn_rcpf(1.f + __expf(-x)); }
__device__ __forceinline__ float siluf_(float x) { return x * __builtin_amdgcn_rcpf(1.f + __expf(-x)); }
__device__ __forceinline__ unsigned pkh(float a, float b) { h16x2 v = {(h16)a, (h16)b}; return __builtin_bit_cast(unsigned, v); }
__device__ __forceinline__ float wave_sum(float v) {
#pragma unroll
    for (int o = 1; o < 64; o <<= 1) v += __shfl_xor(v, o);
    return v;
}
__device__ __forceinline__ int row_cidx(int row) { return row < T_CTX ? 0 : 1 + ((row - T_CTX) >> 11); }
__device__ __forceinline__ int ltid() { int t = threadIdx.x; asm volatile("" : "+v"(t)); return t; }
__device__ __forceinline__ float rdlane(float v, int l) { return __builtin_bit_cast(float, __builtin_amdgcn_readlane(__builtin_bit_cast(int, v), l)); }

struct EpiInProj {
    static constexpr bool PERM = true, AFTER_DRAIN = false;
    h16* proj; float* gates; const float* gate_b;
    __device__ __forceinline__ void operator()(const f32x4 (&acc)[2][2][4][2], const pg8::Unit& u, int wr, int wc, int fr, int fq) const {
        const int row0 = u.pm * 256 + wr * 64 + fr;
#pragma unroll
        for (int bj = 0; bj < 2; ++bj) {
            const int colt = u.pn * 256 + bj * 128, reg = colt >> 9;
            const int act = (reg == 0 || reg == 4) ? 1 : (reg == 8 ? 2 : 0);
            const int col0 = colt + wc * 32 + 8 * fq;
#pragma unroll
            for (int ai = 0; ai < 2; ++ai)
#pragma unroll
                for (int m = 0; m < 4; ++m) {
                    f32x4 v0 = acc[ai][bj][m][0], v1 = acc[ai][bj][m][1];
                    if (act == 1) {
#pragma unroll
                        for (int j = 0; j < 4; ++j) { v0[j] = siluf_(v0[j]); v1[j] = siluf_(v1[j]); }
                    } else if (act == 2) {
#pragma unroll
                        for (int j = 0; j < 4; ++j) { v0[j] = sigmoidf_(v0[j]); v1[j] = sigmoidf_(v1[j]); }
                    }
                    u32x4 w; w.x = pkh(v0[0], v0[1]); w.y = pkh(v0[2], v0[3]); w.z = pkh(v1[0], v1[1]); w.w = pkh(v1[2], v1[3]);
                    *(u32x4*)(proj + (size_t)(row0 + ai * 128 + m * 16) * NPROJ + col0) = w;
                }
        }
    }
};
struct EpiResid {
    static constexpr bool PERM = false, AFTER_DRAIN = false;
    const float* base_ctx; const float* base_lat; float* out; const float* gate;
    __device__ __forceinline__ void operator()(const f32x4 (&acc)[2][2][4][2], const pg8::Unit& u, int wr, int wc, int fr, int fq) const {
        const int cidx = u.pm < 32 ? 0 : 1 + ((u.pm - 32) >> 3);
        const float* gt = gate + cidx * 6144;
        const float* bs = u.pm < 32 ? base_ctx : base_lat - (size_t)T_CTX * DM;
        const int colb = u.pn * 256 + wc * 32 + 4 * fq;
        f32x4 g[2][2];
#pragma unroll
        for (int bj = 0; bj < 2; ++bj)
#pragma unroll
            for (int n = 0; n < 2; ++n) g[bj][n] = *(const f32x4*)(gt + colb + bj * 128 + n * 16);
#pragma unroll
        for (int ai = 0; ai < 2; ++ai)
#pragma unroll
            for (int m = 0; m < 4; ++m) {
                const size_t off = (size_t)(u.pm * 256 + ai * 128 + wr * 64 + m * 16 + fr) * DM + colb;
                f32x4 x[2][2];
#pragma unroll
                for (int bj = 0; bj < 2; ++bj)
#pragma unroll
                    for (int n = 0; n < 2; ++n) x[bj][n] = *(const f32x4*)(bs + off + bj * 128 + n * 16);
#pragma unroll
                for (int bj = 0; bj < 2; ++bj)
#pragma unroll
                    for (int n = 0; n < 2; ++n) *(f32x4*)(out + off + bj * 128 + n * 16) = x[bj][n] + g[bj][n] * acc[ai][bj][m][n];
                asm volatile("" ::: "memory");
            }
    }
};
struct EpiGateUp {
    static constexpr bool PERM = true, AFTER_DRAIN = false;
    h16* ff;
    __device__ __forceinline__ void operator()(const f32x4 (&acc)[2][2][4][2], const pg8::Unit& u, int wr, int wc, int fr, int fq) const {
        const int row0 = u.pm * 256 + wr * 64 + fr, col0 = u.pn * 128 + wc * 32 + 8 * fq;
#pragma unroll
        for (int ai = 0; ai < 2; ++ai)
#pragma unroll
            for (int m = 0; m < 4; ++m) {
                f32x4 v0, v1;
#pragma unroll
                for (int j = 0; j < 4; ++j) { v0[j] = siluf_(acc[ai][0][m][0][j]) * acc[ai][1][m][0][j]; v1[j] = siluf_(acc[ai][0][m][1][j]) * acc[ai][1][m][1][j]; }
                u32x4 w; w.x = pkh(v0[0], v0[1]); w.y = pkh(v0[2], v0[3]); w.z = pkh(v1[0], v1[1]); w.w = pkh(v1[2], v1[3]);
                *(u32x4*)(ff + (size_t)(row0 + ai * 128 + m * 16) * DFF + col0) = w;
            }
    }
};

__device__ __forceinline__ void phase_mod_partial(const Params& p, LAS float* ldsf) {
    const int tidx = ltid();
    for (int e = tidx; e < 9 * 1024; e += NTHR) { const int c = e >> 10, k = e & 1023; const float v = c == 0 ? p.c_ctx[k] : p.cnd[(c - 1) * 1024 + k]; ldsf[e] = siluf_(v); }
    __syncthreads();
    float* modp = (float*)(p.ws + WS_MODP);
    const int wave = tidx >> 6, lane = tidx & 63;
    const int gw = blockIdx.x * NWV + wave, NGW = gridDim.x * NWV;
    for (int it = gw; it < 4 * 96 * 8; it += NGW) {
        const int kq = it & 7, cgp = (it >> 3) % 96, l = it / (8 * 96);
        const int j = cgp * 64 + lane;
        const float* w = p.w_mod + ((size_t)l * 1024 + kq * 128) * 6144 + j;
        float acc[9];
#pragma unroll
        for (int c = 0; c < 9; ++c) acc[c] = 0.f;
#pragma unroll 4
        for (int k4 = 0; k4 < 32; ++k4) {
            const float w0 = w[(size_t)(4 * k4 + 0) * 6144], w1 = w[(size_t)(4 * k4 + 1) * 6144], w2 = w[(size_t)(4 * k4 + 2) * 6144], w3 = w[(size_t)(4 * k4 + 3) * 6144];
#pragma unroll
            for (int c = 0; c < 9; ++c) { const f32x4 s = *(const LAS f32x4*)(ldsf + c * 1024 + kq * 128 + 4 * k4); acc[c] += s.x * w0 + s.y * w1 + s.z * w2 + s.w * w3; }
        }
#pragma unroll
        for (int c = 0; c < 9; ++c) modp[(((size_t)kq * 4 + l) * 9 + c) * 6144 + j] = acc[c];
    }
    if (blockIdx.x == 0) {
        float* lb = (float*)(p.ws + WS_LB);
        for (int e = tidx; e < 1024; e += NTHR) {
            const float x0 = p.lb_logits[e], x1 = p.lb_logits[1024 + e], x2 = p.lb_logits[2048 + e], x3 = p.lb_logits[3072 + e];
            const float mx = fmaxf(fmaxf(x0, x1), fmaxf(x2, x3));
            const float e0 = expf(x0 - mx), e1 = expf(x1 - mx), e2 = expf(x2 - mx), e3 = expf(x3 - mx);
            const float inv = 1.f / (e0 + e1 + e2 + e3);
            lb[e] = 0.f; lb[1024 + e] = e1 * inv; lb[2048 + e] = (e1 + e2) * inv; lb[3072 + e] = (e1 + e2 + e3) * inv;
        }
    }
}
__device__ __forceinline__ void phase_mod_reduce(const Params& p) {
    const float* modp = (const float*)(p.ws + WS_MODP); float* mod = (float*)(p.ws + WS_MOD);
    for (int e = blockIdx.x * NTHR + ltid(); e < 4 * 9 * 6144; e += gridDim.x * NTHR) {
        const int j = e % 6144, l = e / (9 * 6144);
        float s = p.b_mod[l * 6144 + j];
#pragma unroll
        for (int kq = 0; kq < 8; ++kq) s += modp[(size_t)kq * (4 * 9 * 6144) + e];
        mod[e] = s;
    }
}

__device__ __forceinline__ void transpose_item(const float* W, int K, int N, h16* WT, int kb, int n0, int dst_row0, LAS float* scr, int lane) {
    const int k0 = 64 * kb, n = n0 + (lane & 31);
#pragma unroll 8
    for (int i = 0; i < 32; ++i) { const int kk = 2 * i + (lane >> 5); scr[kk * 33 + (lane & 31)] = (n < N) ? W[(size_t)(k0 + kk) * N + n] : 0.f; }
    asm volatile("s_waitcnt lgkmcnt(0)" ::: "memory");
    const int c = lane & 7;
#pragma unroll
    for (int j = 0; j < 4; ++j) {
        const int nn = (lane >> 3) + 8 * j; const LAS float* s = scr + (8 * c) * 33 + nn;
        u32x4 o; o.x = pkh(s[0 * 33], s[1 * 33]); o.y = pkh(s[2 * 33], s[3 * 33]); o.z = pkh(s[4 * 33], s[5 * 33]); o.w = pkh(s[6 * 33], s[7 * 33]);
        *(u32x4*)(WT + (size_t)(dst_row0 + nn) * K + k0 + 8 * c) = o;
    }
    asm volatile("s_waitcnt lgkmcnt(0)" ::: "memory");
}
__device__ __forceinline__ void convert_weights(const Params& p, int l, LAS float* scr, int gw, int NGW, int lane) {
    {
        h16* wg = (h16*)(p.ws + WS_WG16);
        const float* src = p.w_in + (size_t)l * DM * NIN + NPROJ;
        for (int e = gw * 64 + lane; e < 16 * 1024; e += NGW * 64) { const int k = e >> 4, g = e & 15; wg[g * 1024 + k] = (h16)src[(size_t)k * NIN + g]; }
    }
    h16* win = (h16*)(p.ws + WS_WIN); h16* wout = (h16*)(p.ws + WS_WOUT); h16* wgu = (h16*)(p.ws + WS_WGU); h16* wdn = (h16*)(p.ws + WS_WDN);
    constexpr int I_IN = 16 * 144, I_OUT = 16 * 32, I_G = 16 * 88, I_DN = 44 * 32;
    for (int it = gw; it < I_IN + I_OUT + 2 * I_G + I_DN; it += NGW) {
        int r = it;
        if (r < I_IN) { const int kb = r / 144, nb = r % 144; transpose_item(p.w_in + (size_t)l * DM * NIN, DM, NIN, win, kb, 32 * nb, 32 * nb, scr, lane); continue; } r -= I_IN;
        if (r < I_OUT) { const int kb = r / 32, nb = r % 32; transpose_item(p.w_out + (size_t)l * DM * DM, DM, DM, wout, kb, 32 * nb, 32 * nb, scr, lane); continue; } r -= I_OUT;
        if (r < I_G) { const int kb = r / 88, nb = r % 88, n0 = 32 * nb; transpose_item(p.w_gate + (size_t)l * DM * DFF, DM, DFF, wgu, kb, n0, (n0 >> 7) * 256 + (n0 & 127), scr, lane); continue; } r -= I_G;
        if (r < I_G) { const int kb = r / 88, nb = r % 88, n0 = 32 * nb; transpose_item(p.w_up + (size_t)l * DM * DFF, DM, DFF, wgu, kb, n0, (n0 >> 7) * 256 + 128 + (n0 & 127), scr, lane); continue; } r -= I_G;
        { const int kb = r / 32, nb = r % 32; transpose_item(p.w_down + (size_t)l * DFF * DM, DFF, DM, wdn, kb, 32 * nb, 32 * nb, scr, lane); }
    }
}
__device__ __forceinline__ void norm_mod_row(const float* xrow, const float* nw, const float* sc, const float* sh, h16* orow, int lane) {
    const f32x4* xr = (const f32x4*)xrow + lane;
    f32x4 v[4]; float s = 0.f;
#pragma unroll
    for (int j = 0; j < 4; ++j) { v[j] = xr[64 * j]; s += (v[j].x * v[j].x + v[j].y * v[j].y) + (v[j].z * v[j].z + v[j].w * v[j].w); }
    const float rstd = rsqrtf(wave_sum(s) * (1.f / DM) + EPS);
#pragma unroll
    for (int j = 0; j < 4; ++j) {
        const int col = 4 * lane + 256 * j;
        const f32x4 w4 = *(const f32x4*)(nw + col), s4 = *(const f32x4*)(sc + col), h4 = *(const f32x4*)(sh + col);
        const f32x4 y = v[j] * rstd * w4 * (1.f + s4) + h4;
        uint2 o; o.x = pkh(y.x, y.y); o.y = pkh(y.z, y.w);
        *(uint2*)(orow + col) = o;
    }
}
__device__ __forceinline__ void phase_norm(const Params& p, int l, int which, bool from_inputs, int gw, int NGW, int lane) {
    const float* mod = (const float*)(p.ws + WS_MOD) + (size_t)l * 9 * 6144;
    const float* nw = (which == 0 ? p.n1w : p.n2w) + l * DM;
    h16* hn = (h16*)(p.ws + WS_HN);
    for (int r = gw; r < T_ALL; r += NGW) {
        const float* xrow = from_inputs ? (r < T_CTX ? p.x_prompt + (size_t)r * DM : p.x_sample + (size_t)(r - T_CTX) * DM) : p.out + (size_t)r * DM;
        const float* m = mod + row_cidx(r) * 6144 + which * 3072;
        norm_mod_row(xrow, nw, m + 1024, m, hn + (size_t)r * DM, lane);
    }
}
__device__ __forceinline__ void phase_final_norm(const Params& p, int gw, int NGW, int lane) {
    for (int r = gw; r < T_ALL; r += NGW) {
        f32x4* xr = (f32x4*)(p.out + (size_t)r * DM) + lane;
        f32x4 v[4]; float s = 0.f;
#pragma unroll
        for (int j = 0; j < 4; ++j) { v[j] = xr[64 * j]; s += (v[j].x * v[j].x + v[j].y * v[j].y) + (v[j].z * v[j].z + v[j].w * v[j].w); }
        const float rstd = rsqrtf(wave_sum(s) * (1.f / DM) + EPS);
#pragma unroll
        for (int j = 0; j < 4; ++j) { const f32x4 w4 = *(const f32x4*)(p.fin_w + 4 * lane + 256 * j); xr[64 * j] = v[j] * rstd * w4; }
    }
}
__device__ __forceinline__ void phase_gates(const Params& p, int l, int gw, int NGW, int lane) {
    const h16* hn = (const h16*)(p.ws + WS_HN); const h16* wg = (const h16*)(p.ws + WS_WG16);
    float* gates = (float*)(p.ws + WS_GATES);
    const int c = lane & 15, q = lane >> 4;
    for (int grp = gw; grp < T_ALL / 16; grp += NGW) {
        const h16* ar = hn + (size_t)(16 * grp + c) * DM + 8 * q;
        const h16* br = wg + (size_t)c * DM + 8 * q;
        f32x4 acc = {0.f, 0.f, 0.f, 0.f};
#pragma unroll 8
        for (int kp = 0; kp < 32; ++kp) {
            const h16x8 a = *(const h16x8*)(ar + 32 * kp), bq = *(const h16x8*)(br + 32 * kp);
            acc = __builtin_amdgcn_mfma_f32_16x16x32_f16(a, bq, acc, 0, 0, 0);
        }
        const float bias = p.gate_b[l * 16 + c];
#pragma unroll
        for (int j = 0; j < 4; ++j) gates[(size_t)(16 * grp + 4 * q + j) * 16 + c] = acc[j] + bias;
    }
}
__device__ __forceinline__ void phase_conv(const Params& p, int l) {
    const h16* proj = (const h16*)(p.ws + WS_PROJ); h16* qkm = (h16*)(p.ws + WS_QKM);
    const float* cw = p.conv_w + (size_t)l * 9 * 1024; const float* cb = p.conv_b + l * 1024;
    for (int idx = blockIdx.x * NTHR + ltid(); idx < T_ALL * 128; idx += gridDim.x * NTHR) {
        const int r = idx >> 7, ch0 = (idx & 127) * 8;
        float acc[8];
        { const f32x4 b0 = *(const f32x4*)(cb + ch0), b1 = *(const f32x4*)(cb + ch0 + 4); acc[0] = b0.x; acc[1] = b0.y; acc[2] = b0.z; acc[3] = b0.w; acc[4] = b1.x; acc[5] = b1.y; acc[6] = b1.z; acc[7] = b1.w; }
        const h16* src = proj + 2560 + ch0;
        const bool lat = r >= T_CTX;
        const int pp = lat ? ((r - T_CTX) & 2047) : (r & 255);
        const int gy = lat ? (pp >> 6) : 0, gx = lat ? (pp & 63) : pp;
        const int H = lat ? 32 : 1, W = lat ? 64 : 256;
#pragma unroll
        for (int a = 0; a < 3; ++a) {
            const int yy = gy + a - 1;
            if (!lat && a != 1) continue;
            if (yy < 0 || yy >= H) continue;
#pragma unroll
            for (int b = 0; b < 3; ++b) {
                const int xx = gx + b - 1;
                if (xx < 0 || xx >= W) continue;
                const int rr = r + (a - 1) * 64 + (b - 1);
                const h16x8 x = *(const h16x8*)(src + (size_t)rr * NPROJ);
                const f32x4 t0 = *(const f32x4*)(cw + (a * 3 + b) * 1024 + ch0), t1 = *(const f32x4*)(cw + (a * 3 + b) * 1024 + ch0 + 4);
                acc[0] += t0.x * (float)x[0]; acc[1] += t0.y * (float)x[1]; acc[2] += t0.z * (float)x[2]; acc[3] += t0.w * (float)x[3];
                acc[4] += t1.x * (float)x[4]; acc[5] += t1.y * (float)x[5]; acc[6] += t1.z * (float)x[6]; acc[7] += t1.w * (float)x[7];
            }
        }
        const float sc = ch0 >= 512 ? 0.08838834764831845f : 1.f;
        u32x4 w; w.x = pkh(siluf_(acc[0]) * sc, siluf_(acc[1]) * sc); w.y = pkh(siluf_(acc[2]) * sc, siluf_(acc[3]) * sc);
        w.z = pkh(siluf_(acc[4]) * sc, siluf_(acc[5]) * sc); w.w = pkh(siluf_(acc[6]) * sc, siluf_(acc[7]) * sc);
        *(u32x4*)(qkm + (size_t)r * DM + ch0) = w;
    }
}

template <int TYPE  , int CMP = 0>
__device__ __forceinline__ void scan_item(const Params& p, int l, int lat, int b, int h, int dir, LAS float* lds) {
    const int tid = ltid(), lane = tid & 63, w = __builtin_amdgcn_readfirstlane(tid >> 6);
    const int L = lat ? 2048 : 256, row0 = lat ? T_CTX + b * 2048 : b * 256, NB = L / 16;
    LAS float* qs = lds;
    LAS float* fs = lds + 2048;
    LAS float* vs = lds + 4096;
    LAS float* part = lds + 6144;
    LAS float* partn = lds + 6144 + 16384;
    LAS float* scal = partn + 128;
    LAS float* mst = scal + 128;
    LAS float* cerr = mst + 16;
    LAS float* cref = cerr + 32;
    const h16* proj = (const h16*)(p.ws + WS_PROJ); const h16* qkm = (const h16*)(p.ws + WS_QKM); const float* gates = (const float*)(p.ws + WS_GATES);
    h16* odst = (h16*)(p.ws + (ODIR(dir) ? WS_OB : WS_HN));
    const size_t sidx = (((size_t)b * 4 + l) * 2 + dir) * 4 + h;
    if (CMP) { if (tid < 64) cerr[tid] = 0.f; __syncthreads(); }

    f32x2 S[16]; float nv = 0.f;
    if (lat) {
        const float* src = (TYPE == 0 ? p.st_hg : p.st_mc) + sidx * 16384;
#pragma unroll
        for (int dd = 0; dd < 16; ++dd) S[dd] = *(const f32x2*)(src + (16 * w + dd) * 128 + 2 * lane);
        if (TYPE == 1) { nv = lane < 16 ? p.st_mn[sidx * 128 + 16 * w + lane] : 0.f; if (tid == 0) mst[0] = p.st_mm[sidx]; }
    } else {
#pragma unroll
        for (int dd = 0; dd < 16; ++dd) S[dd] = (f32x2){0.f, 0.f};
        if (TYPE == 1 && tid == 0) mst[0] = 0.f;
    }
    const int tl = tid >> 5, d0 = 4 * (tid & 31);
    f32x4 lb4 = {0.f, 0.f, 0.f, 0.f};
    if (TYPE == 0) lb4 = *(const f32x4*)((const float*)(p.ws + WS_LB) + (l * 2 + dir) * 512 + h * 128 + d0);
    h16x4 pq, pz, pv; float pgi = 0.f, pgf = 0.f;
#define SCAN_LOAD(ii) do { const int pos_ = 16 * (ii) + tl, tok_ = dir ? L - 1 - pos_ : pos_; const size_t r_ = (size_t)(row0 + tok_); \
        if (TYPE == 0) { pq = *(const h16x4*)(proj + r_ * NPROJ + h * 128 + d0); pz = *(const h16x4*)(proj + r_ * NPROJ + 512 + dir * 512 + h * 128 + d0); pv = *(const h16x4*)(proj + r_ * NPROJ + 1536 + h * 128 + d0); } \
        else { pq = *(const h16x4*)(qkm + r_ * DM + h * 128 + d0); pz = *(const h16x4*)(qkm + r_ * DM + 512 + h * 128 + d0); pv = *(const h16x4*)(proj + r_ * NPROJ + 3584 + h * 128 + d0); \
               if (w == 0) { const int ps_ = 16 * (ii) + (lane & 15), tk_ = dir ? L - 1 - ps_ : ps_; const float* g_ = gates + (size_t)(row0 + tk_) * 16; pgi = g_[dir * 4 + h]; pgf = g_[8 + dir * 4 + h]; } } } while (0)
    SCAN_LOAD(0);
    for (int i = 0; i < NB; ++i) {
        const int par = i & 1;
        const int pos = 16 * i + tl, tok = dir ? L - 1 - pos : pos;
        const size_t r = (size_t)(row0 + tok);
        {
            *(LAS f32x4*)(qs + tl * 128 + d0) = (f32x4){(float)pq[0], (float)pq[1], (float)pq[2], (float)pq[3]};
            *(LAS f32x4*)(vs + tl * 128 + d0) = (f32x4){(float)pv[0], (float)pv[1], (float)pv[2], (float)pv[3]};
            if (TYPE == 0) {
                f32x4 f4;
#pragma unroll
                for (int j = 0; j < 4; ++j) f4[j] = lb4[j] + (1.f - lb4[j]) * sigmoidf_((float)pz[j]);
                *(LAS f32x4*)(fs + tl * 128 + d0) = f4;
            } else {
                *(LAS f32x4*)(fs + tl * 128 + d0) = (f32x4){(float)pz[0], (float)pz[1], (float)pz[2], (float)pz[3]};
                if (w == 0) {
                    const int t = lane & 15;
                    const float m0 = mst[0];
                    const float gi = pgi, lf = fminf(pgf, 0.f) - log1pf(__expf(-fabsf(pgf)));
                    float bc = lf;
#pragma unroll
                    for (int o = 1; o < 16; o <<= 1) { const float x = __shfl_up(bc, o, 16); if (t >= o) bc += x; }
                    float pm = gi - bc;
#pragma unroll
                    for (int o = 1; o < 16; o <<= 1) { const float x = __shfl_up(pm, o, 16); if (t >= o) pm = fmaxf(pm, x); }
                    const float mt = bc + fmaxf(m0, pm);
                    float mp = __shfl_up(mt, 1, 16); if (t == 0) mp = m0;
                    if (lane < 16) {
                        scal[(par * 16 + t) * 4 + 0] = __expf(lf + mp - mt);
                        scal[(par * 16 + t) * 4 + 1] = __expf(gi - mt);
                        scal[(par * 16 + t) * 4 + 2] = __expf(-mt);
                    }
                    asm volatile("s_waitcnt lgkmcnt(0)" ::: "memory");
                    if (lane == 15) mst[0] = mt;
                }
            }
        }
        if (i + 1 < NB) SCAN_LOAD(i + 1);
        __syncthreads();
#pragma unroll 2
        for (int t = 0; t < 16; ++t) {
            float fv = 0.f, qv = 0.f;
            if (lane < 16) { fv = fs[t * 128 + 16 * w + lane]; qv = qs[t * 128 + 16 * w + lane]; }
            const f32x2 v2 = *(const LAS f32x2*)(vs + t * 128 + 2 * lane);
            f32x2 o = {0.f, 0.f};
            if (TYPE == 0) {
#pragma unroll
                for (int dd = 0; dd < 16; ++dd) { const float sf = rdlane(fv, dd), sq = rdlane(qv, dd); S[dd] = v2 + sf * (S[dd] - v2); o += S[dd] * sq; }
            } else {
                const float a = __builtin_bit_cast(float, __builtin_amdgcn_readfirstlane(__builtin_bit_cast(int, scal[(par * 16 + t) * 4 + 0])));
                const float g = __builtin_bit_cast(float, __builtin_amdgcn_readfirstlane(__builtin_bit_cast(int, scal[(par * 16 + t) * 4 + 1])));
                const float gk = g * fv;
                nv = a * nv + gk;
                float nq = nv * qv;
                nq += __shfl_xor(nq, 8); nq += __shfl_xor(nq, 4); nq += __shfl_xor(nq, 2); nq += __shfl_xor(nq, 1);
                if (lane == 0) partn[t * 8 + w] = nq;
#pragma unroll
                for (int dd = 0; dd < 16; ++dd) { const float sk = rdlane(gk, dd), sq = rdlane(qv, dd); S[dd] = a * S[dd] + sk * v2; o += S[dd] * sq; }
            }
            *(LAS f32x2*)(part + (t * 8 + w) * 128 + 2 * lane) = o;
        }
        __syncthreads();
        {
            f32x4 acc = {0.f, 0.f, 0.f, 0.f};
#pragma unroll
            for (int ww = 0; ww < 8; ++ww) acc += *(const LAS f32x4*)(part + (tl * 8 + ww) * 128 + d0);
            if (TYPE == 1) {
                float den = 0.f;
#pragma unroll
                for (int ww = 0; ww < 8; ++ww) den += partn[tl * 8 + ww];
                const float sc = 1.f / fmaxf(fabsf(den), scal[(par * 16 + tl) * 4 + 2]);
                acc = acc * sc;
            }
            uint2 o; o.x = pkh(acc.x, acc.y); o.y = pkh(acc.z, acc.w);
            if (CMP) {
                const h16x4 old = *(const h16x4*)(odst + r * DM + TYPE * 512 + h * 128 + d0);
                float e = 0.f, rr = 0.f;
#pragma unroll
                for (int j = 0; j < 4; ++j) { const float df = (float)old[j] - acc[j]; e += df * df; rr += acc[j] * acc[j]; }
                e = wave_sum(e); rr = wave_sum(rr);
                if (lane == 0) { atomicAdd((float*)(cerr + (i >> 2)), e); atomicAdd((float*)(cref + (i >> 2)), rr); }
            }
            *(uint2*)(odst + r * DM + TYPE * 512 + h * 128 + d0) = o;
        }
    }
    if (CMP) {
        __syncthreads();
        if (tid == 0) {
            float best = -1.f; int bc_ = 0; float tot_e = 0.f, tot_r = 0.f;
            for (int cI = 0; cI < 32; ++cI) { const float rt = cerr[cI] / fmaxf(cref[cI], 1e-30f); tot_e += cerr[cI]; tot_r += cref[cI]; if (rt > best) { best = rt; bc_ = cI; } }
            float* dg = (float*)(p.ws + WS_MODP) + 4 * blockIdx.x;
#if defined(DIAG_ALL)
            const float tot = tot_e / fmaxf(tot_r, 1e-30f);
            if (tot > dg[0]) { dg[0] = tot; dg[1] = (float)(l * 8 + TYPE * 4 + lat * 2 + dir); dg[2] = best; dg[3] = (float)bc_; }
#else
            dg[0] = best; dg[1] = (float)bc_; dg[2] = tot_e / fmaxf(tot_r, 1e-30f); dg[3] = 0.f;
#endif
        }
    }
    if (!lat) {
        float* dst = p.out + (TYPE == 0 ? OUT_HG : OUT_MC) + sidx * 16384;
#pragma unroll
        for (int dd = 0; dd < 16; ++dd) *(f32x2*)(dst + (16 * w + dd) * 128 + 2 * lane) = S[dd];
        if (TYPE == 1) { if (lane < 16) p.out[OUT_MN + sidx * 128 + 16 * w + lane] = nv; if (tid == 0) p.out[OUT_MM + sidx] = mst[0]; }
    }
    __syncthreads();
#undef SCAN_LOAD
}
typedef unsigned u32x2 __attribute__((ext_vector_type(2)));
typedef short s16x8 __attribute__((ext_vector_type(8)));
typedef short s16x4 __attribute__((ext_vector_type(4)));
typedef __bf16 bf16x2_t __attribute__((ext_vector_type(2)));
__device__ __forceinline__ unsigned pkb(float a, float b) { f32x2 v = {a, b}; bf16x2_t r = __builtin_convertvector(v, bf16x2_t); return __builtin_bit_cast(unsigned, r); }
__device__ __forceinline__ unsigned short f2b(float a) { return (unsigned short)(pkb(a, 0.f) & 0xffffu); }
__device__ __forceinline__ s16x4 tr_read(LAS const unsigned char* ptr) { return __builtin_bit_cast(s16x4, __builtin_amdgcn_ds_read_tr16_b64_v4i16((LAS s16x4*)ptr)); }
constexpr int HP = 272;
__device__ __forceinline__ void scan_hgrn_mfma(const Params& p, int l, int lat, int b, int h, int dir, LAS unsigned char* lds) {
    const int tid = ltid(), lane = tid & 63, w = __builtin_amdgcn_readfirstlane(tid >> 6), c = lane & 15, q = lane >> 4;
    const int L = lat ? 2048 : 256, row0 = lat ? T_CTX + b * 2048 : b * 256, NB = L / 16;
    constexpr int IMG = 16 * HP, BUF = 4 * IMG + 512;
    LAS float* GS = (LAS float*)(lds + 2 * BUF);
    const h16* proj = (const h16*)(p.ws + WS_PROJ);
    h16* odst = (h16*)(p.ws + (ODIR(dir) ? WS_OB : WS_HN));
    const size_t sidx = (((size_t)b * 4 + l) * 2 + dir) * 4 + h;
    f32x4 S[8];
    if (lat) {
        const float* src = p.st_hg + sidx * 16384;
#pragma unroll
        for (int dt = 0; dt < 8; ++dt)
#pragma unroll
            for (int j = 0; j < 4; ++j) S[dt][j] = src[(16 * dt + 4 * q + j) * 128 + 16 * w + c];
    } else {
#pragma unroll
        for (int dt = 0; dt < 8; ++dt) S[dt] = (f32x4){0.f, 0.f, 0.f, 0.f};
    }
    const int pt = lane & 15, d0 = 16 * w + 4 * (lane >> 4);
    const f32x4 lb4 = *(const f32x4*)((const float*)(p.ws + WS_LB) + (l * 2 + dir) * 512 + h * 128 + d0);
    h16x4 rq, rz, rv;
#define HG_LOAD(ii) do { const int pos_ = 16 * (ii) + pt, tok_ = dir ? L - 1 - pos_ : pos_; const h16* r_ = proj + (size_t)(row0 + tok_) * NPROJ + h * 128 + d0; \
        rq = *(const h16x4*)(r_); rz = *(const h16x4*)(r_ + 512 + dir * 512); rv = *(const h16x4*)(r_ + 1536); } while (0)
#define HG_ROW_SHR(x, ctl) __builtin_bit_cast(float, __builtin_amdgcn_update_dpp(0, __builtin_bit_cast(int, (x)), (ctl), 0xF, 0xF, false))
    HG_LOAD(0);
    for (int i = 0; i < NB; ++i) {
        LAS unsigned char* buf = lds + (i & 1) * BUF;
        LAS unsigned char* QT = buf; LAS unsigned char* KT = buf + IMG; LAS unsigned char* KH = buf + 2 * IMG; LAS unsigned char* VV = buf + 3 * IMG; LAS float* AD = (LAS float*)(buf + 4 * IMG);
        asm volatile("s_waitcnt vmcnt(0)" ::: "memory");
        {
            float kk[4], G[4];
#pragma unroll
            for (int j = 0; j < 4; ++j) { const float f = lb4[j] + (1.f - lb4[j]) * sigmoidf_((float)rz[j]); kk[j] = 1.f - f; G[j] = __logf(f); }
#pragma unroll
            for (int j = 0; j < 4; ++j) {
                G[j] += HG_ROW_SHR(G[j], 0x111); G[j] += HG_ROW_SHR(G[j], 0x112); G[j] += HG_ROW_SHR(G[j], 0x114); G[j] += HG_ROW_SHR(G[j], 0x118);
            }
            float oq[4], ok[4], oh[4];
            float ev[4];
#pragma unroll
            for (int j = 0; j < 4; ++j) {
                const float e = __expf(G[j]), ei = __builtin_amdgcn_rcpf(fmaxf(e, 8.7565e-27f)); ev[j] = e;
                const float et = __shfl(e, 15, 16);
                oq[j] = (float)rq[j] * e; ok[j] = kk[j] * ei; oh[j] = kk[j] * (et * ei);
            }
            u32x2 wq, wk, wh, wv;
            wq.x = pkb(oq[0], oq[1]); wq.y = pkb(oq[2], oq[3]); wk.x = pkb(ok[0], ok[1]); wk.y = pkb(ok[2], ok[3]);
            wh.x = pkb(oh[0], oh[1]); wh.y = pkb(oh[2], oh[3]); wv.x = pkb((float)rv[0], (float)rv[1]); wv.y = pkb((float)rv[2], (float)rv[3]);
            *(LAS u32x2*)(QT + pt * HP + 2 * d0) = wq; *(LAS u32x2*)(KT + pt * HP + 2 * d0) = wk; *(LAS u32x2*)(KH + pt * HP + 2 * d0) = wh; *(LAS u32x2*)(VV + pt * HP + 2 * d0) = wv;
            if (pt == 15) *(LAS f32x4*)(AD + d0) = (f32x4){ev[0], ev[1], ev[2], ev[3]};
        }
        { const int nx = (i + 1 < NB) ? i + 1 : NB - 1; HG_LOAD(nx); }
        __syncthreads();
        {
            f32x4 accO = {0.f, 0.f, 0.f, 0.f};
#pragma unroll
            for (int kp = 0; kp < 4; ++kp) {
                u32x4 sa; sa.x = pkb(S[2 * kp][0], S[2 * kp][1]); sa.y = pkb(S[2 * kp][2], S[2 * kp][3]); sa.z = pkb(S[2 * kp + 1][0], S[2 * kp + 1][1]); sa.w = pkb(S[2 * kp + 1][2], S[2 * kp + 1][3]);
                const u32x2 b0 = *(const LAS u32x2*)(QT + c * HP + 2 * (32 * kp + 4 * q)), b1 = *(const LAS u32x2*)(QT + c * HP + 2 * (32 * kp + 16 + 4 * q));
                u32x4 bb; bb.x = b0.x; bb.y = b0.y; bb.z = b1.x; bb.w = b1.y;
                accO = __builtin_amdgcn_mfma_f32_16x16x32_bf16(__builtin_bit_cast(s16x8, sa), __builtin_bit_cast(s16x8, bb), accO, 0, 0, 0);
            }
            f32x4 accP = {0.f, 0.f, 0.f, 0.f};
#pragma unroll
            for (int kp = 0; kp < 4; ++kp) {
                const s16x8 a = *(const LAS s16x8*)(KT + c * HP + 2 * (32 * kp + 8 * q));
                const s16x8 bq = *(const LAS s16x8*)(QT + c * HP + 2 * (32 * kp + 8 * q));
                accP = __builtin_amdgcn_mfma_f32_16x16x32_bf16(a, bq, accP, 0, 0, 0);
            }
#pragma unroll
            for (int j = 0; j < 4; ++j) accP[j] = (4 * q + j > c) ? 0.f : accP[j];
            u32x2 pb; pb.x = pkb(accP[0], accP[1]); pb.y = pkb(accP[2], accP[3]);
            const s16x4 vtr = tr_read(VV + (4 * q + (c >> 2)) * HP + 2 * (16 * w + 4 * (c & 3)));
            accO = __builtin_amdgcn_mfma_f32_16x16x16bf16_1k(vtr, __builtin_bit_cast(s16x4, pb), accO, 0, 0, 0);
            {
                const int pos = 16 * i + c, tok = dir ? L - 1 - pos : pos;
                uint2 o; o.x = pkh(accO[0], accO[1]); o.y = pkh(accO[2], accO[3]);
                *(uint2*)(odst + (size_t)(row0 + tok) * DM + h * 128 + 16 * w + 4 * q) = o;
            }
#pragma unroll
            for (int dt = 0; dt < 8; ++dt) {
                const s16x4 ktr = tr_read(KH + (4 * q + (c >> 2)) * HP + 2 * (16 * dt + 4 * (c & 3)));
                const f32x4 ad = *(const LAS f32x4*)(AD + 16 * dt + 4 * q);
                S[dt] = S[dt] * ad;
                S[dt] = __builtin_amdgcn_mfma_f32_16x16x16bf16_1k(ktr, vtr, S[dt], 0, 0, 0);
            }
        }
#if defined(HG_EXTRA_SYNC)
        asm volatile("s_waitcnt vmcnt(0) lgkmcnt(0)" ::: "memory");
        __syncthreads();
#endif
    }
    if (!lat) {
        float* dst = p.out + OUT_HG + sidx * 16384;
#pragma unroll
        for (int dt = 0; dt < 8; ++dt)
#pragma unroll
            for (int j = 0; j < 4; ++j) dst[(16 * dt + 4 * q + j) * 128 + 16 * w + c] = S[dt][j];
    }
    __syncthreads();
#undef HG_LOAD
#undef HG_ROW_SHR
}
constexpr int MP = 272;
constexpr int PP = 144;
__device__ __forceinline__ void scan_mlstm_mfma(const Params& p, int l, int lat, int b, int h, int dir, LAS unsigned char* lds) {
    const int tid = ltid(), lane = tid & 63, w = __builtin_amdgcn_readfirstlane(tid >> 6), c = lane & 15, q = lane >> 4;
    const int L = lat ? 2048 : 256, row0 = lat ? T_CTX + b * 2048 : b * 256, NC = L / 64;
    constexpr int IMG = 64 * MP, BUF = 3 * IMG + 1536;
    LAS unsigned char* PM = lds + 2 * BUF;
    LAS float* DENP = (LAS float*)(PM + 64 * PP);
    LAS float* QNP = DENP + 256;
    LAS float* NP = QNP + 512;
    LAS float* NV = NP + 512;
    LAS float* mst = NV + 128;
    const h16* proj = (const h16*)(p.ws + WS_PROJ); const h16* qkm = (const h16*)(p.ws + WS_QKM); const float* gates = (const float*)(p.ws + WS_GATES);
    h16* odst = (h16*)(p.ws + (ODIR(dir) ? WS_OB : WS_HN));
    const size_t sidx = (((size_t)b * 4 + l) * 2 + dir) * 4 + h;
    f32x4 C[8];
    if (lat) {
        const float* src = p.st_mc + sidx * 16384;
#pragma unroll
        for (int dt = 0; dt < 8; ++dt)
#pragma unroll
            for (int j = 0; j < 4; ++j) C[dt][j] = src[(16 * dt + 4 * q + j) * 128 + 16 * w + c];
        if (tid < 128) NV[tid] = p.st_mn[sidx * 128 + tid];
        if (tid == 0) mst[0] = p.st_mm[sidx];
    } else {
#pragma unroll
        for (int dt = 0; dt < 8; ++dt) C[dt] = (f32x4){0.f, 0.f, 0.f, 0.f};
        if (tid < 128) NV[tid] = 0.f;
        if (tid == 0) mst[0] = 0.f;
    }
    u32x4 pq[2], pk[2], pv[2]; float pgi = 0.f, pgf = 0.f;
#define ML_LOAD(ii) do { _Pragma("unroll") for (int j_ = 0; j_ < 2; ++j_) { const int e_ = tid + 512 * j_, rw_ = e_ >> 4, pc_ = e_ & 15; const int pos_ = 64 * (ii) + rw_, tok_ = dir ? L - 1 - pos_ : pos_; \
            const size_t r_ = (size_t)(row0 + tok_); pq[j_] = *(const u32x4*)(qkm + r_ * DM + h * 128 + 8 * pc_); pk[j_] = *(const u32x4*)(qkm + r_ * DM + 512 + h * 128 + 8 * pc_); \
            pv[j_] = *(const u32x4*)(proj + r_ * NPROJ + 3584 + h * 128 + 8 * pc_); } \
        if (w == 0) { const int ps_ = 64 * (ii) + lane, tk_ = dir ? L - 1 - ps_ : ps_; const float* g_ = gates + (size_t)(row0 + tk_) * 16; pgi = g_[dir * 4 + h]; pgf = g_[8 + dir * 4 + h]; } } while (0)
    ML_LOAD(0);
    for (int i = 0; i < NC; ++i) {
        LAS unsigned char* buf = lds + (i & 1) * BUF;
        LAS unsigned char* QM = buf; LAS unsigned char* KM = buf + IMG; LAS unsigned char* VM = buf + 2 * IMG;
        LAS float* U = (LAS float*)(buf + 3 * IMG); LAS float* MM = U + 64; LAS float* AI = U + 128; LAS float* EN = U + 192; LAS float* UE = U + 256;
        asm volatile("s_waitcnt vmcnt(0)" ::: "memory");
#pragma unroll
        for (int j = 0; j < 2; ++j) { const int e = tid + 512 * j, rw = e >> 4, pc = e & 15;
            *(LAS u32x4*)(QM + rw * MP + 16 * pc) = pq[j]; *(LAS u32x4*)(KM + rw * MP + 16 * pc) = pk[j]; *(LAS u32x4*)(VM + rw * MP + 16 * pc) = pv[j]; }
        if (w == 0) {
            const float m0 = mst[0];
            const float gi = pgi, lf = fminf(pgf, 0.f) - log1pf(__expf(-fabsf(pgf)));
            float bc = lf;
#pragma unroll
            for (int o = 1; o < 64; o <<= 1) { const float x = __shfl_up(bc, o); if (lane >= o) bc += x; }
            const float u = gi - bc;
            float pm = u;
#pragma unroll
            for (int o = 1; o < 64; o <<= 1) { const float x = __shfl_up(pm, o); if (lane >= o) pm = fmaxf(pm, x); }
            const float Mt = fmaxf(m0, pm);
            const float M63 = rdlane(Mt, 63), bc63 = rdlane(bc, 63);
            U[lane] = u; MM[lane] = Mt; AI[lane] = __expf(m0 - Mt); EN[lane] = __expf(-(bc + Mt)); UE[lane] = __expf(u - M63);
            asm volatile("s_waitcnt lgkmcnt(0)" ::: "memory");
            if (lane == 0) mst[0] = bc63 + M63;
        }
        { const int nx = (i + 1 < NC) ? i + 1 : NC - 1; ML_LOAD(nx); }
        __syncthreads();
        {
            const int tt = w >> 1;
#pragma unroll
            for (int k2 = 0; k2 < 2; ++k2) {
                const int st = 2 * (w & 1) + k2;
                if (st <= tt) {
                    f32x4 accP = {0.f, 0.f, 0.f, 0.f};
#pragma unroll
                    for (int kp = 0; kp < 4; ++kp) {
                        const h16x8 a = *(const LAS h16x8*)(KM + (16 * st + c) * MP + 2 * (32 * kp + 8 * q));
                        const h16x8 bq = *(const LAS h16x8*)(QM + (16 * tt + c) * MP + 2 * (32 * kp + 8 * q));
                        accP = __builtin_amdgcn_mfma_f32_16x16x32_f16(a, bq, accP, 0, 0, 0);
                    }
                    const f32x4 u4 = *(const LAS f32x4*)(U + 16 * st + 4 * q); const float mt = MM[16 * tt + c];
                    float pj[4];
#pragma unroll
                    for (int j = 0; j < 4; ++j) { const float e = accP[j] * __expf(u4[j] - mt); pj[j] = (16 * st + 4 * q + j <= 16 * tt + c) ? e : 0.f; }
                    u32x2 pw; pw.x = pkh(pj[0], pj[1]); pw.y = pkh(pj[2], pj[3]);
                    *(LAS u32x2*)(PM + (16 * tt + c) * PP + 2 * (16 * st + 4 * q)) = pw;
                    float cs = (pj[0] + pj[1]) + (pj[2] + pj[3]);
                    cs += __shfl_xor(cs, 16); cs += __shfl_xor(cs, 32);
                    if (q == 0) DENP[st * 64 + 16 * tt + c] = cs;
                }
            }
            {
                const h16x8 qa = *(const LAS h16x8*)(QM + lane * MP + 2 * (16 * w)), qb = *(const LAS h16x8*)(QM + lane * MP + 2 * (16 * w + 8));
                const f32x4 n0 = *(const LAS f32x4*)(NV + 16 * w), n1 = *(const LAS f32x4*)(NV + 16 * w + 4), n2 = *(const LAS f32x4*)(NV + 16 * w + 8), n3 = *(const LAS f32x4*)(NV + 16 * w + 12);
                float s = 0.f;
#pragma unroll
                for (int j = 0; j < 4; ++j) s += (float)qa[j] * n0[j] + (float)qa[4 + j] * n1[j] + (float)qb[j] * n2[j] + (float)qb[4 + j] * n3[j];
                QNP[w * 64 + lane] = s;
            }
            {
                const int d = tid & 127, part = tid >> 7;
                float s = 0.f;
#pragma unroll
                for (int ss = 0; ss < 16; ++ss) s += UE[16 * part + ss] * (float)*(const LAS h16*)(KM + (16 * part + ss) * MP + 2 * d);
                NP[part * 128 + d] = s;
            }
        }
        __syncthreads();
        {
            h16x4 vtr[4];
#pragma unroll
            for (int st = 0; st < 4; ++st) vtr[st] = __builtin_bit_cast(h16x4, tr_read(VM + (16 * st + 4 * q + (c >> 2)) * MP + 2 * (16 * w + 4 * (c & 3))));
            h16x8 cp[4];
#pragma unroll
            for (int kp = 0; kp < 4; ++kp) { u32x4 sa; sa.x = pkh(C[2 * kp][0], C[2 * kp][1]); sa.y = pkh(C[2 * kp][2], C[2 * kp][3]); sa.z = pkh(C[2 * kp + 1][0], C[2 * kp + 1][1]); sa.w = pkh(C[2 * kp + 1][2], C[2 * kp + 1][3]); cp[kp] = __builtin_bit_cast(h16x8, sa); }
#pragma unroll
            for (int tt = 0; tt < 4; ++tt) {
                const int t = 16 * tt + c;
                f32x4 accI = {0.f, 0.f, 0.f, 0.f}, accN = {0.f, 0.f, 0.f, 0.f};
#pragma unroll
                for (int kp = 0; kp < 4; ++kp) {
                    const u32x2 b0 = *(const LAS u32x2*)(QM + t * MP + 2 * (32 * kp + 4 * q)), b1 = *(const LAS u32x2*)(QM + t * MP + 2 * (32 * kp + 16 + 4 * q));
                    u32x4 bb; bb.x = b0.x; bb.y = b0.y; bb.z = b1.x; bb.w = b1.y;
                    accI = __builtin_amdgcn_mfma_f32_16x16x32_f16(cp[kp], __builtin_bit_cast(h16x8, bb), accI, 0, 0, 0);
                }
                float den = 0.f;
#pragma unroll
                for (int st = 0; st < 4; ++st) if (st <= tt) {
                    const u32x2 pb = *(const LAS u32x2*)(PM + t * PP + 2 * (16 * st + 4 * q));
                    accN = __builtin_amdgcn_mfma_f32_16x16x16f16(vtr[st], __builtin_bit_cast(h16x4, pb), accN, 0, 0, 0);
                    den += DENP[st * 64 + t];
                }
                float qn = 0.f;
#pragma unroll
                for (int ww = 0; ww < 8; ++ww) qn += QNP[ww * 64 + t];
                const float ai = AI[t];
                den += ai * qn;
                const float sc = 1.f / fmaxf(fabsf(den), EN[t]);
                f32x4 hv = (accN + accI * ai) * sc;
#pragma unroll
                for (int j = 0; j < 4; ++j) hv[j] = fminf(fmaxf(hv[j], -60000.f), 60000.f);
                const int pos = 64 * i + t, tok = dir ? L - 1 - pos : pos;
                u32x2 o; o.x = pkh(hv[0], hv[1]); o.y = pkh(hv[2], hv[3]);
                *(u32x2*)(odst + (size_t)(row0 + tok) * DM + 512 + h * 128 + 16 * w + 4 * q) = o;
            }
            const float a63 = AI[63];
            h16x4 vs[4];
#pragma unroll
            for (int st = 0; st < 4; ++st) { const f32x4 ue4 = *(const LAS f32x4*)(UE + 16 * st + 4 * q);
#pragma unroll
                for (int j = 0; j < 4; ++j) vs[st][j] = (h16)((float)vtr[st][j] * ue4[j]); }
#pragma unroll
            for (int dt = 0; dt < 8; ++dt) {
                C[dt] = C[dt] * a63;
#pragma unroll
                for (int st = 0; st < 4; ++st) {
                    const h16x4 ktr = __builtin_bit_cast(h16x4, tr_read(KM + (16 * st + 4 * q + (c >> 2)) * MP + 2 * (16 * dt + 4 * (c & 3))));
                    C[dt] = __builtin_amdgcn_mfma_f32_16x16x16f16(ktr, vs[st], C[dt], 0, 0, 0);
                }
            }
            if (tid < 128) NV[tid] = a63 * NV[tid] + (NP[tid] + NP[128 + tid]) + (NP[256 + tid] + NP[384 + tid]);
        }
#if defined(ML_EXTRA_SYNC)
        asm volatile("s_waitcnt vmcnt(0) lgkmcnt(0)" ::: "memory");
        __syncthreads();
#endif
    }
    __syncthreads();
    if (!lat) {
        float* dst = p.out + OUT_MC + sidx * 16384;
#pragma unroll
        for (int dt = 0; dt < 8; ++dt)
#pragma unroll
            for (int j = 0; j < 4; ++j) dst[(16 * dt + 4 * q + j) * 128 + 16 * w + c] = C[dt][j];
        if (tid < 128) p.out[OUT_MN + sidx * 128 + tid] = NV[tid];
        if (tid == 0) p.out[OUT_MM + sidx] = mst[0];
    }
    __syncthreads();
#undef ML_LOAD
}
#if defined(DIAG_ALL)
#define SCAN_HG(p, l, lat, b, h, dir, lds) do { scan_hgrn_mfma(p, l, lat, b, h, dir, (LAS unsigned char*)(lds)); asm volatile("s_waitcnt vmcnt(0)" ::: "memory"); __syncthreads(); scan_item<0, 1>(p, l, lat, b, h, dir, lds); } while (0)
#elif defined(HGRN_VALU)
#define SCAN_HG(p, l, lat, b, h, dir, lds) scan_item<0>(p, l, lat, b, h, dir, lds)
#else
#define SCAN_HG(p, l, lat, b, h, dir, lds) scan_hgrn_mfma(p, l, lat, b, h, dir, (LAS unsigned char*)(lds))
#endif
#if defined(MLSTM_VALU)
#define SCAN_ML(p, l, lat, b, h, dir, lds) scan_item<1>(p, l, lat, b, h, dir, lds)
#else
#if defined(DIAG_ALL)
#define SCAN_ML(p, l, lat, b, h, dir, lds) do { scan_mlstm_mfma(p, l, lat, b, h, dir, (LAS unsigned char*)(lds)); asm volatile("s_waitcnt vmcnt(0)" ::: "memory"); __syncthreads(); scan_item<1, 1>(p, l, lat, b, h, dir, lds); } while (0)
#elif defined(MLSTM_DIAG)
#define SCAN_ML(p, l, lat, b, h, dir, lds) do { scan_mlstm_mfma(p, l, lat, b, h, dir, (LAS unsigned char*)(lds)); \
        if ((lat) && (dir) == 0 && (l) == DIAG_LAYER) { asm volatile("s_waitcnt vmcnt(0)" ::: "memory"); __syncthreads(); scan_item<1, 1>(p, l, lat, b, h, dir, lds); } } while (0)
#elif defined(MLSTM_VALU_CTX)
#define SCAN_ML(p, l, lat, b, h, dir, lds) do { if (lat) scan_mlstm_mfma(p, l, lat, b, h, dir, (LAS unsigned char*)(lds)); else scan_item<1>(p, l, lat, b, h, dir, lds); } while (0)
#elif defined(MLSTM_MFMA_DIR0)
#define SCAN_ML(p, l, lat, b, h, dir, lds) do { if ((dir) == 0) scan_mlstm_mfma(p, l, lat, b, h, dir, (LAS unsigned char*)(lds)); else scan_item<1>(p, l, lat, b, h, dir, lds); } while (0)
#elif defined(MLSTM_BISECT)
#define SCAN_ML(p, l, lat, b, h, dir, lds) do { if (!((lat) && (dir) == 0 && (MLSTM_BISECT_COND))) scan_mlstm_mfma(p, l, lat, b, h, dir, (LAS unsigned char*)(lds)); else scan_item<1>(p, l, lat, b, h, dir, lds); } while (0)
#elif defined(MLSTM_VALU_LAT)
#define SCAN_ML(p, l, lat, b, h, dir, lds) do { if (!(lat)) scan_mlstm_mfma(p, l, lat, b, h, dir, (LAS unsigned char*)(lds)); else scan_item<1>(p, l, lat, b, h, dir, lds); } while (0)
#else
#define SCAN_ML(p, l, lat, b, h, dir, lds) scan_mlstm_mfma(p, l, lat, b, h, dir, (LAS unsigned char*)(lds))
#endif
#endif
__device__ __forceinline__ void scan_dispatch(const Params& p, int l, int it, LAS float* lds) {
    if (it < 128) { const int type = it >> 6, r = it & 63, b = r >> 3, h = (r >> 1) & 3, dir = r & 1; if (type == 0) SCAN_HG(p, l, 1, b, h, dir, lds); else SCAN_ML(p, l, 1, b, h, dir, lds); }
    else { const int q = it - 128, type = q >> 8, r = q & 255, b = r >> 3, h = (r >> 1) & 3, dir = r & 1; if (type == 0) SCAN_HG(p, l, 0, b, h, dir, lds); else SCAN_ML(p, l, 0, b, h, dir, lds); }
}
__device__ __forceinline__ void ctx_pair_mixnorm(const Params& p, int l, int b, int h) {
    asm volatile("s_waitcnt vmcnt(0)" ::: "memory");
    __syncthreads();
    const int tid = ltid(), lane = tid & 63, wave = __builtin_amdgcn_readfirstlane(tid >> 6);
    const h16* of = (const h16*)(p.ws + WS_HN); const h16* ob = (const h16*)(p.ws + WS_OB); const h16* proj = (const h16*)(p.ws + WS_PROJ);
    h16* mix = (h16*)(p.ws + WS_QKM);
    const float wh0 = p.hg_nw[l * 512 + h * 128 + 2 * lane], wh1 = p.hg_nw[l * 512 + h * 128 + 2 * lane + 1];
    const float wm0 = p.ml_nw[l * 512 + h * 128 + 2 * lane], wm1 = p.ml_nw[l * 512 + h * 128 + 2 * lane + 1];
    for (int pi = wave; pi < 512; pi += NWV) {
        const int row = b * 256 + (pi >> 1), type = pi & 1;
        const int cb = type * 512 + h * 128 + 2 * lane, gc = (type ? 4096 : 2048) + h * 128 + 2 * lane;
        const h16x2 a = *(const h16x2*)(of + (size_t)row * DM + cb), c2 = *(const h16x2*)(ob + (size_t)row * DM + cb), g = *(const h16x2*)(proj + (size_t)row * NPROJ + gc);
        const float o0 = (float)a[0] + (float)c2[0], o1 = (float)a[1] + (float)c2[1];
        const float ss = wave_sum(o0 * o0 + o1 * o1);
        const float rstd = rsqrtf(ss * (1.f / 128.f) + EPS);
        const float w0 = type ? wm0 : wh0, w1 = type ? wm1 : wh1;
        *(unsigned*)(mix + (size_t)row * DM + cb) = pkh(o0 * rstd * w0 * (float)g[0], o1 * rstd * w1 * (float)g[1]);
    }
}
__device__ __forceinline__ void phase_scan(const Params& p, int l, LAS float* lds) {
    const int G = gridDim.x, bid = blockIdx.x;
    if (G == 256) {
        if (bid < 128) scan_dispatch(p, l, bid, lds);
        else {
            const int pr = bid - 128, b = pr >> 2, h = pr & 3;
            SCAN_HG(p, l, 0, b, h, 0, lds); SCAN_HG(p, l, 0, b, h, 1, lds); SCAN_ML(p, l, 0, b, h, 0, lds); SCAN_ML(p, l, 0, b, h, 1, lds);
            ctx_pair_mixnorm(p, l, b, h);
        }
    } else {
        for (int it = bid; it < 640; it += G) scan_dispatch(p, l, it, lds);
    }
}
__device__ __forceinline__ void phase_mixnorm(const Params& p, int l, int gw, int NGW, int lane, int row_begin) {
    const h16* of = (const h16*)(p.ws + WS_HN); const h16* ob = (const h16*)(p.ws + WS_OB); const h16* proj = (const h16*)(p.ws + WS_PROJ);
    h16* mix = (h16*)(p.ws + WS_QKM);
    const int col = 16 * lane;
    const float* nw = col < 512 ? p.hg_nw + l * 512 + col : p.ml_nw + l * 512 + (col - 512);
    float wv[16];
#pragma unroll
    for (int j = 0; j < 4; ++j) { const f32x4 t = *(const f32x4*)(nw + 4 * j); wv[4 * j] = t.x; wv[4 * j + 1] = t.y; wv[4 * j + 2] = t.z; wv[4 * j + 3] = t.w; }
    const int gcol = col < 512 ? 2048 + col : 4096 + (col - 512);
    for (int r = row_begin + gw; r < T_ALL; r += NGW) {
        const h16x8 a0 = *(const h16x8*)(of + (size_t)r * DM + col), a1 = *(const h16x8*)(of + (size_t)r * DM + col + 8);
        const h16x8 b0 = *(const h16x8*)(ob + (size_t)r * DM + col), b1 = *(const h16x8*)(ob + (size_t)r * DM + col + 8);
        const h16x8 g0 = *(const h16x8*)(proj + (size_t)r * NPROJ + gcol), g1 = *(const h16x8*)(proj + (size_t)r * NPROJ + gcol + 8);
        float o[16]; float ss = 0.f;
#pragma unroll
        for (int j = 0; j < 8; ++j) { o[j] = (float)a0[j] + (float)b0[j]; o[8 + j] = (float)a1[j] + (float)b1[j]; }
#pragma unroll
        for (int j = 0; j < 16; ++j) ss += o[j] * o[j];
        ss += __shfl_xor(ss, 1); ss += __shfl_xor(ss, 2); ss += __shfl_xor(ss, 4);
        const float rstd = rsqrtf(ss * (1.f / 128.f) + EPS);
        u32x4 w0, w1;
        w0.x = pkh(o[0] * rstd * wv[0] * (float)g0[0], o[1] * rstd * wv[1] * (float)g0[1]); w0.y = pkh(o[2] * rstd * wv[2] * (float)g0[2], o[3] * rstd * wv[3] * (float)g0[3]);
        w0.z = pkh(o[4] * rstd * wv[4] * (float)g0[4], o[5] * rstd * wv[5] * (float)g0[5]); w0.w = pkh(o[6] * rstd * wv[6] * (float)g0[6], o[7] * rstd * wv[7] * (float)g0[7]);
        w1.x = pkh(o[8] * rstd * wv[8] * (float)g1[0], o[9] * rstd * wv[9] * (float)g1[1]); w1.y = pkh(o[10] * rstd * wv[10] * (float)g1[2], o[11] * rstd * wv[11] * (float)g1[3]);
        w1.z = pkh(o[12] * rstd * wv[12] * (float)g1[4], o[13] * rstd * wv[13] * (float)g1[5]); w1.w = pkh(o[14] * rstd * wv[14] * (float)g1[6], o[15] * rstd * wv[15] * (float)g1[7]);
        *(u32x4*)(mix + (size_t)r * DM + col) = w0; *(u32x4*)(mix + (size_t)r * DM + col + 8) = w1;
    }
}

#define XB_TMO      128
#define XB_XCNT(j)  (256  + 64 * (j))
#define XB_XSUB(j)  (1280 + 64 * (j))
#define XB_XGEN(j)  (2304 + 64 * (j))
#define XB_TOP      3328
#define XB_TOPGEN   3392
#define XCD_BAR_WORDS 3456
#define XB_SPIN_CAP (1u << 18)

__device__ __forceinline__ unsigned xb_ld(unsigned* p)              { return __hip_atomic_load(p, __ATOMIC_RELAXED, __HIP_MEMORY_SCOPE_AGENT); }
__device__ __forceinline__ unsigned xb_add(unsigned* p, unsigned v) { return __hip_atomic_fetch_add(p, v, __ATOMIC_RELAXED, __HIP_MEMORY_SCOPE_AGENT); }
__device__ __forceinline__ unsigned xb_xcc_id() { return (unsigned)__builtin_amdgcn_s_getreg((3 << 11) | 20) & 0xFu; }
#define XB_SPIN(cond, bar) do { unsigned _sp = 0; while (cond) { __builtin_amdgcn_s_sleep(1); \
    if ((++_sp & 255u) == 0u) { if (xb_ld(&(bar)[XB_TMO])) break; if (_sp > XB_SPIN_CAP) { atomicAdd(&(bar)[XB_TMO], 1u); break; } } } } while (0)

struct XcdBarrier {
    unsigned* bar; unsigned x;
    volatile LAS unsigned* st;
};

__device__ __forceinline__ XcdBarrier xcd_barrier_post(unsigned* bar, volatile LAS unsigned* st) {
    XcdBarrier b; b.bar = bar; b.x = xb_xcc_id(); b.st = st;
    if (threadIdx.x == 0) (void)xb_add(&bar[XB_XCNT(b.x)], 1u);
    return b;
}
__device__ __forceinline__ void xcd_barrier_complete(unsigned* bar, unsigned x, unsigned& nloc, unsigned& nx) {
    const unsigned G = gridDim.x * gridDim.y * gridDim.z;
    unsigned sum, cnt, mine, sp = 0u;
    for (;;) {
        sum = 0u; cnt = 0u; mine = 0u;
#pragma unroll
        for (unsigned j = 0; j < 16; ++j) { const unsigned c = xb_ld(&bar[XB_XCNT(j)]); sum += c; cnt += (c > 0u) ? 1u : 0u; mine = (j == x) ? c : mine; }
        if (sum == G) break;
        __builtin_amdgcn_s_sleep(1);
        if ((++sp & 255u) == 0u) { if (xb_ld(&bar[XB_TMO])) break; if (sp > XB_SPIN_CAP) { atomicAdd(&bar[XB_TMO], 1u); break; } }
    }
    nloc = mine > 0u ? mine : 1u; nx = cnt > 0u ? cnt : 1u;
}

__device__ __forceinline__ void xcd_barrier(const XcdBarrier& b) {
    asm volatile("s_waitcnt vmcnt(0)" ::: "memory");
    __syncthreads();
    if (threadIdx.x == 0) {
        unsigned* bar = b.bar;
        __builtin_amdgcn_s_waitcnt(0);
        unsigned nloc = b.st[0], nx = b.st[1];
        if (nloc == 0u) { xcd_barrier_complete(bar, b.x, nloc, nx); b.st[0] = nloc; b.st[1] = nx; }
        const unsigned old = xb_add(&bar[XB_XSUB(b.x)], 1u);
        const unsigned gen = old / nloc;
        if (old + 1u == (gen + 1u) * nloc) {
            __builtin_amdgcn_fence(__ATOMIC_RELEASE, "agent");
            asm volatile("s_waitcnt vmcnt(0)" ::: "memory");
            const unsigned og = xb_add(&bar[XB_TOP], 1u);
            const unsigned tg = og / nx;
            if (og + 1u == (tg + 1u) * nx) xb_add(&bar[XB_TOPGEN], 1u);
            else XB_SPIN(xb_ld(&bar[XB_TOPGEN]) == tg, bar);
            __builtin_amdgcn_fence(__ATOMIC_ACQUIRE, "agent");
            xb_add(&bar[XB_XGEN(b.x)], 1u);
            asm volatile("s_waitcnt vmcnt(0)" ::: "memory");
        } else {
            XB_SPIN(xb_ld(&bar[XB_XGEN(b.x)]) == gen, bar);
            __builtin_amdgcn_fence(__ATOMIC_ACQUIRE, "agent");
            asm volatile("s_waitcnt vmcnt(0)" ::: "memory");
        }
    }
    __syncthreads();
}


__global__ void __launch_bounds__(NTHR, 2) fwd_megakernel(Params p) {
    extern __shared__ __attribute__((aligned(16))) unsigned char lds_raw[];
    cg::grid_group grid = cg::this_grid();
#if defined(USE_CG_SYNC)
#define GSYNC() do { asm volatile("s_waitcnt vmcnt(0)" ::: "memory"); grid.sync(); } while (0)
#else
#define GSYNC() do { XcdBarrier xb_; xb_.bar = (unsigned*)(p.ws + WS_BAR); xb_.x = xb_xcc_id(); xb_.st = (volatile LAS unsigned*)(lds + 131072 + 512); xcd_barrier(xb_); } while (0)
#endif
    LAS unsigned char* lds = (LAS unsigned char*)lds_raw;
    LAS float* ldsf = (LAS float*)lds_raw;
    const int G = gridDim.x, NGW = G * NWV;
#define PHASE_IDS() const int tid = ltid(), lane = tid & 63, wave = __builtin_amdgcn_readfirstlane(tid >> 6), gw = blockIdx.x * NWV + wave; (void)tid; (void)lane; (void)gw
    const float* mod = (const float*)(p.ws + WS_MOD);
    h16* hn = (h16*)(p.ws + WS_HN); h16* proj = (h16*)(p.ws + WS_PROJ); h16* mix = (h16*)(p.ws + WS_QKM); h16* ff = (h16*)(p.ws + WS_PROJ);

    volatile LAS unsigned* xst = (volatile LAS unsigned*)(lds + 131072 + 512);
    if (ltid() < 4) xst[ltid()] = 0u;
    __syncthreads();
    XcdBarrier xbar = xcd_barrier_post((unsigned*)(p.ws + WS_BAR), xst);
    phase_mod_partial(p, ldsf);
    asm volatile("s_waitcnt vmcnt(0)" ::: "memory"); grid.sync();
    (void)xbar;
    phase_mod_reduce(p);
    GSYNC();
#if defined(DIAG_ALL)
    if (ltid() == 0) { float* dg = (float*)(p.ws + WS_MODP) + 4 * blockIdx.x; dg[0] = 0.f; dg[1] = 0.f; dg[2] = 0.f; dg[3] = 0.f; }
#endif
    for (int l = 0; l < 4; ++l) {
        { PHASE_IDS(); convert_weights(p, l, ldsf + wave * 2176, gw, NGW, lane); }
        { PHASE_IDS(); phase_norm(p, l, 0, l == 0, gw, NGW, lane); }
        GSYNC();
        {
            pg8::Gemm g{(const pg8::bf16_t*)hn, (const pg8::bf16_t*)(p.ws + WS_WIN), T_ALL, NPROJ_PAD, DM}; pg8::StaticOrder S; S.init(T_ALL, NPROJ_PAD, G, (int)blockIdx.x);
            EpiInProj E{proj, (float*)(p.ws + WS_GATES), p.gate_b + l * 16};
            pg8::gemm_phase<EpiInProj, pg8::StaticOrder, true, true>(lds, g, S, E);
#if defined(PROBE_GEMM2)
            GSYNC();
            pg8::gemm_phase<EpiInProj, pg8::StaticOrder, true, true>(lds, g, S, E);
#endif
        }
        GSYNC();
        { PHASE_IDS(); phase_gates(p, l, gw, NGW, lane); }
        phase_conv(p, l);
        GSYNC();
#if defined(PERTURB)
        { if (ltid() == 0) { const unsigned long long t0_ = __builtin_amdgcn_s_memrealtime(); const unsigned long long dl_ = (unsigned long long)(((blockIdx.x * 37u + l * 11u) % 64u) * 300u); while (__builtin_amdgcn_s_memrealtime() - t0_ < dl_) __builtin_amdgcn_s_sleep(4); } __syncthreads(); }
#endif
        phase_scan(p, l, ldsf);
#if defined(PERTURB)
        { if (ltid() == 0) { const unsigned long long t0_ = __builtin_amdgcn_s_memrealtime(); const unsigned long long dl_ = (unsigned long long)(((blockIdx.x * 53u + l * 7u) % 32u) * 400u); while (__builtin_amdgcn_s_memrealtime() - t0_ < dl_) __builtin_amdgcn_s_sleep(4); } __syncthreads(); }
#endif
#if defined(DELAY_AFTER_SCAN)
        { if (ltid() == 0) { const unsigned long long t0_ = __builtin_amdgcn_s_memrealtime(); while (__builtin_amdgcn_s_memrealtime() - t0_ < (unsigned long long)(DELAY_AFTER_SCAN) * 100ull) __builtin_amdgcn_s_sleep(8); } __syncthreads(); }
#endif
#if defined(LDS_CLEAR)
        { __syncthreads(); const int t_ = ltid(); for (int e = t_; e < 32768; e += NTHR) ldsf[e] = LDS_CLEAR_VAL; __syncthreads(); }
#endif
        GSYNC();
#if defined(MLSTM_DIAG)
        if (l == DIAG_LAYER && blockIdx.x == 0 && ltid() == 0) {
            const float* dg = (const float*)(p.ws + WS_MODP);
            float best = -1.f; int code = 0;
            for (int bb = 64; bb < 128; bb += 2) { const float rt = dg[4 * bb + DIAG_FIELD]; if (rt > best) { best = rt; int lg = 0; float x = rt; while (x < 1.f && lg < 31) { x *= 2.f; ++lg; } code = DIAG_CODE; } }
            const unsigned long long t0 = __builtin_amdgcn_s_memrealtime();
            while (__builtin_amdgcn_s_memrealtime() - t0 < (unsigned long long)code * 5000ull) __builtin_amdgcn_s_sleep(8);
        }
#endif
#if defined(PROBE_GSYNC10)
        for (int rep = 0; rep < 10; ++rep) GSYNC();
#endif
#if defined(PROBE_SCAN_TYPE)
        { const int bid_ = blockIdx.x;
          if (bid_ < 128) { if ((bid_ >> 6) == PROBE_SCAN_TYPE) scan_dispatch(p, l, bid_, ldsf); }
          else for (int it = 128 + (bid_ - 128); it < 640; it += 128) { if (((it - 128) >> 8) == PROBE_SCAN_TYPE) scan_dispatch(p, l, it, ldsf); } }
        GSYNC();
#endif
#if defined(PROBE_SCAN2)
        phase_scan(p, l, ldsf);
        GSYNC();
#endif
        { PHASE_IDS(); phase_mixnorm(p, l, gw, NGW, lane, G == 256 ? T_CTX : 0); }
        GSYNC();
        {
            pg8::Gemm g{(const pg8::bf16_t*)mix, (const pg8::bf16_t*)(p.ws + WS_WOUT), T_ALL, DM, DM}; pg8::StaticOrder S; S.init(T_ALL, DM, G, (int)blockIdx.x);
            EpiResid E{l == 0 ? p.x_prompt : p.out, l == 0 ? p.x_sample : p.out + (size_t)T_CTX * DM, p.out, mod + (size_t)l * 9 * 6144 + 2048};
#if defined(PROBE_GEMM2)
            { EpiResid E2 = E; E2.out = (float*)(p.ws + WS_PROJ); pg8::gemm_phase<EpiResid, pg8::StaticOrder, true, true>(lds, g, S, E2); GSYNC(); }
#endif
            pg8::gemm_phase<EpiResid, pg8::StaticOrder, true, true>(lds, g, S, E);
        }
        GSYNC();
        { PHASE_IDS(); phase_norm(p, l, 1, false, gw, NGW, lane); }
        GSYNC();
        {
            pg8::Gemm g{(const pg8::bf16_t*)hn, (const pg8::bf16_t*)(p.ws + WS_WGU), T_ALL, NGU, DM}; pg8::StaticOrder S; S.init(T_ALL, NGU, G, (int)blockIdx.x);
            EpiGateUp E{ff};
            pg8::gemm_phase<EpiGateUp, pg8::StaticOrder, true, true>(lds, g, S, E);
#if defined(PROBE_GEMM2)
            GSYNC();
            pg8::gemm_phase<EpiGateUp, pg8::StaticOrder, true, true>(lds, g, S, E);
#endif
        }
        GSYNC();
        {
            pg8::Gemm g{(const pg8::bf16_t*)ff, (const pg8::bf16_t*)(p.ws + WS_WDN), T_ALL, DM, DFF}; pg8::StaticOrder S; S.init(T_ALL, DM, G, (int)blockIdx.x);
            EpiResid E{p.out, p.out + (size_t)T_CTX * DM, p.out, mod + (size_t)l * 9 * 6144 + 5120};
#if defined(PROBE_GEMM2)
            { EpiResid E2 = E; E2.out = (float*)(p.ws + WS_QKM); pg8::gemm_phase<EpiResid, pg8::StaticOrder, true, true>(lds, g, S, E2); GSYNC(); }
#endif
            pg8::gemm_phase<EpiResid, pg8::StaticOrder, true, true>(lds, g, S, E);
        }
        GSYNC();
    }
    { PHASE_IDS(); phase_final_norm(p, gw, NGW, lane); }
#if defined(DIAG_ALL)
    if (blockIdx.x == 0 && ltid() == 0) {
        const float* dg = (const float*)(p.ws + WS_MODP);
        float best = -1.f; int code = 0;
        for (int bb = 0; bb < (int)gridDim.x; ++bb) { const float rt = dg[4 * bb]; if (rt > best) { best = rt; int lg = 0; float x = rt; while (x < 1.f && lg < 31) { x *= 2.f; ++lg; } code = DIAG_ALL_CODE; } }
        const unsigned long long t0 = __builtin_amdgcn_s_memrealtime();
        while (__builtin_amdgcn_s_memrealtime() - t0 < (unsigned long long)code * 5000ull) __builtin_amdgcn_s_sleep(8);
    }
#endif
}

extern "C" void kernel_launch(void* const* d_in, const int* in_sizes, int n_in, void* d_out, int out_size, void* d_ws, size_t ws_size, hipStream_t stream) {
    static int grid_blocks = 0;
    if (grid_blocks == 0) {
        if (n_in != 24 || (size_t)out_size != OUT_TOTAL || ws_size < WS_END) {
            fprintf(stderr, "kernel_launch: unexpected sizes n_in %d out %d ws %zu (need %zu)\n", n_in, out_size, ws_size, (size_t)WS_END); grid_blocks = -1; return;
        }
        int dev = 0, cus = 0, per_cu = 0;
        hipGetDevice(&dev);
        hipDeviceGetAttribute(&cus, hipDeviceAttributeMultiprocessorCount, dev);
        hipFuncSetAttribute((const void*)fwd_megakernel, hipFuncAttributeMaxDynamicSharedMemorySize, LDS_BYTES);
        hipOccupancyMaxActiveBlocksPerMultiprocessor(&per_cu, (const void*)fwd_megakernel, NTHR, LDS_BYTES);
        if (per_cu < 1) { fprintf(stderr, "kernel_launch: occupancy query says %d blocks per CU\n", per_cu); per_cu = 1; }
        grid_blocks = cus * 1;
        (void)hipGetLastError();
    }
    if (grid_blocks < 0) return;
    Params p{};
    const float** f = (const float**)&p;
    for (int i = 0; i < 24; ++i) f[i] = (const float*)d_in[i];
    p.out = (float*)d_out; p.ws = (unsigned char*)d_ws;
    if (hipMemsetAsync((char*)d_ws + WS_BAR, 0, 16384, stream) != hipSuccess) { fprintf(stderr, "kernel_launch: memset of the barrier words failed\n"); return; }
    void* args[] = {&p};
    hipError_t e = hipLaunchCooperativeKernel((const void*)fwd_megakernel, dim3(grid_blocks), dim3(NTHR), args, LDS_BYTES, stream);
    if (e != hipSuccess) fprintf(stderr, "cooperative launch failed: %s (grid %d)\n", hipGetErrorString(e), grid_blocks);
}
```

```cpp
#include <hip/hip_runtime.h>
#include <hip/hip_cooperative_groups.h>
#include <cstdio>
#include <cstdint>
namespace cg = cooperative_groups;
typedef _Float16 h16;
typedef _Float16 h16x8 __attribute__((ext_vector_type(8)));
typedef _Float16 h16x4 __attribute__((ext_vector_type(4)));
typedef _Float16 h16x2 __attribute__((ext_vector_type(2)));
typedef float f32x2 __attribute__((ext_vector_type(2)));
namespace pg8 {
#define PG8_LAS __attribute__((address_space(3)))
typedef unsigned short bf16_t;
typedef short bf16x8 __attribute__((ext_vector_type(8)));
typedef float f32x4 __attribute__((ext_vector_type(4)));
typedef unsigned u32x4 __attribute__((ext_vector_type(4)));
constexpr int BM = 256, BK = 64, HALF = 128, HTB = HALF * BK * 2  , STAGE_BYTES = 8 * HTB, NXCD = 8, WGM = 8;

__host__ __device__ __forceinline__ int lds_byte(int r, int c) { const int st = (r >> 4) * 2 + (c >> 5), rr = r & 15, cc = c & 31, ob = rr * 64 + cc * 2; return st * 1024 + (ob ^ (((ob >> 9) & 1) << 5)); }
__host__ __device__ __forceinline__ void stage_rc(int b, int& R, int& C) { const int st = b / 1024, sb = b % 1024, swz = sb ^ (((sb >> 9) & 1) << 5); R = (st >> 1) * 16 + swz / 64; C = (st & 1) * 32 + (swz % 64) / 2; }
__host__ __device__ __forceinline__ int perm32(int rho) { const int n = rho >> 4, i = rho & 15; return 8 * (i >> 2) + 4 * n + (i & 3); }

struct Unit { int pm, pn; };
struct Gemm { const bf16_t* A; const bf16_t* Bt; int M, N, K; };

struct StaticOrder {
    int nM, nN, nwg, G, c;
    __host__ __device__ void init(int M, int N, int G_, int c_) { nM = M / BM; nN = N / BM; nwg = nM * nN; G = G_; c = c_; }
    __host__ __device__ bool next(int i, Unit& u) const {
        const long L = (long)i * G + c; if (L >= nwg) return false;
        int wgid = (int)L; { const int q = nwg / NXCD, r = nwg % NXCD, xcd = wgid % NXCD, off = wgid / NXCD; wgid = (xcd < r ? xcd * (q + 1) : r * (q + 1) + (xcd - r) * q) + off; }
        const int nig = WGM * nN, gid = wgid / nig, fm = gid * WGM, gsz = (nM - fm) < WGM ? (nM - fm) : WGM;
        u.pm = fm + ((wgid % nig) % gsz); u.pn = (wgid % nig) / gsz; return true;
    }
    __device__ __forceinline__ void a_ready(const Unit&) const {}
    __device__ __forceinline__ void done(const Unit&) const {}
};

template <class Epi, class Sched, bool ALIGN_EPI = false, bool SP2 = false>
__device__ __forceinline__ void gemm_phase(PG8_LAS unsigned char* lds, const Gemm g, const Sched& S, const Epi& E) {
    int tid_l = threadIdx.x; asm volatile("" : "+v"(tid_l));
    const int tid = tid_l, wid = __builtin_amdgcn_readfirstlane(tid >> 6), lane = tid & 63, wr = wid >> 2, wc = wid & 3, fr = lane & 15, fq = lane >> 4;
    const int K = g.K, nt = K / BK;
    unsigned voffA[2], voffB[2];
#pragma unroll
    for (int i = 0; i < 2; ++i) { int R, C; stage_rc(tid * 16 + i * 8192, R, C); const int Rb = Epi::PERM ? ((R & ~31) + perm32(R & 31)) : R;
        voffA[i] = (unsigned)(R * K + C) * 2u; voffB[i] = (unsigned)(Rb * K + C) * 2u; }
    const size_t kstep = (size_t)(BK * 2);
    const size_t hstep = (size_t)HALF * K * 2;
    const size_t tstep = 2 * hstep;
    const unsigned ldsw = (unsigned)wid * 1024u;
    const int aoff = lds_byte(wr * 64 + fr, fq * 8), boff = lds_byte(wc * 32 + fr, fq * 8);
#define PG8_SA(b, h) (((b) * 2 + (h)) * HTB)
#define PG8_SB(b, h) ((4 + (b) * 2 + (h)) * HTB)
#define PG8_STAGE(bufoff, gbase, voff) do { _Pragma("unroll") for (int _i = 0; _i < 2; ++_i) \
        __builtin_amdgcn_global_load_lds((const unsigned*)((const char*)(gbase) + (voff)[_i]), (PG8_LAS unsigned*)(lds + (bufoff) + ldsw + _i * 8192), 16, 0, 0); } while (0)
#define PG8_LDA(dst, b, h) do { _Pragma("unroll") for (int m = 0; m < 4; ++m) _Pragma("unroll") for (int k = 0; k < 2; ++k) dst[m][k] = *(const PG8_LAS bf16x8*)(lds + PG8_SA(b, h) + aoff + m * 2048 + k * 1024); } while (0)
#define PG8_LDB(dst, b, h) do { _Pragma("unroll") for (int n = 0; n < 2; ++n) _Pragma("unroll") for (int k = 0; k < 2; ++k) dst[n][k] = *(const PG8_LAS bf16x8*)(lds + PG8_SB(b, h) + boff + n * 2048 + k * 1024); } while (0)
#define PG8_MMA(ai, bj, At, Bt) do { __builtin_amdgcn_s_setprio(1); _Pragma("unroll") for (int m = 0; m < 4; ++m) _Pragma("unroll") for (int n = 0; n < 2; ++n) _Pragma("unroll") for (int k = 0; k < 2; ++k) \
        acc[ai][bj][m][n] = __builtin_amdgcn_mfma_f32_16x16x32_f16(__builtin_bit_cast(h16x8, Bt[n][k]), __builtin_bit_cast(h16x8, At[m][k]), acc[ai][bj][m][n], 0, 0, 0); __builtin_amdgcn_s_setprio(0); } while (0)
#define PG8_WAIT_V(n) asm volatile("s_waitcnt vmcnt(" #n ")" ::: "memory")
#define PG8_WAIT_L(n) asm volatile("s_waitcnt lgkmcnt(" #n ")" ::: "memory")
#define PG8_BAR __builtin_amdgcn_s_barrier()
#define PG8_SCHED __builtin_amdgcn_sched_barrier(0)
    Unit cur, nxt; int ui = 0;
    if (!S.next(0, cur)) return;
    f32x4 acc[2][2][4][2];
#pragma unroll
    for (int a = 0; a < 2; ++a)
#pragma unroll
        for (int b = 0; b < 2; ++b)
#pragma unroll
            for (int m = 0; m < 4; ++m)
#pragma unroll
                for (int n = 0; n < 2; ++n) acc[a][b][m][n] = (f32x4){0.f, 0.f, 0.f, 0.f};
    bf16x8 At[4][2], B0[2][2], B1[2][2];
    const char* cA = (const char*)g.A + (size_t)cur.pm * tstep; const char* cB = (const char*)g.Bt + (size_t)cur.pn * tstep;
    S.a_ready(cur);
    if constexpr (SP2) {
        PG8_STAGE(PG8_SB(0, 0), cB, voffB); PG8_STAGE(PG8_SB(0, 1), cB + hstep, voffB); PG8_STAGE(PG8_SA(0, 0), cA, voffA); PG8_STAGE(PG8_SA(0, 1), cA + hstep, voffA);
        if (wr == 1) PG8_BAR;
        PG8_WAIT_V(2); PG8_BAR;
        PG8_STAGE(PG8_SB(1, 0), cB + kstep, voffB); PG8_STAGE(PG8_SA(1, 0), cA + kstep, voffA); PG8_STAGE(PG8_SB(1, 1), cB + hstep + kstep, voffB);
        PG8_WAIT_V(6); PG8_BAR;
    } else {
        PG8_STAGE(PG8_SB(0, 0), cB, voffB); PG8_STAGE(PG8_SA(0, 0), cA, voffA); PG8_STAGE(PG8_SB(0, 1), cB + hstep, voffB); PG8_STAGE(PG8_SA(0, 1), cA + hstep, voffA);
        if (wr == 1) PG8_BAR;
        PG8_WAIT_V(4); PG8_BAR;
        PG8_STAGE(PG8_SB(1, 0), cB + kstep, voffB); PG8_STAGE(PG8_SA(1, 0), cA + kstep, voffA); PG8_STAGE(PG8_SB(1, 1), cB + hstep + kstep, voffB);
        PG8_WAIT_V(6); PG8_BAR;
    }
    for (;;) {
        const bool has_next = S.next(ui + 1, nxt);
        const char* nA = has_next ? (const char*)g.A + (size_t)nxt.pm * tstep : cA; const char* nB = has_next ? (const char*)g.Bt + (size_t)nxt.pn * tstep : cB;
        for (int t = 0; t < nt; t += 2) {
            const bool last = (t == nt - 2);
            const char* a1 = cA + (size_t)(t + 1) * kstep;
            const char* a2 = last ? nA : cA + (size_t)(t + 2) * kstep; const char* b2 = last ? nB : cB + (size_t)(t + 2) * kstep;
            const char* a3 = a2 + kstep; const char* b3 = b2 + kstep;
            if (last && has_next) S.a_ready(nxt);
            if constexpr (SP2) {
            PG8_LDB(B0, 0, 0); PG8_LDB(B1, 0, 1); PG8_SCHED; PG8_LDA(At, 0, 0); PG8_STAGE(PG8_SA(1, 1), a1 + hstep, voffA);
            PG8_WAIT_V(8); PG8_WAIT_L(0); PG8_BAR; PG8_MMA(0, 0, At, B0); PG8_MMA(0, 1, At, B1); PG8_BAR; PG8_SCHED;
            PG8_LDA(At, 0, 1); PG8_STAGE(PG8_SB(0, 0), b2, voffB); PG8_STAGE(PG8_SB(0, 1), b2 + hstep, voffB); PG8_STAGE(PG8_SA(0, 0), a2, voffA);
            PG8_WAIT_V(8); PG8_WAIT_L(0); PG8_BAR; PG8_MMA(1, 0, At, B0); PG8_MMA(1, 1, At, B1); PG8_BAR; PG8_SCHED;
            PG8_LDB(B0, 1, 0); PG8_LDB(B1, 1, 1); PG8_SCHED; PG8_LDA(At, 1, 0); PG8_STAGE(PG8_SA(0, 1), a2 + hstep, voffA);
            PG8_WAIT_V(8); PG8_WAIT_L(0); PG8_BAR; PG8_MMA(0, 0, At, B0); PG8_MMA(0, 1, At, B1); PG8_BAR; PG8_SCHED;
            PG8_LDA(At, 1, 1); PG8_STAGE(PG8_SB(1, 0), b3, voffB); PG8_STAGE(PG8_SB(1, 1), b3 + hstep, voffB); PG8_STAGE(PG8_SA(1, 0), a3, voffA);
            PG8_WAIT_V(8); PG8_WAIT_L(0); PG8_BAR; PG8_MMA(1, 0, At, B0); PG8_MMA(1, 1, At, B1); PG8_BAR; PG8_SCHED;
            } else {
            PG8_LDB(B0, 0, 0); PG8_SCHED; PG8_LDA(At, 0, 0); PG8_STAGE(PG8_SA(1, 1), a1 + hstep, voffA);
            PG8_WAIT_L(8); PG8_BAR; PG8_WAIT_L(0); PG8_MMA(0, 0, At, B0); PG8_BAR; PG8_SCHED;
            PG8_LDB(B1, 0, 1); PG8_STAGE(PG8_SB(0, 0), b2, voffB);
            PG8_BAR; PG8_WAIT_L(0); PG8_MMA(0, 1, At, B1); PG8_BAR;
            PG8_LDA(At, 0, 1); PG8_STAGE(PG8_SA(0, 0), a2, voffA);
            PG8_BAR; PG8_WAIT_L(0); PG8_MMA(1, 0, At, B0); PG8_BAR; PG8_SCHED;
            PG8_STAGE(PG8_SB(0, 1), b2 + hstep, voffB);
            PG8_WAIT_V(6); PG8_BAR; PG8_MMA(1, 1, At, B1); PG8_BAR;
            PG8_LDB(B0, 1, 0); PG8_SCHED; PG8_LDA(At, 1, 0); PG8_STAGE(PG8_SA(0, 1), a2 + hstep, voffA);
            PG8_WAIT_L(8); PG8_BAR; PG8_WAIT_L(0); PG8_MMA(0, 0, At, B0); PG8_BAR; PG8_SCHED;
            PG8_LDB(B1, 1, 1); PG8_STAGE(PG8_SB(1, 0), b3, voffB);
            PG8_BAR; PG8_WAIT_L(0); PG8_MMA(0, 1, At, B1); PG8_BAR;
            PG8_LDA(At, 1, 1); PG8_STAGE(PG8_SA(1, 0), a3, voffA);
            PG8_BAR; PG8_WAIT_L(0); PG8_MMA(1, 0, At, B0); PG8_BAR; PG8_SCHED;
            PG8_STAGE(PG8_SB(1, 1), b3 + hstep, voffB);
            PG8_WAIT_V(6); PG8_BAR; PG8_MMA(1, 1, At, B1); PG8_BAR;
            }
        }
        if constexpr (ALIGN_EPI) { if (wr == 0) PG8_BAR; }
        if constexpr (!Epi::AFTER_DRAIN) { E(acc, cur, wr, wc, fr, fq); S.done(cur); }
        if (!has_next) break;
#pragma unroll
        for (int a = 0; a < 2; ++a)
#pragma unroll
            for (int b = 0; b < 2; ++b)
#pragma unroll
                for (int m = 0; m < 4; ++m)
#pragma unroll
                    for (int n = 0; n < 2; ++n) acc[a][b][m][n] = (f32x4){0.f, 0.f, 0.f, 0.f};
        cur = nxt; cA = nA; cB = nB; ++ui;
        if constexpr (ALIGN_EPI) { if (wr == 1) PG8_BAR; }
    }
    PG8_WAIT_V(0);
    if constexpr (!ALIGN_EPI) { if (wr == 0) PG8_BAR; }
    PG8_BAR;
    if constexpr (Epi::AFTER_DRAIN) { E.fused(acc, cur, wr, wc, fr, fq, lds, wid, lane); S.done(cur); }
#undef PG8_SA
#undef PG8_SB
#undef PG8_STAGE
#undef PG8_LDA
#undef PG8_LDB
#undef PG8_MMA
#undef PG8_WAIT_V
#undef PG8_WAIT_L
#undef PG8_BAR
#undef PG8_SCHED
}
}
#define LAS __attribute__((address_space(3)))
using pg8::f32x4;
using pg8::u32x4;
constexpr int T_CTX = 8192, T_LAT = 16384, T_ALL = 24576, DM = 1024;
constexpr int NPROJ = 4608, NPROJ_PAD = 4608, NIN = 4624, DFF = 2816, NGU = 5632;
constexpr int NTHR = 512, NWV = 8;
constexpr float EPS = 1e-6f;
constexpr int LDS_BYTES = 132096;

constexpr size_t OUT_HG = 25165824, OUT_MC = 41943040, OUT_MN = 58720256, OUT_MM = 58851328, OUT_TOTAL = 58852352;

constexpr size_t al256(size_t x) { return (x + 255) & ~(size_t)255; }
constexpr size_t WS_WIN = 0;
constexpr size_t WS_WOUT = WS_WIN + al256((size_t)NPROJ_PAD * DM * 2);
constexpr size_t WS_WGU = WS_WOUT + al256((size_t)DM * DM * 2);
constexpr size_t WS_WDN = WS_WGU + al256((size_t)NGU * DM * 2);
constexpr size_t WS_MODP = WS_WDN + al256((size_t)DM * DFF * 2);
constexpr size_t WS_MOD = WS_MODP + al256((size_t)8 * 4 * 9 * 6144 * 4);
constexpr size_t WS_LB = WS_MOD + al256((size_t)4 * 9 * 6144 * 4);
constexpr size_t WS_HN = WS_LB + al256((size_t)4 * 2 * 512 * 4);
constexpr size_t WS_PROJ = WS_HN + al256((size_t)T_ALL * DM * 2);
constexpr size_t WS_GATES = WS_PROJ + al256((size_t)T_ALL * NPROJ * 2);
constexpr size_t WS_QKM = WS_GATES + al256((size_t)T_ALL * 16 * 4);
constexpr size_t WS_OB = WS_QKM + al256((size_t)T_ALL * DM * 2);
constexpr size_t WS_BAR = WS_OB + al256((size_t)T_ALL * DM * 2);
constexpr size_t WS_WG16 = WS_BAR + 16384;
constexpr size_t WS_END = WS_WG16 + 32768;

#if defined(SWAP_OBUF)
#define ODIR(d) (!(d))
#else
#define ODIR(d) (d)
#endif
struct Params {
    const float *x_prompt, *x_sample, *st_hg, *st_mc, *st_mn, *st_mm, *cnd, *c_ctx, *n1w, *n2w, *w_mod, *b_mod, *w_in, *conv_w, *conv_b, *gate_b,
        *lb_logits, *hg_nw, *ml_nw, *w_out, *w_gate, *w_up, *w_down, *fin_w;
    float* out; unsigned char* ws;
};

__device__ __forceinline__ float sigmoidf_(float x) { return __builtin_amdgcn_rcpf(1.f + __expf(-x)); }
__device__ __forceinline__ float siluf_(float x) { return x * __builtin_amdgcn_rcpf(1.f + __expf(-x)); }
__device__ __forceinline__ unsigned pkh(float a, float b) { h16x2 v = {(h16)a, (h16)b}; return __builtin_bit_cast(unsigned, v); }
__device__ __forceinline__ float wave_sum(float v) {
#pragma unroll
    for (int o = 1; o < 64; o <<= 1) v += __shfl_xor(v, o);
    return v;
}
__device__ __forceinline__ int row_cidx(int row) { return row < T_CTX ? 0 : 1 + ((row - T_CTX) >> 11); }
__device__ __forceinline__ int ltid() { int t = threadIdx.x; asm volatile("" : "+v"(t)); return t; }
__device__ __forceinline__ float rdlane(float v, int l) { return __builtin_bit_cast(float, __builtin_amdgcn_readlane(__builtin_bit_cast(int, v), l)); }

struct EpiInProj {
    static constexpr bool PERM = true, AFTER_DRAIN = false;
    h16* proj; float* gates; const float* gate_b;
    __device__ __forceinline__ void operator()(const f32x4 (&acc)[2][2][4][2], const pg8::Unit& u, int wr, int wc, int fr, int fq) const {
        const int row0 = u.pm * 256 + wr * 64 + fr;
#pragma unroll
        for (int bj = 0; bj < 2; ++bj) {
            const int colt = u.pn * 256 + bj * 128, reg = colt >> 9;
            const int act = (reg == 0 || reg == 4) ? 1 : (reg == 8 ? 2 : 0);
            const int col0 = colt + wc * 32 + 8 * fq;
#pragma unroll
            for (int ai = 0; ai < 2; ++ai)
#pragma unroll
                for (int m = 0; m < 4; ++m) {
                    f32x4 v0 = acc[ai][bj][m][0], v1 = acc[ai][bj][m][1];
                    if (act == 1) {
#pragma unroll
                        for (int j = 0; j < 4; ++j) { v0[j] = siluf_(v0[j]); v1[j] = siluf_(v1[j]); }
                    } else if (act == 2) {
#pragma unroll
                        for (int j = 0; j < 4; ++j) { v0[j] = sigmoidf_(v0[j]); v1[j] = sigmoidf_(v1[j]); }
                    }
                    u32x4 w; w.x = pkh(v0[0], v0[1]); w.y = pkh(v0[2], v0[3]); w.z = pkh(v1[0], v1[1]); w.w = pkh(v1[2], v1[3]);
                    *(u32x4*)(proj + (size_t)(row0 + ai * 128 + m * 16) * NPROJ + col0) = w;
                }
        }
    }
};
struct EpiResid {
    static constexpr bool PERM = false, AFTER_DRAIN = false;
    const float* base_ctx; const float* base_lat; float* out; const float* gate;
    __device__ __forceinline__ void operator()(const f32x4 (&acc)[2][2][4][2], const pg8::Unit& u, int wr, int wc, int fr, int fq) const {
        const int cidx = u.pm < 32 ? 0 : 1 + ((u.pm - 32) >> 3);
        const float* gt = gate + cidx * 6144;
        const float* bs = u.pm < 32 ? base_ctx : base_lat - (size_t)T_CTX * DM;
        const int colb = u.pn * 256 + wc * 32 + 4 * fq;
        f32x4 g[2][2];
#pragma unroll
        for (int bj = 0; bj < 2; ++bj)
#pragma unroll
            for (int n = 0; n < 2; ++n) g[bj][n] = *(const f32x4*)(gt + colb + bj * 128 + n * 16);
#pragma unroll
        for (int ai = 0; ai < 2; ++ai)
#pragma unroll
            for (int m = 0; m < 4; ++m) {
                const size_t off = (size_t)(u.pm * 256 + ai * 128 + wr * 64 + m * 16 + fr) * DM + colb;
                f32x4 x[2][2];
#pragma unroll
                for (int bj = 0; bj < 2; ++bj)
#pragma unroll
                    for (int n = 0; n < 2; ++n) x[bj][n] = *(const f32x4*)(bs + off + bj * 128 + n * 16);
#pragma unroll
                for (int bj = 0; bj < 2; ++bj)
#pragma unroll
                    for (int n = 0; n < 2; ++n) *(f32x4*)(out + off + bj * 128 + n * 16) = x[bj][n] + g[bj][n] * acc[ai][bj][m][n];
                asm volatile("" ::: "memory");
            }
    }
};
struct EpiGateUp {
    static constexpr bool PERM = true, AFTER_DRAIN = false;
    h16* ff;
    __device__ __forceinline__ void operator()(const f32x4 (&acc)[2][2][4][2], const pg8::Unit& u, int wr, int wc, int fr, int fq) const {
        const int row0 = u.pm * 256 + wr * 64 + fr, col0 = u.pn * 128 + wc * 32 + 8 * fq;
#pragma unroll
        for (int ai = 0; ai < 2; ++ai)
#pragma unroll
            for (int m = 0; m < 4; ++m) {
                f32x4 v0, v1;
#pragma unroll
                for (int j = 0; j < 4; ++j) { v0[j] = siluf_(acc[ai][0][m][0][j]) * acc[ai][1][m][0][j]; v1[j] = siluf_(acc[ai][0][m][1][j]) * acc[ai][1][m][1][j]; }
                u32x4 w; w.x = pkh(v0[0], v0[1]); w.y = pkh(v0[2], v0[3]); w.z = pkh(v1[0], v1[1]); w.w = pkh(v1[2], v1[3]);
                *(u32x4*)(ff + (size_t)(row0 + ai * 128 + m * 16) * DFF + col0) = w;
            }
    }
};

__device__ __forceinline__ void phase_mod_partial(const Params& p, LAS float* ldsf) {
    const int tidx = ltid();
    for (int e = tidx; e < 9 * 1024; e += NTHR) { const int c = e >> 10, k = e & 1023; const float v = c == 0 ? p.c_ctx[k] : p.cnd[(c - 1) * 1024 + k]; ldsf[e] = siluf_(v); }
    __syncthreads();
    float* modp = (float*)(p.ws + WS_MODP);
    const int wave = tidx >> 6, lane = tidx & 63;
    const int gw = blockIdx.x * NWV + wave, NGW = gridDim.x * NWV;
    for (int it = gw; it < 4 * 96 * 8; it += NGW) {
        const int kq = it & 7, cgp = (it >> 3) % 96, l = it / (8 * 96);
        const int j = cgp * 64 + lane;
        const float* w = p.w_mod + ((size_t)l * 1024 + kq * 128) * 6144 + j;
        float acc[9];
#pragma unroll
        for (int c = 0; c < 9; ++c) acc[c] = 0.f;
#pragma unroll 4
        for (int k4 = 0; k4 < 32; ++k4) {
            const float w0 = w[(size_t)(4 * k4 + 0) * 6144], w1 = w[(size_t)(4 * k4 + 1) * 6144], w2 = w[(size_t)(4 * k4 + 2) * 6144], w3 = w[(size_t)(4 * k4 + 3) * 6144];
#pragma unroll
            for (int c = 0; c < 9; ++c) { const f32x4 s = *(const LAS f32x4*)(ldsf + c * 1024 + kq * 128 + 4 * k4); acc[c] += s.x * w0 + s.y * w1 + s.z * w2 + s.w * w3; }
        }
#pragma unroll
        for (int c = 0; c < 9; ++c) modp[(((size_t)kq * 4 + l) * 9 + c) * 6144 + j] = acc[c];
    }
    if (blockIdx.x == 0) {
        float* lb = (float*)(p.ws + WS_LB);
        for (int e = tidx; e < 1024; e += NTHR) {
            const float x0 = p.lb_logits[e], x1 = p.lb_logits[1024 + e], x2 = p.lb_logits[2048 + e], x3 = p.lb_logits[3072 + e];
            const float mx = fmaxf(fmaxf(x0, x1), fmaxf(x2, x3));
            const float e0 = expf(x0 - mx), e1 = expf(x1 - mx), e2 = expf(x2 - mx), e3 = expf(x3 - mx);
            const float inv = 1.f / (e0 + e1 + e2 + e3);
            lb[e] = 0.f; lb[1024 + e] = e1 * inv; lb[2048 + e] = (e1 + e2) * inv; lb[3072 + e] = (e1 + e2 + e3) * inv;
        }
    }
}
__device__ __forceinline__ void phase_mod_reduce(const Params& p) {
    const float* modp = (const float*)(p.ws + WS_MODP); float* mod = (float*)(p.ws + WS_MOD);
    for (int e = blockIdx.x * NTHR + ltid(); e < 4 * 9 * 6144; e += gridDim.x * NTHR) {
        const int j = e % 6144, l = e / (9 * 6144);
        float s = p.b_mod[l * 6144 + j];
#pragma unroll
        for (int kq = 0; kq < 8; ++kq) s += modp[(size_t)kq * (4 * 9 * 6144) + e];
        mod[e] = s;
    }
}

__device__ __forceinline__ void transpose_item(const float* W, int K, int N, h16* WT, int kb, int n0, int dst_row0, LAS float* scr, int lane) {
    const int k0 = 64 * kb, n = n0 + (lane & 31);
#pragma unroll 8
    for (int i = 0; i < 32; ++i) { const int kk = 2 * i + (lane >> 5); scr[kk * 33 + (lane & 31)] = (n < N) ? W[(size_t)(k0 + kk) * N + n] : 0.f; }
    asm volatile("s_waitcnt lgkmcnt(0)" ::: "memory");
    const int c = lane & 7;
#pragma unroll
    for (int j = 0; j < 4; ++j) {
        const int nn = (lane >> 3) + 8 * j; const LAS float* s = scr + (8 * c) * 33 + nn;
        u32x4 o; o.x = pkh(s[0 * 33], s[1 * 33]); o.y = pkh(s[2 * 33], s[3 * 33]); o.z = pkh(s[4 * 33], s[5 * 33]); o.w = pkh(s[6 * 33], s[7 * 33]);
        *(u32x4*)(WT + (size_t)(dst_row0 + nn) * K + k0 + 8 * c) = o;
    }
    asm volatile("s_waitcnt lgkmcnt(0)" ::: "memory");
}
__device__ __forceinline__ void convert_weights(const Params& p, int l, LAS float* scr, int gw, int NGW, int lane) {
    {
        h16* wg = (h16*)(p.ws + WS_WG16);
        const float* src = p.w_in + (size_t)l * DM * NIN + NPROJ;
        for (int e = gw * 64 + lane; e < 16 * 1024; e += NGW * 64) { const int k = e >> 4, g = e & 15; wg[g * 1024 + k] = (h16)src[(size_t)k * NIN + g]; }
    }
    h16* win = (h16*)(p.ws + WS_WIN); h16* wout = (h16*)(p.ws + WS_WOUT); h16* wgu = (h16*)(p.ws + WS_WGU); h16* wdn = (h16*)(p.ws + WS_WDN);
    constexpr int I_IN = 16 * 144, I_OUT = 16 * 32, I_G = 16 * 88, I_DN = 44 * 32;
    for (int it = gw; it < I_IN + I_OUT + 2 * I_G + I_DN; it += NGW) {
        int r = it;
        if (r < I_IN) { const int kb = r / 144, nb = r % 144; transpose_item(p.w_in + (size_t)l * DM * NIN, DM, NIN, win, kb, 32 * nb, 32 * nb, scr, lane); continue; } r -= I_IN;
        if (r < I_OUT) { const int kb = r / 32, nb = r % 32; transpose_item(p.w_out + (size_t)l * DM * DM, DM, DM, wout, kb, 32 * nb, 32 * nb, scr, lane); continue; } r -= I_OUT;
        if (r < I_G) { const int kb = r / 88, nb = r % 88, n0 = 32 * nb; transpose_item(p.w_gate + (size_t)l * DM * DFF, DM, DFF, wgu, kb, n0, (n0 >> 7) * 256 + (n0 & 127), scr, lane); continue; } r -= I_G;
        if (r < I_G) { const int kb = r / 88, nb = r % 88, n0 = 32 * nb; transpose_item(p.w_up + (size_t)l * DM * DFF, DM, DFF, wgu, kb, n0, (n0 >> 7) * 256 + 128 + (n0 & 127), scr, lane); continue; } r -= I_G;
        { const int kb = r / 32, nb = r % 32; transpose_item(p.w_down + (size_t)l * DFF * DM, DFF, DM, wdn, kb, 32 * nb, 32 * nb, scr, lane); }
    }
}
__device__ __forceinline__ void norm_mod_row(const float* xrow, const float* nw, const float* sc, const float* sh, h16* orow, int lane) {
    const f32x4* xr = (const f32x4*)xrow + lane;
    f32x4 v[4]; float s = 0.f;
#pragma unroll
    for (int j = 0; j < 4; ++j) { v[j] = xr[64 * j]; s += (v[j].x * v[j].x + v[j].y * v[j].y) + (v[j].z * v[j].z + v[j].w * v[j].w); }
    const float rstd = rsqrtf(wave_sum(s) * (1.f / DM) + EPS);
#pragma unroll
    for (int j = 0; j < 4; ++j) {
        const int col = 4 * lane + 256 * j;
        const f32x4 w4 = *(const f32x4*)(nw + col), s4 = *(const f32x4*)(sc + col), h4 = *(const f32x4*)(sh + col);
        const f32x4 y = v[j] * rstd * w4 * (1.f + s4) + h4;
        uint2 o; o.x = pkh(y.x, y.y); o.y = pkh(y.z, y.w);
        *(uint2*)(orow + col) = o;
    }
}
__device__ __forceinline__ void phase_norm(const Params& p, int l, int which, bool from_inputs, int gw, int NGW, int lane) {
    const float* mod = (const float*)(p.ws + WS_MOD) + (size_t)l * 9 * 6144;
    const float* nw = (which == 0 ? p.n1w : p.n2w) + l * DM;
    h16* hn = (h16*)(p.ws + WS_HN);
    for (int r = gw; r < T_ALL; r += NGW) {
        const float* xrow = from_inputs ? (r < T_CTX ? p.x_prompt + (size_t)r * DM : p.x_sample + (size_t)(r - T_CTX) * DM) : p.out + (size_t)r * DM;
        const float* m = mod + row_cidx(r) * 6144 + which * 3072;
        norm_mod_row(xrow, nw, m + 1024, m, hn + (size_t)r * DM, lane);
    }
}
__device__ __forceinline__ void phase_final_norm(const Params& p, int gw, int NGW, int lane) {
    for (int r = gw; r < T_ALL; r += NGW) {
        f32x4* xr = (f32x4*)(p.out + (size_t)r * DM) + lane;
        f32x4 v[4]; float s = 0.f;
#pragma unroll
        for (int j = 0; j < 4; ++j) { v[j] = xr[64 * j]; s += (v[j].x * v[j].x + v[j].y * v[j].y) + (v[j].z * v[j].z + v[j].w * v[j].w); }
        const float rstd = rsqrtf(wave_sum(s) * (1.f / DM) + EPS);
#pragma unroll
        for (int j = 0; j < 4; ++j) { const f32x4 w4 = *(const f32x4*)(p.fin_w + 4 * lane + 256 * j); xr[64 * j] = v[j] * rstd * w4; }
    }
}
__device__ __forceinline__ void phase_gates(const Params& p, int l, int gw, int NGW, int lane) {
    const h16* hn = (const h16*)(p.ws + WS_HN); const h16* wg = (const h16*)(p.ws + WS_WG16);
    float* gates = (float*)(p.ws + WS_GATES);
    const int c = lane & 15, q = lane >> 4;
    for (int grp = gw; grp < T_ALL / 16; grp += NGW) {
        const h16* ar = hn + (size_t)(16 * grp + c) * DM + 8 * q;
        const h16* br = wg + (size_t)c * DM + 8 * q;
        f32x4 acc = {0.f, 0.f, 0.f, 0.f};
#pragma unroll 8
        for (int kp = 0; kp < 32; ++kp) {
            const h16x8 a = *(const h16x8*)(ar + 32 * kp), bq = *(const h16x8*)(br + 32 * kp);
            acc = __builtin_amdgcn_mfma_f32_16x16x32_f16(a, bq, acc, 0, 0, 0);
        }
        const float bias = p.gate_b[l * 16 + c];
#pragma unroll
        for (int j = 0; j < 4; ++j) gates[(size_t)(16 * grp + 4 * q + j) * 16 + c] = acc[j] + bias;
    }
}
__device__ __forceinline__ void phase_conv(const Params& p, int l) {
    const h16* proj = (const h16*)(p.ws + WS_PROJ); h16* qkm = (h16*)(p.ws + WS_QKM);
    const float* cw = p.conv_w + (size_t)l * 9 * 1024; const float* cb = p.conv_b + l * 1024;
    for (int idx = blockIdx.x * NTHR + ltid(); idx < T_ALL * 128; idx += gridDim.x * NTHR) {
        const int r = idx >> 7, ch0 = (idx & 127) * 8;
        float acc[8];
        { const f32x4 b0 = *(const f32x4*)(cb + ch0), b1 = *(const f32x4*)(cb + ch0 + 4); acc[0] = b0.x; acc[1] = b0.y; acc[2] = b0.z; acc[3] = b0.w; acc[4] = b1.x; acc[5] = b1.y; acc[6] = b1.z; acc[7] = b1.w; }
        const h16* src = proj + 2560 + ch0;
        const bool lat = r >= T_CTX;
        const int pp = lat ? ((r - T_CTX) & 2047) : (r & 255);
        const int gy = lat ? (pp >> 6) : 0, gx = lat ? (pp & 63) : pp;
        const int H = lat ? 32 : 1, W = lat ? 64 : 256;
#pragma unroll
        for (int a = 0; a < 3; ++a) {
            const int yy = gy + a - 1;
            if (!lat && a != 1) continue;
            if (yy < 0 || yy >= H) continue;
#pragma unroll
            for (int b = 0; b < 3; ++b) {
                const int xx = gx + b - 1;
                if (xx < 0 || xx >= W) continue;
                const int rr = r + (a - 1) * 64 + (b - 1);
                const h16x8 x = *(const h16x8*)(src + (size_t)rr * NPROJ);
                const f32x4 t0 = *(const f32x4*)(cw + (a * 3 + b) * 1024 + ch0), t1 = *(const f32x4*)(cw + (a * 3 + b) * 1024 + ch0 + 4);
                acc[0] += t0.x * (float)x[0]; acc[1] += t0.y * (float)x[1]; acc[2] += t0.z * (float)x[2]; acc[3] += t0.w * (float)x[3];
                acc[4] += t1.x * (float)x[4]; acc[5] += t1.y * (float)x[5]; acc[6] += t1.z * (float)x[6]; acc[7] += t1.w * (float)x[7];
            }
        }
        const float sc = ch0 >= 512 ? 0.08838834764831845f : 1.f;
        u32x4 w; w.x = pkh(siluf_(acc[0]) * sc, siluf_(acc[1]) * sc); w.y = pkh(siluf_(acc[2]) * sc, siluf_(acc[3]) * sc);
        w.z = pkh(siluf_(acc[4]) * sc, siluf_(acc[5]) * sc); w.w = pkh(siluf_(acc[6]) * sc, siluf_(acc[7]) * sc);
        *(u32x4*)(qkm + (size_t)r * DM + ch0) = w;
    }
}

template <int TYPE  , int CMP = 0>
__device__ __forceinline__ void scan_item(const Params& p, int l, int lat, int b, int h, int dir, LAS float* lds) {
    const int tid = ltid(), lane = tid & 63, w = __builtin_amdgcn_readfirstlane(tid >> 6);
    const int L = lat ? 2048 : 256, row0 = lat ? T_CTX + b * 2048 : b * 256, NB = L / 16;
    LAS float* qs = lds;
    LAS float* fs = lds + 2048;
    LAS float* vs = lds + 4096;
    LAS float* part = lds + 6144;
    LAS float* partn = lds + 6144 + 16384;
    LAS float* scal = partn + 128;
    LAS float* mst = scal + 128;
    LAS float* cerr = mst + 16;
    LAS float* cref = cerr + 32;
    const h16* proj = (const h16*)(p.ws + WS_PROJ); const h16* qkm = (const h16*)(p.ws + WS_QKM); const float* gates = (const float*)(p.ws + WS_GATES);
    h16* odst = (h16*)(p.ws + (ODIR(dir) ? WS_OB : WS_HN));
    const size_t sidx = (((size_t)b * 4 + l) * 2 + dir) * 4 + h;
    if (CMP) { if (tid < 64) cerr[tid] = 0.f; __syncthreads(); }

    f32x2 S[16]; float nv = 0.f;
    if (lat) {
        const float* src = (TYPE == 0 ? p.st_hg : p.st_mc) + sidx * 16384;
#pragma unroll
        for (int dd = 0; dd < 16; ++dd) S[dd] = *(const f32x2*)(src + (16 * w + dd) * 128 + 2 * lane);
        if (TYPE == 1) { nv = lane < 16 ? p.st_mn[sidx * 128 + 16 * w + lane] : 0.f; if (tid == 0) mst[0] = p.st_mm[sidx]; }
    } else {
#pragma unroll
        for (int dd = 0; dd < 16; ++dd) S[dd] = (f32x2){0.f, 0.f};
        if (TYPE == 1 && tid == 0) mst[0] = 0.f;
    }
    const int tl = tid >> 5, d0 = 4 * (tid & 31);
    f32x4 lb4 = {0.f, 0.f, 0.f, 0.f};
    if (TYPE == 0) lb4 = *(const f32x4*)((const float*)(p.ws + WS_LB) + (l * 2 + dir) * 512 + h * 128 + d0);
    h16x4 pq, pz, pv; float pgi = 0.f, pgf = 0.f;
#define SCAN_LOAD(ii) do { const int pos_ = 16 * (ii) + tl, tok_ = dir ? L - 1 - pos_ : pos_; const size_t r_ = (size_t)(row0 + tok_); \
        if (TYPE == 0) { pq = *(const h16x4*)(proj + r_ * NPROJ + h * 128 + d0); pz = *(const h16x4*)(proj + r_ * NPROJ + 512 + dir * 512 + h * 128 + d0); pv = *(const h16x4*)(proj + r_ * NPROJ + 1536 + h * 128 + d0); } \
        else { pq = *(const h16x4*)(qkm + r_ * DM + h * 128 + d0); pz = *(const h16x4*)(qkm + r_ * DM + 512 + h * 128 + d0); pv = *(const h16x4*)(proj + r_ * NPROJ + 3584 + h * 128 + d0); \
               if (w == 0) { const int ps_ = 16 * (ii) + (lane & 15), tk_ = dir ? L - 1 - ps_ : ps_; const float* g_ = gates + (size_t)(row0 + tk_) * 16; pgi = g_[dir * 4 + h]; pgf = g_[8 + dir * 4 + h]; } } } while (0)
    SCAN_LOAD(0);
    for (int i = 0; i < NB; ++i) {
        const int par = i & 1;
        const int pos = 16 * i + tl, tok = dir ? L - 1 - pos : pos;
        const size_t r = (size_t)(row0 + tok);
        {
            *(LAS f32x4*)(qs + tl * 128 + d0) = (f32x4){(float)pq[0], (float)pq[1], (float)pq[2], (float)pq[3]};
            *(LAS f32x4*)(vs + tl * 128 + d0) = (f32x4){(float)pv[0], (float)pv[1], (float)pv[2], (float)pv[3]};
            if (TYPE == 0) {
                f32x4 f4;
#pragma unroll
                for (int j = 0; j < 4; ++j) f4[j] = lb4[j] + (1.f - lb4[j]) * sigmoidf_((float)pz[j]);
                *(LAS f32x4*)(fs + tl * 128 + d0) = f4;
            } else {
                *(LAS f32x4*)(fs + tl * 128 + d0) = (f32x4){(float)pz[0], (float)pz[1], (float)pz[2], (float)pz[3]};
                if (w == 0) {
                    const int t = lane & 15;
                    const float m0 = mst[0];
                    const float gi = pgi, lf = fminf(pgf, 0.f) - log1pf(__expf(-fabsf(pgf)));
                    float bc = lf;
#pragma unroll
                    for (int o = 1; o < 16; o <<= 1) { const float x = __shfl_up(bc, o, 16); if (t >= o) bc += x; }
                    float pm = gi - bc;
#pragma unroll
                    for (int o = 1; o < 16; o <<= 1) { const float x = __shfl_up(pm, o, 16); if (t >= o) pm = fmaxf(pm, x); }
                    const float mt = bc + fmaxf(m0, pm);
                    float mp = __shfl_up(mt, 1, 16); if (t == 0) mp = m0;
                    if (lane < 16) {
                        scal[(par * 16 + t) * 4 + 0] = __expf(lf + mp - mt);
                        scal[(par * 16 + t) * 4 + 1] = __expf(gi - mt);
                        scal[(par * 16 + t) * 4 + 2] = __expf(-mt);
                    }
                    asm volatile("s_waitcnt lgkmcnt(0)" ::: "memory");
                    if (lane == 15) mst[0] = mt;
                }
            }
        }
        if (i + 1 < NB) SCAN_LOAD(i + 1);
        __syncthreads();
#pragma unroll 2
        for (int t = 0; t < 16; ++t) {
            float fv = 0.f, qv = 0.f;
            if (lane < 16) { fv = fs[t * 128 + 16 * w + lane]; qv = qs[t * 128 + 16 * w + lane]; }
            const f32x2 v2 = *(const LAS f32x2*)(vs + t * 128 + 2 * lane);
            f32x2 o = {0.f, 0.f};
            if (TYPE == 0) {
#pragma unroll
                for (int dd = 0; dd < 16; ++dd) { const float sf = rdlane(fv, dd), sq = rdlane(qv, dd); S[dd] = v2 + sf * (S[dd] - v2); o += S[dd] * sq; }
            } else {
                const float a = __builtin_bit_cast(float, __builtin_amdgcn_readfirstlane(__builtin_bit_cast(int, scal[(par * 16 + t) * 4 + 0])));
                const float g = __builtin_bit_cast(float, __builtin_amdgcn_readfirstlane(__builtin_bit_cast(int, scal[(par * 16 + t) * 4 + 1])));
                const float gk = g * fv;
                nv = a * nv + gk;
                float nq = nv * qv;
                nq += __shfl_xor(nq, 8); nq += __shfl_xor(nq, 4); nq += __shfl_xor(nq, 2); nq += __shfl_xor(nq, 1);
                if (lane == 0) partn[t * 8 + w] = nq;
#pragma unroll
                for (int dd = 0; dd < 16; ++dd) { const float sk = rdlane(gk, dd), sq = rdlane(qv, dd); S[dd] = a * S[dd] + sk * v2; o += S[dd] * sq; }
            }
            *(LAS f32x2*)(part + (t * 8 + w) * 128 + 2 * lane) = o;
        }
        __syncthreads();
        {
            f32x4 acc = {0.f, 0.f, 0.f, 0.f};
#pragma unroll
            for (int ww = 0; ww < 8; ++ww) acc += *(const LAS f32x4*)(part + (tl * 8 + ww) * 128 + d0);
            if (TYPE == 1) {
                float den = 0.f;
#pragma unroll
                for (int ww = 0; ww < 8; ++ww) den += partn[tl * 8 + ww];
                const float sc = 1.f / fmaxf(fabsf(den), scal[(par * 16 + tl) * 4 + 2]);
                acc = acc * sc;
            }
            uint2 o; o.x = pkh(acc.x, acc.y); o.y = pkh(acc.z, acc.w);
            if (CMP) {
                const h16x4 old = *(const h16x4*)(odst + r * DM + TYPE * 512 + h * 128 + d0);
                float e = 0.f, rr = 0.f;
#pragma unroll
                for (int j = 0; j < 4; ++j) { const float df = (float)old[j] - acc[j]; e += df * df; rr += acc[j] * acc[j]; }
                e = wave_sum(e); rr = wave_sum(rr);
                if (lane == 0) { atomicAdd((float*)(cerr + (i >> 2)), e); atomicAdd((float*)(cref + (i >> 2)), rr); }
            }
            *(uint2*)(odst + r * DM + TYPE * 512 + h * 128 + d0) = o;
        }
    }
    if (CMP) {
        __syncthreads();
        if (tid == 0) {
            float best = -1.f; int bc_ = 0; float tot_e = 0.f, tot_r = 0.f;
            for (int cI = 0; cI < 32; ++cI) { const float rt = cerr[cI] / fmaxf(cref[cI], 1e-30f); tot_e += cerr[cI]; tot_r += cref[cI]; if (rt > best) { best = rt; bc_ = cI; } }
            float* dg = (float*)(p.ws + WS_MODP) + 4 * blockIdx.x;
#if defined(DIAG_ALL)
            const float tot = tot_e / fmaxf(tot_r, 1e-30f);
            if (tot > dg[0]) { dg[0] = tot; dg[1] = (float)(l * 8 + TYPE * 4 + lat * 2 + dir); dg[2] = best; dg[3] = (float)bc_; }
#else
            dg[0] = best; dg[1] = (float)bc_; dg[2] = tot_e / fmaxf(tot_r, 1e-30f); dg[3] = 0.f;
#endif
        }
    }
    if (!lat) {
        float* dst = p.out + (TYPE == 0 ? OUT_HG : OUT_MC) + sidx * 16384;
#pragma unroll
        for (int dd = 0; dd < 16; ++dd) *(f32x2*)(dst + (16 * w + dd) * 128 + 2 * lane) = S[dd];
        if (TYPE == 1) { if (lane < 16) p.out[OUT_MN + sidx * 128 + 16 * w + lane] = nv; if (tid == 0) p.out[OUT_MM + sidx] = mst[0]; }
    }
    __syncthreads();
#undef SCAN_LOAD
}
typedef unsigned u32x2 __attribute__((ext_vector_type(2)));
typedef short s16x8 __attribute__((ext_vector_type(8)));
typedef short s16x4 __attribute__((ext_vector_type(4)));
typedef __bf16 bf16x2_t __attribute__((ext_vector_type(2)));
__device__ __forceinline__ unsigned pkb(float a, float b) { f32x2 v = {a, b}; bf16x2_t r = __builtin_convertvector(v, bf16x2_t); return __builtin_bit_cast(unsigned, r); }
__device__ __forceinline__ unsigned short f2b(float a) { return (unsigned short)(pkb(a, 0.f) & 0xffffu); }
__device__ __forceinline__ s16x4 tr_read(LAS const unsigned char* ptr) { return __builtin_bit_cast(s16x4, __builtin_amdgcn_ds_read_tr16_b64_v4i16((LAS s16x4*)ptr)); }
constexpr int HP = 272;
__device__ __forceinline__ void scan_hgrn_mfma(const Params& p, int l, int lat, int b, int h, int dir, LAS unsigned char* lds) {
    const int tid = ltid(), lane = tid & 63, w = __builtin_amdgcn_readfirstlane(tid >> 6), c = lane & 15, q = lane >> 4;
    const int L = lat ? 2048 : 256, row0 = lat ? T_CTX + b * 2048 : b * 256, NB = L / 16;
    constexpr int IMG = 16 * HP, BUF = 4 * IMG + 512;
    LAS float* GS = (LAS float*)(lds + 2 * BUF);
    const h16* proj = (const h16*)(p.ws + WS_PROJ);
    h16* odst = (h16*)(p.ws + (ODIR(dir) ? WS_OB : WS_HN));
    const size_t sidx = (((size_t)b * 4 + l) * 2 + dir) * 4 + h;
    f32x4 S[8];
    if (lat) {
        const float* src = p.st_hg + sidx * 16384;
#pragma unroll
        for (int dt = 0; dt < 8; ++dt)
#pragma unroll
            for (int j = 0; j < 4; ++j) S[dt][j] = src[(16 * dt + 4 * q + j) * 128 + 16 * w + c];
    } else {
#pragma unroll
        for (int dt = 0; dt < 8; ++dt) S[dt] = (f32x4){0.f, 0.f, 0.f, 0.f};
    }
    const int pt = lane & 15, d0 = 16 * w + 4 * (lane >> 4);
    const f32x4 lb4 = *(const f32x4*)((const float*)(p.ws + WS_LB) + (l * 2 + dir) * 512 + h * 128 + d0);
    h16x4 rq, rz, rv;
#define HG_LOAD(ii) do { const int pos_ = 16 * (ii) + pt, tok_ = dir ? L - 1 - pos_ : pos_; const h16* r_ = proj + (size_t)(row0 + tok_) * NPROJ + h * 128 + d0; \
        rq = *(const h16x4*)(r_); rz = *(const h16x4*)(r_ + 512 + dir * 512); rv = *(const h16x4*)(r_ + 1536); } while (0)
#define HG_ROW_SHR(x, ctl) __builtin_bit_cast(float, __builtin_amdgcn_update_dpp(0, __builtin_bit_cast(int, (x)), (ctl), 0xF, 0xF, false))
    HG_LOAD(0);
    u32x2 o_prev = {0u, 0u}; h16* o_ptr = odst;
    for (int i = 0; i < NB; ++i) {
        LAS unsigned char* buf = lds + (i & 1) * BUF;
        LAS unsigned char* QT = buf; LAS unsigned char* KT = buf + IMG; LAS unsigned char* KH = buf + 2 * IMG; LAS unsigned char* VV = buf + 3 * IMG; LAS float* AD = (LAS float*)(buf + 4 * IMG);
        asm volatile("s_waitcnt vmcnt(0)" ::: "memory");
        if (i > 0) *(u32x2*)o_ptr = o_prev;
        {
            float kk[4], G[4];
#pragma unroll
            for (int j = 0; j < 4; ++j) { const float f = lb4[j] + (1.f - lb4[j]) * sigmoidf_((float)rz[j]); kk[j] = 1.f - f; G[j] = __logf(f); }
#pragma unroll
            for (int j = 0; j < 4; ++j) {
                G[j] += HG_ROW_SHR(G[j], 0x111); G[j] += HG_ROW_SHR(G[j], 0x112); G[j] += HG_ROW_SHR(G[j], 0x114); G[j] += HG_ROW_SHR(G[j], 0x118);
            }
            float oq[4], ok[4], oh[4];
            float ev[4];
#pragma unroll
            for (int j = 0; j < 4; ++j) {
                const float e = __expf(G[j]), ei = __builtin_amdgcn_rcpf(fmaxf(e, 8.7565e-27f)); ev[j] = e;
                const float et = __shfl(e, 15, 16);
                oq[j] = (float)rq[j] * e; ok[j] = kk[j] * ei; oh[j] = kk[j] * (et * ei);
            }
            u32x2 wq, wk, wh, wv;
            wq.x = pkb(oq[0], oq[1]); wq.y = pkb(oq[2], oq[3]); wk.x = pkb(ok[0], ok[1]); wk.y = pkb(ok[2], ok[3]);
            wh.x = pkb(oh[0], oh[1]); wh.y = pkb(oh[2], oh[3]); wv.x = pkb((float)rv[0], (float)rv[1]); wv.y = pkb((float)rv[2], (float)rv[3]);
            *(LAS u32x2*)(QT + pt * HP + 2 * d0) = wq; *(LAS u32x2*)(KT + pt * HP + 2 * d0) = wk; *(LAS u32x2*)(KH + pt * HP + 2 * d0) = wh; *(LAS u32x2*)(VV + pt * HP + 2 * d0) = wv;
            if (pt == 15) *(LAS f32x4*)(AD + d0) = (f32x4){ev[0], ev[1], ev[2], ev[3]};
        }
        { const int nx = (i + 1 < NB) ? i + 1 : NB - 1; HG_LOAD(nx); }
        __syncthreads();
        {
            f32x4 accO = {0.f, 0.f, 0.f, 0.f};
#pragma unroll
            for (int kp = 0; kp < 4; ++kp) {
                u32x4 sa; sa.x = pkb(S[2 * kp][0], S[2 * kp][1]); sa.y = pkb(S[2 * kp][2], S[2 * kp][3]); sa.z = pkb(S[2 * kp + 1][0], S[2 * kp + 1][1]); sa.w = pkb(S[2 * kp + 1][2], S[2 * kp + 1][3]);
                const u32x2 b0 = *(const LAS u32x2*)(QT + c * HP + 2 * (32 * kp + 4 * q)), b1 = *(const LAS u32x2*)(QT + c * HP + 2 * (32 * kp + 16 + 4 * q));
                u32x4 bb; bb.x = b0.x; bb.y = b0.y; bb.z = b1.x; bb.w = b1.y;
                accO = __builtin_amdgcn_mfma_f32_16x16x32_bf16(__builtin_bit_cast(s16x8, sa), __builtin_bit_cast(s16x8, bb), accO, 0, 0, 0);
            }
            f32x4 accP = {0.f, 0.f, 0.f, 0.f};
#pragma unroll
            for (int kp = 0; kp < 4; ++kp) {
                const s16x8 a = *(const LAS s16x8*)(KT + c * HP + 2 * (32 * kp + 8 * q));
                const s16x8 bq = *(const LAS s16x8*)(QT + c * HP + 2 * (32 * kp + 8 * q));
                accP = __builtin_amdgcn_mfma_f32_16x16x32_bf16(a, bq, accP, 0, 0, 0);
            }
#pragma unroll
            for (int j = 0; j < 4; ++j) accP[j] = (4 * q + j > c) ? 0.f : accP[j];
            u32x2 pb; pb.x = pkb(accP[0], accP[1]); pb.y = pkb(accP[2], accP[3]);
            const s16x4 vtr = tr_read(VV + (4 * q + (c >> 2)) * HP + 2 * (16 * w + 4 * (c & 3)));
            accO = __builtin_amdgcn_mfma_f32_16x16x16bf16_1k(vtr, __builtin_bit_cast(s16x4, pb), accO, 0, 0, 0);
            {
                const int pos = 16 * i + c, tok = dir ? L - 1 - pos : pos;
                o_prev.x = pkh(accO[0], accO[1]); o_prev.y = pkh(accO[2], accO[3]);
                o_ptr = odst + (size_t)(row0 + tok) * DM + h * 128 + 16 * w + 4 * q;
            }
#pragma unroll
            for (int dt = 0; dt < 8; ++dt) {
                const s16x4 ktr = tr_read(KH + (4 * q + (c >> 2)) * HP + 2 * (16 * dt + 4 * (c & 3)));
                const f32x4 ad = *(const LAS f32x4*)(AD + 16 * dt + 4 * q);
                S[dt] = S[dt] * ad;
                S[dt] = __builtin_amdgcn_mfma_f32_16x16x16bf16_1k(ktr, vtr, S[dt], 0, 0, 0);
            }
        }
#if defined(HG_EXTRA_SYNC)
        asm volatile("s_waitcnt vmcnt(0) lgkmcnt(0)" ::: "memory");
        __syncthreads();
#endif
    }
    *(u32x2*)o_ptr = o_prev;
    if (!lat) {
        float* dst = p.out + OUT_HG + sidx * 16384;
#pragma unroll
        for (int dt = 0; dt < 8; ++dt)
#pragma unroll
            for (int j = 0; j < 4; ++j) dst[(16 * dt + 4 * q + j) * 128 + 16 * w + c] = S[dt][j];
    }
    __syncthreads();
#undef HG_LOAD
#undef HG_ROW_SHR
}
constexpr int MP = 272;
constexpr int PP = 144;
__device__ __forceinline__ void scan_mlstm_mfma(const Params& p, int l, int lat, int b, int h, int dir, LAS unsigned char* lds) {
    const int tid = ltid(), lane = tid & 63, w = __builtin_amdgcn_readfirstlane(tid >> 6), c = lane & 15, q = lane >> 4;
    const int L = lat ? 2048 : 256, row0 = lat ? T_CTX + b * 2048 : b * 256, NC = L / 64;
    constexpr int IMG = 64 * MP, BUF = 3 * IMG + 1536;
    LAS unsigned char* PM = lds + 2 * BUF;
    LAS float* DENP = (LAS float*)(PM + 64 * PP);
    LAS float* QNP = DENP + 256;
    LAS float* NP = QNP + 512;
    LAS float* NV = NP + 512;
    LAS float* mst = NV + 128;
    const h16* proj = (const h16*)(p.ws + WS_PROJ); const h16* qkm = (const h16*)(p.ws + WS_QKM); const float* gates = (const float*)(p.ws + WS_GATES);
    h16* odst = (h16*)(p.ws + (ODIR(dir) ? WS_OB : WS_HN));
    const size_t sidx = (((size_t)b * 4 + l) * 2 + dir) * 4 + h;
    f32x4 C[8];
    if (lat) {
        const float* src = p.st_mc + sidx * 16384;
#pragma unroll
        for (int dt = 0; dt < 8; ++dt)
#pragma unroll
            for (int j = 0; j < 4; ++j) C[dt][j] = src[(16 * dt + 4 * q + j) * 128 + 16 * w + c];
        if (tid < 128) NV[tid] = p.st_mn[sidx * 128 + tid];
        if (tid == 0) mst[0] = p.st_mm[sidx];
    } else {
#pragma unroll
        for (int dt = 0; dt < 8; ++dt) C[dt] = (f32x4){0.f, 0.f, 0.f, 0.f};
        if (tid < 128) NV[tid] = 0.f;
        if (tid == 0) mst[0] = 0.f;
    }
    u32x4 pq[2], pk[2], pv[2]; float pgi = 0.f, pgf = 0.f;
#define ML_LOAD(ii) do { _Pragma("unroll") for (int j_ = 0; j_ < 2; ++j_) { const int e_ = tid + 512 * j_, rw_ = e_ >> 4, pc_ = e_ & 15; const int pos_ = 64 * (ii) + rw_, tok_ = dir ? L - 1 - pos_ : pos_; \
            const size_t r_ = (size_t)(row0 + tok_); pq[j_] = *(const u32x4*)(qkm + r_ * DM + h * 128 + 8 * pc_); pk[j_] = *(const u32x4*)(qkm + r_ * DM + 512 + h * 128 + 8 * pc_); \
            pv[j_] = *(const u32x4*)(proj + r_ * NPROJ + 3584 + h * 128 + 8 * pc_); } \
        if (w == 0) { const int ps_ = 64 * (ii) + lane, tk_ = dir ? L - 1 - ps_ : ps_; const float* g_ = gates + (size_t)(row0 + tk_) * 16; pgi = g_[dir * 4 + h]; pgf = g_[8 + dir * 4 + h]; } } while (0)
    ML_LOAD(0);
    for (int i = 0; i < NC; ++i) {
        LAS unsigned char* buf = lds + (i & 1) * BUF;
        LAS unsigned char* QM = buf; LAS unsigned char* KM = buf + IMG; LAS unsigned char* VM = buf + 2 * IMG;
        LAS float* U = (LAS float*)(buf + 3 * IMG); LAS float* MM = U + 64; LAS float* AI = U + 128; LAS float* EN = U + 192; LAS float* UE = U + 256;
        asm volatile("s_waitcnt vmcnt(0)" ::: "memory");
#pragma unroll
        for (int j = 0; j < 2; ++j) { const int e = tid + 512 * j, rw = e >> 4, pc = e & 15;
            *(LAS u32x4*)(QM + rw * MP + 16 * pc) = pq[j]; *(LAS u32x4*)(KM + rw * MP + 16 * pc) = pk[j]; *(LAS u32x4*)(VM + rw * MP + 16 * pc) = pv[j]; }
        if (w == 0) {
            const float m0 = mst[0];
            const float gi = pgi, lf = fminf(pgf, 0.f) - log1pf(__expf(-fabsf(pgf)));
            float bc = lf;
#pragma unroll
            for (int o = 1; o < 64; o <<= 1) { const float x = __shfl_up(bc, o); if (lane >= o) bc += x; }
            const float u = gi - bc;
            float pm = u;
#pragma unroll
            for (int o = 1; o < 64; o <<= 1) { const float x = __shfl_up(pm, o); if (lane >= o) pm = fmaxf(pm, x); }
            const float Mt = fmaxf(m0, pm);
            const float M63 = rdlane(Mt, 63), bc63 = rdlane(bc, 63);
            U[lane] = u; MM[lane] = Mt; AI[lane] = __expf(m0 - Mt); EN[lane] = __expf(-(bc + Mt)); UE[lane] = __expf(u - M63);
            asm volatile("s_waitcnt lgkmcnt(0)" ::: "memory");
            if (lane == 0) mst[0] = bc63 + M63;
        }
        { const int nx = (i + 1 < NC) ? i + 1 : NC - 1; ML_LOAD(nx); }
        __syncthreads();
        {
            const int tt = w >> 1;
#pragma unroll
            for (int k2 = 0; k2 < 2; ++k2) {
                const int st = 2 * (w & 1) + k2;
                if (st <= tt) {
                    f32x4 accP = {0.f, 0.f, 0.f, 0.f};
#pragma unroll
                    for (int kp = 0; kp < 4; ++kp) {
                        const h16x8 a = *(const LAS h16x8*)(KM + (16 * st + c) * MP + 2 * (32 * kp + 8 * q));
                        const h16x8 bq = *(const LAS h16x8*)(QM + (16 * tt + c) * MP + 2 * (32 * kp + 8 * q));
                        accP = __builtin_amdgcn_mfma_f32_16x16x32_f16(a, bq, accP, 0, 0, 0);
                    }
                    const f32x4 u4 = *(const LAS f32x4*)(U + 16 * st + 4 * q); const float mt = MM[16 * tt + c];
                    float pj[4];
#pragma unroll
                    for (int j = 0; j < 4; ++j) { const float e = accP[j] * __expf(u4[j] - mt); pj[j] = (16 * st + 4 * q + j <= 16 * tt + c) ? e : 0.f; }
                    u32x2 pw; pw.x = pkh(pj[0], pj[1]); pw.y = pkh(pj[2], pj[3]);
                    *(LAS u32x2*)(PM + (16 * tt + c) * PP + 2 * (16 * st + 4 * q)) = pw;
                    float cs = (pj[0] + pj[1]) + (pj[2] + pj[3]);
                    cs += __shfl_xor(cs, 16); cs += __shfl_xor(cs, 32);
                    if (q == 0) DENP[st * 64 + 16 * tt + c] = cs;
                }
            }
            {
                const h16x8 qa = *(const LAS h16x8*)(QM + lane * MP + 2 * (16 * w)), qb = *(const LAS h16x8*)(QM + lane * MP + 2 * (16 * w + 8));
                const f32x4 n0 = *(const LAS f32x4*)(NV + 16 * w), n1 = *(const LAS f32x4*)(NV + 16 * w + 4), n2 = *(const LAS f32x4*)(NV + 16 * w + 8), n3 = *(const LAS f32x4*)(NV + 16 * w + 12);
                float s = 0.f;
#pragma unroll
                for (int j = 0; j < 4; ++j) s += (float)qa[j] * n0[j] + (float)qa[4 + j] * n1[j] + (float)qb[j] * n2[j] + (float)qb[4 + j] * n3[j];
                QNP[w * 64 + lane] = s;
            }
            {
                const int d = tid & 127, part = tid >> 7;
                float s = 0.f;
#pragma unroll
                for (int ss = 0; ss < 16; ++ss) s += UE[16 * part + ss] * (float)*(const LAS h16*)(KM + (16 * part + ss) * MP + 2 * d);
                NP[part * 128 + d] = s;
            }
        }
        __syncthreads();
        {
            h16x4 vtr[4];
#pragma unroll
            for (int st = 0; st < 4; ++st) vtr[st] = __builtin_bit_cast(h16x4, tr_read(VM + (16 * st + 4 * q + (c >> 2)) * MP + 2 * (16 * w + 4 * (c & 3))));
            h16x8 cp[4];
#pragma unroll
            for (int kp = 0; kp < 4; ++kp) { u32x4 sa; sa.x = pkh(C[2 * kp][0], C[2 * kp][1]); sa.y = pkh(C[2 * kp][2], C[2 * kp][3]); sa.z = pkh(C[2 * kp + 1][0], C[2 * kp + 1][1]); sa.w = pkh(C[2 * kp + 1][2], C[2 * kp + 1][3]); cp[kp] = __builtin_bit_cast(h16x8, sa); }
#pragma unroll
            for (int tt = 0; tt < 4; ++tt) {
                const int t = 16 * tt + c;
                f32x4 accI = {0.f, 0.f, 0.f, 0.f}, accN = {0.f, 0.f, 0.f, 0.f};
#pragma unroll
                for (int kp = 0; kp < 4; ++kp) {
                    const u32x2 b0 = *(const LAS u32x2*)(QM + t * MP + 2 * (32 * kp + 4 * q)), b1 = *(const LAS u32x2*)(QM + t * MP + 2 * (32 * kp + 16 + 4 * q));
                    u32x4 bb; bb.x = b0.x; bb.y = b0.y; bb.z = b1.x; bb.w = b1.y;
                    accI = __builtin_amdgcn_mfma_f32_16x16x32_f16(cp[kp], __builtin_bit_cast(h16x8, bb), accI, 0, 0, 0);
                }
                float den = 0.f;
#pragma unroll
                for (int st = 0; st < 4; ++st) if (st <= tt) {
                    const u32x2 pb = *(const LAS u32x2*)(PM + t * PP + 2 * (16 * st + 4 * q));
                    accN = __builtin_amdgcn_mfma_f32_16x16x16f16(vtr[st], __builtin_bit_cast(h16x4, pb), accN, 0, 0, 0);
                    den += DENP[st * 64 + t];
                }
                float qn = 0.f;
#pragma unroll
                for (int ww = 0; ww < 8; ++ww) qn += QNP[ww * 64 + t];
                const float ai = AI[t];
                den += ai * qn;
                const float sc = 1.f / fmaxf(fabsf(den), EN[t]);
                f32x4 hv = (accN + accI * ai) * sc;
#pragma unroll
                for (int j = 0; j < 4; ++j) hv[j] = fminf(fmaxf(hv[j], -60000.f), 60000.f);
                const int pos = 64 * i + t, tok = dir ? L - 1 - pos : pos;
                u32x2 o; o.x = pkh(hv[0], hv[1]); o.y = pkh(hv[2], hv[3]);
                *(u32x2*)(odst + (size_t)(row0 + tok) * DM + 512 + h * 128 + 16 * w + 4 * q) = o;
            }
            const float a63 = AI[63];
            h16x4 vs[4];
#pragma unroll
            for (int st = 0; st < 4; ++st) { const f32x4 ue4 = *(const LAS f32x4*)(UE + 16 * st + 4 * q);
#pragma unroll
                for (int j = 0; j < 4; ++j) vs[st][j] = (h16)((float)vtr[st][j] * ue4[j]); }
#pragma unroll
            for (int dt = 0; dt < 8; ++dt) {
                C[dt] = C[dt] * a63;
#pragma unroll
                for (int st = 0; st < 4; ++st) {
                    const h16x4 ktr = __builtin_bit_cast(h16x4, tr_read(KM + (16 * st + 4 * q + (c >> 2)) * MP + 2 * (16 * dt + 4 * (c & 3))));
                    C[dt] = __builtin_amdgcn_mfma_f32_16x16x16f16(ktr, vs[st], C[dt], 0, 0, 0);
                }
            }
            if (tid < 128) NV[tid] = a63 * NV[tid] + (NP[tid] + NP[128 + tid]) + (NP[256 + tid] + NP[384 + tid]);
        }
#if defined(ML_EXTRA_SYNC)
        asm volatile("s_waitcnt vmcnt(0) lgkmcnt(0)" ::: "memory");
        __syncthreads();
#endif
    }
    __syncthreads();
    if (!lat) {
        float* dst = p.out + OUT_MC + sidx * 16384;
#pragma unroll
        for (int dt = 0; dt < 8; ++dt)
#pragma unroll
            for (int j = 0; j < 4; ++j) dst[(16 * dt + 4 * q + j) * 128 + 16 * w + c] = C[dt][j];
        if (tid < 128) p.out[OUT_MN + sidx * 128 + tid] = NV[tid];
        if (tid == 0) p.out[OUT_MM + sidx] = mst[0];
    }
    __syncthreads();
#undef ML_LOAD
}
#if defined(DIAG_ALL)
#define SCAN_HG(p, l, lat, b, h, dir, lds) do { scan_hgrn_mfma(p, l, lat, b, h, dir, (LAS unsigned char*)(lds)); asm volatile("s_waitcnt vmcnt(0)" ::: "memory"); __syncthreads(); scan_item<0, 1>(p, l, lat, b, h, dir, lds); } while (0)
#elif defined(HGRN_VALU)
#define SCAN_HG(p, l, lat, b, h, dir, lds) scan_item<0>(p, l, lat, b, h, dir, lds)
#else
#define SCAN_HG(p, l, lat, b, h, dir, lds) scan_hgrn_mfma(p, l, lat, b, h, dir, (LAS unsigned char*)(lds))
#endif
#if defined(MLSTM_VALU)
#define SCAN_ML(p, l, lat, b, h, dir, lds) scan_item<1>(p, l, lat, b, h, dir, lds)
#else
#if defined(DIAG_ALL)
#define SCAN_ML(p, l, lat, b, h, dir, lds) do { scan_mlstm_mfma(p, l, lat, b, h, dir, (LAS unsigned char*)(lds)); asm volatile("s_waitcnt vmcnt(0)" ::: "memory"); __syncthreads(); scan_item<1, 1>(p, l, lat, b, h, dir, lds); } while (0)
#elif defined(MLSTM_DIAG)
#define SCAN_ML(p, l, lat, b, h, dir, lds) do { scan_mlstm_mfma(p, l, lat, b, h, dir, (LAS unsigned char*)(lds)); \
        if ((lat) && (dir) == 0 && (l) == DIAG_LAYER) { asm volatile("s_waitcnt vmcnt(0)" ::: "memory"); __syncthreads(); scan_item<1, 1>(p, l, lat, b, h, dir, lds); } } while (0)
#elif defined(MLSTM_VALU_CTX)
#define SCAN_ML(p, l, lat, b, h, dir, lds) do { if (lat) scan_mlstm_mfma(p, l, lat, b, h, dir, (LAS unsigned char*)(lds)); else scan_item<1>(p, l, lat, b, h, dir, lds); } while (0)
#elif defined(MLSTM_MFMA_DIR0)
#define SCAN_ML(p, l, lat, b, h, dir, lds) do { if ((dir) == 0) scan_mlstm_mfma(p, l, lat, b, h, dir, (LAS unsigned char*)(lds)); else scan_item<1>(p, l, lat, b, h, dir, lds); } while (0)
#elif defined(MLSTM_BISECT)
#define SCAN_ML(p, l, lat, b, h, dir, lds) do { if (!((lat) && (dir) == 0 && (MLSTM_BISECT_COND))) scan_mlstm_mfma(p, l, lat, b, h, dir, (LAS unsigned char*)(lds)); else scan_item<1>(p, l, lat, b, h, dir, lds); } while (0)
#elif defined(MLSTM_VALU_LAT)
#define SCAN_ML(p, l, lat, b, h, dir, lds) do { if (!(lat)) scan_mlstm_mfma(p, l, lat, b, h, dir, (LAS unsigned char*)(lds)); else scan_item<1>(p, l, lat, b, h, dir, lds); } while (0)
#else
#define SCAN_ML(p, l, lat, b, h, dir, lds) scan_mlstm_mfma(p, l, lat, b, h, dir, (LAS unsigned char*)(lds))
#endif
#endif
__device__ __forceinline__ void scan_dispatch(const Params& p, int l, int it, LAS float* lds) {
    if (it < 128) { const int type = it >> 6, r = it & 63, b = r >> 3, h = (r >> 1) & 3, dir = r & 1; if (type == 0) SCAN_HG(p, l, 1, b, h, dir, lds); else SCAN_ML(p, l, 1, b, h, dir, lds); }
    else { const int q = it - 128, type = q >> 8, r = q & 255, b = r >> 3, h = (r >> 1) & 3, dir = r & 1; if (type == 0) SCAN_HG(p, l, 0, b, h, dir, lds); else SCAN_ML(p, l, 0, b, h, dir, lds); }
}
__device__ __forceinline__ void ctx_pair_mixnorm(const Params& p, int l, int b, int h) {
    asm volatile("s_waitcnt vmcnt(0)" ::: "memory");
    __syncthreads();
    const int tid = ltid(), lane = tid & 63, wave = __builtin_amdgcn_readfirstlane(tid >> 6);
    const h16* of = (const h16*)(p.ws + WS_HN); const h16* ob = (const h16*)(p.ws + WS_OB); const h16* proj = (const h16*)(p.ws + WS_PROJ);
    h16* mix = (h16*)(p.ws + WS_QKM);
    const float wh0 = p.hg_nw[l * 512 + h * 128 + 2 * lane], wh1 = p.hg_nw[l * 512 + h * 128 + 2 * lane + 1];
    const float wm0 = p.ml_nw[l * 512 + h * 128 + 2 * lane], wm1 = p.ml_nw[l * 512 + h * 128 + 2 * lane + 1];
    for (int pi = wave; pi < 512; pi += NWV) {
        const int row = b * 256 + (pi >> 1), type = pi & 1;
        const int cb = type * 512 + h * 128 + 2 * lane, gc = (type ? 4096 : 2048) + h * 128 + 2 * lane;
        const h16x2 a = *(const h16x2*)(of + (size_t)row * DM + cb), c2 = *(const h16x2*)(ob + (size_t)row * DM + cb), g = *(const h16x2*)(proj + (size_t)row * NPROJ + gc);
        const float o0 = (float)a[0] + (float)c2[0], o1 = (float)a[1] + (float)c2[1];
        const float ss = wave_sum(o0 * o0 + o1 * o1);
        const float rstd = rsqrtf(ss * (1.f / 128.f) + EPS);
        const float w0 = type ? wm0 : wh0, w1 = type ? wm1 : wh1;
        *(unsigned*)(mix + (size_t)row * DM + cb) = pkh(o0 * rstd * w0 * (float)g[0], o1 * rstd * w1 * (float)g[1]);
    }
}
__device__ __forceinline__ void phase_scan(const Params& p, int l, LAS float* lds) {
    const int G = gridDim.x, bid = blockIdx.x;
    if (G == 256) {
        if (bid < 128) scan_dispatch(p, l, bid, lds);
        else {
            const int pr = bid - 128, b = pr >> 2, h = pr & 3;
            SCAN_HG(p, l, 0, b, h, 0, lds); SCAN_HG(p, l, 0, b, h, 1, lds); SCAN_ML(p, l, 0, b, h, 0, lds); SCAN_ML(p, l, 0, b, h, 1, lds);
            ctx_pair_mixnorm(p, l, b, h);
        }
    } else {
        for (int it = bid; it < 640; it += G) scan_dispatch(p, l, it, lds);
    }
}
__device__ __forceinline__ void phase_mixnorm(const Params& p, int l, int gw, int NGW, int lane, int row_begin) {
    const h16* of = (const h16*)(p.ws + WS_HN); const h16* ob = (const h16*)(p.ws + WS_OB); const h16* proj = (const h16*)(p.ws + WS_PROJ);
    h16* mix = (h16*)(p.ws + WS_QKM);
    const int col = 16 * lane;
    const float* nw = col < 512 ? p.hg_nw + l * 512 + col : p.ml_nw + l * 512 + (col - 512);
    float wv[16];
#pragma unroll
    for (int j = 0; j < 4; ++j) { const f32x4 t = *(const f32x4*)(nw + 4 * j); wv[4 * j] = t.x; wv[4 * j + 1] = t.y; wv[4 * j + 2] = t.z; wv[4 * j + 3] = t.w; }
    const int gcol = col < 512 ? 2048 + col : 4096 + (col - 512);
    for (int r = row_begin + gw; r < T_ALL; r += NGW) {
        const h16x8 a0 = *(const h16x8*)(of + (size_t)r * DM + col), a1 = *(const h16x8*)(of + (size_t)r * DM + col + 8);
        const h16x8 b0 = *(const h16x8*)(ob + (size_t)r * DM + col), b1 = *(const h16x8*)(ob + (size_t)r * DM + col + 8);
        const h16x8 g0 = *(const h16x8*)(proj + (size_t)r * NPROJ + gcol), g1 = *(const h16x8*)(proj + (size_t)r * NPROJ + gcol + 8);
        float o[16]; float ss = 0.f;
#pragma unroll
        for (int j = 0; j < 8; ++j) { o[j] = (float)a0[j] + (float)b0[j]; o[8 + j] = (float)a1[j] + (float)b1[j]; }
#pragma unroll
        for (int j = 0; j < 16; ++j) ss += o[j] * o[j];
        ss += __shfl_xor(ss, 1); ss += __shfl_xor(ss, 2); ss += __shfl_xor(ss, 4);
        const float rstd = rsqrtf(ss * (1.f / 128.f) + EPS);
        u32x4 w0, w1;
        w0.x = pkh(o[0] * rstd * wv[0] * (float)g0[0], o[1] * rstd * wv[1] * (float)g0[1]); w0.y = pkh(o[2] * rstd * wv[2] * (float)g0[2], o[3] * rstd * wv[3] * (float)g0[3]);
        w0.z = pkh(o[4] * rstd * wv[4] * (float)g0[4], o[5] * rstd * wv[5] * (float)g0[5]); w0.w = pkh(o[6] * rstd * wv[6] * (float)g0[6], o[7] * rstd * wv[7] * (float)g0[7]);
        w1.x = pkh(o[8] * rstd * wv[8] * (float)g1[0], o[9] * rstd * wv[9] * (float)g1[1]); w1.y = pkh(o[10] * rstd * wv[10] * (float)g1[2], o[11] * rstd * wv[11] * (float)g1[3]);
        w1.z = pkh(o[12] * rstd * wv[12] * (float)g1[4], o[13] * rstd * wv[13] * (float)g1[5]); w1.w = pkh(o[14] * rstd * wv[14] * (float)g1[6], o[15] * rstd * wv[15] * (float)g1[7]);
        *(u32x4*)(mix + (size_t)r * DM + col) = w0; *(u32x4*)(mix + (size_t)r * DM + col + 8) = w1;
    }
}

#define XB_TMO      128
#define XB_XCNT(j)  (256  + 64 * (j))
#define XB_XSUB(j)  (1280 + 64 * (j))
#define XB_XGEN(j)  (2304 + 64 * (j))
#define XB_TOP      3328
#define XB_TOPGEN   3392
#define XCD_BAR_WORDS 3456
#define XB_SPIN_CAP (1u << 18)

__device__ __forceinline__ unsigned xb_ld(unsigned* p)              { return __hip_atomic_load(p, __ATOMIC_RELAXED, __HIP_MEMORY_SCOPE_AGENT); }
__device__ __forceinline__ unsigned xb_add(unsigned* p, unsigned v) { return __hip_atomic_fetch_add(p, v, __ATOMIC_RELAXED, __HIP_MEMORY_SCOPE_AGENT); }
__device__ __forceinline__ unsigned xb_xcc_id() { return (unsigned)__builtin_amdgcn_s_getreg((3 << 11) | 20) & 0xFu; }
#define XB_SPIN(cond, bar) do { unsigned _sp = 0; while (cond) { __builtin_amdgcn_s_sleep(1); \
    if ((++_sp & 255u) == 0u) { if (xb_ld(&(bar)[XB_TMO])) break; if (_sp > XB_SPIN_CAP) { atomicAdd(&(bar)[XB_TMO], 1u); break; } } } } while (0)

struct XcdBarrier {
    unsigned* bar; unsigned x;
    volatile LAS unsigned* st;
};

__device__ __forceinline__ XcdBarrier xcd_barrier_post(unsigned* bar, volatile LAS unsigned* st) {
    XcdBarrier b; b.bar = bar; b.x = xb_xcc_id(); b.st = st;
    if (threadIdx.x == 0) (void)xb_add(&bar[XB_XCNT(b.x)], 1u);
    return b;
}
__device__ __forceinline__ void xcd_barrier_complete(unsigned* bar, unsigned x, unsigned& nloc, unsigned& nx) {
    const unsigned G = gridDim.x * gridDim.y * gridDim.z;
    unsigned sum, cnt, mine, sp = 0u;
    for (;;) {
        sum = 0u; cnt = 0u; mine = 0u;
#pragma unroll
        for (unsigned j = 0; j < 16; ++j) { const unsigned c = xb_ld(&bar[XB_XCNT(j)]); sum += c; cnt += (c > 0u) ? 1u : 0u; mine = (j == x) ? c : mine; }
        if (sum == G) break;
        __builtin_amdgcn_s_sleep(1);
        if ((++sp & 255u) == 0u) { if (xb_ld(&bar[XB_TMO])) break; if (sp > XB_SPIN_CAP) { atomicAdd(&bar[XB_TMO], 1u); break; } }
    }
    nloc = mine > 0u ? mine : 1u; nx = cnt > 0u ? cnt : 1u;
}

__device__ __forceinline__ void xcd_barrier(const XcdBarrier& b) {
    asm volatile("s_waitcnt vmcnt(0)" ::: "memory");
    __syncthreads();
    if (threadIdx.x == 0) {
        unsigned* bar = b.bar;
        __builtin_amdgcn_s_waitcnt(0);
        unsigned nloc = b.st[0], nx = b.st[1];
        if (nloc == 0u) { xcd_barrier_complete(bar, b.x, nloc, nx); b.st[0] = nloc; b.st[1] = nx; }
        const unsigned old = xb_add(&bar[XB_XSUB(b.x)], 1u);
        const unsigned gen = old / nloc;
        if (old + 1u == (gen + 1u) * nloc) {
            __builtin_amdgcn_fence(__ATOMIC_RELEASE, "agent");
            asm volatile("s_waitcnt vmcnt(0)" ::: "memory");
            const unsigned og = xb_add(&bar[XB_TOP], 1u);
            const unsigned tg = og / nx;
            if (og + 1u == (tg + 1u) * nx) xb_add(&bar[XB_TOPGEN], 1u);
            else XB_SPIN(xb_ld(&bar[XB_TOPGEN]) == tg, bar);
            __builtin_amdgcn_fence(__ATOMIC_ACQUIRE, "agent");
            xb_add(&bar[XB_XGEN(b.x)], 1u);
            asm volatile("s_waitcnt vmcnt(0)" ::: "memory");
        } else {
            XB_SPIN(xb_ld(&bar[XB_XGEN(b.x)]) == gen, bar);
            __builtin_amdgcn_fence(__ATOMIC_ACQUIRE, "agent");
            asm volatile("s_waitcnt vmcnt(0)" ::: "memory");
        }
    }
    __syncthreads();
}


__global__ void __launch_bounds__(NTHR, 2) fwd_megakernel(Params p) {
    extern __shared__ __attribute__((aligned(16))) unsigned char lds_raw[];
    cg::grid_group grid = cg::this_grid();
#if defined(USE_CG_SYNC)
#define GSYNC() do { asm volatile("s_waitcnt vmcnt(0)" ::: "memory"); grid.sync(); } while (0)
#else
#define GSYNC() do { XcdBarrier xb_; xb_.bar = (unsigned*)(p.ws + WS_BAR); xb_.x = xb_xcc_id(); xb_.st = (volatile LAS unsigned*)(lds + 131072 + 512); xcd_barrier(xb_); } while (0)
#endif
    LAS unsigned char* lds = (LAS unsigned char*)lds_raw;
    LAS float* ldsf = (LAS float*)lds_raw;
    const int G = gridDim.x, NGW = G * NWV;
#define PHASE_IDS() const int tid = ltid(), lane = tid & 63, wave = __builtin_amdgcn_readfirstlane(tid >> 6), gw = blockIdx.x * NWV + wave; (void)tid; (void)lane; (void)gw
    const float* mod = (const float*)(p.ws + WS_MOD);
    h16* hn = (h16*)(p.ws + WS_HN); h16* proj = (h16*)(p.ws + WS_PROJ); h16* mix = (h16*)(p.ws + WS_QKM); h16* ff = (h16*)(p.ws + WS_PROJ);

    volatile LAS unsigned* xst = (volatile LAS unsigned*)(lds + 131072 + 512);
    if (ltid() < 4) xst[ltid()] = 0u;
    __syncthreads();
    XcdBarrier xbar = xcd_barrier_post((unsigned*)(p.ws + WS_BAR), xst);
    phase_mod_partial(p, ldsf);
    asm volatile("s_waitcnt vmcnt(0)" ::: "memory"); grid.sync();
    (void)xbar;
    phase_mod_reduce(p);
    GSYNC();
#if defined(DIAG_ALL)
    if (ltid() == 0) { float* dg = (float*)(p.ws + WS_MODP) + 4 * blockIdx.x; dg[0] = 0.f; dg[1] = 0.f; dg[2] = 0.f; dg[3] = 0.f; }
#endif
    for (int l = 0; l < 4; ++l) {
        { PHASE_IDS(); convert_weights(p, l, ldsf + wave * 2176, gw, NGW, lane); }
        { PHASE_IDS(); phase_norm(p, l, 0, l == 0, gw, NGW, lane); }
        GSYNC();
        {
            pg8::Gemm g{(const pg8::bf16_t*)hn, (const pg8::bf16_t*)(p.ws + WS_WIN), T_ALL, NPROJ_PAD, DM}; pg8::StaticOrder S; S.init(T_ALL, NPROJ_PAD, G, (int)blockIdx.x);
            EpiInProj E{proj, (float*)(p.ws + WS_GATES), p.gate_b + l * 16};
            pg8::gemm_phase<EpiInProj, pg8::StaticOrder, true, true>(lds, g, S, E);
#if defined(PROBE_GEMM2)
            GSYNC();
            pg8::gemm_phase<EpiInProj, pg8::StaticOrder, true, true>(lds, g, S, E);
#endif
        }
        GSYNC();
        { PHASE_IDS(); phase_gates(p, l, gw, NGW, lane); }
        phase_conv(p, l);
        GSYNC();
#if defined(PERTURB)
        { if (ltid() == 0) { const unsigned long long t0_ = __builtin_amdgcn_s_memrealtime(); const unsigned long long dl_ = (unsigned long long)(((blockIdx.x * 37u + l * 11u) % 64u) * 300u); while (__builtin_amdgcn_s_memrealtime() - t0_ < dl_) __builtin_amdgcn_s_sleep(4); } __syncthreads(); }
#endif
        phase_scan(p, l, ldsf);
#if defined(PERTURB)
        { if (ltid() == 0) { const unsigned long long t0_ = __builtin_amdgcn_s_memrealtime(); const unsigned long long dl_ = (unsigned long long)(((blockIdx.x * 53u + l * 7u) % 32u) * 400u); while (__builtin_amdgcn_s_memrealtime() - t0_ < dl_) __builtin_amdgcn_s_sleep(4); } __syncthreads(); }
#endif
#if defined(DELAY_AFTER_SCAN)
        { if (ltid() == 0) { const unsigned long long t0_ = __builtin_amdgcn_s_memrealtime(); while (__builtin_amdgcn_s_memrealtime() - t0_ < (unsigned long long)(DELAY_AFTER_SCAN) * 100ull) __builtin_amdgcn_s_sleep(8); } __syncthreads(); }
#endif
#if defined(LDS_CLEAR)
        { __syncthreads(); const int t_ = ltid(); for (int e = t_; e < 32768; e += NTHR) ldsf[e] = LDS_CLEAR_VAL; __syncthreads(); }
#endif
        GSYNC();
#if defined(MLSTM_DIAG)
        if (l == DIAG_LAYER && blockIdx.x == 0 && ltid() == 0) {
            const float* dg = (const float*)(p.ws + WS_MODP);
            float best = -1.f; int code = 0;
            for (int bb = 64; bb < 128; bb += 2) { const float rt = dg[4 * bb + DIAG_FIELD]; if (rt > best) { best = rt; int lg = 0; float x = rt; while (x < 1.f && lg < 31) { x *= 2.f; ++lg; } code = DIAG_CODE; } }
            const unsigned long long t0 = __builtin_amdgcn_s_memrealtime();
            while (__builtin_amdgcn_s_memrealtime() - t0 < (unsigned long long)code * 5000ull) __builtin_amdgcn_s_sleep(8);
        }
#endif
#if defined(PROBE_GSYNC10)
        for (int rep = 0; rep < 10; ++rep) GSYNC();
#endif
#if defined(PROBE_SCAN_TYPE)
        { const int bid_ = blockIdx.x;
          if (bid_ < 128) { if ((bid_ >> 6) == PROBE_SCAN_TYPE) scan_dispatch(p, l, bid_, ldsf); }
          else for (int it = 128 + (bid_ - 128); it < 640; it += 128) { if (((it - 128) >> 8) == PROBE_SCAN_TYPE) scan_dispatch(p, l, it, ldsf); } }
        GSYNC();
#endif
#if defined(PROBE_SCAN2)
        phase_scan(p, l, ldsf);
        GSYNC();
#endif
        { PHASE_IDS(); phase_mixnorm(p, l, gw, NGW, lane, G == 256 ? T_CTX : 0); }
        GSYNC();
        {
            pg8::Gemm g{(const pg8::bf16_t*)mix, (const pg8::bf16_t*)(p.ws + WS_WOUT), T_ALL, DM, DM}; pg8::StaticOrder S; S.init(T_ALL, DM, G, (int)blockIdx.x);
            EpiResid E{l == 0 ? p.x_prompt : p.out, l == 0 ? p.x_sample : p.out + (size_t)T_CTX * DM, p.out, mod + (size_t)l * 9 * 6144 + 2048};
#if defined(PROBE_GEMM2)
            { EpiResid E2 = E; E2.out = (float*)(p.ws + WS_PROJ); pg8::gemm_phase<EpiResid, pg8::StaticOrder, true, true>(lds, g, S, E2); GSYNC(); }
#endif
            pg8::gemm_phase<EpiResid, pg8::StaticOrder, true, true>(lds, g, S, E);
        }
        GSYNC();
        { PHASE_IDS(); phase_norm(p, l, 1, false, gw, NGW, lane); }
        GSYNC();
        {
            pg8::Gemm g{(const pg8::bf16_t*)hn, (const pg8::bf16_t*)(p.ws + WS_WGU), T_ALL, NGU, DM}; pg8::StaticOrder S; S.init(T_ALL, NGU, G, (int)blockIdx.x);
            EpiGateUp E{ff};
            pg8::gemm_phase<EpiGateUp, pg8::StaticOrder, true, true>(lds, g, S, E);
#if defined(PROBE_GEMM2)
            GSYNC();
            pg8::gemm_phase<EpiGateUp, pg8::StaticOrder, true, true>(lds, g, S, E);
#endif
        }
        GSYNC();
        {
            pg8::Gemm g{(const pg8::bf16_t*)ff, (const pg8::bf16_t*)(p.ws + WS_WDN), T_ALL, DM, DFF}; pg8::StaticOrder S; S.init(T_ALL, DM, G, (int)blockIdx.x);
            EpiResid E{p.out, p.out + (size_t)T_CTX * DM, p.out, mod + (size_t)l * 9 * 6144 + 5120};
#if defined(PROBE_GEMM2)
            { EpiResid E2 = E; E2.out = (float*)(p.ws + WS_QKM); pg8::gemm_phase<EpiResid, pg8::StaticOrder, true, true>(lds, g, S, E2); GSYNC(); }
#endif
            pg8::gemm_phase<EpiResid, pg8::StaticOrder, true, true>(lds, g, S, E);
        }
        GSYNC();
    }
    { PHASE_IDS(); phase_final_norm(p, gw, NGW, lane); }
#if defined(DIAG_ALL)
    if (blockIdx.x == 0 && ltid() == 0) {
        const float* dg = (const float*)(p.ws + WS_MODP);
        float best = -1.f; int code = 0;
        for (int bb = 0; bb < (int)gridDim.x; ++bb) { const float rt = dg[4 * bb]; if (rt > best) { best = rt; int lg = 0; float x = rt; while (x < 1.f && lg < 31) { x *= 2.f; ++lg; } code = DIAG_ALL_CODE; } }
        const unsigned long long t0 = __builtin_amdgcn_s_memrealtime();
        while (__builtin_amdgcn_s_memrealtime() - t0 < (unsigned long long)code * 5000ull) __builtin_amdgcn_s_sleep(8);
    }
#endif
}

extern "C" void kernel_launch(void* const* d_in, const int* in_sizes, int n_in, void* d_out, int out_size, void* d_ws, size_t ws_size, hipStream_t stream) {
    static int grid_blocks = 0;
    if (grid_blocks == 0) {
        if (n_in != 24 || (size_t)out_size != OUT_TOTAL || ws_size < WS_END) {
            fprintf(stderr, "kernel_launch: unexpected sizes n_in %d out %d ws %zu (need %zu)\n", n_in, out_size, ws_size, (size_t)WS_END); grid_blocks = -1; return;
        }
        int dev = 0, cus = 0, per_cu = 0;
        hipGetDevice(&dev);
        hipDeviceGetAttribute(&cus, hipDeviceAttributeMultiprocessorCount, dev);
        hipFuncSetAttribute((const void*)fwd_megakernel, hipFuncAttributeMaxDynamicSharedMemorySize, LDS_BYTES);
        hipOccupancyMaxActiveBlocksPerMultiprocessor(&per_cu, (const void*)fwd_megakernel, NTHR, LDS_BYTES);
        if (per_cu < 1) { fprintf(stderr, "kernel_launch: occupancy query says %d blocks per CU\n", per_cu); per_cu = 1; }
        grid_blocks = cus * 1;
        (void)hipGetLastError();
    }
    if (grid_blocks < 0) return;
    Params p{};
    const float** f = (const float**)&p;
    for (int i = 0; i < 24; ++i) f[i] = (const float*)d_in[i];
    p.out = (float*)d_out; p.ws = (unsigned char*)d_ws;
    if (hipMemsetAsync((char*)d_ws + WS_BAR, 0, 16384, stream) != hipSuccess) { fprintf(stderr, "kernel_launch: memset of the barrier words failed\n"); return; }
    void* args[] = {&p};
    hipError_t e = hipLaunchCooperativeKernel((const void*)fwd_megakernel, dim3(grid_blocks), dim3(NTHR), args, LDS_BYTES, stream);
    if (e != hipSuccess) fprintf(stderr, "cooperative launch failed: %s (grid %d)\n", hipGetErrorString(e), grid_blocks);
}
```

```cpp
#include <hip/hip_runtime.h>
#include <hip/hip_cooperative_groups.h>
#include <cstdio>
#include <cstdint>
namespace cg = cooperative_groups;
typedef _Float16 h16;
typedef _Float16 h16x8 __attribute__((ext_vector_type(8)));
typedef _Float16 h16x4 __attribute__((ext_vector_type(4)));
typedef _Float16 h16x2 __attribute__((ext_vector_type(2)));
typedef float f32x2 __attribute__((ext_vector_type(2)));
namespace pg8 {
#define PG8_LAS __attribute__((address_space(3)))
typedef unsigned short bf16_t;
typedef short bf16x8 __attribute__((ext_vector_type(8)));
typedef float f32x4 __attribute__((ext_vector_type(4)));
typedef unsigned u32x4 __attribute__((ext_vector_type(4)));
constexpr int BM = 256, BK = 64, HALF = 128, HTB = HALF * BK * 2  , STAGE_BYTES = 8 * HTB, NXCD = 8, WGM = 8;

__host__ __device__ __forceinline__ int lds_byte(int r, int c) { const int st = (r >> 4) * 2 + (c >> 5), rr = r & 15, cc = c & 31, ob = rr * 64 + cc * 2; return st * 1024 + (ob ^ (((ob >> 9) & 1) << 5)); }
__host__ __device__ __forceinline__ void stage_rc(int b, int& R, int& C) { const int st = b / 1024, sb = b % 1024, swz = sb ^ (((sb >> 9) & 1) << 5); R = (st >> 1) * 16 + swz / 64; C = (st & 1) * 32 + (swz % 64) / 2; }
__host__ __device__ __forceinline__ int perm32(int rho) { const int n = rho >> 4, i = rho & 15; return 8 * (i >> 2) + 4 * n + (i & 3); }

struct Unit { int pm, pn; };
struct Gemm { const bf16_t* A; const bf16_t* Bt; int M, N, K; };

struct StaticOrder {
    int nM, nN, nwg, G, c;
    __host__ __device__ void init(int M, int N, int G_, int c_) { nM = M / BM; nN = N / BM; nwg = nM * nN; G = G_; c = c_; }
    __host__ __device__ bool next(int i, Unit& u) const {
        const long L = (long)i * G + c; if (L >= nwg) return false;
        int wgid = (int)L; { const int q = nwg / NXCD, r = nwg % NXCD, xcd = wgid % NXCD, off = wgid / NXCD; wgid = (xcd < r ? xcd * (q + 1) : r * (q + 1) + (xcd - r) * q) + off; }
        const int nig = WGM * nN, gid = wgid / nig, fm = gid * WGM, gsz = (nM - fm) < WGM ? (nM - fm) : WGM;
        u.pm = fm + ((wgid % nig) % gsz); u.pn = (wgid % nig) / gsz; return true;
    }
    __device__ __forceinline__ void a_ready(const Unit&) const {}
    __device__ __forceinline__ void done(const Unit&) const {}
};

template <class Epi, class Sched, bool ALIGN_EPI = false, bool SP2 = false>
__device__ __forceinline__ void gemm_phase(PG8_LAS unsigned char* lds, const Gemm g, const Sched& S, const Epi& E) {
    int tid_l = threadIdx.x; asm volatile("" : "+v"(tid_l));
    const int tid = tid_l, wid = __builtin_amdgcn_readfirstlane(tid >> 6), lane = tid & 63, wr = wid >> 2, wc = wid & 3, fr = lane & 15, fq = lane >> 4;
    const int K = g.K, nt = K / BK;
    unsigned voffA[2], voffB[2];
#pragma unroll
    for (int i = 0; i < 2; ++i) { int R, C; stage_rc(tid * 16 + i * 8192, R, C); const int Rb = Epi::PERM ? ((R & ~31) + perm32(R & 31)) : R;
        voffA[i] = (unsigned)(R * K + C) * 2u; voffB[i] = (unsigned)(Rb * K + C) * 2u; }
    const size_t kstep = (size_t)(BK * 2);
    const size_t hstep = (size_t)HALF * K * 2;
    const size_t tstep = 2 * hstep;
    const unsigned ldsw = (unsigned)wid * 1024u;
    const int aoff = lds_byte(wr * 64 + fr, fq * 8), boff = lds_byte(wc * 32 + fr, fq * 8);
#define PG8_SA(b, h) (((b) * 2 + (h)) * HTB)
#define PG8_SB(b, h) ((4 + (b) * 2 + (h)) * HTB)
#define PG8_STAGE(bufoff, gbase, voff) do { _Pragma("unroll") for (int _i = 0; _i < 2; ++_i) \
        __builtin_amdgcn_global_load_lds((const unsigned*)((const char*)(gbase) + (voff)[_i]), (PG8_LAS unsigned*)(lds + (bufoff) + ldsw + _i * 8192), 16, 0, 0); } while (0)
#define PG8_LDA(dst, b, h) do { _Pragma("unroll") for (int m = 0; m < 4; ++m) _Pragma("unroll") for (int k = 0; k < 2; ++k) dst[m][k] = *(const PG8_LAS bf16x8*)(lds + PG8_SA(b, h) + aoff + m * 2048 + k * 1024); } while (0)
#define PG8_LDB(dst, b, h) do { _Pragma("unroll") for (int n = 0; n < 2; ++n) _Pragma("unroll") for (int k = 0; k < 2; ++k) dst[n][k] = *(const PG8_LAS bf16x8*)(lds + PG8_SB(b, h) + boff + n * 2048 + k * 1024); } while (0)
#define PG8_MMA(ai, bj, At, Bt) do { __builtin_amdgcn_s_setprio(1); _Pragma("unroll") for (int m = 0; m < 4; ++m) _Pragma("unroll") for (int n = 0; n < 2; ++n) _Pragma("unroll") for (int k = 0; k < 2; ++k) \
        acc[ai][bj][m][n] = __builtin_amdgcn_mfma_f32_16x16x32_f16(__builtin_bit_cast(h16x8, Bt[n][k]), __builtin_bit_cast(h16x8, At[m][k]), acc[ai][bj][m][n], 0, 0, 0); __builtin_amdgcn_s_setprio(0); } while (0)
#define PG8_WAIT_V(n) asm volatile("s_waitcnt vmcnt(" #n ")" ::: "memory")
#define PG8_WAIT_L(n) asm volatile("s_waitcnt lgkmcnt(" #n ")" ::: "memory")
#define PG8_BAR __builtin_amdgcn_s_barrier()
#define PG8_SCHED __builtin_amdgcn_sched_barrier(0)
    Unit cur, nxt; int ui = 0;
    if (!S.next(0, cur)) return;
    f32x4 acc[2][2][4][2];
#pragma unroll
    for (int a = 0; a < 2; ++a)
#pragma unroll
        for (int b = 0; b < 2; ++b)
#pragma unroll
            for (int m = 0; m < 4; ++m)
#pragma unroll
                for (int n = 0; n < 2; ++n) acc[a][b][m][n] = (f32x4){0.f, 0.f, 0.f, 0.f};
    bf16x8 At[4][2], B0[2][2], B1[2][2];
    const char* cA = (const char*)g.A + (size_t)cur.pm * tstep; const char* cB = (const char*)g.Bt + (size_t)cur.pn * tstep;
    S.a_ready(cur);
    if constexpr (SP2) {
        PG8_STAGE(PG8_SB(0, 0), cB, voffB); PG8_STAGE(PG8_SB(0, 1), cB + hstep, voffB); PG8_STAGE(PG8_SA(0, 0), cA, voffA); PG8_STAGE(PG8_SA(0, 1), cA + hstep, voffA);
        if (wr == 1) PG8_BAR;
        PG8_WAIT_V(2); PG8_BAR;
        PG8_STAGE(PG8_SB(1, 0), cB + kstep, voffB); PG8_STAGE(PG8_SA(1, 0), cA + kstep, voffA); PG8_STAGE(PG8_SB(1, 1), cB + hstep + kstep, voffB);
        PG8_WAIT_V(6); PG8_BAR;
    } else {
        PG8_STAGE(PG8_SB(0, 0), cB, voffB); PG8_STAGE(PG8_SA(0, 0), cA, voffA); PG8_STAGE(PG8_SB(0, 1), cB + hstep, voffB); PG8_STAGE(PG8_SA(0, 1), cA + hstep, voffA);
        if (wr == 1) PG8_BAR;
        PG8_WAIT_V(4); PG8_BAR;
        PG8_STAGE(PG8_SB(1, 0), cB + kstep, voffB); PG8_STAGE(PG8_SA(1, 0), cA + kstep, voffA); PG8_STAGE(PG8_SB(1, 1), cB + hstep + kstep, voffB);
        PG8_WAIT_V(6); PG8_BAR;
    }
    for (;;) {
        const bool has_next = S.next(ui + 1, nxt);
        const char* nA = has_next ? (const char*)g.A + (size_t)nxt.pm * tstep : cA; const char* nB = has_next ? (const char*)g.Bt + (size_t)nxt.pn * tstep : cB;
        for (int t = 0; t < nt; t += 2) {
            const bool last = (t == nt - 2);
            const char* a1 = cA + (size_t)(t + 1) * kstep;
            const char* a2 = last ? nA : cA + (size_t)(t + 2) * kstep; const char* b2 = last ? nB : cB + (size_t)(t + 2) * kstep;
            const char* a3 = a2 + kstep; const char* b3 = b2 + kstep;
            if (last && has_next) S.a_ready(nxt);
            if constexpr (SP2) {
            PG8_LDB(B0, 0, 0); PG8_LDB(B1, 0, 1); PG8_SCHED; PG8_LDA(At, 0, 0); PG8_STAGE(PG8_SA(1, 1), a1 + hstep, voffA);
            PG8_WAIT_V(8); PG8_WAIT_L(0); PG8_BAR; PG8_MMA(0, 0, At, B0); PG8_MMA(0, 1, At, B1); PG8_BAR; PG8_SCHED;
            PG8_LDA(At, 0, 1); PG8_STAGE(PG8_SB(0, 0), b2, voffB); PG8_STAGE(PG8_SB(0, 1), b2 + hstep, voffB); PG8_STAGE(PG8_SA(0, 0), a2, voffA);
            PG8_WAIT_V(8); PG8_WAIT_L(0); PG8_BAR; PG8_MMA(1, 0, At, B0); PG8_MMA(1, 1, At, B1); PG8_BAR; PG8_SCHED;
            PG8_LDB(B0, 1, 0); PG8_LDB(B1, 1, 1); PG8_SCHED; PG8_LDA(At, 1, 0); PG8_STAGE(PG8_SA(0, 1), a2 + hstep, voffA);
            PG8_WAIT_V(8); PG8_WAIT_L(0); PG8_BAR; PG8_MMA(0, 0, At, B0); PG8_MMA(0, 1, At, B1); PG8_BAR; PG8_SCHED;
            PG8_LDA(At, 1, 1); PG8_STAGE(PG8_SB(1, 0), b3, voffB); PG8_STAGE(PG8_SB(1, 1), b3 + hstep, voffB); PG8_STAGE(PG8_SA(1, 0), a3, voffA);
            PG8_WAIT_V(8); PG8_WAIT_L(0); PG8_BAR; PG8_MMA(1, 0, At, B0); PG8_MMA(1, 1, At, B1); PG8_BAR; PG8_SCHED;
            } else {
            PG8_LDB(B0, 0, 0); PG8_SCHED; PG8_LDA(At, 0, 0); PG8_STAGE(PG8_SA(1, 1), a1 + hstep, voffA);
            PG8_WAIT_L(8); PG8_BAR; PG8_WAIT_L(0); PG8_MMA(0, 0, At, B0); PG8_BAR; PG8_SCHED;
            PG8_LDB(B1, 0, 1); PG8_STAGE(PG8_SB(0, 0), b2, voffB);
            PG8_BAR; PG8_WAIT_L(0); PG8_MMA(0, 1, At, B1); PG8_BAR;
            PG8_LDA(At, 0, 1); PG8_STAGE(PG8_SA(0, 0), a2, voffA);
            PG8_BAR; PG8_WAIT_L(0); PG8_MMA(1, 0, At, B0); PG8_BAR; PG8_SCHED;
            PG8_STAGE(PG8_SB(0, 1), b2 + hstep, voffB);
            PG8_WAIT_V(6); PG8_BAR; PG8_MMA(1, 1, At, B1); PG8_BAR;
            PG8_LDB(B0, 1, 0); PG8_SCHED; PG8_LDA(At, 1, 0); PG8_STAGE(PG8_SA(0, 1), a2 + hstep, voffA);
            PG8_WAIT_L(8); PG8_BAR; PG8_WAIT_L(0); PG8_MMA(0, 0, At, B0); PG8_BAR; PG8_SCHED;
            PG8_LDB(B1, 1, 1); PG8_STAGE(PG8_SB(1, 0), b3, voffB);
            PG8_BAR; PG8_WAIT_L(0); PG8_MMA(0, 1, At, B1); PG8_BAR;
            PG8_LDA(At, 1, 1); PG8_STAGE(PG8_SA(1, 0), a3, voffA);
            PG8_BAR; PG8_WAIT_L(0); PG8_MMA(1, 0, At, B0); PG8_BAR; PG8_SCHED;
            PG8_STAGE(PG8_SB(1, 1), b3 + hstep, voffB);
            PG8_WAIT_V(6); PG8_BAR; PG8_MMA(1, 1, At, B1); PG8_BAR;
            }
        }
        if constexpr (ALIGN_EPI) { if (wr == 0) PG8_BAR; }
        if constexpr (!Epi::AFTER_DRAIN) { E(acc, cur, wr, wc, fr, fq); S.done(cur); }
        if (!has_next) break;
#pragma unroll
        for (int a = 0; a < 2; ++a)
#pragma unroll
            for (int b = 0; b < 2; ++b)
#pragma unroll
                for (int m = 0; m < 4; ++m)
#pragma unroll
                    for (int n = 0; n < 2; ++n) acc[a][b][m][n] = (f32x4){0.f, 0.f, 0.f, 0.f};
        cur = nxt; cA = nA; cB = nB; ++ui;
        if constexpr (ALIGN_EPI) { if (wr == 1) PG8_BAR; }
    }
    PG8_WAIT_V(0);
    if constexpr (!ALIGN_EPI) { if (wr == 0) PG8_BAR; }
    PG8_BAR;
    if constexpr (Epi::AFTER_DRAIN) { E.fused(acc, cur, wr, wc, fr, fq, lds, wid, lane); S.done(cur); }
#undef PG8_SA
#undef PG8_SB
#undef PG8_STAGE
#undef PG8_LDA
#undef PG8_LDB
#undef PG8_MMA
#undef PG8_WAIT_V
#undef PG8_WAIT_L
#undef PG8_BAR
#undef PG8_SCHED
}
}
#define LAS __attribute__((address_space(3)))
using pg8::f32x4;
using pg8::u32x4;
constexpr int T_CTX = 8192, T_LAT = 16384, T_ALL = 24576, DM = 1024;
constexpr int NPROJ = 4608, NPROJ_PAD = 4608, NIN = 4624, DFF = 2816, NGU = 5632;
constexpr int NTHR = 512, NWV = 8;
constexpr float EPS = 1e-6f;
constexpr int LDS_BYTES = 132096;

constexpr size_t OUT_HG = 25165824, OUT_MC = 41943040, OUT_MN = 58720256, OUT_MM = 58851328, OUT_TOTAL = 58852352;

constexpr size_t al256(size_t x) { return (x + 255) & ~(size_t)255; }
constexpr size_t WS_WIN = 0;
constexpr size_t WS_WOUT = WS_WIN + al256((size_t)NPROJ_PAD * DM * 2);
constexpr size_t WS_WGU = WS_WOUT + al256((size_t)DM * DM * 2);
constexpr size_t WS_WDN = WS_WGU + al256((size_t)NGU * DM * 2);
constexpr size_t WS_MODP = WS_WDN + al256((size_t)DM * DFF * 2);
constexpr size_t WS_MOD = WS_MODP + al256((size_t)8 * 4 * 9 * 6144 * 4);
constexpr size_t WS_LB = WS_MOD + al256((size_t)4 * 9 * 6144 * 4);
constexpr size_t WS_HN = WS_LB + al256((size_t)4 * 2 * 512 * 4);
constexpr size_t WS_PROJ = WS_HN + al256((size_t)T_ALL * DM * 2);
constexpr size_t WS_GATES = WS_PROJ + al256((size_t)T_ALL * NPROJ * 2);
constexpr size_t WS_QKM = WS_GATES + al256((size_t)T_ALL * 16 * 4);
constexpr size_t WS_OB = WS_QKM + al256((size_t)T_ALL * DM * 2);
constexpr size_t WS_BAR = WS_OB + al256((size_t)T_ALL * DM * 2);
constexpr size_t WS_WG16 = WS_BAR + 16384;
constexpr size_t WS_END = WS_WG16 + 32768;

#if defined(SWAP_OBUF)
#define ODIR(d) (!(d))
#else
#define ODIR(d) (d)
#endif
struct Params {
    const float *x_prompt, *x_sample, *st_hg, *st_mc, *st_mn, *st_mm, *cnd, *c_ctx, *n1w, *n2w, *w_mod, *b_mod, *w_in, *conv_w, *conv_b, *gate_b,
        *lb_logits, *hg_nw, *ml_nw, *w_out, *w_gate, *w_up, *w_down, *fin_w;
    float* out; unsigned char* ws;
};

__device__ __forceinline__ float sigmoidf_(float x) { return __builtin_amdgcn_rcpf(1.f + __expf(-x)); }
__device__ __forceinline__ float siluf_(float x) { return x * __builtin_amdgcn_rcpf(1.f + __expf(-x)); }
__device__ __forceinline__ unsigned pkh(float a, float b) { h16x2 v = {(h16)a, (h16)b}; return __builtin_bit_cast(unsigned, v); }
__device__ __forceinline__ float wave_sum(float v) {
#pragma unroll
    for (int o = 1; o < 64; o <<= 1) v += __shfl_xor(v, o);
    return v;
}
__device__ __forceinline__ int row_cidx(int row) { return row < T_CTX ? 0 : 1 + ((row - T_CTX) >> 11); }
__device__ __forceinline__ int ltid() { int t = threadIdx.x; asm volatile("" : "+v"(t)); return t; }
__device__ __forceinline__ float rdlane(float v, int l) { return __builtin_bit_cast(float, __builtin_amdgcn_readlane(__builtin_bit_cast(int, v), l)); }

struct EpiInProj {
    static constexpr bool PERM = true, AFTER_DRAIN = false;
    h16* proj; float* gates; const float* gate_b;
    __device__ __forceinline__ void operator()(const f32x4 (&acc)[2][2][4][2], const pg8::Unit& u, int wr, int wc, int fr, int fq) const {
        const int row0 = u.pm * 256 + wr * 64 + fr;
#pragma unroll
        for (int bj = 0; bj < 2; ++bj) {
            const int colt = u.pn * 256 + bj * 128, reg = colt >> 9;
            const int act = (reg == 0 || reg == 4) ? 1 : (reg == 8 ? 2 : 0);
            const int col0 = colt + wc * 32 + 8 * fq;
#pragma unroll
            for (int ai = 0; ai < 2; ++ai)
#pragma unroll
                for (int m = 0; m < 4; ++m) {
                    f32x4 v0 = acc[ai][bj][m][0], v1 = acc[ai][bj][m][1];
                    if (act == 1) {
#pragma unroll
                        for (int j = 0; j < 4; ++j) { v0[j] = siluf_(v0[j]); v1[j] = siluf_(v1[j]); }
                    } else if (act == 2) {
#pragma unroll
                        for (int j = 0; j < 4; ++j) { v0[j] = sigmoidf_(v0[j]); v1[j] = sigmoidf_(v1[j]); }
                    }
                    u32x4 w; w.x = pkh(v0[0], v0[1]); w.y = pkh(v0[2], v0[3]); w.z = pkh(v1[0], v1[1]); w.w = pkh(v1[2], v1[3]);
                    *(u32x4*)(proj + (size_t)(row0 + ai * 128 + m * 16) * NPROJ + col0) = w;
                }
        }
    }
};
struct EpiResid {
    static constexpr bool PERM = false, AFTER_DRAIN = false;
    const float* base_ctx; const float* base_lat; float* out; const float* gate;
    __device__ __forceinline__ void operator()(const f32x4 (&acc)[2][2][4][2], const pg8::Unit& u, int wr, int wc, int fr, int fq) const {
        const int cidx = u.pm < 32 ? 0 : 1 + ((u.pm - 32) >> 3);
        const float* gt = gate + cidx * 6144;
        const float* bs = u.pm < 32 ? base_ctx : base_lat - (size_t)T_CTX * DM;
        const int colb = u.pn * 256 + wc * 32 + 4 * fq;
        f32x4 g[2][2];
#pragma unroll
        for (int bj = 0; bj < 2; ++bj)
#pragma unroll
            for (int n = 0; n < 2; ++n) g[bj][n] = *(const f32x4*)(gt + colb + bj * 128 + n * 16);
#pragma unroll
        for (int ai = 0; ai < 2; ++ai)
#pragma unroll
            for (int m = 0; m < 4; ++m) {
                const size_t off = (size_t)(u.pm * 256 + ai * 128 + wr * 64 + m * 16 + fr) * DM + colb;
                f32x4 x[2][2];
#pragma unroll
                for (int bj = 0; bj < 2; ++bj)
#pragma unroll
                    for (int n = 0; n < 2; ++n) x[bj][n] = *(const f32x4*)(bs + off + bj * 128 + n * 16);
#pragma unroll
                for (int bj = 0; bj < 2; ++bj)
#pragma unroll
                    for (int n = 0; n < 2; ++n) *(f32x4*)(out + off + bj * 128 + n * 16) = x[bj][n] + g[bj][n] * acc[ai][bj][m][n];
                asm volatile("" ::: "memory");
            }
    }
};
struct EpiGateUp {
    static constexpr bool PERM = true, AFTER_DRAIN = false;
    h16* ff;
    __device__ __forceinline__ void operator()(const f32x4 (&acc)[2][2][4][2], const pg8::Unit& u, int wr, int wc, int fr, int fq) const {
        const int row0 = u.pm * 256 + wr * 64 + fr, col0 = u.pn * 128 + wc * 32 + 8 * fq;
#pragma unroll
        for (int ai = 0; ai < 2; ++ai)
#pragma unroll
            for (int m = 0; m < 4; ++m) {
                f32x4 v0, v1;
#pragma unroll
                for (int j = 0; j < 4; ++j) { v0[j] = siluf_(acc[ai][0][m][0][j]) * acc[ai][1][m][0][j]; v1[j] = siluf_(acc[ai][0][m][1][j]) * acc[ai][1][m][1][j]; }
                u32x4 w; w.x = pkh(v0[0], v0[1]); w.y = pkh(v0[2], v0[3]); w.z = pkh(v1[0], v1[1]); w.w = pkh(v1[2], v1[3]);
                *(u32x4*)(ff + (size_t)(row0 + ai * 128 + m * 16) * DFF + col0) = w;
            }
    }
};

__device__ __forceinline__ void phase_mod_partial(const Params& p, LAS float* ldsf) {
    const int tidx = ltid();
    for (int e = tidx; e < 9 * 1024; e += NTHR) { const int c = e >> 10, k = e & 1023; const float v = c == 0 ? p.c_ctx[k] : p.cnd[(c - 1) * 1024 + k]; ldsf[e] = siluf_(v); }
    __syncthreads();
    float* modp = (float*)(p.ws + WS_MODP);
    const int wave = tidx >> 6, lane = tidx & 63;
    const int gw = blockIdx.x * NWV + wave, NGW = gridDim.x * NWV;
    for (int it = gw; it < 4 * 96 * 8; it += NGW) {
        const int kq = it & 7, cgp = (it >> 3) % 96, l = it / (8 * 96);
        const int j = cgp * 64 + lane;
        const float* w = p.w_mod + ((size_t)l * 1024 + kq * 128) * 6144 + j;
        float acc[9];
#pragma unroll
        for (int c = 0; c < 9; ++c) acc[c] = 0.f;
#pragma unroll 4
        for (int k4 = 0; k4 < 32; ++k4) {
            const float w0 = w[(size_t)(4 * k4 + 0) * 6144], w1 = w[(size_t)(4 * k4 + 1) * 6144], w2 = w[(size_t)(4 * k4 + 2) * 6144], w3 = w[(size_t)(4 * k4 + 3) * 6144];
#pragma unroll
            for (int c = 0; c < 9; ++c) { const f32x4 s = *(const LAS f32x4*)(ldsf + c * 1024 + kq * 128 + 4 * k4); acc[c] += s.x * w0 + s.y * w1 + s.z * w2 + s.w * w3; }
        }
#pragma unroll
        for (int c = 0; c < 9; ++c) modp[(((size_t)kq * 4 + l) * 9 + c) * 6144 + j] = acc[c];
    }
    if (blockIdx.x == 0) {
        float* lb = (float*)(p.ws + WS_LB);
        for (int e = tidx; e < 1024; e += NTHR) {
            const float x0 = p.lb_logits[e], x1 = p.lb_logits[1024 + e], x2 = p.lb_logits[2048 + e], x3 = p.lb_logits[3072 + e];
            const float mx = fmaxf(fmaxf(x0, x1), fmaxf(x2, x3));
            const float e0 = expf(x0 - mx), e1 = expf(x1 - mx), e2 = expf(x2 - mx), e3 = expf(x3 - mx);
            const float inv = 1.f / (e0 + e1 + e2 + e3);
            lb[e] = 0.f; lb[1024 + e] = e1 * inv; lb[2048 + e] = (e1 + e2) * inv; lb[3072 + e] = (e1 + e2 + e3) * inv;
        }
    }
}
__device__ __forceinline__ void phase_mod_reduce(const Params& p) {
    const float* modp = (const float*)(p.ws + WS_MODP); float* mod = (float*)(p.ws + WS_MOD);
    for (int e = blockIdx.x * NTHR + ltid(); e < 4 * 9 * 6144; e += gridDim.x * NTHR) {
        const int j = e % 6144, l = e / (9 * 6144);
        float s = p.b_mod[l * 6144 + j];
#pragma unroll
        for (int kq = 0; kq < 8; ++kq) s += modp[(size_t)kq * (4 * 9 * 6144) + e];
        mod[e] = s;
    }
}

__device__ __forceinline__ void transpose_item(const float* W, int K, int N, h16* WT, int kb, int n0, int dst_row0, LAS float* scr, int lane) {
    const int k0 = 64 * kb, n = n0 + (lane & 31);
#pragma unroll 8
    for (int i = 0; i < 32; ++i) { const int kk = 2 * i + (lane >> 5); scr[kk * 33 + (lane & 31)] = (n < N) ? W[(size_t)(k0 + kk) * N + n] : 0.f; }
    asm volatile("s_waitcnt lgkmcnt(0)" ::: "memory");
    const int c = lane & 7;
#pragma unroll
    for (int j = 0; j < 4; ++j) {
        const int nn = (lane >> 3) + 8 * j; const LAS float* s = scr + (8 * c) * 33 + nn;
        u32x4 o; o.x = pkh(s[0 * 33], s[1 * 33]); o.y = pkh(s[2 * 33], s[3 * 33]); o.z = pkh(s[4 * 33], s[5 * 33]); o.w = pkh(s[6 * 33], s[7 * 33]);
        *(u32x4*)(WT + (size_t)(dst_row0 + nn) * K + k0 + 8 * c) = o;
    }
    asm volatile("s_waitcnt lgkmcnt(0)" ::: "memory");
}
__device__ __forceinline__ void convert_weights(const Params& p, int l, LAS float* scr, int gw, int NGW, int lane) {
    {
        h16* wg = (h16*)(p.ws + WS_WG16);
        const float* src = p.w_in + (size_t)l * DM * NIN + NPROJ;
        for (int e = gw * 64 + lane; e < 16 * 1024; e += NGW * 64) { const int k = e >> 4, g = e & 15; wg[g * 1024 + k] = (h16)src[(size_t)k * NIN + g]; }
    }
    h16* win = (h16*)(p.ws + WS_WIN); h16* wout = (h16*)(p.ws + WS_WOUT); h16* wgu = (h16*)(p.ws + WS_WGU); h16* wdn = (h16*)(p.ws + WS_WDN);
    constexpr int I_IN = 16 * 144, I_OUT = 16 * 32, I_G = 16 * 88, I_DN = 44 * 32;
    for (int it = gw; it < I_IN + I_OUT + 2 * I_G + I_DN; it += NGW) {
        int r = it;
        if (r < I_IN) { const int kb = r / 144, nb = r % 144; transpose_item(p.w_in + (size_t)l * DM * NIN, DM, NIN, win, kb, 32 * nb, 32 * nb, scr, lane); continue; } r -= I_IN;
        if (r < I_OUT) { const int kb = r / 32, nb = r % 32; transpose_item(p.w_out + (size_t)l * DM * DM, DM, DM, wout, kb, 32 * nb, 32 * nb, scr, lane); continue; } r -= I_OUT;
        if (r < I_G) { const int kb = r / 88, nb = r % 88, n0 = 32 * nb; transpose_item(p.w_gate + (size_t)l * DM * DFF, DM, DFF, wgu, kb, n0, (n0 >> 7) * 256 + (n0 & 127), scr, lane); continue; } r -= I_G;
        if (r < I_G) { const int kb = r / 88, nb = r % 88, n0 = 32 * nb; transpose_item(p.w_up + (size_t)l * DM * DFF, DM, DFF, wgu, kb, n0, (n0 >> 7) * 256 + 128 + (n0 & 127), scr, lane); continue; } r -= I_G;
        { const int kb = r / 32, nb = r % 32; transpose_item(p.w_down + (size_t)l * DFF * DM, DFF, DM, wdn, kb, 32 * nb, 32 * nb, scr, lane); }
    }
}
__device__ __forceinline__ void norm_mod_row(const float* xrow, const float* nw, const float* sc, const float* sh, h16* orow, int lane) {
    const f32x4* xr = (const f32x4*)xrow + lane;
    f32x4 v[4]; float s = 0.f;
#pragma unroll
    for (int j = 0; j < 4; ++j) { v[j] = xr[64 * j]; s += (v[j].x * v[j].x + v[j].y * v[j].y) + (v[j].z * v[j].z + v[j].w * v[j].w); }
    const float rstd = rsqrtf(wave_sum(s) * (1.f / DM) + EPS);
#pragma unroll
    for (int j = 0; j < 4; ++j) {
        const int col = 4 * lane + 256 * j;
        const f32x4 w4 = *(const f32x4*)(nw + col), s4 = *(const f32x4*)(sc + col), h4 = *(const f32x4*)(sh + col);
        const f32x4 y = v[j] * rstd * w4 * (1.f + s4) + h4;
        uint2 o; o.x = pkh(y.x, y.y); o.y = pkh(y.z, y.w);
        *(uint2*)(orow + col) = o;
    }
}
__device__ __forceinline__ void phase_norm(const Params& p, int l, int which, bool from_inputs, int gw, int NGW, int lane) {
    const float* mod = (const float*)(p.ws + WS_MOD) + (size_t)l * 9 * 6144;
    const float* nw = (which == 0 ? p.n1w : p.n2w) + l * DM;
    h16* hn = (h16*)(p.ws + WS_HN);
    for (int r = gw; r < T_ALL; r += NGW) {
        const float* xrow = from_inputs ? (r < T_CTX ? p.x_prompt + (size_t)r * DM : p.x_sample + (size_t)(r - T_CTX) * DM) : p.out + (size_t)r * DM;
        const float* m = mod + row_cidx(r) * 6144 + which * 3072;
        norm_mod_row(xrow, nw, m + 1024, m, hn + (size_t)r * DM, lane);
    }
}
__device__ __forceinline__ void phase_final_norm(const Params& p, int gw, int NGW, int lane) {
    for (int r = gw; r < T_ALL; r += NGW) {
        f32x4* xr = (f32x4*)(p.out + (size_t)r * DM) + lane;
        f32x4 v[4]; float s = 0.f;
#pragma unroll
        for (int j = 0; j < 4; ++j) { v[j] = xr[64 * j]; s += (v[j].x * v[j].x + v[j].y * v[j].y) + (v[j].z * v[j].z + v[j].w * v[j].w); }
        const float rstd = rsqrtf(wave_sum(s) * (1.f / DM) + EPS);
#pragma unroll
        for (int j = 0; j < 4; ++j) { const f32x4 w4 = *(const f32x4*)(p.fin_w + 4 * lane + 256 * j); xr[64 * j] = v[j] * rstd * w4; }
    }
}
__device__ __forceinline__ void phase_gates(const Params& p, int l, int gw, int NGW, int lane) {
    const h16* hn = (const h16*)(p.ws + WS_HN); const h16* wg = (const h16*)(p.ws + WS_WG16);
    float* gates = (float*)(p.ws + WS_GATES);
    const int c = lane & 15, q = lane >> 4;
    for (int grp = gw; grp < T_ALL / 16; grp += NGW) {
        const h16* ar = hn + (size_t)(16 * grp + c) * DM + 8 * q;
        const h16* br = wg + (size_t)c * DM + 8 * q;
        f32x4 acc = {0.f, 0.f, 0.f, 0.f};
#pragma unroll 8
        for (int kp = 0; kp < 32; ++kp) {
            const h16x8 a = *(const h16x8*)(ar + 32 * kp), bq = *(const h16x8*)(br + 32 * kp);
            acc = __builtin_amdgcn_mfma_f32_16x16x32_f16(a, bq, acc, 0, 0, 0);
        }
        const float bias = p.gate_b[l * 16 + c];
#pragma unroll
        for (int j = 0; j < 4; ++j) gates[(size_t)(16 * grp + 4 * q + j) * 16 + c] = acc[j] + bias;
    }
}
__device__ __forceinline__ void phase_conv(const Params& p, int l) {
    const h16* proj = (const h16*)(p.ws + WS_PROJ); h16* qkm = (h16*)(p.ws + WS_QKM);
    const float* cw = p.conv_w + (size_t)l * 9 * 1024; const float* cb = p.conv_b + l * 1024;
    for (int idx = blockIdx.x * NTHR + ltid(); idx < T_ALL * 128; idx += gridDim.x * NTHR) {
        const int r = idx >> 7, ch0 = (idx & 127) * 8;
        float acc[8];
        { const f32x4 b0 = *(const f32x4*)(cb + ch0), b1 = *(const f32x4*)(cb + ch0 + 4); acc[0] = b0.x; acc[1] = b0.y; acc[2] = b0.z; acc[3] = b0.w; acc[4] = b1.x; acc[5] = b1.y; acc[6] = b1.z; acc[7] = b1.w; }
        const h16* src = proj + 2560 + ch0;
        const bool lat = r >= T_CTX;
        const int pp = lat ? ((r - T_CTX) & 2047) : (r & 255);
        const int gy = lat ? (pp >> 6) : 0, gx = lat ? (pp & 63) : pp;
        const int H = lat ? 32 : 1, W = lat ? 64 : 256;
#pragma unroll
        for (int a = 0; a < 3; ++a) {
            const int yy = gy + a - 1;
            if (!lat && a != 1) continue;
            if (yy < 0 || yy >= H) continue;
#pragma unroll
            for (int b = 0; b < 3; ++b) {
                const int xx = gx + b - 1;
                if (xx < 0 || xx >= W) continue;
                const int rr = r + (a - 1) * 64 + (b - 1);
                const h16x8 x = *(const h16x8*)(src + (size_t)rr * NPROJ);
                const f32x4 t0 = *(const f32x4*)(cw + (a * 3 + b) * 1024 + ch0), t1 = *(const f32x4*)(cw + (a * 3 + b) * 1024 + ch0 + 4);
                acc[0] += t0.x * (float)x[0]; acc[1] += t0.y * (float)x[1]; acc[2] += t0.z * (float)x[2]; acc[3] += t0.w * (float)x[3];
                acc[4] += t1.x * (float)x[4]; acc[5] += t1.y * (float)x[5]; acc[6] += t1.z * (float)x[6]; acc[7] += t1.w * (float)x[7];
            }
        }
        const float sc = ch0 >= 512 ? 0.08838834764831845f : 1.f;
        u32x4 w; w.x = pkh(siluf_(acc[0]) * sc, siluf_(acc[1]) * sc); w.y = pkh(siluf_(acc[2]) * sc, siluf_(acc[3]) * sc);
        w.z = pkh(siluf_(acc[4]) * sc, siluf_(acc[5]) * sc); w.w = pkh(siluf_(acc[6]) * sc, siluf_(acc[7]) * sc);
        *(u32x4*)(qkm + (size_t)r * DM + ch0) = w;
    }
}

template <int TYPE  , int CMP = 0>
__device__ __forceinline__ void scan_item(const Params& p, int l, int lat, int b, int h, int dir, LAS float* lds) {
    const int tid = ltid(), lane = tid & 63, w = __builtin_amdgcn_readfirstlane(tid >> 6);
    const int L = lat ? 2048 : 256, row0 = lat ? T_CTX + b * 2048 : b * 256, NB = L / 16;
    LAS float* qs = lds;
    LAS float* fs = lds + 2048;
    LAS float* vs = lds + 4096;
    LAS float* part = lds + 6144;
    LAS float* partn = lds + 6144 + 16384;
    LAS float* scal = partn + 128;
    LAS float* mst = scal + 128;
    LAS float* cerr = mst + 16;
    LAS float* cref = cerr + 32;
    const h16* proj = (const h16*)(p.ws + WS_PROJ); const h16* qkm = (const h16*)(p.ws + WS_QKM); const float* gates = (const float*)(p.ws + WS_GATES);
    h16* odst = (h16*)(p.ws + (ODIR(dir) ? WS_OB : WS_HN));
    const size_t sidx = (((size_t)b * 4 + l) * 2 + dir) * 4 + h;
    if (CMP) { if (tid < 64) cerr[tid] = 0.f; __syncthreads(); }

    f32x2 S[16]; float nv = 0.f;
    if (lat) {
        const float* src = (TYPE == 0 ? p.st_hg : p.st_mc) + sidx * 16384;
#pragma unroll
        for (int dd = 0; dd < 16; ++dd) S[dd] = *(const f32x2*)(src + (16 * w + dd) * 128 + 2 * lane);
        if (TYPE == 1) { nv = lane < 16 ? p.st_mn[sidx * 128 + 16 * w + lane] : 0.f; if (tid == 0) mst[0] = p.st_mm[sidx]; }
    } else {
#pragma unroll
        for (int dd = 0; dd < 16; ++dd) S[dd] = (f32x2){0.f, 0.f};
        if (TYPE == 1 && tid == 0) mst[0] = 0.f;
    }
    const int tl = tid >> 5, d0 = 4 * (tid & 31);
    f32x4 lb4 = {0.f, 0.f, 0.f, 0.f};
    if (TYPE == 0) lb4 = *(const f32x4*)((const float*)(p.ws + WS_LB) + (l * 2 + dir) * 512 + h * 128 + d0);
    h16x4 pq, pz, pv; float pgi = 0.f, pgf = 0.f;
#define SCAN_LOAD(ii) do { const int pos_ = 16 * (ii) + tl, tok_ = dir ? L - 1 - pos_ : pos_; const size_t r_ = (size_t)(row0 + tok_); \
        if (TYPE == 0) { pq = *(const h16x4*)(proj + r_ * NPROJ + h * 128 + d0); pz = *(const h16x4*)(proj + r_ * NPROJ + 512 + dir * 512 + h * 128 + d0); pv = *(const h16x4*)(proj + r_ * NPROJ + 1536 + h * 128 + d0); } \
        else { pq = *(const h16x4*)(qkm + r_ * DM + h * 128 + d0); pz = *(const h16x4*)(qkm + r_ * DM + 512 + h * 128 + d0); pv = *(const h16x4*)(proj + r_ * NPROJ + 3584 + h * 128 + d0); \
               if (w == 0) { const int ps_ = 16 * (ii) + (lane & 15), tk_ = dir ? L - 1 - ps_ : ps_; const float* g_ = gates + (size_t)(row0 + tk_) * 16; pgi = g_[dir * 4 + h]; pgf = g_[8 + dir * 4 + h]; } } } while (0)
    SCAN_LOAD(0);
    for (int i = 0; i < NB; ++i) {
        const int par = i & 1;
        const int pos = 16 * i + tl, tok = dir ? L - 1 - pos : pos;
        const size_t r = (size_t)(row0 + tok);
        {
            *(LAS f32x4*)(qs + tl * 128 + d0) = (f32x4){(float)pq[0], (float)pq[1], (float)pq[2], (float)pq[3]};
            *(LAS f32x4*)(vs + tl * 128 + d0) = (f32x4){(float)pv[0], (float)pv[1], (float)pv[2], (float)pv[3]};
            if (TYPE == 0) {
                f32x4 f4;
#pragma unroll
                for (int j = 0; j < 4; ++j) f4[j] = lb4[j] + (1.f - lb4[j]) * sigmoidf_((float)pz[j]);
                *(LAS f32x4*)(fs + tl * 128 + d0) = f4;
            } else {
                *(LAS f32x4*)(fs + tl * 128 + d0) = (f32x4){(float)pz[0], (float)pz[1], (float)pz[2], (float)pz[3]};
                if (w == 0) {
                    const int t = lane & 15;
                    const float m0 = mst[0];
                    const float gi = pgi, lf = fminf(pgf, 0.f) - log1pf(__expf(-fabsf(pgf)));
                    float bc = lf;
#pragma unroll
                    for (int o = 1; o < 16; o <<= 1) { const float x = __shfl_up(bc, o, 16); if (t >= o) bc += x; }
                    float pm = gi - bc;
#pragma unroll
                    for (int o = 1; o < 16; o <<= 1) { const float x = __shfl_up(pm, o, 16); if (t >= o) pm = fmaxf(pm, x); }
                    const float mt = bc + fmaxf(m0, pm);
                    float mp = __shfl_up(mt, 1, 16); if (t == 0) mp = m0;
                    if (lane < 16) {
                        scal[(par * 16 + t) * 4 + 0] = __expf(lf + mp - mt);
                        scal[(par * 16 + t) * 4 + 1] = __expf(gi - mt);
                        scal[(par * 16 + t) * 4 + 2] = __expf(-mt);
                    }
                    asm volatile("s_waitcnt lgkmcnt(0)" ::: "memory");
                    if (lane == 15) mst[0] = mt;
                }
            }
        }
        if (i + 1 < NB) SCAN_LOAD(i + 1);
        __syncthreads();
#pragma unroll 2
        for (int t = 0; t < 16; ++t) {
            float fv = 0.f, qv = 0.f;
            if (lane < 16) { fv = fs[t * 128 + 16 * w + lane]; qv = qs[t * 128 + 16 * w + lane]; }
            const f32x2 v2 = *(const LAS f32x2*)(vs + t * 128 + 2 * lane);
            f32x2 o = {0.f, 0.f};
            if (TYPE == 0) {
#pragma unroll
                for (int dd = 0; dd < 16; ++dd) { const float sf = rdlane(fv, dd), sq = rdlane(qv, dd); S[dd] = v2 + sf * (S[dd] - v2); o += S[dd] * sq; }
            } else {
                const float a = __builtin_bit_cast(float, __builtin_amdgcn_readfirstlane(__builtin_bit_cast(int, scal[(par * 16 + t) * 4 + 0])));
                const float g = __builtin_bit_cast(float, __builtin_amdgcn_readfirstlane(__builtin_bit_cast(int, scal[(par * 16 + t) * 4 + 1])));
                const float gk = g * fv;
                nv = a * nv + gk;
                float nq = nv * qv;
                nq += __shfl_xor(nq, 8); nq += __shfl_xor(nq, 4); nq += __shfl_xor(nq, 2); nq += __shfl_xor(nq, 1);
                if (lane == 0) partn[t * 8 + w] = nq;
#pragma unroll
                for (int dd = 0; dd < 16; ++dd) { const float sk = rdlane(gk, dd), sq = rdlane(qv, dd); S[dd] = a * S[dd] + sk * v2; o += S[dd] * sq; }
            }
            *(LAS f32x2*)(part + (t * 8 + w) * 128 + 2 * lane) = o;
        }
        __syncthreads();
        {
            f32x4 acc = {0.f, 0.f, 0.f, 0.f};
#pragma unroll
            for (int ww = 0; ww < 8; ++ww) acc += *(const LAS f32x4*)(part + (tl * 8 + ww) * 128 + d0);
            if (TYPE == 1) {
                float den = 0.f;
#pragma unroll
                for (int ww = 0; ww < 8; ++ww) den += partn[tl * 8 + ww];
                const float sc = 1.f / fmaxf(fabsf(den), scal[(par * 16 + tl) * 4 + 2]);
                acc = acc * sc;
            }
            uint2 o; o.x = pkh(acc.x, acc.y); o.y = pkh(acc.z, acc.w);
            if (CMP) {
                const h16x4 old = *(const h16x4*)(odst + r * DM + TYPE * 512 + h * 128 + d0);
                float e = 0.f, rr = 0.f;
#pragma unroll
                for (int j = 0; j < 4; ++j) { const float df = (float)old[j] - acc[j]; e += df * df; rr += acc[j] * acc[j]; }
                e = wave_sum(e); rr = wave_sum(rr);
                if (lane == 0) { atomicAdd((float*)(cerr + (i >> 2)), e); atomicAdd((float*)(cref + (i >> 2)), rr); }
            }
            *(uint2*)(odst + r * DM + TYPE * 512 + h * 128 + d0) = o;
        }
    }
    if (CMP) {
        __syncthreads();
        if (tid == 0) {
            float best = -1.f; int bc_ = 0; float tot_e = 0.f, tot_r = 0.f;
            for (int cI = 0; cI < 32; ++cI) { const float rt = cerr[cI] / fmaxf(cref[cI], 1e-30f); tot_e += cerr[cI]; tot_r += cref[cI]; if (rt > best) { best = rt; bc_ = cI; } }
            float* dg = (float*)(p.ws + WS_MODP) + 4 * blockIdx.x;
#if defined(DIAG_ALL)
            const float tot = tot_e / fmaxf(tot_r, 1e-30f);
            if (tot > dg[0]) { dg[0] = tot; dg[1] = (float)(l * 8 + TYPE * 4 + lat * 2 + dir); dg[2] = best; dg[3] = (float)bc_; }
#else
            dg[0] = best; dg[1] = (float)bc_; dg[2] = tot_e / fmaxf(tot_r, 1e-30f); dg[3] = 0.f;
#endif
        }
    }
    if (!lat) {
        float* dst = p.out + (TYPE == 0 ? OUT_HG : OUT_MC) + sidx * 16384;
#pragma unroll
        for (int dd = 0; dd < 16; ++dd) *(f32x2*)(dst + (16 * w + dd) * 128 + 2 * lane) = S[dd];
        if (TYPE == 1) { if (lane < 16) p.out[OUT_MN + sidx * 128 + 16 * w + lane] = nv; if (tid == 0) p.out[OUT_MM + sidx] = mst[0]; }
    }
    __syncthreads();
#undef SCAN_LOAD
}
typedef unsigned u32x2 __attribute__((ext_vector_type(2)));
typedef short s16x8 __attribute__((ext_vector_type(8)));
typedef short s16x4 __attribute__((ext_vector_type(4)));
typedef __bf16 bf16x2_t __attribute__((ext_vector_type(2)));
__device__ __forceinline__ unsigned pkb(float a, float b) { f32x2 v = {a, b}; bf16x2_t r = __builtin_convertvector(v, bf16x2_t); return __builtin_bit_cast(unsigned, r); }
__device__ __forceinline__ unsigned short f2b(float a) { return (unsigned short)(pkb(a, 0.f) & 0xffffu); }
__device__ __forceinline__ s16x4 tr_read(LAS const unsigned char* ptr) { return __builtin_bit_cast(s16x4, __builtin_amdgcn_ds_read_tr16_b64_v4i16((LAS s16x4*)ptr)); }
constexpr int HP = 272;
__device__ __forceinline__ void scan_hgrn_mfma(const Params& p, int l, int lat, int b, int h, int dir, LAS unsigned char* lds) {
    const int tid = ltid(), lane = tid & 63, w = __builtin_amdgcn_readfirstlane(tid >> 6), c = lane & 15, q = lane >> 4;
    const int L = lat ? 2048 : 256, row0 = lat ? T_CTX + b * 2048 : b * 256, NB = L / 16;
    constexpr int IMG = 16 * HP, BUF = 4 * IMG + 512;
    LAS float* GS = (LAS float*)(lds + 2 * BUF);
    const h16* proj = (const h16*)(p.ws + WS_PROJ);
    h16* odst = (h16*)(p.ws + (ODIR(dir) ? WS_OB : WS_HN));
    const size_t sidx = (((size_t)b * 4 + l) * 2 + dir) * 4 + h;
    f32x4 S[8];
    if (lat) {
        const float* src = p.st_hg + sidx * 16384;
#pragma unroll
        for (int dt = 0; dt < 8; ++dt)
#pragma unroll
            for (int j = 0; j < 4; ++j) S[dt][j] = src[(16 * dt + 4 * q + j) * 128 + 16 * w + c];
    } else {
#pragma unroll
        for (int dt = 0; dt < 8; ++dt) S[dt] = (f32x4){0.f, 0.f, 0.f, 0.f};
    }
    const int pt = lane & 15, d0 = 16 * w + 4 * (lane >> 4);
    const f32x4 lb4 = *(const f32x4*)((const float*)(p.ws + WS_LB) + (l * 2 + dir) * 512 + h * 128 + d0);
    h16x4 rq, rz, rv;
#define HG_LOAD(ii) do { const int pos_ = 16 * (ii) + pt, tok_ = dir ? L - 1 - pos_ : pos_; const h16* r_ = proj + (size_t)(row0 + tok_) * NPROJ + h * 128 + d0; \
        rq = *(const h16x4*)(r_); rz = *(const h16x4*)(r_ + 512 + dir * 512); rv = *(const h16x4*)(r_ + 1536); } while (0)
#define HG_ROW_SHR(x, ctl) __builtin_bit_cast(float, __builtin_amdgcn_update_dpp(0, __builtin_bit_cast(int, (x)), (ctl), 0xF, 0xF, false))
    HG_LOAD(0);
    u32x2 o_prev = {0u, 0u}; h16* o_ptr = odst;
    for (int i = 0; i < NB; ++i) {
        LAS unsigned char* buf = lds + (i & 1) * BUF;
        LAS unsigned char* QT = buf; LAS unsigned char* KT = buf + IMG; LAS unsigned char* KH = buf + 2 * IMG; LAS unsigned char* VV = buf + 3 * IMG; LAS float* AD = (LAS float*)(buf + 4 * IMG);
        asm volatile("s_waitcnt vmcnt(0)" ::: "memory");
        if (i > 0) *(u32x2*)o_ptr = o_prev;
        {
            float kk[4], G[4];
#pragma unroll
            for (int j = 0; j < 4; ++j) { const float f = lb4[j] + (1.f - lb4[j]) * sigmoidf_((float)rz[j]); kk[j] = 1.f - f; G[j] = __logf(f); }
#pragma unroll
            for (int j = 0; j < 4; ++j) {
                G[j] += HG_ROW_SHR(G[j], 0x111); G[j] += HG_ROW_SHR(G[j], 0x112); G[j] += HG_ROW_SHR(G[j], 0x114); G[j] += HG_ROW_SHR(G[j], 0x118);
            }
            float oq[4], ok[4], oh[4];
            float ev[4];
#pragma unroll
            for (int j = 0; j < 4; ++j) {
                const float e = __expf(G[j]), ei = __builtin_amdgcn_rcpf(fmaxf(e, 8.7565e-27f)); ev[j] = e;
                const float et = __builtin_bit_cast(float, __builtin_amdgcn_update_dpp(0, __builtin_bit_cast(int, e), 0x15F, 0xF, 0xF, false));
                oq[j] = (float)rq[j] * e; ok[j] = kk[j] * ei; oh[j] = kk[j] * (et * ei);
            }
            u32x2 wq, wk, wh, wv;
            wq.x = pkb(oq[0], oq[1]); wq.y = pkb(oq[2], oq[3]); wk.x = pkb(ok[0], ok[1]); wk.y = pkb(ok[2], ok[3]);
            wh.x = pkb(oh[0], oh[1]); wh.y = pkb(oh[2], oh[3]); wv.x = pkb((float)rv[0], (float)rv[1]); wv.y = pkb((float)rv[2], (float)rv[3]);
            *(LAS u32x2*)(QT + pt * HP + 2 * d0) = wq; *(LAS u32x2*)(KT + pt * HP + 2 * d0) = wk; *(LAS u32x2*)(KH + pt * HP + 2 * d0) = wh; *(LAS u32x2*)(VV + pt * HP + 2 * d0) = wv;
            if (pt == 15) *(LAS f32x4*)(AD + d0) = (f32x4){ev[0], ev[1], ev[2], ev[3]};
        }
        { const int nx = (i + 1 < NB) ? i + 1 : NB - 1; HG_LOAD(nx); }
        __syncthreads();
        {
            f32x4 accO = {0.f, 0.f, 0.f, 0.f};
#pragma unroll
            for (int kp = 0; kp < 4; ++kp) {
                u32x4 sa; sa.x = pkb(S[2 * kp][0], S[2 * kp][1]); sa.y = pkb(S[2 * kp][2], S[2 * kp][3]); sa.z = pkb(S[2 * kp + 1][0], S[2 * kp + 1][1]); sa.w = pkb(S[2 * kp + 1][2], S[2 * kp + 1][3]);
                const u32x2 b0 = *(const LAS u32x2*)(QT + c * HP + 2 * (32 * kp + 4 * q)), b1 = *(const LAS u32x2*)(QT + c * HP + 2 * (32 * kp + 16 + 4 * q));
                u32x4 bb; bb.x = b0.x; bb.y = b0.y; bb.z = b1.x; bb.w = b1.y;
                accO = __builtin_amdgcn_mfma_f32_16x16x32_bf16(__builtin_bit_cast(s16x8, sa), __builtin_bit_cast(s16x8, bb), accO, 0, 0, 0);
            }
            f32x4 accP = {0.f, 0.f, 0.f, 0.f};
#pragma unroll
            for (int kp = 0; kp < 4; ++kp) {
                const s16x8 a = *(const LAS s16x8*)(KT + c * HP + 2 * (32 * kp + 8 * q));
                const s16x8 bq = *(const LAS s16x8*)(QT + c * HP + 2 * (32 * kp + 8 * q));
                accP = __builtin_amdgcn_mfma_f32_16x16x32_bf16(a, bq, accP, 0, 0, 0);
            }
#pragma unroll
            for (int j = 0; j < 4; ++j) accP[j] = (4 * q + j > c) ? 0.f : accP[j];
            u32x2 pb; pb.x = pkb(accP[0], accP[1]); pb.y = pkb(accP[2], accP[3]);
            const s16x4 vtr = tr_read(VV + (4 * q + (c >> 2)) * HP + 2 * (16 * w + 4 * (c & 3)));
            accO = __builtin_amdgcn_mfma_f32_16x16x16bf16_1k(vtr, __builtin_bit_cast(s16x4, pb), accO, 0, 0, 0);
            {
                const int pos = 16 * i + c, tok = dir ? L - 1 - pos : pos;
                o_prev.x = pkh(accO[0], accO[1]); o_prev.y = pkh(accO[2], accO[3]);
                o_ptr = odst + (size_t)(row0 + tok) * DM + h * 128 + 16 * w + 4 * q;
            }
#pragma unroll
            for (int dt = 0; dt < 8; ++dt) {
                const s16x4 ktr = tr_read(KH + (4 * q + (c >> 2)) * HP + 2 * (16 * dt + 4 * (c & 3)));
                const f32x4 ad = *(const LAS f32x4*)(AD + 16 * dt + 4 * q);
                S[dt] = S[dt] * ad;
                S[dt] = __builtin_amdgcn_mfma_f32_16x16x16bf16_1k(ktr, vtr, S[dt], 0, 0, 0);
            }
        }
#if defined(HG_EXTRA_SYNC)
        asm volatile("s_waitcnt vmcnt(0) lgkmcnt(0)" ::: "memory");
        __syncthreads();
#endif
    }
    *(u32x2*)o_ptr = o_prev;
    if (!lat) {
        float* dst = p.out + OUT_HG + sidx * 16384;
#pragma unroll
        for (int dt = 0; dt < 8; ++dt)
#pragma unroll
            for (int j = 0; j < 4; ++j) dst[(16 * dt + 4 * q + j) * 128 + 16 * w + c] = S[dt][j];
    }
    __syncthreads();
#undef HG_LOAD
#undef HG_ROW_SHR
}
constexpr int MP = 272;
constexpr int PP = 144;
__device__ __forceinline__ void scan_mlstm_mfma(const Params& p, int l, int lat, int b, int h, int dir, LAS unsigned char* lds) {
    const int tid = ltid(), lane = tid & 63, w = __builtin_amdgcn_readfirstlane(tid >> 6), c = lane & 15, q = lane >> 4;
    const int L = lat ? 2048 : 256, row0 = lat ? T_CTX + b * 2048 : b * 256, NC = L / 64;
    constexpr int IMG = 64 * MP, BUF = 3 * IMG + 1536;
    LAS unsigned char* PM = lds + 2 * BUF;
    LAS float* DENP = (LAS float*)(PM + 64 * PP);
    LAS float* QNP = DENP + 256;
    LAS float* NP = QNP + 512;
    LAS float* NV = NP + 512;
    LAS float* mst = NV + 128;
    const h16* proj = (const h16*)(p.ws + WS_PROJ); const h16* qkm = (const h16*)(p.ws + WS_QKM); const float* gates = (const float*)(p.ws + WS_GATES);
    h16* odst = (h16*)(p.ws + (ODIR(dir) ? WS_OB : WS_HN));
    const size_t sidx = (((size_t)b * 4 + l) * 2 + dir) * 4 + h;
    f32x4 C[8];
    if (lat) {
        const float* src = p.st_mc + sidx * 16384;
#pragma unroll
        for (int dt = 0; dt < 8; ++dt)
#pragma unroll
            for (int j = 0; j < 4; ++j) C[dt][j] = src[(16 * dt + 4 * q + j) * 128 + 16 * w + c];
        if (tid < 128) NV[tid] = p.st_mn[sidx * 128 + tid];
        if (tid == 0) mst[0] = p.st_mm[sidx];
    } else {
#pragma unroll
        for (int dt = 0; dt < 8; ++dt) C[dt] = (f32x4){0.f, 0.f, 0.f, 0.f};
        if (tid < 128) NV[tid] = 0.f;
        if (tid == 0) mst[0] = 0.f;
    }
    u32x4 pq[2], pk[2], pv[2]; float pgi = 0.f, pgf = 0.f;
#define ML_LOAD(ii) do { _Pragma("unroll") for (int j_ = 0; j_ < 2; ++j_) { const int e_ = tid + 512 * j_, rw_ = e_ >> 4, pc_ = e_ & 15; const int pos_ = 64 * (ii) + rw_, tok_ = dir ? L - 1 - pos_ : pos_; \
            const size_t r_ = (size_t)(row0 + tok_); pq[j_] = *(const u32x4*)(qkm + r_ * DM + h * 128 + 8 * pc_); pk[j_] = *(const u32x4*)(qkm + r_ * DM + 512 + h * 128 + 8 * pc_); \
            pv[j_] = *(const u32x4*)(proj + r_ * NPROJ + 3584 + h * 128 + 8 * pc_); } \
        if (w == 0) { const int ps_ = 64 * (ii) + lane, tk_ = dir ? L - 1 - ps_ : ps_; const float* g_ = gates + (size_t)(row0 + tk_) * 16; pgi = g_[dir * 4 + h]; pgf = g_[8 + dir * 4 + h]; } } while (0)
    ML_LOAD(0);
    for (int i = 0; i < NC; ++i) {
        LAS unsigned char* buf = lds + (i & 1) * BUF;
        LAS unsigned char* QM = buf; LAS unsigned char* KM = buf + IMG; LAS unsigned char* VM = buf + 2 * IMG;
        LAS float* U = (LAS float*)(buf + 3 * IMG); LAS float* MM = U + 64; LAS float* AI = U + 128; LAS float* EN = U + 192; LAS float* UE = U + 256;
        asm volatile("s_waitcnt vmcnt(0)" ::: "memory");
#pragma unroll
        for (int j = 0; j < 2; ++j) { const int e = tid + 512 * j, rw = e >> 4, pc = e & 15;
            *(LAS u32x4*)(QM + rw * MP + 16 * pc) = pq[j]; *(LAS u32x4*)(KM + rw * MP + 16 * pc) = pk[j]; *(LAS u32x4*)(VM + rw * MP + 16 * pc) = pv[j]; }
        if (w == 0) {
            const float m0 = mst[0];
            const float gi = pgi, lf = fminf(pgf, 0.f) - log1pf(__expf(-fabsf(pgf)));
            float bc = lf;
#pragma unroll
            for (int o = 1; o < 64; o <<= 1) { const float x = __shfl_up(bc, o); if (lane >= o) bc += x; }
            const float u = gi - bc;
            float pm = u;
#pragma unroll
            for (int o = 1; o < 64; o <<= 1) { const float x = __shfl_up(pm, o); if (lane >= o) pm = fmaxf(pm, x); }
            const float Mt = fmaxf(m0, pm);
            const float M63 = rdlane(Mt, 63), bc63 = rdlane(bc, 63);
            U[lane] = u; MM[lane] = Mt; AI[lane] = __expf(m0 - Mt); EN[lane] = __expf(-(bc + Mt)); UE[lane] = __expf(u - M63);
            asm volatile("s_waitcnt lgkmcnt(0)" ::: "memory");
            if (lane == 0) mst[0] = bc63 + M63;
        }
        { const int nx = (i + 1 < NC) ? i + 1 : NC - 1; ML_LOAD(nx); }
        __syncthreads();
        {
            const int tt = w >> 1;
#pragma unroll
            for (int k2 = 0; k2 < 2; ++k2) {
                const int st = 2 * (w & 1) + k2;
                if (st <= tt) {
                    f32x4 accP = {0.f, 0.f, 0.f, 0.f};
#pragma unroll
                    for (int kp = 0; kp < 4; ++kp) {
                        const h16x8 a = *(const LAS h16x8*)(KM + (16 * st + c) * MP + 2 * (32 * kp + 8 * q));
                        const h16x8 bq = *(const LAS h16x8*)(QM + (16 * tt + c) * MP + 2 * (32 * kp + 8 * q));
                        accP = __builtin_amdgcn_mfma_f32_16x16x32_f16(a, bq, accP, 0, 0, 0);
                    }
                    const f32x4 u4 = *(const LAS f32x4*)(U + 16 * st + 4 * q); const float mt = MM[16 * tt + c];
                    float pj[4];
#pragma unroll
                    for (int j = 0; j < 4; ++j) { const float e = accP[j] * __expf(u4[j] - mt); pj[j] = (16 * st + 4 * q + j <= 16 * tt + c) ? e : 0.f; }
                    u32x2 pw; pw.x = pkh(pj[0], pj[1]); pw.y = pkh(pj[2], pj[3]);
                    *(LAS u32x2*)(PM + (16 * tt + c) * PP + 2 * (16 * st + 4 * q)) = pw;
                    float cs = (pj[0] + pj[1]) + (pj[2] + pj[3]);
                    cs += __shfl_xor(cs, 16); cs += __shfl_xor(cs, 32);
                    if (q == 0) DENP[st * 64 + 16 * tt + c] = cs;
                }
            }
            {
                const h16x8 qa = *(const LAS h16x8*)(QM + lane * MP + 2 * (16 * w)), qb = *(const LAS h16x8*)(QM + lane * MP + 2 * (16 * w + 8));
                const f32x4 n0 = *(const LAS f32x4*)(NV + 16 * w), n1 = *(const LAS f32x4*)(NV + 16 * w + 4), n2 = *(const LAS f32x4*)(NV + 16 * w + 8), n3 = *(const LAS f32x4*)(NV + 16 * w + 12);
                float s = 0.f;
#pragma unroll
                for (int j = 0; j < 4; ++j) s += (float)qa[j] * n0[j] + (float)qa[4 + j] * n1[j] + (float)qb[j] * n2[j] + (float)qb[4 + j] * n3[j];
                QNP[w * 64 + lane] = s;
            }
            {
                const int d = tid & 127, part = tid >> 7;
                float s = 0.f;
#pragma unroll
                for (int ss = 0; ss < 16; ++ss) s += UE[16 * part + ss] * (float)*(const LAS h16*)(KM + (16 * part + ss) * MP + 2 * d);
                NP[part * 128 + d] = s;
            }
        }
        __syncthreads();
        {
            h16x4 vtr[4];
#pragma unroll
            for (int st = 0; st < 4; ++st) vtr[st] = __builtin_bit_cast(h16x4, tr_read(VM + (16 * st + 4 * q + (c >> 2)) * MP + 2 * (16 * w + 4 * (c & 3))));
            h16x8 cp[4];
#pragma unroll
            for (int kp = 0; kp < 4; ++kp) { u32x4 sa; sa.x = pkh(C[2 * kp][0], C[2 * kp][1]); sa.y = pkh(C[2 * kp][2], C[2 * kp][3]); sa.z = pkh(C[2 * kp + 1][0], C[2 * kp + 1][1]); sa.w = pkh(C[2 * kp + 1][2], C[2 * kp + 1][3]); cp[kp] = __builtin_bit_cast(h16x8, sa); }
#pragma unroll
            for (int tt = 0; tt < 4; ++tt) {
                const int t = 16 * tt + c;
                f32x4 accI = {0.f, 0.f, 0.f, 0.f}, accN = {0.f, 0.f, 0.f, 0.f};
#pragma unroll
                for (int kp = 0; kp < 4; ++kp) {
                    const u32x2 b0 = *(const LAS u32x2*)(QM + t * MP + 2 * (32 * kp + 4 * q)), b1 = *(const LAS u32x2*)(QM + t * MP + 2 * (32 * kp + 16 + 4 * q));
                    u32x4 bb; bb.x = b0.x; bb.y = b0.y; bb.z = b1.x; bb.w = b1.y;
                    accI = __builtin_amdgcn_mfma_f32_16x16x32_f16(cp[kp], __builtin_bit_cast(h16x8, bb), accI, 0, 0, 0);
                }
                float den = 0.f;
#pragma unroll
                for (int st = 0; st < 4; ++st) if (st <= tt) {
                    const u32x2 pb = *(const LAS u32x2*)(PM + t * PP + 2 * (16 * st + 4 * q));
                    accN = __builtin_amdgcn_mfma_f32_16x16x16f16(vtr[st], __builtin_bit_cast(h16x4, pb), accN, 0, 0, 0);
                    den += DENP[st * 64 + t];
                }
                float qn = 0.f;
#pragma unroll
                for (int ww = 0; ww < 8; ++ww) qn += QNP[ww * 64 + t];
                const float ai = AI[t];
                den += ai * qn;
                const float sc = 1.f / fmaxf(fabsf(den), EN[t]);
                f32x4 hv = (accN + accI * ai) * sc;
#pragma unroll
                for (int j = 0; j < 4; ++j) hv[j] = fminf(fmaxf(hv[j], -60000.f), 60000.f);
                const int pos = 64 * i + t, tok = dir ? L - 1 - pos : pos;
                u32x2 o; o.x = pkh(hv[0], hv[1]); o.y = pkh(hv[2], hv[3]);
                *(u32x2*)(odst + (size_t)(row0 + tok) * DM + 512 + h * 128 + 16 * w + 4 * q) = o;
            }
            const float a63 = AI[63];
            h16x4 vs[4];
#pragma unroll
            for (int st = 0; st < 4; ++st) { const f32x4 ue4 = *(const LAS f32x4*)(UE + 16 * st + 4 * q);
#pragma unroll
                for (int j = 0; j < 4; ++j) vs[st][j] = (h16)((float)vtr[st][j] * ue4[j]); }
#pragma unroll
            for (int dt = 0; dt < 8; ++dt) {
                C[dt] = C[dt] * a63;
#pragma unroll
                for (int st = 0; st < 4; ++st) {
                    const h16x4 ktr = __builtin_bit_cast(h16x4, tr_read(KM + (16 * st + 4 * q + (c >> 2)) * MP + 2 * (16 * dt + 4 * (c & 3))));
                    C[dt] = __builtin_amdgcn_mfma_f32_16x16x16f16(ktr, vs[st], C[dt], 0, 0, 0);
                }
            }
            if (tid < 128) NV[tid] = a63 * NV[tid] + (NP[tid] + NP[128 + tid]) + (NP[256 + tid] + NP[384 + tid]);
        }
#if defined(ML_EXTRA_SYNC)
        asm volatile("s_waitcnt vmcnt(0) lgkmcnt(0)" ::: "memory");
        __syncthreads();
#endif
    }
    __syncthreads();
    if (!lat) {
        float* dst = p.out + OUT_MC + sidx * 16384;
#pragma unroll
        for (int dt = 0; dt < 8; ++dt)
#pragma unroll
            for (int j = 0; j < 4; ++j) dst[(16 * dt + 4 * q + j) * 128 + 16 * w + c] = C[dt][j];
        if (tid < 128) p.out[OUT_MN + sidx * 128 + tid] = NV[tid];
        if (tid == 0) p.out[OUT_MM + sidx] = mst[0];
    }
    __syncthreads();
#undef ML_LOAD
}
#if defined(DIAG_ALL)
#define SCAN_HG(p, l, lat, b, h, dir, lds) do { scan_hgrn_mfma(p, l, lat, b, h, dir, (LAS unsigned char*)(lds)); asm volatile("s_waitcnt vmcnt(0)" ::: "memory"); __syncthreads(); scan_item<0, 1>(p, l, lat, b, h, dir, lds); } while (0)
#elif defined(HGRN_VALU)
#define SCAN_HG(p, l, lat, b, h, dir, lds) scan_item<0>(p, l, lat, b, h, dir, lds)
#else
#define SCAN_HG(p, l, lat, b, h, dir, lds) scan_hgrn_mfma(p, l, lat, b, h, dir, (LAS unsigned char*)(lds))
#endif
#if defined(MLSTM_VALU)
#define SCAN_ML(p, l, lat, b, h, dir, lds) scan_item<1>(p, l, lat, b, h, dir, lds)
#else
#if defined(DIAG_ALL)
#define SCAN_ML(p, l, lat, b, h, dir, lds) do { scan_mlstm_mfma(p, l, lat, b, h, dir, (LAS unsigned char*)(lds)); asm volatile("s_waitcnt vmcnt(0)" ::: "memory"); __syncthreads(); scan_item<1, 1>(p, l, lat, b, h, dir, lds); } while (0)
#elif defined(MLSTM_DIAG)
#define SCAN_ML(p, l, lat, b, h, dir, lds) do { scan_mlstm_mfma(p, l, lat, b, h, dir, (LAS unsigned char*)(lds)); \
        if ((lat) && (dir) == 0 && (l) == DIAG_LAYER) { asm volatile("s_waitcnt vmcnt(0)" ::: "memory"); __syncthreads(); scan_item<1, 1>(p, l, lat, b, h, dir, lds); } } while (0)
#elif defined(MLSTM_VALU_CTX)
#define SCAN_ML(p, l, lat, b, h, dir, lds) do { if (lat) scan_mlstm_mfma(p, l, lat, b, h, dir, (LAS unsigned char*)(lds)); else scan_item<1>(p, l, lat, b, h, dir, lds); } while (0)
#elif defined(MLSTM_MFMA_DIR0)
#define SCAN_ML(p, l, lat, b, h, dir, lds) do { if ((dir) == 0) scan_mlstm_mfma(p, l, lat, b, h, dir, (LAS unsigned char*)(lds)); else scan_item<1>(p, l, lat, b, h, dir, lds); } while (0)
#elif defined(MLSTM_BISECT)
#define SCAN_ML(p, l, lat, b, h, dir, lds) do { if (!((lat) && (dir) == 0 && (MLSTM_BISECT_COND))) scan_mlstm_mfma(p, l, lat, b, h, dir, (LAS unsigned char*)(lds)); else scan_item<1>(p, l, lat, b, h, dir, lds); } while (0)
#elif defined(MLSTM_VALU_LAT)
#define SCAN_ML(p, l, lat, b, h, dir, lds) do { if (!(lat)) scan_mlstm_mfma(p, l, lat, b, h, dir, (LAS unsigned char*)(lds)); else scan_item<1>(p, l, lat, b, h, dir, lds); } while (0)
#else
#define SCAN_ML(p, l, lat, b, h, dir, lds) scan_mlstm_mfma(p, l, lat, b, h, dir, (LAS unsigned char*)(lds))
#endif
#endif
__device__ __forceinline__ void scan_dispatch(const Params& p, int l, int it, LAS float* lds) {
    if (it < 128) { const int type = it >> 6, r = it & 63, b = r >> 3, h = (r >> 1) & 3, dir = r & 1; if (type == 0) SCAN_HG(p, l, 1, b, h, dir, lds); else SCAN_ML(p, l, 1, b, h, dir, lds); }
    else { const int q = it - 128, type = q >> 8, r = q & 255, b = r >> 3, h = (r >> 1) & 3, dir = r & 1; if (type == 0) SCAN_HG(p, l, 0, b, h, dir, lds); else SCAN_ML(p, l, 0, b, h, dir, lds); }
}
__device__ __forceinline__ void ctx_pair_mixnorm(const Params& p, int l, int b, int h) {
    asm volatile("s_waitcnt vmcnt(0)" ::: "memory");
    __syncthreads();
    const int tid = ltid(), lane = tid & 63, wave = __builtin_amdgcn_readfirstlane(tid >> 6);
    const h16* of = (const h16*)(p.ws + WS_HN); const h16* ob = (const h16*)(p.ws + WS_OB); const h16* proj = (const h16*)(p.ws + WS_PROJ);
    h16* mix = (h16*)(p.ws + WS_QKM);
    const float wh0 = p.hg_nw[l * 512 + h * 128 + 2 * lane], wh1 = p.hg_nw[l * 512 + h * 128 + 2 * lane + 1];
    const float wm0 = p.ml_nw[l * 512 + h * 128 + 2 * lane], wm1 = p.ml_nw[l * 512 + h * 128 + 2 * lane + 1];
    for (int pi = wave; pi < 512; pi += NWV) {
        const int row = b * 256 + (pi >> 1), type = pi & 1;
        const int cb = type * 512 + h * 128 + 2 * lane, gc = (type ? 4096 : 2048) + h * 128 + 2 * lane;
        const h16x2 a = *(const h16x2*)(of + (size_t)row * DM + cb), c2 = *(const h16x2*)(ob + (size_t)row * DM + cb), g = *(const h16x2*)(proj + (size_t)row * NPROJ + gc);
        const float o0 = (float)a[0] + (float)c2[0], o1 = (float)a[1] + (float)c2[1];
        const float ss = wave_sum(o0 * o0 + o1 * o1);
        const float rstd = rsqrtf(ss * (1.f / 128.f) + EPS);
        const float w0 = type ? wm0 : wh0, w1 = type ? wm1 : wh1;
        *(unsigned*)(mix + (size_t)row * DM + cb) = pkh(o0 * rstd * w0 * (float)g[0], o1 * rstd * w1 * (float)g[1]);
    }
}
__device__ __forceinline__ void phase_scan(const Params& p, int l, LAS float* lds) {
    const int G = gridDim.x, bid = blockIdx.x;
    if (G == 256) {
        if (bid < 128) scan_dispatch(p, l, bid, lds);
        else {
            const int pr = bid - 128, b = pr >> 2, h = pr & 3;
            SCAN_HG(p, l, 0, b, h, 0, lds); SCAN_HG(p, l, 0, b, h, 1, lds); SCAN_ML(p, l, 0, b, h, 0, lds); SCAN_ML(p, l, 0, b, h, 1, lds);
            ctx_pair_mixnorm(p, l, b, h);
        }
    } else {
        for (int it = bid; it < 640; it += G) scan_dispatch(p, l, it, lds);
    }
}
__device__ __forceinline__ void phase_mixnorm(const Params& p, int l, int gw, int NGW, int lane, int row_begin) {
    const h16* of = (const h16*)(p.ws + WS_HN); const h16* ob = (const h16*)(p.ws + WS_OB); const h16* proj = (const h16*)(p.ws + WS_PROJ);
    h16* mix = (h16*)(p.ws + WS_QKM);
    const int col = 16 * lane;
    const float* nw = col < 512 ? p.hg_nw + l * 512 + col : p.ml_nw + l * 512 + (col - 512);
    float wv[16];
#pragma unroll
    for (int j = 0; j < 4; ++j) { const f32x4 t = *(const f32x4*)(nw + 4 * j); wv[4 * j] = t.x; wv[4 * j + 1] = t.y; wv[4 * j + 2] = t.z; wv[4 * j + 3] = t.w; }
    const int gcol = col < 512 ? 2048 + col : 4096 + (col - 512);
    for (int r = row_begin + gw; r < T_ALL; r += NGW) {
        const h16x8 a0 = *(const h16x8*)(of + (size_t)r * DM + col), a1 = *(const h16x8*)(of + (size_t)r * DM + col + 8);
        const h16x8 b0 = *(const h16x8*)(ob + (size_t)r * DM + col), b1 = *(const h16x8*)(ob + (size_t)r * DM + col + 8);
        const h16x8 g0 = *(const h16x8*)(proj + (size_t)r * NPROJ + gcol), g1 = *(const h16x8*)(proj + (size_t)r * NPROJ + gcol + 8);
        float o[16]; float ss = 0.f;
#pragma unroll
        for (int j = 0; j < 8; ++j) { o[j] = (float)a0[j] + (float)b0[j]; o[8 + j] = (float)a1[j] + (float)b1[j]; }
#pragma unroll
        for (int j = 0; j < 16; ++j) ss += o[j] * o[j];
        ss += __shfl_xor(ss, 1); ss += __shfl_xor(ss, 2); ss += __shfl_xor(ss, 4);
        const float rstd = rsqrtf(ss * (1.f / 128.f) + EPS);
        u32x4 w0, w1;
        w0.x = pkh(o[0] * rstd * wv[0] * (float)g0[0], o[1] * rstd * wv[1] * (float)g0[1]); w0.y = pkh(o[2] * rstd * wv[2] * (float)g0[2], o[3] * rstd * wv[3] * (float)g0[3]);
        w0.z = pkh(o[4] * rstd * wv[4] * (float)g0[4], o[5] * rstd * wv[5] * (float)g0[5]); w0.w = pkh(o[6] * rstd * wv[6] * (float)g0[6], o[7] * rstd * wv[7] * (float)g0[7]);
        w1.x = pkh(o[8] * rstd * wv[8] * (float)g1[0], o[9] * rstd * wv[9] * (float)g1[1]); w1.y = pkh(o[10] * rstd * wv[10] * (float)g1[2], o[11] * rstd * wv[11] * (float)g1[3]);
        w1.z = pkh(o[12] * rstd * wv[12] * (float)g1[4], o[13] * rstd * wv[13] * (float)g1[5]); w1.w = pkh(o[14] * rstd * wv[14] * (float)g1[6], o[15] * rstd * wv[15] * (float)g1[7]);
        *(u32x4*)(mix + (size_t)r * DM + col) = w0; *(u32x4*)(mix + (size_t)r * DM + col + 8) = w1;
    }
}

#define XB_TMO      128
#define XB_XCNT(j)  (256  + 64 * (j))
#define XB_XSUB(j)  (1280 + 64 * (j))
#define XB_XGEN(j)  (2304 + 64 * (j))
#define XB_TOP      3328
#define XB_TOPGEN   3392
#define XCD_BAR_WORDS 3456
#define XB_SPIN_CAP (1u << 18)

__device__ __forceinline__ unsigned xb_ld(unsigned* p)              { return __hip_atomic_load(p, __ATOMIC_RELAXED, __HIP_MEMORY_SCOPE_AGENT); }
__device__ __forceinline__ unsigned xb_add(unsigned* p, unsigned v) { return __hip_atomic_fetch_add(p, v, __ATOMIC_RELAXED, __HIP_MEMORY_SCOPE_AGENT); }
__device__ __forceinline__ unsigned xb_xcc_id() { return (unsigned)__builtin_amdgcn_s_getreg((3 << 11) | 20) & 0xFu; }
#define XB_SPIN(cond, bar) do { unsigned _sp = 0; while (cond) { __builtin_amdgcn_s_sleep(1); \
    if ((++_sp & 255u) == 0u) { if (xb_ld(&(bar)[XB_TMO])) break; if (_sp > XB_SPIN_CAP) { atomicAdd(&(bar)[XB_TMO], 1u); break; } } } } while (0)

struct XcdBarrier {
    unsigned* bar; unsigned x;
    volatile LAS unsigned* st;
};

__device__ __forceinline__ XcdBarrier xcd_barrier_post(unsigned* bar, volatile LAS unsigned* st) {
    XcdBarrier b; b.bar = bar; b.x = xb_xcc_id(); b.st = st;
    if (threadIdx.x == 0) (void)xb_add(&bar[XB_XCNT(b.x)], 1u);
    return b;
}
__device__ __forceinline__ void xcd_barrier_complete(unsigned* bar, unsigned x, unsigned& nloc, unsigned& nx) {
    const unsigned G = gridDim.x * gridDim.y * gridDim.z;
    unsigned sum, cnt, mine, sp = 0u;
    for (;;) {
        sum = 0u; cnt = 0u; mine = 0u;
#pragma unroll
        for (unsigned j = 0; j < 16; ++j) { const unsigned c = xb_ld(&bar[XB_XCNT(j)]); sum += c; cnt += (c > 0u) ? 1u : 0u; mine = (j == x) ? c : mine; }
        if (sum == G) break;
        __builtin_amdgcn_s_sleep(1);
        if ((++sp & 255u) == 0u) { if (xb_ld(&bar[XB_TMO])) break; if (sp > XB_SPIN_CAP) { atomicAdd(&bar[XB_TMO], 1u); break; } }
    }
    nloc = mine > 0u ? mine : 1u; nx = cnt > 0u ? cnt : 1u;
}

__device__ __forceinline__ void xcd_barrier(const XcdBarrier& b) {
    asm volatile("s_waitcnt vmcnt(0)" ::: "memory");
    __syncthreads();
    if (threadIdx.x == 0) {
        unsigned* bar = b.bar;
        __builtin_amdgcn_s_waitcnt(0);
        unsigned nloc = b.st[0], nx = b.st[1];
        if (nloc == 0u) { xcd_barrier_complete(bar, b.x, nloc, nx); b.st[0] = nloc; b.st[1] = nx; }
        const unsigned old = xb_add(&bar[XB_XSUB(b.x)], 1u);
        const unsigned gen = old / nloc;
        if (old + 1u == (gen + 1u) * nloc) {
            __builtin_amdgcn_fence(__ATOMIC_RELEASE, "agent");
            asm volatile("s_waitcnt vmcnt(0)" ::: "memory");
            const unsigned og = xb_add(&bar[XB_TOP], 1u);
            const unsigned tg = og / nx;
            if (og + 1u == (tg + 1u) * nx) xb_add(&bar[XB_TOPGEN], 1u);
            else XB_SPIN(xb_ld(&bar[XB_TOPGEN]) == tg, bar);
            __builtin_amdgcn_fence(__ATOMIC_ACQUIRE, "agent");
            xb_add(&bar[XB_XGEN(b.x)], 1u);
            asm volatile("s_waitcnt vmcnt(0)" ::: "memory");
        } else {
            XB_SPIN(xb_ld(&bar[XB_XGEN(b.x)]) == gen, bar);
            __builtin_amdgcn_fence(__ATOMIC_ACQUIRE, "agent");
            asm volatile("s_waitcnt vmcnt(0)" ::: "memory");
        }
    }
    __syncthreads();
}


__global__ void __launch_bounds__(NTHR, 2) fwd_megakernel(Params p) {
    extern __shared__ __attribute__((aligned(16))) unsigned char lds_raw[];
    cg::grid_group grid = cg::this_grid();
#if defined(USE_CG_SYNC)
#define GSYNC() do { asm volatile("s_waitcnt vmcnt(0)" ::: "memory"); grid.sync(); } while (0)
#else
#define GSYNC() do { XcdBarrier xb_; xb_.bar = (unsigned*)(p.ws + WS_BAR); xb_.x = xb_xcc_id(); xb_.st = (volatile LAS unsigned*)(lds + 131072 + 512); xcd_barrier(xb_); } while (0)
#endif
    LAS unsigned char* lds = (LAS unsigned char*)lds_raw;
    LAS float* ldsf = (LAS float*)lds_raw;
    const int G = gridDim.x, NGW = G * NWV;
#define PHASE_IDS() const int tid = ltid(), lane = tid & 63, wave = __builtin_amdgcn_readfirstlane(tid >> 6), gw = blockIdx.x * NWV + wave; (void)tid; (void)lane; (void)gw
    const float* mod = (const float*)(p.ws + WS_MOD);
    h16* hn = (h16*)(p.ws + WS_HN); h16* proj = (h16*)(p.ws + WS_PROJ); h16* mix = (h16*)(p.ws + WS_QKM); h16* ff = (h16*)(p.ws + WS_PROJ);

    volatile LAS unsigned* xst = (volatile LAS unsigned*)(lds + 131072 + 512);
    if (ltid() < 4) xst[ltid()] = 0u;
    __syncthreads();
    XcdBarrier xbar = xcd_barrier_post((unsigned*)(p.ws + WS_BAR), xst);
    phase_mod_partial(p, ldsf);
    asm volatile("s_waitcnt vmcnt(0)" ::: "memory"); grid.sync();
    (void)xbar;
    phase_mod_reduce(p);
    GSYNC();
#if defined(DIAG_ALL)
    if (ltid() == 0) { float* dg = (float*)(p.ws + WS_MODP) + 4 * blockIdx.x; dg[0] = 0.f; dg[1] = 0.f; dg[2] = 0.f; dg[3] = 0.f; }
#endif
    for (int l = 0; l < 4; ++l) {
        { PHASE_IDS(); convert_weights(p, l, ldsf + wave * 2176, gw, NGW, lane); }
        { PHASE_IDS(); phase_norm(p, l, 0, l == 0, gw, NGW, lane); }
        GSYNC();
        {
            pg8::Gemm g{(const pg8::bf16_t*)hn, (const pg8::bf16_t*)(p.ws + WS_WIN), T_ALL, NPROJ_PAD, DM}; pg8::StaticOrder S; S.init(T_ALL, NPROJ_PAD, G, (int)blockIdx.x);
            EpiInProj E{proj, (float*)(p.ws + WS_GATES), p.gate_b + l * 16};
            pg8::gemm_phase<EpiInProj, pg8::StaticOrder, true, true>(lds, g, S, E);
#if defined(PROBE_GEMM2)
            GSYNC();
            pg8::gemm_phase<EpiInProj, pg8::StaticOrder, true, true>(lds, g, S, E);
#endif
        }
        GSYNC();
        { PHASE_IDS(); phase_gates(p, l, gw, NGW, lane); }
        phase_conv(p, l);
        GSYNC();
#if defined(PERTURB)
        { if (ltid() == 0) { const unsigned long long t0_ = __builtin_amdgcn_s_memrealtime(); const unsigned long long dl_ = (unsigned long long)(((blockIdx.x * 37u + l * 11u) % 64u) * 300u); while (__builtin_amdgcn_s_memrealtime() - t0_ < dl_) __builtin_amdgcn_s_sleep(4); } __syncthreads(); }
#endif
        phase_scan(p, l, ldsf);
#if defined(PERTURB)
        { if (ltid() == 0) { const unsigned long long t0_ = __builtin_amdgcn_s_memrealtime(); const unsigned long long dl_ = (unsigned long long)(((blockIdx.x * 53u + l * 7u) % 32u) * 400u); while (__builtin_amdgcn_s_memrealtime() - t0_ < dl_) __builtin_amdgcn_s_sleep(4); } __syncthreads(); }
#endif
#if defined(DELAY_AFTER_SCAN)
        { if (ltid() == 0) { const unsigned long long t0_ = __builtin_amdgcn_s_memrealtime(); while (__builtin_amdgcn_s_memrealtime() - t0_ < (unsigned long long)(DELAY_AFTER_SCAN) * 100ull) __builtin_amdgcn_s_sleep(8); } __syncthreads(); }
#endif
#if defined(LDS_CLEAR)
        { __syncthreads(); const int t_ = ltid(); for (int e = t_; e < 32768; e += NTHR) ldsf[e] = LDS_CLEAR_VAL; __syncthreads(); }
#endif
        GSYNC();
#if defined(MLSTM_DIAG)
        if (l == DIAG_LAYER && blockIdx.x == 0 && ltid() == 0) {
            const float* dg = (const float*)(p.ws + WS_MODP);
            float best = -1.f; int code = 0;
            for (int bb = 64; bb < 128; bb += 2) { const float rt = dg[4 * bb + DIAG_FIELD]; if (rt > best) { best = rt; int lg = 0; float x = rt; while (x < 1.f && lg < 31) { x *= 2.f; ++lg; } code = DIAG_CODE; } }
            const unsigned long long t0 = __builtin_amdgcn_s_memrealtime();
            while (__builtin_amdgcn_s_memrealtime() - t0 < (unsigned long long)code * 5000ull) __builtin_amdgcn_s_sleep(8);
        }
#endif
#if defined(PROBE_GSYNC10)
        for (int rep = 0; rep < 10; ++rep) GSYNC();
#endif
#if defined(PROBE_SCAN_TYPE)
        { const int bid_ = blockIdx.x;
          if (bid_ < 128) { if ((bid_ >> 6) == PROBE_SCAN_TYPE) scan_dispatch(p, l, bid_, ldsf); }
          else for (int it = 128 + (bid_ - 128); it < 640; it += 128) { if (((it - 128) >> 8) == PROBE_SCAN_TYPE) scan_dispatch(p, l, it, ldsf); } }
        GSYNC();
#endif
#if defined(PROBE_SCAN2)
        phase_scan(p, l, ldsf);
        GSYNC();
#endif
        { PHASE_IDS(); phase_mixnorm(p, l, gw, NGW, lane, G == 256 ? T_CTX : 0); }
        GSYNC();
        {
            pg8::Gemm g{(const pg8::bf16_t*)mix, (const pg8::bf16_t*)(p.ws + WS_WOUT), T_ALL, DM, DM}; pg8::StaticOrder S; S.init(T_ALL, DM, G, (int)blockIdx.x);
            EpiResid E{l == 0 ? p.x_prompt : p.out, l == 0 ? p.x_sample : p.out + (size_t)T_CTX * DM, p.out, mod + (size_t)l * 9 * 6144 + 2048};
#if defined(PROBE_GEMM2)
            { EpiResid E2 = E; E2.out = (float*)(p.ws + WS_PROJ); pg8::gemm_phase<EpiResid, pg8::StaticOrder, true, true>(lds, g, S, E2); GSYNC(); }
#endif
            pg8::gemm_phase<EpiResid, pg8::StaticOrder, true, true>(lds, g, S, E);
        }
        GSYNC();
        { PHASE_IDS(); phase_norm(p, l, 1, false, gw, NGW, lane); }
        GSYNC();
        {
            pg8::Gemm g{(const pg8::bf16_t*)hn, (const pg8::bf16_t*)(p.ws + WS_WGU), T_ALL, NGU, DM}; pg8::StaticOrder S; S.init(T_ALL, NGU, G, (int)blockIdx.x);
            EpiGateUp E{ff};
            pg8::gemm_phase<EpiGateUp, pg8::StaticOrder, true, true>(lds, g, S, E);
#if defined(PROBE_GEMM2)
            GSYNC();
            pg8::gemm_phase<EpiGateUp, pg8::StaticOrder, true, true>(lds, g, S, E);
#endif
        }
        GSYNC();
        {
            pg8::Gemm g{(const pg8::bf16_t*)ff, (const pg8::bf16_t*)(p.ws + WS_WDN), T_ALL, DM, DFF}; pg8::StaticOrder S; S.init(T_ALL, DM, G, (int)blockIdx.x);
            EpiResid E{p.out, p.out + (size_t)T_CTX * DM, p.out, mod + (size_t)l * 9 * 6144 + 5120};
#if defined(PROBE_GEMM2)
            { EpiResid E2 = E; E2.out = (float*)(p.ws + WS_QKM); pg8::gemm_phase<EpiResid, pg8::StaticOrder, true, true>(lds, g, S, E2); GSYNC(); }
#endif
            pg8::gemm_phase<EpiResid, pg8::StaticOrder, true, true>(lds, g, S, E);
        }
        GSYNC();
    }
    { PHASE_IDS(); phase_final_norm(p, gw, NGW, lane); }
#if defined(DIAG_ALL)
    if (blockIdx.x == 0 && ltid() == 0) {
        const float* dg = (const float*)(p.ws + WS_MODP);
        float best = -1.f; int code = 0;
        for (int bb = 0; bb < (int)gridDim.x; ++bb) { const float rt = dg[4 * bb]; if (rt > best) { best = rt; int lg = 0; float x = rt; while (x < 1.f && lg < 31) { x *= 2.f; ++lg; } code = DIAG_ALL_CODE; } }
        const unsigned long long t0 = __builtin_amdgcn_s_memrealtime();
        while (__builtin_amdgcn_s_memrealtime() - t0 < (unsigned long long)code * 5000ull) __builtin_amdgcn_s_sleep(8);
    }
#endif
}

extern "C" void kernel_launch(void* const* d_in, const int* in_sizes, int n_in, void* d_out, int out_size, void* d_ws, size_t ws_size, hipStream_t stream) {
    static int grid_blocks = 0;
    if (grid_blocks == 0) {
        if (n_in != 24 || (size_t)out_size != OUT_TOTAL || ws_size < WS_END) {
            fprintf(stderr, "kernel_launch: unexpected sizes n_in %d out %d ws %zu (need %zu)\n", n_in, out_size, ws_size, (size_t)WS_END); grid_blocks = -1; return;
        }
        int dev = 0, cus = 0, per_cu = 0;
        hipGetDevice(&dev);
        hipDeviceGetAttribute(&cus, hipDeviceAttributeMultiprocessorCount, dev);
        hipFuncSetAttribute((const void*)fwd_megakernel, hipFuncAttributeMaxDynamicSharedMemorySize, LDS_BYTES);
        hipOccupancyMaxActiveBlocksPerMultiprocessor(&per_cu, (const void*)fwd_megakernel, NTHR, LDS_BYTES);
        if (per_cu < 1) { fprintf(stderr, "kernel_launch: occupancy query says %d blocks per CU\n", per_cu); per_cu = 1; }
        grid_blocks = cus * 1;
        (void)hipGetLastError();
    }
    if (grid_blocks < 0) return;
    Params p{};
    const float** f = (const float**)&p;
    for (int i = 0; i < 24; ++i) f[i] = (const float*)d_in[i];
    p.out = (float*)d_out; p.ws = (unsigned char*)d_ws;
    if (hipMemsetAsync((char*)d_ws + WS_BAR, 0, 16384, stream) != hipSuccess) { fprintf(stderr, "kernel_launch: memset of the barrier words failed\n"); return; }
    void* args[] = {&p};
    hipError_t e = hipLaunchCooperativeKernel((const void*)fwd_megakernel, dim3(grid_blocks), dim3(NTHR), args, LDS_BYTES, stream);
    if (e != hipSuccess) fprintf(stderr, "cooperative launch failed: %s (grid %d)\n", hipGetErrorString(e), grid_blocks);
}
```

```cpp
#include <hip/hip_runtime.h>
#include <hip/hip_cooperative_groups.h>
#include <cstdio>
#include <cstdint>
namespace cg = cooperative_groups;
typedef _Float16 h16;
typedef _Float16 h16x8 __attribute__((ext_vector_type(8)));
typedef _Float16 h16x4 __attribute__((ext_vector_type(4)));
typedef _Float16 h16x2 __attribute__((ext_vector_type(2)));
typedef float f32x2 __attribute__((ext_vector_type(2)));
namespace pg8 {
#define PG8_LAS __attribute__((address_space(3)))
typedef unsigned short bf16_t;
typedef short bf16x8 __attribute__((ext_vector_type(8)));
typedef float f32x4 __attribute__((ext_vector_type(4)));
typedef unsigned u32x4 __attribute__((ext_vector_type(4)));
constexpr int BM = 256, BK = 64, HALF = 128, HTB = HALF * BK * 2  , STAGE_BYTES = 8 * HTB, NXCD = 8, WGM = 8;

__host__ __device__ __forceinline__ int lds_byte(int r, int c) { const int st = (r >> 4) * 2 + (c >> 5), rr = r & 15, cc = c & 31, ob = rr * 64 + cc * 2; return st * 1024 + (ob ^ (((ob >> 9) & 1) << 5)); }
__host__ __device__ __forceinline__ void stage_rc(int b, int& R, int& C) { const int st = b / 1024, sb = b % 1024, swz = sb ^ (((sb >> 9) & 1) << 5); R = (st >> 1) * 16 + swz / 64; C = (st & 1) * 32 + (swz % 64) / 2; }
__host__ __device__ __forceinline__ int perm32(int rho) { const int n = rho >> 4, i = rho & 15; return 8 * (i >> 2) + 4 * n + (i & 3); }

struct Unit { int pm, pn; };
struct Gemm { const bf16_t* A; const bf16_t* Bt; int M, N, K; };

struct StaticOrder {
    int nM, nN, nwg, G, c;
    __host__ __device__ void init(int M, int N, int G_, int c_) { nM = M / BM; nN = N / BM; nwg = nM * nN; G = G_; c = c_; }
    __host__ __device__ bool next(int i, Unit& u) const {
        const long L = (long)i * G + c; if (L >= nwg) return false;
        int wgid = (int)L; { const int q = nwg / NXCD, r = nwg % NXCD, xcd = wgid % NXCD, off = wgid / NXCD; wgid = (xcd < r ? xcd * (q + 1) : r * (q + 1) + (xcd - r) * q) + off; }
        const int nig = WGM * nN, gid = wgid / nig, fm = gid * WGM, gsz = (nM - fm) < WGM ? (nM - fm) : WGM;
        u.pm = fm + ((wgid % nig) % gsz); u.pn = (wgid % nig) / gsz; return true;
    }
    __device__ __forceinline__ void a_ready(const Unit&) const {}
    __device__ __forceinline__ void done(const Unit&) const {}
};

template <class Epi, class Sched, bool ALIGN_EPI = false, bool SP2 = false>
__device__ __forceinline__ void gemm_phase(PG8_LAS unsigned char* lds, const Gemm g, const Sched& S, const Epi& E) {
    int tid_l = threadIdx.x; asm volatile("" : "+v"(tid_l));
    const int tid = tid_l, wid = __builtin_amdgcn_readfirstlane(tid >> 6), lane = tid & 63, wr = wid >> 2, wc = wid & 3, fr = lane & 15, fq = lane >> 4;
    const int K = g.K, nt = K / BK;
    unsigned voffA[2], voffB[2];
#pragma unroll
    for (int i = 0; i < 2; ++i) { int R, C; stage_rc(tid * 16 + i * 8192, R, C); const int Rb = Epi::PERM ? ((R & ~31) + perm32(R & 31)) : R;
        voffA[i] = (unsigned)(R * K + C) * 2u; voffB[i] = (unsigned)(Rb * K + C) * 2u; }
    const size_t kstep = (size_t)(BK * 2);
    const size_t hstep = (size_t)HALF * K * 2;
    const size_t tstep = 2 * hstep;
    const unsigned ldsw = (unsigned)wid * 1024u;
    const int aoff = lds_byte(wr * 64 + fr, fq * 8), boff = lds_byte(wc * 32 + fr, fq * 8);
#define PG8_SA(b, h) (((b) * 2 + (h)) * HTB)
#define PG8_SB(b, h) ((4 + (b) * 2 + (h)) * HTB)
#define PG8_STAGE(bufoff, gbase, voff) do { _Pragma("unroll") for (int _i = 0; _i < 2; ++_i) \
        __builtin_amdgcn_global_load_lds((const unsigned*)((const char*)(gbase) + (voff)[_i]), (PG8_LAS unsigned*)(lds + (bufoff) + ldsw + _i * 8192), 16, 0, 0); } while (0)
#define PG8_LDA(dst, b, h) do { _Pragma("unroll") for (int m = 0; m < 4; ++m) _Pragma("unroll") for (int k = 0; k < 2; ++k) dst[m][k] = *(const PG8_LAS bf16x8*)(lds + PG8_SA(b, h) + aoff + m * 2048 + k * 1024); } while (0)
#define PG8_LDB(dst, b, h) do { _Pragma("unroll") for (int n = 0; n < 2; ++n) _Pragma("unroll") for (int k = 0; k < 2; ++k) dst[n][k] = *(const PG8_LAS bf16x8*)(lds + PG8_SB(b, h) + boff + n * 2048 + k * 1024); } while (0)
#define PG8_MMA(ai, bj, At, Bt) do { __builtin_amdgcn_s_setprio(1); _Pragma("unroll") for (int m = 0; m < 4; ++m) _Pragma("unroll") for (int n = 0; n < 2; ++n) _Pragma("unroll") for (int k = 0; k < 2; ++k) \
        acc[ai][bj][m][n] = __builtin_amdgcn_mfma_f32_16x16x32_f16(__builtin_bit_cast(h16x8, Bt[n][k]), __builtin_bit_cast(h16x8, At[m][k]), acc[ai][bj][m][n], 0, 0, 0); __builtin_amdgcn_s_setprio(0); } while (0)
#define PG8_WAIT_V(n) asm volatile("s_waitcnt vmcnt(" #n ")" ::: "memory")
#define PG8_WAIT_L(n) asm volatile("s_waitcnt lgkmcnt(" #n ")" ::: "memory")
#define PG8_BAR __builtin_amdgcn_s_barrier()
#define PG8_SCHED __builtin_amdgcn_sched_barrier(0)
    Unit cur, nxt; int ui = 0;
    if (!S.next(0, cur)) return;
    f32x4 acc[2][2][4][2];
#pragma unroll
    for (int a = 0; a < 2; ++a)
#pragma unroll
        for (int b = 0; b < 2; ++b)
#pragma unroll
            for (int m = 0; m < 4; ++m)
#pragma unroll
                for (int n = 0; n < 2; ++n) acc[a][b][m][n] = (f32x4){0.f, 0.f, 0.f, 0.f};
    bf16x8 At[4][2], B0[2][2], B1[2][2];
    const char* cA = (const char*)g.A + (size_t)cur.pm * tstep; const char* cB = (const char*)g.Bt + (size_t)cur.pn * tstep;
    S.a_ready(cur);
    if constexpr (SP2) {
        PG8_STAGE(PG8_SB(0, 0), cB, voffB); PG8_STAGE(PG8_SB(0, 1), cB + hstep, voffB); PG8_STAGE(PG8_SA(0, 0), cA, voffA); PG8_STAGE(PG8_SA(0, 1), cA + hstep, voffA);
        if (wr == 1) PG8_BAR;
        PG8_WAIT_V(2); PG8_BAR;
        PG8_STAGE(PG8_SB(1, 0), cB + kstep, voffB); PG8_STAGE(PG8_SA(1, 0), cA + kstep, voffA); PG8_STAGE(PG8_SB(1, 1), cB + hstep + kstep, voffB);
        PG8_WAIT_V(6); PG8_BAR;
    } else {
        PG8_STAGE(PG8_SB(0, 0), cB, voffB); PG8_STAGE(PG8_SA(0, 0), cA, voffA); PG8_STAGE(PG8_SB(0, 1), cB + hstep, voffB); PG8_STAGE(PG8_SA(0, 1), cA + hstep, voffA);
        if (wr == 1) PG8_BAR;
        PG8_WAIT_V(4); PG8_BAR;
        PG8_STAGE(PG8_SB(1, 0), cB + kstep, voffB); PG8_STAGE(PG8_SA(1, 0), cA + kstep, voffA); PG8_STAGE(PG8_SB(1, 1), cB + hstep + kstep, voffB);
        PG8_WAIT_V(6); PG8_BAR;
    }
    for (;;) {
        const bool has_next = S.next(ui + 1, nxt);
        const char* nA = has_next ? (const char*)g.A + (size_t)nxt.pm * tstep : cA; const char* nB = has_next ? (const char*)g.Bt + (size_t)nxt.pn * tstep : cB;
        for (int t = 0; t < nt; t += 2) {
            const bool last = (t == nt - 2);
            const char* a1 = cA + (size_t)(t + 1) * kstep;
            const char* a2 = last ? nA : cA + (size_t)(t + 2) * kstep; const char* b2 = last ? nB : cB + (size_t)(t + 2) * kstep;
            const char* a3 = a2 + kstep; const char* b3 = b2 + kstep;
            if (last && has_next) S.a_ready(nxt);
            if constexpr (SP2) {
            PG8_LDB(B0, 0, 0); PG8_LDB(B1, 0, 1); PG8_SCHED; PG8_LDA(At, 0, 0); PG8_STAGE(PG8_SA(1, 1), a1 + hstep, voffA);
            PG8_WAIT_V(8); PG8_WAIT_L(0); PG8_BAR; PG8_MMA(0, 0, At, B0); PG8_MMA(0, 1, At, B1); PG8_BAR; PG8_SCHED;
            PG8_LDA(At, 0, 1); PG8_STAGE(PG8_SB(0, 0), b2, voffB); PG8_STAGE(PG8_SB(0, 1), b2 + hstep, voffB); PG8_STAGE(PG8_SA(0, 0), a2, voffA);
            PG8_WAIT_V(8); PG8_WAIT_L(0); PG8_BAR; PG8_MMA(1, 0, At, B0); PG8_MMA(1, 1, At, B1); PG8_BAR; PG8_SCHED;
            PG8_LDB(B0, 1, 0); PG8_LDB(B1, 1, 1); PG8_SCHED; PG8_LDA(At, 1, 0); PG8_STAGE(PG8_SA(0, 1), a2 + hstep, voffA);
            PG8_WAIT_V(8); PG8_WAIT_L(0); PG8_BAR; PG8_MMA(0, 0, At, B0); PG8_MMA(0, 1, At, B1); PG8_BAR; PG8_SCHED;
            PG8_LDA(At, 1, 1); PG8_STAGE(PG8_SB(1, 0), b3, voffB); PG8_STAGE(PG8_SB(1, 1), b3 + hstep, voffB); PG8_STAGE(PG8_SA(1, 0), a3, voffA);
            PG8_WAIT_V(8); PG8_WAIT_L(0); PG8_BAR; PG8_MMA(1, 0, At, B0); PG8_MMA(1, 1, At, B1); PG8_BAR; PG8_SCHED;
            } else {
            PG8_LDB(B0, 0, 0); PG8_SCHED; PG8_LDA(At, 0, 0); PG8_STAGE(PG8_SA(1, 1), a1 + hstep, voffA);
            PG8_WAIT_L(8); PG8_BAR; PG8_WAIT_L(0); PG8_MMA(0, 0, At, B0); PG8_BAR; PG8_SCHED;
            PG8_LDB(B1, 0, 1); PG8_STAGE(PG8_SB(0, 0), b2, voffB);
            PG8_BAR; PG8_WAIT_L(0); PG8_MMA(0, 1, At, B1); PG8_BAR;
            PG8_LDA(At, 0, 1); PG8_STAGE(PG8_SA(0, 0), a2, voffA);
            PG8_BAR; PG8_WAIT_L(0); PG8_MMA(1, 0, At, B0); PG8_BAR; PG8_SCHED;
            PG8_STAGE(PG8_SB(0, 1), b2 + hstep, voffB);
            PG8_WAIT_V(6); PG8_BAR; PG8_MMA(1, 1, At, B1); PG8_BAR;
            PG8_LDB(B0, 1, 0); PG8_SCHED; PG8_LDA(At, 1, 0); PG8_STAGE(PG8_SA(0, 1), a2 + hstep, voffA);
            PG8_WAIT_L(8); PG8_BAR; PG8_WAIT_L(0); PG8_MMA(0, 0, At, B0); PG8_BAR; PG8_SCHED;
            PG8_LDB(B1, 1, 1); PG8_STAGE(PG8_SB(1, 0), b3, voffB);
            PG8_BAR; PG8_WAIT_L(0); PG8_MMA(0, 1, At, B1); PG8_BAR;
            PG8_LDA(At, 1, 1); PG8_STAGE(PG8_SA(1, 0), a3, voffA);
            PG8_BAR; PG8_WAIT_L(0); PG8_MMA(1, 0, At, B0); PG8_BAR; PG8_SCHED;
            PG8_STAGE(PG8_SB(1, 1), b3 + hstep, voffB);
            PG8_WAIT_V(6); PG8_BAR; PG8_MMA(1, 1, At, B1); PG8_BAR;
            }
        }
        if constexpr (ALIGN_EPI) { if (wr == 0) PG8_BAR; }
        if constexpr (!Epi::AFTER_DRAIN) { E(acc, cur, wr, wc, fr, fq); S.done(cur); }
        if (!has_next) break;
#pragma unroll
        for (int a = 0; a < 2; ++a)
#pragma unroll
            for (int b = 0; b < 2; ++b)
#pragma unroll
                for (int m = 0; m < 4; ++m)
#pragma unroll
                    for (int n = 0; n < 2; ++n) acc[a][b][m][n] = (f32x4){0.f, 0.f, 0.f, 0.f};
        cur = nxt; cA = nA; cB = nB; ++ui;
        if constexpr (ALIGN_EPI) { if (wr == 1) PG8_BAR; }
    }
    PG8_WAIT_V(0);
    if constexpr (!ALIGN_EPI) { if (wr == 0) PG8_BAR; }
    PG8_BAR;
    if constexpr (Epi::AFTER_DRAIN) { E.fused(acc, cur, wr, wc, fr, fq, lds, wid, lane); S.done(cur); }
#undef PG8_SA
#undef PG8_SB
#undef PG8_STAGE
#undef PG8_LDA
#undef PG8_LDB
#undef PG8_MMA
#undef PG8_WAIT_V
#undef PG8_WAIT_L
#undef PG8_BAR
#undef PG8_SCHED
}
}
#define LAS __attribute__((address_space(3)))
using pg8::f32x4;
using pg8::u32x4;
constexpr int T_CTX = 8192, T_LAT = 16384, T_ALL = 24576, DM = 1024;
constexpr int NPROJ = 4608, NPROJ_PAD = 4608, NIN = 4624, DFF = 2816, NGU = 5632;
constexpr int NTHR = 512, NWV = 8;
constexpr float EPS = 1e-6f;
constexpr int LDS_BYTES = 132096;

constexpr size_t OUT_HG = 25165824, OUT_MC = 41943040, OUT_MN = 58720256, OUT_MM = 58851328, OUT_TOTAL = 58852352;

constexpr size_t al256(size_t x) { return (x + 255) & ~(size_t)255; }
constexpr size_t WS_WIN = 0;
constexpr size_t WS_WOUT = WS_WIN + al256((size_t)NPROJ_PAD * DM * 2);
constexpr size_t WS_WGU = WS_WOUT + al256((size_t)DM * DM * 2);
constexpr size_t WS_WDN = WS_WGU + al256((size_t)NGU * DM * 2);
constexpr size_t WS_MODP = WS_WDN + al256((size_t)DM * DFF * 2);
constexpr size_t WS_MOD = WS_MODP + al256((size_t)8 * 4 * 9 * 6144 * 4);
constexpr size_t WS_LB = WS_MOD + al256((size_t)4 * 9 * 6144 * 4);
constexpr size_t WS_HN = WS_LB + al256((size_t)4 * 2 * 512 * 4);
constexpr size_t WS_PROJ = WS_HN + al256((size_t)T_ALL * DM * 2);
constexpr size_t WS_GATES = WS_PROJ + al256((size_t)T_ALL * NPROJ * 2);
constexpr size_t WS_QKM = WS_GATES + al256((size_t)T_ALL * 16 * 4);
constexpr size_t WS_OB = WS_QKM + al256((size_t)T_ALL * DM * 2);
constexpr size_t WS_BAR = WS_OB + al256((size_t)T_ALL * DM * 2);
constexpr size_t WS_WG16 = WS_BAR + 16384;
constexpr size_t WS_END = WS_WG16 + 32768;

#if defined(SWAP_OBUF)
#define ODIR(d) (!(d))
#else
#define ODIR(d) (d)
#endif
struct Params {
    const float *x_prompt, *x_sample, *st_hg, *st_mc, *st_mn, *st_mm, *cnd, *c_ctx, *n1w, *n2w, *w_mod, *b_mod, *w_in, *conv_w, *conv_b, *gate_b,
        *lb_logits, *hg_nw, *ml_nw, *w_out, *w_gate, *w_up, *w_down, *fin_w;
    float* out; unsigned char* ws;
};

__device__ __forceinline__ float sigmoidf_(float x) { return __builtin_amdgcn_rcpf(1.f + __expf(-x)); }
__device__ __forceinline__ float siluf_(float x) { return x * __builtin_amdgcn_rcpf(1.f + __expf(-x)); }
__device__ __forceinline__ unsigned pkh(float a, float b) { h16x2 v = {(h16)a, (h16)b}; return __builtin_bit_cast(unsigned, v); }
__device__ __forceinline__ float wave_sum(float v) {
#pragma unroll
    for (int o = 1; o < 64; o <<= 1) v += __shfl_xor(v, o);
    return v;
}
__device__ __forceinline__ int row_cidx(int row) { return row < T_CTX ? 0 : 1 + ((row - T_CTX) >> 11); }
__device__ __forceinline__ int ltid() { int t = threadIdx.x; asm volatile("" : "+v"(t)); return t; }
__device__ __forceinline__ float rdlane(float v, int l) { return __builtin_bit_cast(float, __builtin_amdgcn_readlane(__builtin_bit_cast(int, v), l)); }

struct EpiInProj {
    static constexpr bool PERM = true, AFTER_DRAIN = false;
    h16* proj; float* gates; const float* gate_b;
    __device__ __forceinline__ void operator()(const f32x4 (&acc)[2][2][4][2], const pg8::Unit& u, int wr, int wc, int fr, int fq) const {
        const int row0 = u.pm * 256 + wr * 64 + fr;
#pragma unroll
        for (int bj = 0; bj < 2; ++bj) {
            const int colt = u.pn * 256 + bj * 128, reg = colt >> 9;
            const int act = (reg == 0 || reg == 4) ? 1 : (reg == 8 ? 2 : 0);
            const int col0 = colt + wc * 32 + 8 * fq;
#pragma unroll
            for (int ai = 0; ai < 2; ++ai)
#pragma unroll
                for (int m = 0; m < 4; ++m) {
                    f32x4 v0 = acc[ai][bj][m][0], v1 = acc[ai][bj][m][1];
                    if (act == 1) {
#pragma unroll
                        for (int j = 0; j < 4; ++j) { v0[j] = siluf_(v0[j]); v1[j] = siluf_(v1[j]); }
                    } else if (act == 2) {
#pragma unroll
                        for (int j = 0; j < 4; ++j) { v0[j] = sigmoidf_(v0[j]); v1[j] = sigmoidf_(v1[j]); }
                    }
                    u32x4 w; w.x = pkh(v0[0], v0[1]); w.y = pkh(v0[2], v0[3]); w.z = pkh(v1[0], v1[1]); w.w = pkh(v1[2], v1[3]);
                    *(u32x4*)(proj + (size_t)(row0 + ai * 128 + m * 16) * NPROJ + col0) = w;
                }
        }
    }
};
struct EpiResid {
    static constexpr bool PERM = false, AFTER_DRAIN = false;
    const float* base_ctx; const float* base_lat; float* out; const float* gate;
    __device__ __forceinline__ void operator()(const f32x4 (&acc)[2][2][4][2], const pg8::Unit& u, int wr, int wc, int fr, int fq) const {
        const int cidx = u.pm < 32 ? 0 : 1 + ((u.pm - 32) >> 3);
        const float* gt = gate + cidx * 6144;
        const float* bs = u.pm < 32 ? base_ctx : base_lat - (size_t)T_CTX * DM;
        const int colb = u.pn * 256 + wc * 32 + 4 * fq;
        f32x4 g[2][2];
#pragma unroll
        for (int bj = 0; bj < 2; ++bj)
#pragma unroll
            for (int n = 0; n < 2; ++n) g[bj][n] = *(const f32x4*)(gt + colb + bj * 128 + n * 16);
#pragma unroll
        for (int ai = 0; ai < 2; ++ai)
#pragma unroll
            for (int m = 0; m < 4; ++m) {
                const size_t off = (size_t)(u.pm * 256 + ai * 128 + wr * 64 + m * 16 + fr) * DM + colb;
                f32x4 x[2][2];
#pragma unroll
                for (int bj = 0; bj < 2; ++bj)
#pragma unroll
                    for (int n = 0; n < 2; ++n) x[bj][n] = *(const f32x4*)(bs + off + bj * 128 + n * 16);
#pragma unroll
                for (int bj = 0; bj < 2; ++bj)
#pragma unroll
                    for (int n = 0; n < 2; ++n) *(f32x4*)(out + off + bj * 128 + n * 16) = x[bj][n] + g[bj][n] * acc[ai][bj][m][n];
                asm volatile("" ::: "memory");
            }
    }
};
struct EpiGateUp {
    static constexpr bool PERM = true, AFTER_DRAIN = false;
    h16* ff;
    __device__ __forceinline__ void operator()(const f32x4 (&acc)[2][2][4][2], const pg8::Unit& u, int wr, int wc, int fr, int fq) const {
        const int row0 = u.pm * 256 + wr * 64 + fr, col0 = u.pn * 128 + wc * 32 + 8 * fq;
#pragma unroll
        for (int ai = 0; ai < 2; ++ai)
#pragma unroll
            for (int m = 0; m < 4; ++m) {
                f32x4 v0, v1;
#pragma unroll
                for (int j = 0; j < 4; ++j) { v0[j] = siluf_(acc[ai][0][m][0][j]) * acc[ai][1][m][0][j]; v1[j] = siluf_(acc[ai][0][m][1][j]) * acc[ai][1][m][1][j]; }
                u32x4 w; w.x = pkh(v0[0], v0[1]); w.y = pkh(v0[2], v0[3]); w.z = pkh(v1[0], v1[1]); w.w = pkh(v1[2], v1[3]);
                *(u32x4*)(ff + (size_t)(row0 + ai * 128 + m * 16) * DFF + col0) = w;
            }
    }
};

__device__ __forceinline__ void phase_mod_partial(const Params& p, LAS float* ldsf, int it_begin, int it_end, int gw_, int NGW_) {
    const int tidx = ltid();
    for (int e = tidx; e < 9 * 1024; e += NTHR) { const int c = e >> 10, k = e & 1023; const float v = c == 0 ? p.c_ctx[k] : p.cnd[(c - 1) * 1024 + k]; ldsf[e] = siluf_(v); }
    __syncthreads();
    float* modp = (float*)(p.ws + WS_MODP);
    const int lane = tidx & 63;
    const int gw = gw_, NGW = NGW_;
    for (int it = it_begin + gw; it < it_end; it += NGW) {
        const int kq = it & 7, cgp = (it >> 3) % 96, l = it / (8 * 96);
        const int j = cgp * 64 + lane;
        const float* w = p.w_mod + ((size_t)l * 1024 + kq * 128) * 6144 + j;
        float acc[9];
#pragma unroll
        for (int c = 0; c < 9; ++c) acc[c] = 0.f;
#pragma unroll 4
        for (int k4 = 0; k4 < 32; ++k4) {
            const float w0 = w[(size_t)(4 * k4 + 0) * 6144], w1 = w[(size_t)(4 * k4 + 1) * 6144], w2 = w[(size_t)(4 * k4 + 2) * 6144], w3 = w[(size_t)(4 * k4 + 3) * 6144];
#pragma unroll
            for (int c = 0; c < 9; ++c) { const f32x4 s = *(const LAS f32x4*)(ldsf + c * 1024 + kq * 128 + 4 * k4); acc[c] += s.x * w0 + s.y * w1 + s.z * w2 + s.w * w3; }
        }
#pragma unroll
        for (int c = 0; c < 9; ++c) modp[(((size_t)kq * 4 + l) * 9 + c) * 6144 + j] = acc[c];
    }
    __syncthreads();
    if (blockIdx.x == 0 && it_begin == 0) {
        float* lb = (float*)(p.ws + WS_LB);
        for (int e = tidx; e < 1024; e += NTHR) {
            const float x0 = p.lb_logits[e], x1 = p.lb_logits[1024 + e], x2 = p.lb_logits[2048 + e], x3 = p.lb_logits[3072 + e];
            const float mx = fmaxf(fmaxf(x0, x1), fmaxf(x2, x3));
            const float e0 = expf(x0 - mx), e1 = expf(x1 - mx), e2 = expf(x2 - mx), e3 = expf(x3 - mx);
            const float inv = 1.f / (e0 + e1 + e2 + e3);
            lb[e] = 0.f; lb[1024 + e] = e1 * inv; lb[2048 + e] = (e1 + e2) * inv; lb[3072 + e] = (e1 + e2 + e3) * inv;
        }
    }
}
__device__ __forceinline__ void phase_mod_reduce(const Params& p, int e_begin, int e_end) {
    const float* modp = (const float*)(p.ws + WS_MODP); float* mod = (float*)(p.ws + WS_MOD);
    for (int e = e_begin + blockIdx.x * NTHR + ltid(); e < e_end; e += gridDim.x * NTHR) {
        const int j = e % 6144, l = e / (9 * 6144);
        float s = p.b_mod[l * 6144 + j];
#pragma unroll
        for (int kq = 0; kq < 8; ++kq) s += modp[(size_t)kq * (4 * 9 * 6144) + e];
        mod[e] = s;
    }
}

__device__ __forceinline__ void transpose_item(const float* W, int K, int N, h16* WT, int kb, int n0, int dst_row0, LAS float* scr, int lane) {
    const int k0 = 64 * kb, n = n0 + (lane & 31);
#pragma unroll 8
    for (int i = 0; i < 32; ++i) { const int kk = 2 * i + (lane >> 5); scr[kk * 33 + (lane & 31)] = (n < N) ? W[(size_t)(k0 + kk) * N + n] : 0.f; }
    asm volatile("s_waitcnt lgkmcnt(0)" ::: "memory");
    const int c = lane & 7;
#pragma unroll
    for (int j = 0; j < 4; ++j) {
        const int nn = (lane >> 3) + 8 * j; const LAS float* s = scr + (8 * c) * 33 + nn;
        u32x4 o; o.x = pkh(s[0 * 33], s[1 * 33]); o.y = pkh(s[2 * 33], s[3 * 33]); o.z = pkh(s[4 * 33], s[5 * 33]); o.w = pkh(s[6 * 33], s[7 * 33]);
        *(u32x4*)(WT + (size_t)(dst_row0 + nn) * K + k0 + 8 * c) = o;
    }
    asm volatile("s_waitcnt lgkmcnt(0)" ::: "memory");
}
__device__ __forceinline__ void convert_weights(const Params& p, int l, LAS float* scr, int gw, int NGW, int lane) {
    {
        h16* wg = (h16*)(p.ws + WS_WG16);
        const float* src = p.w_in + (size_t)l * DM * NIN + NPROJ;
        for (int e = gw * 64 + lane; e < 16 * 1024; e += NGW * 64) { const int k = e >> 4, g = e & 15; wg[g * 1024 + k] = (h16)src[(size_t)k * NIN + g]; }
    }
    h16* win = (h16*)(p.ws + WS_WIN); h16* wout = (h16*)(p.ws + WS_WOUT); h16* wgu = (h16*)(p.ws + WS_WGU); h16* wdn = (h16*)(p.ws + WS_WDN);
    constexpr int I_IN = 16 * 144, I_OUT = 16 * 32, I_G = 16 * 88, I_DN = 44 * 32;
    for (int it = gw; it < I_IN + I_OUT + 2 * I_G + I_DN; it += NGW) {
        int r = it;
        if (r < I_IN) { const int kb = r / 144, nb = r % 144; transpose_item(p.w_in + (size_t)l * DM * NIN, DM, NIN, win, kb, 32 * nb, 32 * nb, scr, lane); continue; } r -= I_IN;
        if (r < I_OUT) { const int kb = r / 32, nb = r % 32; transpose_item(p.w_out + (size_t)l * DM * DM, DM, DM, wout, kb, 32 * nb, 32 * nb, scr, lane); continue; } r -= I_OUT;
        if (r < I_G) { const int kb = r / 88, nb = r % 88, n0 = 32 * nb; transpose_item(p.w_gate + (size_t)l * DM * DFF, DM, DFF, wgu, kb, n0, (n0 >> 7) * 256 + (n0 & 127), scr, lane); continue; } r -= I_G;
        if (r < I_G) { const int kb = r / 88, nb = r % 88, n0 = 32 * nb; transpose_item(p.w_up + (size_t)l * DM * DFF, DM, DFF, wgu, kb, n0, (n0 >> 7) * 256 + 128 + (n0 & 127), scr, lane); continue; } r -= I_G;
        { const int kb = r / 32, nb = r % 32; transpose_item(p.w_down + (size_t)l * DFF * DM, DFF, DM, wdn, kb, 32 * nb, 32 * nb, scr, lane); }
    }
}
__device__ __forceinline__ void norm_mod_row(const float* xrow, const float* nw, const float* sc, const float* sh, h16* orow, int lane) {
    const f32x4* xr = (const f32x4*)xrow + lane;
    f32x4 v[4]; float s = 0.f;
#pragma unroll
    for (int j = 0; j < 4; ++j) { v[j] = xr[64 * j]; s += (v[j].x * v[j].x + v[j].y * v[j].y) + (v[j].z * v[j].z + v[j].w * v[j].w); }
    const float rstd = rsqrtf(wave_sum(s) * (1.f / DM) + EPS);
#pragma unroll
    for (int j = 0; j < 4; ++j) {
        const int col = 4 * lane + 256 * j;
        const f32x4 w4 = *(const f32x4*)(nw + col), s4 = *(const f32x4*)(sc + col), h4 = *(const f32x4*)(sh + col);
        const f32x4 y = v[j] * rstd * w4 * (1.f + s4) + h4;
        uint2 o; o.x = pkh(y.x, y.y); o.y = pkh(y.z, y.w);
        *(uint2*)(orow + col) = o;
    }
}
__device__ __forceinline__ void phase_norm(const Params& p, int l, int which, bool from_inputs, int gw, int NGW, int lane) {
    const float* mod = (const float*)(p.ws + WS_MOD) + (size_t)l * 9 * 6144;
    const float* nw = (which == 0 ? p.n1w : p.n2w) + l * DM;
    h16* hn = (h16*)(p.ws + WS_HN);
    for (int r = gw; r < T_ALL; r += NGW) {
        const float* xrow = from_inputs ? (r < T_CTX ? p.x_prompt + (size_t)r * DM : p.x_sample + (size_t)(r - T_CTX) * DM) : p.out + (size_t)r * DM;
        const float* m = mod + row_cidx(r) * 6144 + which * 3072;
        norm_mod_row(xrow, nw, m + 1024, m, hn + (size_t)r * DM, lane);
    }
}
__device__ __forceinline__ void phase_final_norm(const Params& p, int gw, int NGW, int lane) {
    for (int r = gw; r < T_ALL; r += NGW) {
        f32x4* xr = (f32x4*)(p.out + (size_t)r * DM) + lane;
        f32x4 v[4]; float s = 0.f;
#pragma unroll
        for (int j = 0; j < 4; ++j) { v[j] = xr[64 * j]; s += (v[j].x * v[j].x + v[j].y * v[j].y) + (v[j].z * v[j].z + v[j].w * v[j].w); }
        const float rstd = rsqrtf(wave_sum(s) * (1.f / DM) + EPS);
#pragma unroll
        for (int j = 0; j < 4; ++j) { const f32x4 w4 = *(const f32x4*)(p.fin_w + 4 * lane + 256 * j); xr[64 * j] = v[j] * rstd * w4; }
    }
}
__device__ __forceinline__ void phase_gates(const Params& p, int l, int gw, int NGW, int lane) {
    const h16* hn = (const h16*)(p.ws + WS_HN); const h16* wg = (const h16*)(p.ws + WS_WG16);
    float* gates = (float*)(p.ws + WS_GATES);
    const int c = lane & 15, q = lane >> 4;
    for (int grp = gw; grp < T_ALL / 16; grp += NGW) {
        const h16* ar = hn + (size_t)(16 * grp + c) * DM + 8 * q;
        const h16* br = wg + (size_t)c * DM + 8 * q;
        f32x4 acc = {0.f, 0.f, 0.f, 0.f};
#pragma unroll 8
        for (int kp = 0; kp < 32; ++kp) {
            const h16x8 a = *(const h16x8*)(ar + 32 * kp), bq = *(const h16x8*)(br + 32 * kp);
            acc = __builtin_amdgcn_mfma_f32_16x16x32_f16(a, bq, acc, 0, 0, 0);
        }
        const float bias = p.gate_b[l * 16 + c];
#pragma unroll
        for (int j = 0; j < 4; ++j) gates[(size_t)(16 * grp + 4 * q + j) * 16 + c] = acc[j] + bias;
    }
}
__device__ __forceinline__ void phase_conv(const Params& p, int l) {
    const h16* proj = (const h16*)(p.ws + WS_PROJ); h16* qkm = (h16*)(p.ws + WS_QKM);
    const float* cw = p.conv_w + (size_t)l * 9 * 1024; const float* cb = p.conv_b + l * 1024;
    for (int idx = blockIdx.x * NTHR + ltid(); idx < T_ALL * 128; idx += gridDim.x * NTHR) {
        const int r = idx >> 7, ch0 = (idx & 127) * 8;
        float acc[8];
        { const f32x4 b0 = *(const f32x4*)(cb + ch0), b1 = *(const f32x4*)(cb + ch0 + 4); acc[0] = b0.x; acc[1] = b0.y; acc[2] = b0.z; acc[3] = b0.w; acc[4] = b1.x; acc[5] = b1.y; acc[6] = b1.z; acc[7] = b1.w; }
        const h16* src = proj + 2560 + ch0;
        const bool lat = r >= T_CTX;
        const int pp = lat ? ((r - T_CTX) & 2047) : (r & 255);
        const int gy = lat ? (pp >> 6) : 0, gx = lat ? (pp & 63) : pp;
        const int H = lat ? 32 : 1, W = lat ? 64 : 256;
#pragma unroll
        for (int a = 0; a < 3; ++a) {
            const int yy = gy + a - 1;
            if (!lat && a != 1) continue;
            if (yy < 0 || yy >= H) continue;
#pragma unroll
            for (int b = 0; b < 3; ++b) {
                const int xx = gx + b - 1;
                if (xx < 0 || xx >= W) continue;
                const int rr = r + (a - 1) * 64 + (b - 1);
                const h16x8 x = *(const h16x8*)(src + (size_t)rr * NPROJ);
                const f32x4 t0 = *(const f32x4*)(cw + (a * 3 + b) * 1024 + ch0), t1 = *(const f32x4*)(cw + (a * 3 + b) * 1024 + ch0 + 4);
                acc[0] += t0.x * (float)x[0]; acc[1] += t0.y * (float)x[1]; acc[2] += t0.z * (float)x[2]; acc[3] += t0.w * (float)x[3];
                acc[4] += t1.x * (float)x[4]; acc[5] += t1.y * (float)x[5]; acc[6] += t1.z * (float)x[6]; acc[7] += t1.w * (float)x[7];
            }
        }
        const float sc = ch0 >= 512 ? 0.08838834764831845f : 1.f;
        u32x4 w; w.x = pkh(siluf_(acc[0]) * sc, siluf_(acc[1]) * sc); w.y = pkh(siluf_(acc[2]) * sc, siluf_(acc[3]) * sc);
        w.z = pkh(siluf_(acc[4]) * sc, siluf_(acc[5]) * sc); w.w = pkh(siluf_(acc[6]) * sc, siluf_(acc[7]) * sc);
        *(u32x4*)(qkm + (size_t)r * DM + ch0) = w;
    }
}

template <int TYPE  , int CMP = 0>
__device__ __forceinline__ void scan_item(const Params& p, int l, int lat, int b, int h, int dir, LAS float* lds) {
    const int tid = ltid(), lane = tid & 63, w = __builtin_amdgcn_readfirstlane(tid >> 6);
    const int L = lat ? 2048 : 256, row0 = lat ? T_CTX + b * 2048 : b * 256, NB = L / 16;
    LAS float* qs = lds;
    LAS float* fs = lds + 2048;
    LAS float* vs = lds + 4096;
    LAS float* part = lds + 6144;
    LAS float* partn = lds + 6144 + 16384;
    LAS float* scal = partn + 128;
    LAS float* mst = scal + 128;
    LAS float* cerr = mst + 16;
    LAS float* cref = cerr + 32;
    const h16* proj = (const h16*)(p.ws + WS_PROJ); const h16* qkm = (const h16*)(p.ws + WS_QKM); const float* gates = (const float*)(p.ws + WS_GATES);
    h16* odst = (h16*)(p.ws + (ODIR(dir) ? WS_OB : WS_HN));
    const size_t sidx = (((size_t)b * 4 + l) * 2 + dir) * 4 + h;
    if (CMP) { if (tid < 64) cerr[tid] = 0.f; __syncthreads(); }

    f32x2 S[16]; float nv = 0.f;
    if (lat) {
        const float* src = (TYPE == 0 ? p.st_hg : p.st_mc) + sidx * 16384;
#pragma unroll
        for (int dd = 0; dd < 16; ++dd) S[dd] = *(const f32x2*)(src + (16 * w + dd) * 128 + 2 * lane);
        if (TYPE == 1) { nv = lane < 16 ? p.st_mn[sidx * 128 + 16 * w + lane] : 0.f; if (tid == 0) mst[0] = p.st_mm[sidx]; }
    } else {
#pragma unroll
        for (int dd = 0; dd < 16; ++dd) S[dd] = (f32x2){0.f, 0.f};
        if (TYPE == 1 && tid == 0) mst[0] = 0.f;
    }
    const int tl = tid >> 5, d0 = 4 * (tid & 31);
    f32x4 lb4 = {0.f, 0.f, 0.f, 0.f};
    if (TYPE == 0) lb4 = *(const f32x4*)((const float*)(p.ws + WS_LB) + (l * 2 + dir) * 512 + h * 128 + d0);
    h16x4 pq, pz, pv; float pgi = 0.f, pgf = 0.f;
#define SCAN_LOAD(ii) do { const int pos_ = 16 * (ii) + tl, tok_ = dir ? L - 1 - pos_ : pos_; const size_t r_ = (size_t)(row0 + tok_); \
        if (TYPE == 0) { pq = *(const h16x4*)(proj + r_ * NPROJ + h * 128 + d0); pz = *(const h16x4*)(proj + r_ * NPROJ + 512 + dir * 512 + h * 128 + d0); pv = *(const h16x4*)(proj + r_ * NPROJ + 1536 + h * 128 + d0); } \
        else { pq = *(const h16x4*)(qkm + r_ * DM + h * 128 + d0); pz = *(const h16x4*)(qkm + r_ * DM + 512 + h * 128 + d0); pv = *(const h16x4*)(proj + r_ * NPROJ + 3584 + h * 128 + d0); \
               if (w == 0) { const int ps_ = 16 * (ii) + (lane & 15), tk_ = dir ? L - 1 - ps_ : ps_; const float* g_ = gates + (size_t)(row0 + tk_) * 16; pgi = g_[dir * 4 + h]; pgf = g_[8 + dir * 4 + h]; } } } while (0)
    SCAN_LOAD(0);
    for (int i = 0; i < NB; ++i) {
        const int par = i & 1;
        const int pos = 16 * i + tl, tok = dir ? L - 1 - pos : pos;
        const size_t r = (size_t)(row0 + tok);
        {
            *(LAS f32x4*)(qs + tl * 128 + d0) = (f32x4){(float)pq[0], (float)pq[1], (float)pq[2], (float)pq[3]};
            *(LAS f32x4*)(vs + tl * 128 + d0) = (f32x4){(float)pv[0], (float)pv[1], (float)pv[2], (float)pv[3]};
            if (TYPE == 0) {
                f32x4 f4;
#pragma unroll
                for (int j = 0; j < 4; ++j) f4[j] = lb4[j] + (1.f - lb4[j]) * sigmoidf_((float)pz[j]);
                *(LAS f32x4*)(fs + tl * 128 + d0) = f4;
            } else {
                *(LAS f32x4*)(fs + tl * 128 + d0) = (f32x4){(float)pz[0], (float)pz[1], (float)pz[2], (float)pz[3]};
                if (w == 0) {
                    const int t = lane & 15;
                    const float m0 = mst[0];
                    const float gi = pgi, lf = fminf(pgf, 0.f) - log1pf(__expf(-fabsf(pgf)));
                    float bc = lf;
#pragma unroll
                    for (int o = 1; o < 16; o <<= 1) { const float x = __shfl_up(bc, o, 16); if (t >= o) bc += x; }
                    float pm = gi - bc;
#pragma unroll
                    for (int o = 1; o < 16; o <<= 1) { const float x = __shfl_up(pm, o, 16); if (t >= o) pm = fmaxf(pm, x); }
                    const float mt = bc + fmaxf(m0, pm);
                    float mp = __shfl_up(mt, 1, 16); if (t == 0) mp = m0;
                    if (lane < 16) {
                        scal[(par * 16 + t) * 4 + 0] = __expf(lf + mp - mt);
                        scal[(par * 16 + t) * 4 + 1] = __expf(gi - mt);
                        scal[(par * 16 + t) * 4 + 2] = __expf(-mt);
                    }
                    asm volatile("s_waitcnt lgkmcnt(0)" ::: "memory");
                    if (lane == 15) mst[0] = mt;
                }
            }
        }
        if (i + 1 < NB) SCAN_LOAD(i + 1);
        __syncthreads();
#pragma unroll 2
        for (int t = 0; t < 16; ++t) {
            float fv = 0.f, qv = 0.f;
            if (lane < 16) { fv = fs[t * 128 + 16 * w + lane]; qv = qs[t * 128 + 16 * w + lane]; }
            const f32x2 v2 = *(const LAS f32x2*)(vs + t * 128 + 2 * lane);
            f32x2 o = {0.f, 0.f};
            if (TYPE == 0) {
#pragma unroll
                for (int dd = 0; dd < 16; ++dd) { const float sf = rdlane(fv, dd), sq = rdlane(qv, dd); S[dd] = v2 + sf * (S[dd] - v2); o += S[dd] * sq; }
            } else {
                const float a = __builtin_bit_cast(float, __builtin_amdgcn_readfirstlane(__builtin_bit_cast(int, scal[(par * 16 + t) * 4 + 0])));
                const float g = __builtin_bit_cast(float, __builtin_amdgcn_readfirstlane(__builtin_bit_cast(int, scal[(par * 16 + t) * 4 + 1])));
                const float gk = g * fv;
                nv = a * nv + gk;
                float nq = nv * qv;
                nq += __shfl_xor(nq, 8); nq += __shfl_xor(nq, 4); nq += __shfl_xor(nq, 2); nq += __shfl_xor(nq, 1);
                if (lane == 0) partn[t * 8 + w] = nq;
#pragma unroll
                for (int dd = 0; dd < 16; ++dd) { const float sk = rdlane(gk, dd), sq = rdlane(qv, dd); S[dd] = a * S[dd] + sk * v2; o += S[dd] * sq; }
            }
            *(LAS f32x2*)(part + (t * 8 + w) * 128 + 2 * lane) = o;
        }
        __syncthreads();
        {
            f32x4 acc = {0.f, 0.f, 0.f, 0.f};
#pragma unroll
            for (int ww = 0; ww < 8; ++ww) acc += *(const LAS f32x4*)(part + (tl * 8 + ww) * 128 + d0);
            if (TYPE == 1) {
                float den = 0.f;
#pragma unroll
                for (int ww = 0; ww < 8; ++ww) den += partn[tl * 8 + ww];
                const float sc = 1.f / fmaxf(fabsf(den), scal[(par * 16 + tl) * 4 + 2]);
                acc = acc * sc;
            }
            uint2 o; o.x = pkh(acc.x, acc.y); o.y = pkh(acc.z, acc.w);
            if (CMP) {
                const h16x4 old = *(const h16x4*)(odst + r * DM + TYPE * 512 + h * 128 + d0);
                float e = 0.f, rr = 0.f;
#pragma unroll
                for (int j = 0; j < 4; ++j) { const float df = (float)old[j] - acc[j]; e += df * df; rr += acc[j] * acc[j]; }
                e = wave_sum(e); rr = wave_sum(rr);
                if (lane == 0) { atomicAdd((float*)(cerr + (i >> 2)), e); atomicAdd((float*)(cref + (i >> 2)), rr); }
            }
            *(uint2*)(odst + r * DM + TYPE * 512 + h * 128 + d0) = o;
        }
    }
    if (CMP) {
        __syncthreads();
        if (tid == 0) {
            float best = -1.f; int bc_ = 0; float tot_e = 0.f, tot_r = 0.f;
            for (int cI = 0; cI < 32; ++cI) { const float rt = cerr[cI] / fmaxf(cref[cI], 1e-30f); tot_e += cerr[cI]; tot_r += cref[cI]; if (rt > best) { best = rt; bc_ = cI; } }
            float* dg = (float*)(p.ws + WS_MODP) + 4 * blockIdx.x;
#if defined(DIAG_ALL)
            const float tot = tot_e / fmaxf(tot_r, 1e-30f);
            if (tot > dg[0]) { dg[0] = tot; dg[1] = (float)(l * 8 + TYPE * 4 + lat * 2 + dir); dg[2] = best; dg[3] = (float)bc_; }
#else
            dg[0] = best; dg[1] = (float)bc_; dg[2] = tot_e / fmaxf(tot_r, 1e-30f); dg[3] = 0.f;
#endif
        }
    }
    if (!lat) {
        float* dst = p.out + (TYPE == 0 ? OUT_HG : OUT_MC) + sidx * 16384;
#pragma unroll
        for (int dd = 0; dd < 16; ++dd) *(f32x2*)(dst + (16 * w + dd) * 128 + 2 * lane) = S[dd];
        if (TYPE == 1) { if (lane < 16) p.out[OUT_MN + sidx * 128 + 16 * w + lane] = nv; if (tid == 0) p.out[OUT_MM + sidx] = mst[0]; }
    }
    __syncthreads();
#undef SCAN_LOAD
}
typedef unsigned u32x2 __attribute__((ext_vector_type(2)));
typedef short s16x8 __attribute__((ext_vector_type(8)));
typedef short s16x4 __attribute__((ext_vector_type(4)));
typedef __bf16 bf16x2_t __attribute__((ext_vector_type(2)));
__device__ __forceinline__ unsigned pkb(float a, float b) { f32x2 v = {a, b}; bf16x2_t r = __builtin_convertvector(v, bf16x2_t); return __builtin_bit_cast(unsigned, r); }
__device__ __forceinline__ unsigned short f2b(float a) { return (unsigned short)(pkb(a, 0.f) & 0xffffu); }
__device__ __forceinline__ s16x4 tr_read(LAS const unsigned char* ptr) { return __builtin_bit_cast(s16x4, __builtin_amdgcn_ds_read_tr16_b64_v4i16((LAS s16x4*)ptr)); }
constexpr int HP = 272;
__device__ __forceinline__ void scan_hgrn_mfma(const Params& p, int l, int lat, int b, int h, int dir, LAS unsigned char* lds) {
    const int tid = ltid(), lane = tid & 63, w = __builtin_amdgcn_readfirstlane(tid >> 6), c = lane & 15, q = lane >> 4;
    const int L = lat ? 2048 : 256, row0 = lat ? T_CTX + b * 2048 : b * 256, NB = L / 16;
    constexpr int IMG = 16 * HP, BUF = 4 * IMG + 512;
    LAS float* GS = (LAS float*)(lds + 2 * BUF);
    const h16* proj = (const h16*)(p.ws + WS_PROJ);
    h16* odst = (h16*)(p.ws + (ODIR(dir) ? WS_OB : WS_HN));
    const size_t sidx = (((size_t)b * 4 + l) * 2 + dir) * 4 + h;
    f32x4 S[8];
    if (lat) {
        const float* src = p.st_hg + sidx * 16384;
#pragma unroll
        for (int dt = 0; dt < 8; ++dt)
#pragma unroll
            for (int j = 0; j < 4; ++j) S[dt][j] = src[(16 * dt + 4 * q + j) * 128 + 16 * w + c];
    } else {
#pragma unroll
        for (int dt = 0; dt < 8; ++dt) S[dt] = (f32x4){0.f, 0.f, 0.f, 0.f};
    }
    const int pt = lane & 15, d0 = 16 * w + 4 * (lane >> 4);
    const f32x4 lb4 = *(const f32x4*)((const float*)(p.ws + WS_LB) + (l * 2 + dir) * 512 + h * 128 + d0);
    h16x4 rq, rz, rv;
#define HG_LOAD(ii) do { const int pos_ = 16 * (ii) + pt, tok_ = dir ? L - 1 - pos_ : pos_; const h16* r_ = proj + (size_t)(row0 + tok_) * NPROJ + h * 128 + d0; \
        rq = *(const h16x4*)(r_); rz = *(const h16x4*)(r_ + 512 + dir * 512); rv = *(const h16x4*)(r_ + 1536); } while (0)
#define HG_ROW_SHR(x, ctl) __builtin_bit_cast(float, __builtin_amdgcn_update_dpp(0, __builtin_bit_cast(int, (x)), (ctl), 0xF, 0xF, false))
    HG_LOAD(0);
    u32x2 o_prev = {0u, 0u}; h16* o_ptr = odst;
    for (int i = 0; i < NB; ++i) {
        LAS unsigned char* buf = lds + (i & 1) * BUF;
        LAS unsigned char* QT = buf; LAS unsigned char* KT = buf + IMG; LAS unsigned char* KH = buf + 2 * IMG; LAS unsigned char* VV = buf + 3 * IMG; LAS float* AD = (LAS float*)(buf + 4 * IMG);
        asm volatile("s_waitcnt vmcnt(0)" ::: "memory");
        if (i > 0) *(u32x2*)o_ptr = o_prev;
        {
            float kk[4], G[4];
#pragma unroll
            for (int j = 0; j < 4; ++j) { const float f = lb4[j] + (1.f - lb4[j]) * sigmoidf_((float)rz[j]); kk[j] = 1.f - f; G[j] = __logf(f); }
#pragma unroll
            for (int j = 0; j < 4; ++j) {
                G[j] += HG_ROW_SHR(G[j], 0x111); G[j] += HG_ROW_SHR(G[j], 0x112); G[j] += HG_ROW_SHR(G[j], 0x114); G[j] += HG_ROW_SHR(G[j], 0x118);
            }
            float oq[4], ok[4], oh[4];
            float ev[4];
#pragma unroll
            for (int j = 0; j < 4; ++j) {
                const float e = __expf(G[j]), ei = __builtin_amdgcn_rcpf(fmaxf(e, 8.7565e-27f)); ev[j] = e;
                const float et = __builtin_bit_cast(float, __builtin_amdgcn_update_dpp(0, __builtin_bit_cast(int, e), 0x15F, 0xF, 0xF, false));
                oq[j] = (float)rq[j] * e; ok[j] = kk[j] * ei; oh[j] = kk[j] * (et * ei);
            }
            u32x2 wq, wk, wh, wv;
            wq.x = pkb(oq[0], oq[1]); wq.y = pkb(oq[2], oq[3]); wk.x = pkb(ok[0], ok[1]); wk.y = pkb(ok[2], ok[3]);
            wh.x = pkb(oh[0], oh[1]); wh.y = pkb(oh[2], oh[3]); wv.x = pkb((float)rv[0], (float)rv[1]); wv.y = pkb((float)rv[2], (float)rv[3]);
            *(LAS u32x2*)(QT + pt * HP + 2 * d0) = wq; *(LAS u32x2*)(KT + pt * HP + 2 * d0) = wk; *(LAS u32x2*)(KH + pt * HP + 2 * d0) = wh; *(LAS u32x2*)(VV + pt * HP + 2 * d0) = wv;
            if (pt == 15) *(LAS f32x4*)(AD + d0) = (f32x4){ev[0], ev[1], ev[2], ev[3]};
        }
        { const int nx = (i + 1 < NB) ? i + 1 : NB - 1; HG_LOAD(nx); }
        __syncthreads();
        {
            f32x4 accO = {0.f, 0.f, 0.f, 0.f};
#pragma unroll
            for (int kp = 0; kp < 4; ++kp) {
                u32x4 sa; sa.x = pkb(S[2 * kp][0], S[2 * kp][1]); sa.y = pkb(S[2 * kp][2], S[2 * kp][3]); sa.z = pkb(S[2 * kp + 1][0], S[2 * kp + 1][1]); sa.w = pkb(S[2 * kp + 1][2], S[2 * kp + 1][3]);
                const u32x2 b0 = *(const LAS u32x2*)(QT + c * HP + 2 * (32 * kp + 4 * q)), b1 = *(const LAS u32x2*)(QT + c * HP + 2 * (32 * kp + 16 + 4 * q));
                u32x4 bb; bb.x = b0.x; bb.y = b0.y; bb.z = b1.x; bb.w = b1.y;
                accO = __builtin_amdgcn_mfma_f32_16x16x32_bf16(__builtin_bit_cast(s16x8, sa), __builtin_bit_cast(s16x8, bb), accO, 0, 0, 0);
            }
            f32x4 accP = {0.f, 0.f, 0.f, 0.f};
#pragma unroll
            for (int kp = 0; kp < 4; ++kp) {
                const s16x8 a = *(const LAS s16x8*)(KT + c * HP + 2 * (32 * kp + 8 * q));
                const s16x8 bq = *(const LAS s16x8*)(QT + c * HP + 2 * (32 * kp + 8 * q));
                accP = __builtin_amdgcn_mfma_f32_16x16x32_bf16(a, bq, accP, 0, 0, 0);
            }
#pragma unroll
            for (int j = 0; j < 4; ++j) accP[j] = (4 * q + j > c) ? 0.f : accP[j];
            u32x2 pb; pb.x = pkb(accP[0], accP[1]); pb.y = pkb(accP[2], accP[3]);
            const s16x4 vtr = tr_read(VV + (4 * q + (c >> 2)) * HP + 2 * (16 * w + 4 * (c & 3)));
            accO = __builtin_amdgcn_mfma_f32_16x16x16bf16_1k(vtr, __builtin_bit_cast(s16x4, pb), accO, 0, 0, 0);
            {
                const int pos = 16 * i + c, tok = dir ? L - 1 - pos : pos;
                o_prev.x = pkh(accO[0], accO[1]); o_prev.y = pkh(accO[2], accO[3]);
                o_ptr = odst + (size_t)(row0 + tok) * DM + h * 128 + 16 * w + 4 * q;
            }
#pragma unroll
            for (int dt = 0; dt < 8; ++dt) {
                const s16x4 ktr = tr_read(KH + (4 * q + (c >> 2)) * HP + 2 * (16 * dt + 4 * (c & 3)));
                const f32x4 ad = *(const LAS f32x4*)(AD + 16 * dt + 4 * q);
                S[dt] = S[dt] * ad;
                S[dt] = __builtin_amdgcn_mfma_f32_16x16x16bf16_1k(ktr, vtr, S[dt], 0, 0, 0);
            }
        }
#if defined(HG_EXTRA_SYNC)
        asm volatile("s_waitcnt vmcnt(0) lgkmcnt(0)" ::: "memory");
        __syncthreads();
#endif
    }
    *(u32x2*)o_ptr = o_prev;
    if (!lat) {
        float* dst = p.out + OUT_HG + sidx * 16384;
#pragma unroll
        for (int dt = 0; dt < 8; ++dt)
#pragma unroll
            for (int j = 0; j < 4; ++j) dst[(16 * dt + 4 * q + j) * 128 + 16 * w + c] = S[dt][j];
    }
    __syncthreads();
#undef HG_LOAD
#undef HG_ROW_SHR
}
constexpr int MP = 272;
constexpr int PP = 144;
__device__ __forceinline__ void scan_mlstm_mfma(const Params& p, int l, int lat, int b, int h, int dir, LAS unsigned char* lds) {
    const int tid = ltid(), lane = tid & 63, w = __builtin_amdgcn_readfirstlane(tid >> 6), c = lane & 15, q = lane >> 4;
    const int L = lat ? 2048 : 256, row0 = lat ? T_CTX + b * 2048 : b * 256, NC = L / 64;
    constexpr int IMG = 64 * MP, BUF = 3 * IMG + 1536;
    LAS unsigned char* PM = lds + 2 * BUF;
    LAS float* DENP = (LAS float*)(PM + 64 * PP);
    LAS float* QNP = DENP + 256;
    LAS float* NP = QNP + 512;
    LAS float* NV = NP + 512;
    LAS float* mst = NV + 128;
    const h16* proj = (const h16*)(p.ws + WS_PROJ); const h16* qkm = (const h16*)(p.ws + WS_QKM); const float* gates = (const float*)(p.ws + WS_GATES);
    h16* odst = (h16*)(p.ws + (ODIR(dir) ? WS_OB : WS_HN));
    const size_t sidx = (((size_t)b * 4 + l) * 2 + dir) * 4 + h;
    f32x4 C[8];
    if (lat) {
        const float* src = p.st_mc + sidx * 16384;
#pragma unroll
        for (int dt = 0; dt < 8; ++dt)
#pragma unroll
            for (int j = 0; j < 4; ++j) C[dt][j] = src[(16 * dt + 4 * q + j) * 128 + 16 * w + c];
        if (tid < 128) NV[tid] = p.st_mn[sidx * 128 + tid];
        if (tid == 0) mst[0] = p.st_mm[sidx];
    } else {
#pragma unroll
        for (int dt = 0; dt < 8; ++dt) C[dt] = (f32x4){0.f, 0.f, 0.f, 0.f};
        if (tid < 128) NV[tid] = 0.f;
        if (tid == 0) mst[0] = 0.f;
    }
    u32x4 pq[2], pk[2], pv[2]; float pgi = 0.f, pgf = 0.f;
#define ML_LOAD(ii) do { _Pragma("unroll") for (int j_ = 0; j_ < 2; ++j_) { const int e_ = tid + 512 * j_, rw_ = e_ >> 4, pc_ = e_ & 15; const int pos_ = 64 * (ii) + rw_, tok_ = dir ? L - 1 - pos_ : pos_; \
            const size_t r_ = (size_t)(row0 + tok_); pq[j_] = *(const u32x4*)(qkm + r_ * DM + h * 128 + 8 * pc_); pk[j_] = *(const u32x4*)(qkm + r_ * DM + 512 + h * 128 + 8 * pc_); \
            pv[j_] = *(const u32x4*)(proj + r_ * NPROJ + 3584 + h * 128 + 8 * pc_); } \
        if (w == 0) { const int ps_ = 64 * (ii) + lane, tk_ = dir ? L - 1 - ps_ : ps_; const float* g_ = gates + (size_t)(row0 + tk_) * 16; pgi = g_[dir * 4 + h]; pgf = g_[8 + dir * 4 + h]; } } while (0)
    ML_LOAD(0);
    for (int i = 0; i < NC; ++i) {
        LAS unsigned char* buf = lds + (i & 1) * BUF;
        LAS unsigned char* QM = buf; LAS unsigned char* KM = buf + IMG; LAS unsigned char* VM = buf + 2 * IMG;
        LAS float* U = (LAS float*)(buf + 3 * IMG); LAS float* MM = U + 64; LAS float* AI = U + 128; LAS float* EN = U + 192; LAS float* UE = U + 256;
        asm volatile("s_waitcnt vmcnt(0)" ::: "memory");
#pragma unroll
        for (int j = 0; j < 2; ++j) { const int e = tid + 512 * j, rw = e >> 4, pc = e & 15;
            *(LAS u32x4*)(QM + rw * MP + 16 * pc) = pq[j]; *(LAS u32x4*)(KM + rw * MP + 16 * pc) = pk[j]; *(LAS u32x4*)(VM + rw * MP + 16 * pc) = pv[j]; }
        if (w == 0) {
            const float m0 = mst[0];
            const float gi = pgi, lf = fminf(pgf, 0.f) - log1pf(__expf(-fabsf(pgf)));
            float bc = lf;
#pragma unroll
            for (int o = 1; o < 64; o <<= 1) { const float x = __shfl_up(bc, o); if (lane >= o) bc += x; }
            const float u = gi - bc;
            float pm = u;
#pragma unroll
            for (int o = 1; o < 64; o <<= 1) { const float x = __shfl_up(pm, o); if (lane >= o) pm = fmaxf(pm, x); }
            const float Mt = fmaxf(m0, pm);
            const float M63 = rdlane(Mt, 63), bc63 = rdlane(bc, 63);
            U[lane] = u; MM[lane] = Mt; AI[lane] = __expf(m0 - Mt); EN[lane] = __expf(-(bc + Mt)); UE[lane] = __expf(u - M63);
            asm volatile("s_waitcnt lgkmcnt(0)" ::: "memory");
            if (lane == 0) mst[0] = bc63 + M63;
        }
        { const int nx = (i + 1 < NC) ? i + 1 : NC - 1; ML_LOAD(nx); }
        __syncthreads();
        {
            const int tt = w >> 1;
#pragma unroll
            for (int k2 = 0; k2 < 2; ++k2) {
                const int st = 2 * (w & 1) + k2;
                if (st <= tt) {
                    f32x4 accP = {0.f, 0.f, 0.f, 0.f};
#pragma unroll
                    for (int kp = 0; kp < 4; ++kp) {
                        const h16x8 a = *(const LAS h16x8*)(KM + (16 * st + c) * MP + 2 * (32 * kp + 8 * q));
                        const h16x8 bq = *(const LAS h16x8*)(QM + (16 * tt + c) * MP + 2 * (32 * kp + 8 * q));
                        accP = __builtin_amdgcn_mfma_f32_16x16x32_f16(a, bq, accP, 0, 0, 0);
                    }
                    const f32x4 u4 = *(const LAS f32x4*)(U + 16 * st + 4 * q); const float mt = MM[16 * tt + c];
                    float pj[4];
#pragma unroll
                    for (int j = 0; j < 4; ++j) { const float e = accP[j] * __expf(u4[j] - mt); pj[j] = (16 * st + 4 * q + j <= 16 * tt + c) ? e : 0.f; }
                    u32x2 pw; pw.x = pkh(pj[0], pj[1]); pw.y = pkh(pj[2], pj[3]);
                    *(LAS u32x2*)(PM + (16 * tt + c) * PP + 2 * (16 * st + 4 * q)) = pw;
                    float cs = (pj[0] + pj[1]) + (pj[2] + pj[3]);
                    cs += __shfl_xor(cs, 16); cs += __shfl_xor(cs, 32);
                    if (q == 0) DENP[st * 64 + 16 * tt + c] = cs;
                }
            }
            {
                const h16x8 qa = *(const LAS h16x8*)(QM + lane * MP + 2 * (16 * w)), qb = *(const LAS h16x8*)(QM + lane * MP + 2 * (16 * w + 8));
                const f32x4 n0 = *(const LAS f32x4*)(NV + 16 * w), n1 = *(const LAS f32x4*)(NV + 16 * w + 4), n2 = *(const LAS f32x4*)(NV + 16 * w + 8), n3 = *(const LAS f32x4*)(NV + 16 * w + 12);
                float s = 0.f;
#pragma unroll
                for (int j = 0; j < 4; ++j) s += (float)qa[j] * n0[j] + (float)qa[4 + j] * n1[j] + (float)qb[j] * n2[j] + (float)qb[4 + j] * n3[j];
                QNP[w * 64 + lane] = s;
            }
            {
                const int d = tid & 127, part = tid >> 7;
                float s = 0.f;
#pragma unroll
                for (int ss = 0; ss < 16; ++ss) s += UE[16 * part + ss] * (float)*(const LAS h16*)(KM + (16 * part + ss) * MP + 2 * d);
                NP[part * 128 + d] = s;
            }
        }
        __syncthreads();
        {
            h16x4 vtr[4];
#pragma unroll
            for (int st = 0; st < 4; ++st) vtr[st] = __builtin_bit_cast(h16x4, tr_read(VM + (16 * st + 4 * q + (c >> 2)) * MP + 2 * (16 * w + 4 * (c & 3))));
            h16x8 cp[4];
#pragma unroll
            for (int kp = 0; kp < 4; ++kp) { u32x4 sa; sa.x = pkh(C[2 * kp][0], C[2 * kp][1]); sa.y = pkh(C[2 * kp][2], C[2 * kp][3]); sa.z = pkh(C[2 * kp + 1][0], C[2 * kp + 1][1]); sa.w = pkh(C[2 * kp + 1][2], C[2 * kp + 1][3]); cp[kp] = __builtin_bit_cast(h16x8, sa); }
#pragma unroll
            for (int tt = 0; tt < 4; ++tt) {
                const int t = 16 * tt + c;
                f32x4 accI = {0.f, 0.f, 0.f, 0.f}, accN = {0.f, 0.f, 0.f, 0.f};
#pragma unroll
                for (int kp = 0; kp < 4; ++kp) {
                    const u32x2 b0 = *(const LAS u32x2*)(QM + t * MP + 2 * (32 * kp + 4 * q)), b1 = *(const LAS u32x2*)(QM + t * MP + 2 * (32 * kp + 16 + 4 * q));
                    u32x4 bb; bb.x = b0.x; bb.y = b0.y; bb.z = b1.x; bb.w = b1.y;
                    accI = __builtin_amdgcn_mfma_f32_16x16x32_f16(cp[kp], __builtin_bit_cast(h16x8, bb), accI, 0, 0, 0);
                }
                float den = 0.f;
#pragma unroll
                for (int st = 0; st < 4; ++st) if (st <= tt) {
                    const u32x2 pb = *(const LAS u32x2*)(PM + t * PP + 2 * (16 * st + 4 * q));
                    accN = __builtin_amdgcn_mfma_f32_16x16x16f16(vtr[st], __builtin_bit_cast(h16x4, pb), accN, 0, 0, 0);
                    den += DENP[st * 64 + t];
                }
                float qn = 0.f;
#pragma unroll
                for (int ww = 0; ww < 8; ++ww) qn += QNP[ww * 64 + t];
                const float ai = AI[t];
                den += ai * qn;
                const float sc = 1.f / fmaxf(fabsf(den), EN[t]);
                f32x4 hv = (accN + accI * ai) * sc;
#pragma unroll
                for (int j = 0; j < 4; ++j) hv[j] = fminf(fmaxf(hv[j], -60000.f), 60000.f);
                const int pos = 64 * i + t, tok = dir ? L - 1 - pos : pos;
                u32x2 o; o.x = pkh(hv[0], hv[1]); o.y = pkh(hv[2], hv[3]);
                *(u32x2*)(odst + (size_t)(row0 + tok) * DM + 512 + h * 128 + 16 * w + 4 * q) = o;
            }
            const float a63 = AI[63];
            h16x4 vs[4];
#pragma unroll
            for (int st = 0; st < 4; ++st) { const f32x4 ue4 = *(const LAS f32x4*)(UE + 16 * st + 4 * q);
#pragma unroll
                for (int j = 0; j < 4; ++j) vs[st][j] = (h16)((float)vtr[st][j] * ue4[j]); }
#pragma unroll
            for (int dt = 0; dt < 8; ++dt) {
                C[dt] = C[dt] * a63;
#pragma unroll
                for (int st = 0; st < 4; ++st) {
                    const h16x4 ktr = __builtin_bit_cast(h16x4, tr_read(KM + (16 * st + 4 * q + (c >> 2)) * MP + 2 * (16 * dt + 4 * (c & 3))));
                    C[dt] = __builtin_amdgcn_mfma_f32_16x16x16f16(ktr, vs[st], C[dt], 0, 0, 0);
                }
            }
            if (tid < 128) NV[tid] = a63 * NV[tid] + (NP[tid] + NP[128 + tid]) + (NP[256 + tid] + NP[384 + tid]);
        }
#if defined(ML_EXTRA_SYNC)
        asm volatile("s_waitcnt vmcnt(0) lgkmcnt(0)" ::: "memory");
        __syncthreads();
#endif
    }
    __syncthreads();
    if (!lat) {
        float* dst = p.out + OUT_MC + sidx * 16384;
#pragma unroll
        for (int dt = 0; dt < 8; ++dt)
#pragma unroll
            for (int j = 0; j < 4; ++j) dst[(16 * dt + 4 * q + j) * 128 + 16 * w + c] = C[dt][j];
        if (tid < 128) p.out[OUT_MN + sidx * 128 + tid] = NV[tid];
        if (tid == 0) p.out[OUT_MM + sidx] = mst[0];
    }
    __syncthreads();
#undef ML_LOAD
}
#if defined(DIAG_ALL)
#define SCAN_HG(p, l, lat, b, h, dir, lds) do { scan_hgrn_mfma(p, l, lat, b, h, dir, (LAS unsigned char*)(lds)); asm volatile("s_waitcnt vmcnt(0)" ::: "memory"); __syncthreads(); scan_item<0, 1>(p, l, lat, b, h, dir, lds); } while (0)
#elif defined(HGRN_VALU)
#define SCAN_HG(p, l, lat, b, h, dir, lds) scan_item<0>(p, l, lat, b, h, dir, lds)
#else
#define SCAN_HG(p, l, lat, b, h, dir, lds) scan_hgrn_mfma(p, l, lat, b, h, dir, (LAS unsigned char*)(lds))
#endif
#if defined(MLSTM_VALU)
#define SCAN_ML(p, l, lat, b, h, dir, lds) scan_item<1>(p, l, lat, b, h, dir, lds)
#else
#if defined(DIAG_ALL)
#define SCAN_ML(p, l, lat, b, h, dir, lds) do { scan_mlstm_mfma(p, l, lat, b, h, dir, (LAS unsigned char*)(lds)); asm volatile("s_waitcnt vmcnt(0)" ::: "memory"); __syncthreads(); scan_item<1, 1>(p, l, lat, b, h, dir, lds); } while (0)
#elif defined(MLSTM_DIAG)
#define SCAN_ML(p, l, lat, b, h, dir, lds) do { scan_mlstm_mfma(p, l, lat, b, h, dir, (LAS unsigned char*)(lds)); \
        if ((lat) && (dir) == 0 && (l) == DIAG_LAYER) { asm volatile("s_waitcnt vmcnt(0)" ::: "memory"); __syncthreads(); scan_item<1, 1>(p, l, lat, b, h, dir, lds); } } while (0)
#elif defined(MLSTM_VALU_CTX)
#define SCAN_ML(p, l, lat, b, h, dir, lds) do { if (lat) scan_mlstm_mfma(p, l, lat, b, h, dir, (LAS unsigned char*)(lds)); else scan_item<1>(p, l, lat, b, h, dir, lds); } while (0)
#elif defined(MLSTM_MFMA_DIR0)
#define SCAN_ML(p, l, lat, b, h, dir, lds) do { if ((dir) == 0) scan_mlstm_mfma(p, l, lat, b, h, dir, (LAS unsigned char*)(lds)); else scan_item<1>(p, l, lat, b, h, dir, lds); } while (0)
#elif defined(MLSTM_BISECT)
#define SCAN_ML(p, l, lat, b, h, dir, lds) do { if (!((lat) && (dir) == 0 && (MLSTM_BISECT_COND))) scan_mlstm_mfma(p, l, lat, b, h, dir, (LAS unsigned char*)(lds)); else scan_item<1>(p, l, lat, b, h, dir, lds); } while (0)
#elif defined(MLSTM_VALU_LAT)
#define SCAN_ML(p, l, lat, b, h, dir, lds) do { if (!(lat)) scan_mlstm_mfma(p, l, lat, b, h, dir, (LAS unsigned char*)(lds)); else scan_item<1>(p, l, lat, b, h, dir, lds); } while (0)
#else
#define SCAN_ML(p, l, lat, b, h, dir, lds) scan_mlstm_mfma(p, l, lat, b, h, dir, (LAS unsigned char*)(lds))
#endif
#endif
__device__ __forceinline__ void scan_dispatch(const Params& p, int l, int it, LAS float* lds) {
    if (it < 128) { const int type = it >> 6, r = it & 63, b = r >> 3, h = (r >> 1) & 3, dir = r & 1; if (type == 0) SCAN_HG(p, l, 1, b, h, dir, lds); else SCAN_ML(p, l, 1, b, h, dir, lds); }
    else { const int q = it - 128, type = q >> 8, r = q & 255, b = r >> 3, h = (r >> 1) & 3, dir = r & 1; if (type == 0) SCAN_HG(p, l, 0, b, h, dir, lds); else SCAN_ML(p, l, 0, b, h, dir, lds); }
}
__device__ __forceinline__ void ctx_pair_mixnorm(const Params& p, int l, int b, int h) {
    asm volatile("s_waitcnt vmcnt(0)" ::: "memory");
    __syncthreads();
    const int tid = ltid(), lane = tid & 63, wave = __builtin_amdgcn_readfirstlane(tid >> 6);
    const h16* of = (const h16*)(p.ws + WS_HN); const h16* ob = (const h16*)(p.ws + WS_OB); const h16* proj = (const h16*)(p.ws + WS_PROJ);
    h16* mix = (h16*)(p.ws + WS_QKM);
    const float wh0 = p.hg_nw[l * 512 + h * 128 + 2 * lane], wh1 = p.hg_nw[l * 512 + h * 128 + 2 * lane + 1];
    const float wm0 = p.ml_nw[l * 512 + h * 128 + 2 * lane], wm1 = p.ml_nw[l * 512 + h * 128 + 2 * lane + 1];
    for (int pi = wave; pi < 512; pi += NWV) {
        const int row = b * 256 + (pi >> 1), type = pi & 1;
        const int cb = type * 512 + h * 128 + 2 * lane, gc = (type ? 4096 : 2048) + h * 128 + 2 * lane;
        const h16x2 a = *(const h16x2*)(of + (size_t)row * DM + cb), c2 = *(const h16x2*)(ob + (size_t)row * DM + cb), g = *(const h16x2*)(proj + (size_t)row * NPROJ + gc);
        const float o0 = (float)a[0] + (float)c2[0], o1 = (float)a[1] + (float)c2[1];
        const float ss = wave_sum(o0 * o0 + o1 * o1);
        const float rstd = rsqrtf(ss * (1.f / 128.f) + EPS);
        const float w0 = type ? wm0 : wh0, w1 = type ? wm1 : wh1;
        *(unsigned*)(mix + (size_t)row * DM + cb) = pkh(o0 * rstd * w0 * (float)g[0], o1 * rstd * w1 * (float)g[1]);
    }
}
__device__ __forceinline__ void phase_scan(const Params& p, int l, LAS float* lds) {
    const int G = gridDim.x, bid = blockIdx.x;
    if (G == 256) {
        if (bid < 128) scan_dispatch(p, l, bid, lds);
        else {
            const int pr = bid - 128, b = pr >> 2, h = pr & 3;
            SCAN_HG(p, l, 0, b, h, 0, lds); SCAN_HG(p, l, 0, b, h, 1, lds); SCAN_ML(p, l, 0, b, h, 0, lds); SCAN_ML(p, l, 0, b, h, 1, lds);
            ctx_pair_mixnorm(p, l, b, h);
            if (l == 0) { __syncthreads(); const int t_ = ltid(); phase_mod_partial(p, lds, 768, 3072, (bid - 128) * NWV + __builtin_amdgcn_readfirstlane(t_ >> 6), 128 * NWV); }
        }
    } else {
        for (int it = bid; it < 640; it += G) scan_dispatch(p, l, it, lds);
    }
}
__device__ __forceinline__ void phase_mixnorm(const Params& p, int l, int gw, int NGW, int lane, int row_begin) {
    const h16* of = (const h16*)(p.ws + WS_HN); const h16* ob = (const h16*)(p.ws + WS_OB); const h16* proj = (const h16*)(p.ws + WS_PROJ);
    h16* mix = (h16*)(p.ws + WS_QKM);
    const int col = 16 * lane;
    const float* nw = col < 512 ? p.hg_nw + l * 512 + col : p.ml_nw + l * 512 + (col - 512);
    float wv[16];
#pragma unroll
    for (int j = 0; j < 4; ++j) { const f32x4 t = *(const f32x4*)(nw + 4 * j); wv[4 * j] = t.x; wv[4 * j + 1] = t.y; wv[4 * j + 2] = t.z; wv[4 * j + 3] = t.w; }
    const int gcol = col < 512 ? 2048 + col : 4096 + (col - 512);
    for (int r = row_begin + gw; r < T_ALL; r += NGW) {
        const h16x8 a0 = *(const h16x8*)(of + (size_t)r * DM + col), a1 = *(const h16x8*)(of + (size_t)r * DM + col + 8);
        const h16x8 b0 = *(const h16x8*)(ob + (size_t)r * DM + col), b1 = *(const h16x8*)(ob + (size_t)r * DM + col + 8);
        const h16x8 g0 = *(const h16x8*)(proj + (size_t)r * NPROJ + gcol), g1 = *(const h16x8*)(proj + (size_t)r * NPROJ + gcol + 8);
        float o[16]; float ss = 0.f;
#pragma unroll
        for (int j = 0; j < 8; ++j) { o[j] = (float)a0[j] + (float)b0[j]; o[8 + j] = (float)a1[j] + (float)b1[j]; }
#pragma unroll
        for (int j = 0; j < 16; ++j) ss += o[j] * o[j];
        ss += __shfl_xor(ss, 1); ss += __shfl_xor(ss, 2); ss += __shfl_xor(ss, 4);
        const float rstd = rsqrtf(ss * (1.f / 128.f) + EPS);
        u32x4 w0, w1;
        w0.x = pkh(o[0] * rstd * wv[0] * (float)g0[0], o[1] * rstd * wv[1] * (float)g0[1]); w0.y = pkh(o[2] * rstd * wv[2] * (float)g0[2], o[3] * rstd * wv[3] * (float)g0[3]);
        w0.z = pkh(o[4] * rstd * wv[4] * (float)g0[4], o[5] * rstd * wv[5] * (float)g0[5]); w0.w = pkh(o[6] * rstd * wv[6] * (float)g0[6], o[7] * rstd * wv[7] * (float)g0[7]);
        w1.x = pkh(o[8] * rstd * wv[8] * (float)g1[0], o[9] * rstd * wv[9] * (float)g1[1]); w1.y = pkh(o[10] * rstd * wv[10] * (float)g1[2], o[11] * rstd * wv[11] * (float)g1[3]);
        w1.z = pkh(o[12] * rstd * wv[12] * (float)g1[4], o[13] * rstd * wv[13] * (float)g1[5]); w1.w = pkh(o[14] * rstd * wv[14] * (float)g1[6], o[15] * rstd * wv[15] * (float)g1[7]);
        *(u32x4*)(mix + (size_t)r * DM + col) = w0; *(u32x4*)(mix + (size_t)r * DM + col + 8) = w1;
    }
}

#define XB_TMO      128
#define XB_XCNT(j)  (256  + 64 * (j))
#define XB_XSUB(j)  (1280 + 64 * (j))
#define XB_XGEN(j)  (2304 + 64 * (j))
#define XB_TOP      3328
#define XB_TOPGEN   3392
#define XCD_BAR_WORDS 3456
#define XB_SPIN_CAP (1u << 18)

__device__ __forceinline__ unsigned xb_ld(unsigned* p)              { return __hip_atomic_load(p, __ATOMIC_RELAXED, __HIP_MEMORY_SCOPE_AGENT); }
__device__ __forceinline__ unsigned xb_add(unsigned* p, unsigned v) { return __hip_atomic_fetch_add(p, v, __ATOMIC_RELAXED, __HIP_MEMORY_SCOPE_AGENT); }
__device__ __forceinline__ unsigned xb_xcc_id() { return (unsigned)__builtin_amdgcn_s_getreg((3 << 11) | 20) & 0xFu; }
#define XB_SPIN(cond, bar) do { unsigned _sp = 0; while (cond) { __builtin_amdgcn_s_sleep(1); \
    if ((++_sp & 255u) == 0u) { if (xb_ld(&(bar)[XB_TMO])) break; if (_sp > XB_SPIN_CAP) { atomicAdd(&(bar)[XB_TMO], 1u); break; } } } } while (0)

struct XcdBarrier {
    unsigned* bar; unsigned x;
    volatile LAS unsigned* st;
};

__device__ __forceinline__ XcdBarrier xcd_barrier_post(unsigned* bar, volatile LAS unsigned* st) {
    XcdBarrier b; b.bar = bar; b.x = xb_xcc_id(); b.st = st;
    if (threadIdx.x == 0) (void)xb_add(&bar[XB_XCNT(b.x)], 1u);
    return b;
}
__device__ __forceinline__ void xcd_barrier_complete(unsigned* bar, unsigned x, unsigned& nloc, unsigned& nx) {
    const unsigned G = gridDim.x * gridDim.y * gridDim.z;
    unsigned sum, cnt, mine, sp = 0u;
    for (;;) {
        sum = 0u; cnt = 0u; mine = 0u;
#pragma unroll
        for (unsigned j = 0; j < 16; ++j) { const unsigned c = xb_ld(&bar[XB_XCNT(j)]); sum += c; cnt += (c > 0u) ? 1u : 0u; mine = (j == x) ? c : mine; }
        if (sum == G) break;
        __builtin_amdgcn_s_sleep(1);
        if ((++sp & 255u) == 0u) { if (xb_ld(&bar[XB_TMO])) break; if (sp > XB_SPIN_CAP) { atomicAdd(&bar[XB_TMO], 1u); break; } }
    }
    nloc = mine > 0u ? mine : 1u; nx = cnt > 0u ? cnt : 1u;
}

__device__ __forceinline__ void xcd_barrier(const XcdBarrier& b) {
    asm volatile("s_waitcnt vmcnt(0)" ::: "memory");
    __syncthreads();
    if (threadIdx.x == 0) {
        unsigned* bar = b.bar;
        __builtin_amdgcn_s_waitcnt(0);
        unsigned nloc = b.st[0], nx = b.st[1];
        if (nloc == 0u) { xcd_barrier_complete(bar, b.x, nloc, nx); b.st[0] = nloc; b.st[1] = nx; }
        const unsigned old = xb_add(&bar[XB_XSUB(b.x)], 1u);
        const unsigned gen = old / nloc;
        if (old + 1u == (gen + 1u) * nloc) {
            __builtin_amdgcn_fence(__ATOMIC_RELEASE, "agent");
            asm volatile("s_waitcnt vmcnt(0)" ::: "memory");
            const unsigned og = xb_add(&bar[XB_TOP], 1u);
            const unsigned tg = og / nx;
            if (og + 1u == (tg + 1u) * nx) xb_add(&bar[XB_TOPGEN], 1u);
            else XB_SPIN(xb_ld(&bar[XB_TOPGEN]) == tg, bar);
            __builtin_amdgcn_fence(__ATOMIC_ACQUIRE, "agent");
            xb_add(&bar[XB_XGEN(b.x)], 1u);
            asm volatile("s_waitcnt vmcnt(0)" ::: "memory");
        } else {
            XB_SPIN(xb_ld(&bar[XB_XGEN(b.x)]) == gen, bar);
            __builtin_amdgcn_fence(__ATOMIC_ACQUIRE, "agent");
            asm volatile("s_waitcnt vmcnt(0)" ::: "memory");
        }
    }
    __syncthreads();
}


__global__ void __launch_bounds__(NTHR, 2) fwd_megakernel(Params p) {
    extern __shared__ __attribute__((aligned(16))) unsigned char lds_raw[];
    cg::grid_group grid = cg::this_grid();
#if defined(USE_CG_SYNC)
#define GSYNC() do { asm volatile("s_waitcnt vmcnt(0)" ::: "memory"); grid.sync(); } while (0)
#else
#define GSYNC() do { XcdBarrier xb_; xb_.bar = (unsigned*)(p.ws + WS_BAR); xb_.x = xb_xcc_id(); xb_.st = (volatile LAS unsigned*)(lds + 131072 + 512); xcd_barrier(xb_); } while (0)
#endif
    LAS unsigned char* lds = (LAS unsigned char*)lds_raw;
    LAS float* ldsf = (LAS float*)lds_raw;
    const int G = gridDim.x, NGW = G * NWV;
#define PHASE_IDS() const int tid = ltid(), lane = tid & 63, wave = __builtin_amdgcn_readfirstlane(tid >> 6), gw = blockIdx.x * NWV + wave; (void)tid; (void)lane; (void)gw
    const float* mod = (const float*)(p.ws + WS_MOD);
    h16* hn = (h16*)(p.ws + WS_HN); h16* proj = (h16*)(p.ws + WS_PROJ); h16* mix = (h16*)(p.ws + WS_QKM); h16* ff = (h16*)(p.ws + WS_PROJ);

    volatile LAS unsigned* xst = (volatile LAS unsigned*)(lds + 131072 + 512);
    if (ltid() < 4) xst[ltid()] = 0u;
    __syncthreads();
    XcdBarrier xbar = xcd_barrier_post((unsigned*)(p.ws + WS_BAR), xst);
    const bool split_mod = (G == 256);
    { PHASE_IDS(); phase_mod_partial(p, ldsf, 0, split_mod ? 768 : 3072, gw, NGW); }
    asm volatile("s_waitcnt vmcnt(0)" ::: "memory"); grid.sync();
    (void)xbar;
    phase_mod_reduce(p, 0, split_mod ? 9 * 6144 : 4 * 9 * 6144);
    GSYNC();
#if defined(DIAG_ALL)
    if (ltid() == 0) { float* dg = (float*)(p.ws + WS_MODP) + 4 * blockIdx.x; dg[0] = 0.f; dg[1] = 0.f; dg[2] = 0.f; dg[3] = 0.f; }
#endif
    for (int l = 0; l < 4; ++l) {
        { PHASE_IDS(); convert_weights(p, l, ldsf + wave * 2176, gw, NGW, lane); }
        { PHASE_IDS(); phase_norm(p, l, 0, l == 0, gw, NGW, lane); }
        GSYNC();
        {
            pg8::Gemm g{(const pg8::bf16_t*)hn, (const pg8::bf16_t*)(p.ws + WS_WIN), T_ALL, NPROJ_PAD, DM}; pg8::StaticOrder S; S.init(T_ALL, NPROJ_PAD, G, (int)blockIdx.x);
            EpiInProj E{proj, (float*)(p.ws + WS_GATES), p.gate_b + l * 16};
            pg8::gemm_phase<EpiInProj, pg8::StaticOrder, true, true>(lds, g, S, E);
#if defined(PROBE_GEMM2)
            GSYNC();
            pg8::gemm_phase<EpiInProj, pg8::StaticOrder, true, true>(lds, g, S, E);
#endif
        }
        GSYNC();
        { PHASE_IDS(); phase_gates(p, l, gw, NGW, lane); }
        phase_conv(p, l);
        GSYNC();
#if defined(PERTURB)
        { if (ltid() == 0) { const unsigned long long t0_ = __builtin_amdgcn_s_memrealtime(); const unsigned long long dl_ = (unsigned long long)(((blockIdx.x * 37u + l * 11u) % 64u) * 300u); while (__builtin_amdgcn_s_memrealtime() - t0_ < dl_) __builtin_amdgcn_s_sleep(4); } __syncthreads(); }
#endif
        phase_scan(p, l, ldsf);
#if defined(PERTURB)
        { if (ltid() == 0) { const unsigned long long t0_ = __builtin_amdgcn_s_memrealtime(); const unsigned long long dl_ = (unsigned long long)(((blockIdx.x * 53u + l * 7u) % 32u) * 400u); while (__builtin_amdgcn_s_memrealtime() - t0_ < dl_) __builtin_amdgcn_s_sleep(4); } __syncthreads(); }
#endif
#if defined(DELAY_AFTER_SCAN)
        { if (ltid() == 0) { const unsigned long long t0_ = __builtin_amdgcn_s_memrealtime(); while (__builtin_amdgcn_s_memrealtime() - t0_ < (unsigned long long)(DELAY_AFTER_SCAN) * 100ull) __builtin_amdgcn_s_sleep(8); } __syncthreads(); }
#endif
#if defined(LDS_CLEAR)
        { __syncthreads(); const int t_ = ltid(); for (int e = t_; e < 32768; e += NTHR) ldsf[e] = LDS_CLEAR_VAL; __syncthreads(); }
#endif
        GSYNC();
#if defined(MLSTM_DIAG)
        if (l == DIAG_LAYER && blockIdx.x == 0 && ltid() == 0) {
            const float* dg = (const float*)(p.ws + WS_MODP);
            float best = -1.f; int code = 0;
            for (int bb = 64; bb < 128; bb += 2) { const float rt = dg[4 * bb + DIAG_FIELD]; if (rt > best) { best = rt; int lg = 0; float x = rt; while (x < 1.f && lg < 31) { x *= 2.f; ++lg; } code = DIAG_CODE; } }
            const unsigned long long t0 = __builtin_amdgcn_s_memrealtime();
            while (__builtin_amdgcn_s_memrealtime() - t0 < (unsigned long long)code * 5000ull) __builtin_amdgcn_s_sleep(8);
        }
#endif
#if defined(PROBE_GSYNC10)
        for (int rep = 0; rep < 10; ++rep) GSYNC();
#endif
#if defined(PROBE_SCAN_TYPE)
        { const int bid_ = blockIdx.x;
          if (bid_ < 128) { if ((bid_ >> 6) == PROBE_SCAN_TYPE) scan_dispatch(p, l, bid_, ldsf); }
          else for (int it = 128 + (bid_ - 128); it < 640; it += 128) { if (((it - 128) >> 8) == PROBE_SCAN_TYPE) scan_dispatch(p, l, it, ldsf); } }
        GSYNC();
#endif
#if defined(PROBE_SCAN2)
        phase_scan(p, l, ldsf);
        GSYNC();
#endif
        { PHASE_IDS(); phase_mixnorm(p, l, gw, NGW, lane, G == 256 ? T_CTX : 0); }
        if (l == 0 && split_mod) phase_mod_reduce(p, 9 * 6144, 4 * 9 * 6144);
        GSYNC();
        {
            pg8::Gemm g{(const pg8::bf16_t*)mix, (const pg8::bf16_t*)(p.ws + WS_WOUT), T_ALL, DM, DM}; pg8::StaticOrder S; S.init(T_ALL, DM, G, (int)blockIdx.x);
            EpiResid E{l == 0 ? p.x_prompt : p.out, l == 0 ? p.x_sample : p.out + (size_t)T_CTX * DM, p.out, mod + (size_t)l * 9 * 6144 + 2048};
#if defined(PROBE_GEMM2)
            { EpiResid E2 = E; E2.out = (float*)(p.ws + WS_PROJ); pg8::gemm_phase<EpiResid, pg8::StaticOrder, true, true>(lds, g, S, E2); GSYNC(); }
#endif
            pg8::gemm_phase<EpiResid, pg8::StaticOrder, true, true>(lds, g, S, E);
        }
        GSYNC();
        { PHASE_IDS(); phase_norm(p, l, 1, false, gw, NGW, lane); }
        GSYNC();
        {
            pg8::Gemm g{(const pg8::bf16_t*)hn, (const pg8::bf16_t*)(p.ws + WS_WGU), T_ALL, NGU, DM}; pg8::StaticOrder S; S.init(T_ALL, NGU, G, (int)blockIdx.x);
            EpiGateUp E{ff};
            pg8::gemm_phase<EpiGateUp, pg8::StaticOrder, true, true>(lds, g, S, E);
#if defined(PROBE_GEMM2)
            GSYNC();
            pg8::gemm_phase<EpiGateUp, pg8::StaticOrder, true, true>(lds, g, S, E);
#endif
        }
        GSYNC();
        {
            pg8::Gemm g{(const pg8::bf16_t*)ff, (const pg8::bf16_t*)(p.ws + WS_WDN), T_ALL, DM, DFF}; pg8::StaticOrder S; S.init(T_ALL, DM, G, (int)blockIdx.x);
            EpiResid E{p.out, p.out + (size_t)T_CTX * DM, p.out, mod + (size_t)l * 9 * 6144 + 5120};
#if defined(PROBE_GEMM2)
            { EpiResid E2 = E; E2.out = (float*)(p.ws + WS_QKM); pg8::gemm_phase<EpiResid, pg8::StaticOrder, true, true>(lds, g, S, E2); GSYNC(); }
#endif
            pg8::gemm_phase<EpiResid, pg8::StaticOrder, true, true>(lds, g, S, E);
        }
        GSYNC();
    }
    { PHASE_IDS(); phase_final_norm(p, gw, NGW, lane); }
#if defined(DIAG_ALL)
    if (blockIdx.x == 0 && ltid() == 0) {
        const float* dg = (const float*)(p.ws + WS_MODP);
        float best = -1.f; int code = 0;
        for (int bb = 0; bb < (int)gridDim.x; ++bb) { const float rt = dg[4 * bb]; if (rt > best) { best = rt; int lg = 0; float x = rt; while (x < 1.f && lg < 31) { x *= 2.f; ++lg; } code = DIAG_ALL_CODE; } }
        const unsigned long long t0 = __builtin_amdgcn_s_memrealtime();
        while (__builtin_amdgcn_s_memrealtime() - t0 < (unsigned long long)code * 5000ull) __builtin_amdgcn_s_sleep(8);
    }
#endif
}

extern "C" void kernel_launch(void* const* d_in, const int* in_sizes, int n_in, void* d_out, int out_size, void* d_ws, size_t ws_size, hipStream_t stream) {
    static int grid_blocks = 0;
    if (grid_blocks == 0) {
        if (n_in != 24 || (size_t)out_size != OUT_TOTAL || ws_size < WS_END) {
            fprintf(stderr, "kernel_launch: unexpected sizes n_in %d out %d ws %zu (need %zu)\n", n_in, out_size, ws_size, (size_t)WS_END); grid_blocks = -1; return;
        }
        int dev = 0, cus = 0, per_cu = 0;
        hipGetDevice(&dev);
        hipDeviceGetAttribute(&cus, hipDeviceAttributeMultiprocessorCount, dev);
        hipFuncSetAttribute((const void*)fwd_megakernel, hipFuncAttributeMaxDynamicSharedMemorySize, LDS_BYTES);
        hipOccupancyMaxActiveBlocksPerMultiprocessor(&per_cu, (const void*)fwd_megakernel, NTHR, LDS_BYTES);
        if (per_cu < 1) { fprintf(stderr, "kernel_launch: occupancy query says %d blocks per CU\n", per_cu); per_cu = 1; }
        grid_blocks = cus * 1;
        (void)hipGetLastError();
    }
    if (grid_blocks < 0) return;
    Params p{};
    const float** f = (const float**)&p;
    for (int i = 0; i < 24; ++i) f[i] = (const float*)d_in[i];
    p.out = (float*)d_out; p.ws = (unsigned char*)d_ws;
    if (hipMemsetAsync((char*)d_ws + WS_BAR, 0, 16384, stream) != hipSuccess) { fprintf(stderr, "kernel_launch: memset of the barrier words failed\n"); return; }
    void* args[] = {&p};
    hipError_t e = hipLaunchCooperativeKernel((const void*)fwd_megakernel, dim3(grid_blocks), dim3(NTHR), args, LDS_BYTES, stream);
    if (e != hipSuccess) fprintf(stderr, "cooperative launch failed: %s (grid %d)\n", hipGetErrorString(e), grid_blocks);
}
```

```cpp
#include <hip/hip_runtime.h>
#include <hip/hip_cooperative_groups.h>
#include <cstdio>
#include <cstdint>
namespace cg = cooperative_groups;
typedef _Float16 h16;
typedef _Float16 h16x8 __attribute__((ext_vector_type(8)));
typedef _Float16 h16x4 __attribute__((ext_vector_type(4)));
typedef _Float16 h16x2 __attribute__((ext_vector_type(2)));
typedef float f32x2 __attribute__((ext_vector_type(2)));
namespace pg8 {
#define PG8_LAS __attribute__((address_space(3)))
typedef unsigned short bf16_t;
typedef short bf16x8 __attribute__((ext_vector_type(8)));
typedef float f32x4 __attribute__((ext_vector_type(4)));
typedef unsigned u32x4 __attribute__((ext_vector_type(4)));
constexpr int BM = 256, BK = 64, HALF = 128, HTB = HALF * BK * 2  , STAGE_BYTES = 8 * HTB, NXCD = 8, WGM = 8;

__host__ __device__ __forceinline__ int lds_byte(int r, int c) { const int st = (r >> 4) * 2 + (c >> 5), rr = r & 15, cc = c & 31, ob = rr * 64 + cc * 2; return st * 1024 + (ob ^ (((ob >> 9) & 1) << 5)); }
__host__ __device__ __forceinline__ void stage_rc(int b, int& R, int& C) { const int st = b / 1024, sb = b % 1024, swz = sb ^ (((sb >> 9) & 1) << 5); R = (st >> 1) * 16 + swz / 64; C = (st & 1) * 32 + (swz % 64) / 2; }
__host__ __device__ __forceinline__ int perm32(int rho) { const int n = rho >> 4, i = rho & 15; return 8 * (i >> 2) + 4 * n + (i & 3); }

struct Unit { int pm, pn; };
struct Gemm { const bf16_t* A; const bf16_t* Bt; int M, N, K; };

struct StaticOrder {
    int nM, nN, nwg, G, c;
    __host__ __device__ void init(int M, int N, int G_, int c_) { nM = M / BM; nN = N / BM; nwg = nM * nN; G = G_; c = c_; }
    __host__ __device__ bool next(int i, Unit& u) const {
        const long L = (long)i * G + c; if (L >= nwg) return false;
        int wgid = (int)L; { const int q = nwg / NXCD, r = nwg % NXCD, xcd = wgid % NXCD, off = wgid / NXCD; wgid = (xcd < r ? xcd * (q + 1) : r * (q + 1) + (xcd - r) * q) + off; }
        const int nig = WGM * nN, gid = wgid / nig, fm = gid * WGM, gsz = (nM - fm) < WGM ? (nM - fm) : WGM;
        u.pm = fm + ((wgid % nig) % gsz); u.pn = (wgid % nig) / gsz; return true;
    }
    __device__ __forceinline__ void a_ready(const Unit&) const {}
    __device__ __forceinline__ void done(const Unit&) const {}
};

template <class Epi, class Sched, bool ALIGN_EPI = false, bool SP2 = false>
__device__ __forceinline__ void gemm_phase(PG8_LAS unsigned char* lds, const Gemm g, const Sched& S, const Epi& E) {
    int tid_l = threadIdx.x; asm volatile("" : "+v"(tid_l));
    const int tid = tid_l, wid = __builtin_amdgcn_readfirstlane(tid >> 6), lane = tid & 63, wr = wid >> 2, wc = wid & 3, fr = lane & 15, fq = lane >> 4;
    const int K = g.K, nt = K / BK;
    unsigned voffA[2], voffB[2];
#pragma unroll
    for (int i = 0; i < 2; ++i) { int R, C; stage_rc(tid * 16 + i * 8192, R, C); const int Rb = Epi::PERM ? ((R & ~31) + perm32(R & 31)) : R;
        voffA[i] = (unsigned)(R * K + C) * 2u; voffB[i] = (unsigned)(Rb * K + C) * 2u; }
    const size_t kstep = (size_t)(BK * 2);
    const size_t hstep = (size_t)HALF * K * 2;
    const size_t tstep = 2 * hstep;
    const unsigned ldsw = (unsigned)wid * 1024u;
    const int aoff = lds_byte(wr * 64 + fr, fq * 8), boff = lds_byte(wc * 32 + fr, fq * 8);
#define PG8_SA(b, h) (((b) * 2 + (h)) * HTB)
#define PG8_SB(b, h) ((4 + (b) * 2 + (h)) * HTB)
#define PG8_STAGE(bufoff, gbase, voff) do { _Pragma("unroll") for (int _i = 0; _i < 2; ++_i) \
        __builtin_amdgcn_global_load_lds((const unsigned*)((const char*)(gbase) + (voff)[_i]), (PG8_LAS unsigned*)(lds + (bufoff) + ldsw + _i * 8192), 16, 0, 0); } while (0)
#define PG8_LDA(dst, b, h) do { _Pragma("unroll") for (int m = 0; m < 4; ++m) _Pragma("unroll") for (int k = 0; k < 2; ++k) dst[m][k] = *(const PG8_LAS bf16x8*)(lds + PG8_SA(b, h) + aoff + m * 2048 + k * 1024); } while (0)
#define PG8_LDB(dst, b, h) do { _Pragma("unroll") for (int n = 0; n < 2; ++n) _Pragma("unroll") for (int k = 0; k < 2; ++k) dst[n][k] = *(const PG8_LAS bf16x8*)(lds + PG8_SB(b, h) + boff + n * 2048 + k * 1024); } while (0)
#define PG8_MMA(ai, bj, At, Bt) do { __builtin_amdgcn_s_setprio(1); _Pragma("unroll") for (int m = 0; m < 4; ++m) _Pragma("unroll") for (int n = 0; n < 2; ++n) _Pragma("unroll") for (int k = 0; k < 2; ++k) \
        acc[ai][bj][m][n] = __builtin_amdgcn_mfma_f32_16x16x32_f16(__builtin_bit_cast(h16x8, Bt[n][k]), __builtin_bit_cast(h16x8, At[m][k]), acc[ai][bj][m][n], 0, 0, 0); __builtin_amdgcn_s_setprio(0); } while (0)
#define PG8_WAIT_V(n) asm volatile("s_waitcnt vmcnt(" #n ")" ::: "memory")
#define PG8_WAIT_L(n) asm volatile("s_waitcnt lgkmcnt(" #n ")" ::: "memory")
#define PG8_BAR __builtin_amdgcn_s_barrier()
#define PG8_SCHED __builtin_amdgcn_sched_barrier(0)
    Unit cur, nxt; int ui = 0;
    if (!S.next(0, cur)) return;
    f32x4 acc[2][2][4][2];
#pragma unroll
    for (int a = 0; a < 2; ++a)
#pragma unroll
        for (int b = 0; b < 2; ++b)
#pragma unroll
            for (int m = 0; m < 4; ++m)
#pragma unroll
                for (int n = 0; n < 2; ++n) acc[a][b][m][n] = (f32x4){0.f, 0.f, 0.f, 0.f};
    bf16x8 At[4][2], B0[2][2], B1[2][2];
    const char* cA = (const char*)g.A + (size_t)cur.pm * tstep; const char* cB = (const char*)g.Bt + (size_t)cur.pn * tstep;
    S.a_ready(cur);
    if constexpr (SP2) {
        PG8_STAGE(PG8_SB(0, 0), cB, voffB); PG8_STAGE(PG8_SB(0, 1), cB + hstep, voffB); PG8_STAGE(PG8_SA(0, 0), cA, voffA); PG8_STAGE(PG8_SA(0, 1), cA + hstep, voffA);
        if (wr == 1) PG8_BAR;
        PG8_WAIT_V(2); PG8_BAR;
        PG8_STAGE(PG8_SB(1, 0), cB + kstep, voffB); PG8_STAGE(PG8_SA(1, 0), cA + kstep, voffA); PG8_STAGE(PG8_SB(1, 1), cB + hstep + kstep, voffB);
        PG8_WAIT_V(6); PG8_BAR;
    } else {
        PG8_STAGE(PG8_SB(0, 0), cB, voffB); PG8_STAGE(PG8_SA(0, 0), cA, voffA); PG8_STAGE(PG8_SB(0, 1), cB + hstep, voffB); PG8_STAGE(PG8_SA(0, 1), cA + hstep, voffA);
        if (wr == 1) PG8_BAR;
        PG8_WAIT_V(4); PG8_BAR;
        PG8_STAGE(PG8_SB(1, 0), cB + kstep, voffB); PG8_STAGE(PG8_SA(1, 0), cA + kstep, voffA); PG8_STAGE(PG8_SB(1, 1), cB + hstep + kstep, voffB);
        PG8_WAIT_V(6); PG8_BAR;
    }
    for (;;) {
        const bool has_next = S.next(ui + 1, nxt);
        const char* nA = has_next ? (const char*)g.A + (size_t)nxt.pm * tstep : cA; const char* nB = has_next ? (const char*)g.Bt + (size_t)nxt.pn * tstep : cB;
        for (int t = 0; t < nt; t += 2) {
            const bool last = (t == nt - 2);
            const char* a1 = cA + (size_t)(t + 1) * kstep;
            const char* a2 = last ? nA : cA + (size_t)(t + 2) * kstep; const char* b2 = last ? nB : cB + (size_t)(t + 2) * kstep;
            const char* a3 = a2 + kstep; const char* b3 = b2 + kstep;
            if (last && has_next) S.a_ready(nxt);
            if constexpr (SP2) {
            PG8_LDB(B0, 0, 0); PG8_LDB(B1, 0, 1); PG8_SCHED; PG8_LDA(At, 0, 0); PG8_STAGE(PG8_SA(1, 1), a1 + hstep, voffA);
            PG8_WAIT_V(8); PG8_WAIT_L(0); PG8_BAR; PG8_MMA(0, 0, At, B0); PG8_MMA(0, 1, At, B1); PG8_BAR; PG8_SCHED;
            PG8_LDA(At, 0, 1); PG8_STAGE(PG8_SB(0, 0), b2, voffB); PG8_STAGE(PG8_SB(0, 1), b2 + hstep, voffB); PG8_STAGE(PG8_SA(0, 0), a2, voffA);
            PG8_WAIT_V(8); PG8_WAIT_L(0); PG8_BAR; PG8_MMA(1, 0, At, B0); PG8_MMA(1, 1, At, B1); PG8_BAR; PG8_SCHED;
            PG8_LDB(B0, 1, 0); PG8_LDB(B1, 1, 1); PG8_SCHED; PG8_LDA(At, 1, 0); PG8_STAGE(PG8_SA(0, 1), a2 + hstep, voffA);
            PG8_WAIT_V(8); PG8_WAIT_L(0); PG8_BAR; PG8_MMA(0, 0, At, B0); PG8_MMA(0, 1, At, B1); PG8_BAR; PG8_SCHED;
            PG8_LDA(At, 1, 1); PG8_STAGE(PG8_SB(1, 0), b3, voffB); PG8_STAGE(PG8_SB(1, 1), b3 + hstep, voffB); PG8_STAGE(PG8_SA(1, 0), a3, voffA);
            PG8_WAIT_V(8); PG8_WAIT_L(0); PG8_BAR; PG8_MMA(1, 0, At, B0); PG8_MMA(1, 1, At, B1); PG8_BAR; PG8_SCHED;
            } else {
            PG8_LDB(B0, 0, 0); PG8_SCHED; PG8_LDA(At, 0, 0); PG8_STAGE(PG8_SA(1, 1), a1 + hstep, voffA);
            PG8_WAIT_L(8); PG8_BAR; PG8_WAIT_L(0); PG8_MMA(0, 0, At, B0); PG8_BAR; PG8_SCHED;
            PG8_LDB(B1, 0, 1); PG8_STAGE(PG8_SB(0, 0), b2, voffB);
            PG8_BAR; PG8_WAIT_L(0); PG8_MMA(0, 1, At, B1); PG8_BAR;
            PG8_LDA(At, 0, 1); PG8_STAGE(PG8_SA(0, 0), a2, voffA);
            PG8_BAR; PG8_WAIT_L(0); PG8_MMA(1, 0, At, B0); PG8_BAR; PG8_SCHED;
            PG8_STAGE(PG8_SB(0, 1), b2 + hstep, voffB);
            PG8_WAIT_V(6); PG8_BAR; PG8_MMA(1, 1, At, B1); PG8_BAR;
            PG8_LDB(B0, 1, 0); PG8_SCHED; PG8_LDA(At, 1, 0); PG8_STAGE(PG8_SA(0, 1), a2 + hstep, voffA);
            PG8_WAIT_L(8); PG8_BAR; PG8_WAIT_L(0); PG8_MMA(0, 0, At, B0); PG8_BAR; PG8_SCHED;
            PG8_LDB(B1, 1, 1); PG8_STAGE(PG8_SB(1, 0), b3, voffB);
            PG8_BAR; PG8_WAIT_L(0); PG8_MMA(0, 1, At, B1); PG8_BAR;
            PG8_LDA(At, 1, 1); PG8_STAGE(PG8_SA(1, 0), a3, voffA);
            PG8_BAR; PG8_WAIT_L(0); PG8_MMA(1, 0, At, B0); PG8_BAR; PG8_SCHED;
            PG8_STAGE(PG8_SB(1, 1), b3 + hstep, voffB);
            PG8_WAIT_V(6); PG8_BAR; PG8_MMA(1, 1, At, B1); PG8_BAR;
            }
        }
        if constexpr (ALIGN_EPI) { if (wr == 0) PG8_BAR; }
        if constexpr (!Epi::AFTER_DRAIN) { E(acc, cur, wr, wc, fr, fq); S.done(cur); }
        if (!has_next) break;
#pragma unroll
        for (int a = 0; a < 2; ++a)
#pragma unroll
            for (int b = 0; b < 2; ++b)
#pragma unroll
                for (int m = 0; m < 4; ++m)
#pragma unroll
                    for (int n = 0; n < 2; ++n) acc[a][b][m][n] = (f32x4){0.f, 0.f, 0.f, 0.f};
        cur = nxt; cA = nA; cB = nB; ++ui;
        if constexpr (ALIGN_EPI) { if (wr == 1) PG8_BAR; }
    }
    PG8_WAIT_V(0);
    if constexpr (!ALIGN_EPI) { if (wr == 0) PG8_BAR; }
    PG8_BAR;
    if constexpr (Epi::AFTER_DRAIN) { E.fused(acc, cur, wr, wc, fr, fq, lds, wid, lane); S.done(cur); }
#undef PG8_SA
#undef PG8_SB
#undef PG8_STAGE
#undef PG8_LDA
#undef PG8_LDB
#undef PG8_MMA
#undef PG8_WAIT_V
#undef PG8_WAIT_L
#undef PG8_BAR
#undef PG8_SCHED
}
}
#define LAS __attribute__((address_space(3)))
using pg8::f32x4;
using pg8::u32x4;
constexpr int T_CTX = 8192, T_LAT = 16384, T_ALL = 24576, DM = 1024;
constexpr int NPROJ = 4608, NPROJ_PAD = 4608, NIN = 4624, DFF = 2816, NGU = 5632;
constexpr int NTHR = 512, NWV = 8;
constexpr float EPS = 1e-6f;
constexpr int LDS_BYTES = 132096;

constexpr size_t OUT_HG = 25165824, OUT_MC = 41943040, OUT_MN = 58720256, OUT_MM = 58851328, OUT_TOTAL = 58852352;

constexpr size_t al256(size_t x) { return (x + 255) & ~(size_t)255; }
constexpr size_t WS_WIN = 0;
constexpr size_t WS_WOUT = WS_WIN + al256((size_t)NPROJ_PAD * DM * 2);
constexpr size_t WS_WGU = WS_WOUT + al256((size_t)DM * DM * 2);
constexpr size_t WS_WDN = WS_WGU + al256((size_t)NGU * DM * 2);
constexpr size_t WS_MODP = WS_WDN + al256((size_t)DM * DFF * 2);
constexpr size_t WS_MOD = WS_MODP + al256((size_t)8 * 4 * 9 * 6144 * 4);
constexpr size_t WS_LB = WS_MOD + al256((size_t)4 * 9 * 6144 * 4);
constexpr size_t WS_HN = WS_LB + al256((size_t)4 * 2 * 512 * 4);
constexpr size_t WS_PROJ = WS_HN + al256((size_t)T_ALL * DM * 2);
constexpr size_t WS_GATES = WS_PROJ + al256((size_t)T_ALL * NPROJ * 2);
constexpr size_t WS_QKM = WS_GATES + al256((size_t)T_ALL * 16 * 4);
constexpr size_t WS_OB = WS_QKM + al256((size_t)T_ALL * DM * 2);
constexpr size_t WS_BAR = WS_OB + al256((size_t)T_ALL * DM * 2);
constexpr size_t WS_WG16 = WS_BAR + 16384;
constexpr size_t WS_END = WS_WG16 + 32768;

#if defined(SWAP_OBUF)
#define ODIR(d) (!(d))
#else
#define ODIR(d) (d)
#endif
struct Params {
    const float *x_prompt, *x_sample, *st_hg, *st_mc, *st_mn, *st_mm, *cnd, *c_ctx, *n1w, *n2w, *w_mod, *b_mod, *w_in, *conv_w, *conv_b, *gate_b,
        *lb_logits, *hg_nw, *ml_nw, *w_out, *w_gate, *w_up, *w_down, *fin_w;
    float* out; unsigned char* ws;
};

__device__ __forceinline__ float sigmoidf_(float x) { return __builtin_amdgcn_rcpf(1.f + __expf(-x)); }
__device__ __forceinline__ float siluf_(float x) { return x * __builtin_amdgcn_rcpf(1.f + __expf(-x)); }
__device__ __forceinline__ unsigned pkh(float a, float b) { h16x2 v = {(h16)a, (h16)b}; return __builtin_bit_cast(unsigned, v); }
__device__ __forceinline__ float wave_sum(float v) {
#pragma unroll
    for (int o = 1; o < 64; o <<= 1) v += __shfl_xor(v, o);
    return v;
}
__device__ __forceinline__ int row_cidx(int row) { return row < T_CTX ? 0 : 1 + ((row - T_CTX) >> 11); }
__device__ __forceinline__ int ltid() { int t = threadIdx.x; asm volatile("" : "+v"(t)); return t; }
__device__ __forceinline__ float rdlane(float v, int l) { return __builtin_bit_cast(float, __builtin_amdgcn_readlane(__builtin_bit_cast(int, v), l)); }

struct EpiInProj {
    static constexpr bool PERM = true, AFTER_DRAIN = false;
    h16* proj; float* gates; const float* gate_b;
    __device__ __forceinline__ void operator()(const f32x4 (&acc)[2][2][4][2], const pg8::Unit& u, int wr, int wc, int fr, int fq) const {
        const int row0 = u.pm * 256 + wr * 64 + fr;
#pragma unroll
        for (int bj = 0; bj < 2; ++bj) {
            const int colt = u.pn * 256 + bj * 128, reg = colt >> 9;
            const int act = (reg == 0 || reg == 4) ? 1 : (reg == 8 ? 2 : 0);
            const int col0 = colt + wc * 32 + 8 * fq;
#pragma unroll
            for (int ai = 0; ai < 2; ++ai)
#pragma unroll
                for (int m = 0; m < 4; ++m) {
                    f32x4 v0 = acc[ai][bj][m][0], v1 = acc[ai][bj][m][1];
                    if (act == 1) {
#pragma unroll
                        for (int j = 0; j < 4; ++j) { v0[j] = siluf_(v0[j]); v1[j] = siluf_(v1[j]); }
                    } else if (act == 2) {
#pragma unroll
                        for (int j = 0; j < 4; ++j) { v0[j] = sigmoidf_(v0[j]); v1[j] = sigmoidf_(v1[j]); }
                    }
                    u32x4 w; w.x = pkh(v0[0], v0[1]); w.y = pkh(v0[2], v0[3]); w.z = pkh(v1[0], v1[1]); w.w = pkh(v1[2], v1[3]);
                    *(u32x4*)(proj + (size_t)(row0 + ai * 128 + m * 16) * NPROJ + col0) = w;
                }
        }
    }
};
struct EpiResid {
    static constexpr bool PERM = false, AFTER_DRAIN = false;
    const float* base_ctx; const float* base_lat; float* out; const float* gate;
    __device__ __forceinline__ void operator()(const f32x4 (&acc)[2][2][4][2], const pg8::Unit& u, int wr, int wc, int fr, int fq) const {
        const int cidx = u.pm < 32 ? 0 : 1 + ((u.pm - 32) >> 3);
        const float* gt = gate + cidx * 6144;
        const float* bs = u.pm < 32 ? base_ctx : base_lat - (size_t)T_CTX * DM;
        const int colb = u.pn * 256 + wc * 32 + 4 * fq;
        f32x4 g[2][2];
#pragma unroll
        for (int bj = 0; bj < 2; ++bj)
#pragma unroll
            for (int n = 0; n < 2; ++n) g[bj][n] = *(const f32x4*)(gt + colb + bj * 128 + n * 16);
#pragma unroll
        for (int ai = 0; ai < 2; ++ai)
#pragma unroll
            for (int m = 0; m < 4; ++m) {
                const size_t off = (size_t)(u.pm * 256 + ai * 128 + wr * 64 + m * 16 + fr) * DM + colb;
                f32x4 x[2][2];
#pragma unroll
                for (int bj = 0; bj < 2; ++bj)
#pragma unroll
                    for (int n = 0; n < 2; ++n) x[bj][n] = *(const f32x4*)(bs + off + bj * 128 + n * 16);
#pragma unroll
                for (int bj = 0; bj < 2; ++bj)
#pragma unroll
                    for (int n = 0; n < 2; ++n) *(f32x4*)(out + off + bj * 128 + n * 16) = x[bj][n] + g[bj][n] * acc[ai][bj][m][n];
                asm volatile("" ::: "memory");
            }
    }
};
struct EpiGateUp {
    static constexpr bool PERM = true, AFTER_DRAIN = false;
    h16* ff;
    __device__ __forceinline__ void operator()(const f32x4 (&acc)[2][2][4][2], const pg8::Unit& u, int wr, int wc, int fr, int fq) const {
        const int row0 = u.pm * 256 + wr * 64 + fr, col0 = u.pn * 128 + wc * 32 + 8 * fq;
#pragma unroll
        for (int ai = 0; ai < 2; ++ai)
#pragma unroll
            for (int m = 0; m < 4; ++m) {
                f32x4 v0, v1;
#pragma unroll
                for (int j = 0; j < 4; ++j) { v0[j] = siluf_(acc[ai][0][m][0][j]) * acc[ai][1][m][0][j]; v1[j] = siluf_(acc[ai][0][m][1][j]) * acc[ai][1][m][1][j]; }
                u32x4 w; w.x = pkh(v0[0], v0[1]); w.y = pkh(v0[2], v0[3]); w.z = pkh(v1[0], v1[1]); w.w = pkh(v1[2], v1[3]);
                *(u32x4*)(ff + (size_t)(row0 + ai * 128 + m * 16) * DFF + col0) = w;
            }
    }
};

__device__ __forceinline__ void phase_mod_partial(const Params& p, LAS float* ldsf, int it_begin, int it_end, int gw_, int NGW_) {
    const int tidx = ltid();
    for (int e = tidx; e < 9 * 1024; e += NTHR) { const int c = e >> 10, k = e & 1023; const float v = c == 0 ? p.c_ctx[k] : p.cnd[(c - 1) * 1024 + k]; ldsf[e] = siluf_(v); }
    __syncthreads();
    float* modp = (float*)(p.ws + WS_MODP);
    const int lane = tidx & 63;
    const int gw = gw_, NGW = NGW_;
    for (int it = it_begin + gw; it < it_end; it += NGW) {
        const int kq = it & 7, cgp = (it >> 3) % 96, l = it / (8 * 96);
        const int j = cgp * 64 + lane;
        const float* w = p.w_mod + ((size_t)l * 1024 + kq * 128) * 6144 + j;
        float acc[9];
#pragma unroll
        for (int c = 0; c < 9; ++c) acc[c] = 0.f;
#pragma unroll 4
        for (int k4 = 0; k4 < 32; ++k4) {
            const float w0 = w[(size_t)(4 * k4 + 0) * 6144], w1 = w[(size_t)(4 * k4 + 1) * 6144], w2 = w[(size_t)(4 * k4 + 2) * 6144], w3 = w[(size_t)(4 * k4 + 3) * 6144];
#pragma unroll
            for (int c = 0; c < 9; ++c) { const f32x4 s = *(const LAS f32x4*)(ldsf + c * 1024 + kq * 128 + 4 * k4); acc[c] += s.x * w0 + s.y * w1 + s.z * w2 + s.w * w3; }
        }
#pragma unroll
        for (int c = 0; c < 9; ++c) modp[(((size_t)kq * 4 + l) * 9 + c) * 6144 + j] = acc[c];
    }
    __syncthreads();
    if (blockIdx.x == 0 && it_begin == 0) {
        float* lb = (float*)(p.ws + WS_LB);
        for (int e = tidx; e < 1024; e += NTHR) {
            const float x0 = p.lb_logits[e], x1 = p.lb_logits[1024 + e], x2 = p.lb_logits[2048 + e], x3 = p.lb_logits[3072 + e];
            const float mx = fmaxf(fmaxf(x0, x1), fmaxf(x2, x3));
            const float e0 = expf(x0 - mx), e1 = expf(x1 - mx), e2 = expf(x2 - mx), e3 = expf(x3 - mx);
            const float inv = 1.f / (e0 + e1 + e2 + e3);
            lb[e] = 0.f; lb[1024 + e] = e1 * inv; lb[2048 + e] = (e1 + e2) * inv; lb[3072 + e] = (e1 + e2 + e3) * inv;
        }
    }
}
__device__ __forceinline__ void phase_mod_reduce(const Params& p, int e_begin, int e_end) {
    const float* modp = (const float*)(p.ws + WS_MODP); float* mod = (float*)(p.ws + WS_MOD);
    for (int e = e_begin + blockIdx.x * NTHR + ltid(); e < e_end; e += gridDim.x * NTHR) {
        const int j = e % 6144, l = e / (9 * 6144);
        float s = p.b_mod[l * 6144 + j];
#pragma unroll
        for (int kq = 0; kq < 8; ++kq) s += modp[(size_t)kq * (4 * 9 * 6144) + e];
        mod[e] = s;
    }
}

__device__ __forceinline__ void transpose_item(const float* W, int K, int N, h16* WT, int kb, int n0, int dst_row0, LAS float* scr, int lane) {
    const int k0 = 64 * kb, n = n0 + (lane & 31);
#pragma unroll 8
    for (int i = 0; i < 32; ++i) { const int kk = 2 * i + (lane >> 5); scr[kk * 33 + (lane & 31)] = (n < N) ? W[(size_t)(k0 + kk) * N + n] : 0.f; }
    asm volatile("s_waitcnt lgkmcnt(0)" ::: "memory");
    const int c = lane & 7;
#pragma unroll
    for (int j = 0; j < 4; ++j) {
        const int nn = (lane >> 3) + 8 * j; const LAS float* s = scr + (8 * c) * 33 + nn;
        u32x4 o; o.x = pkh(s[0 * 33], s[1 * 33]); o.y = pkh(s[2 * 33], s[3 * 33]); o.z = pkh(s[4 * 33], s[5 * 33]); o.w = pkh(s[6 * 33], s[7 * 33]);
        *(u32x4*)(WT + (size_t)(dst_row0 + nn) * K + k0 + 8 * c) = o;
    }
    asm volatile("s_waitcnt lgkmcnt(0)" ::: "memory");
}
__device__ __forceinline__ void convert_weights(const Params& p, int l, LAS float* scr, int gw, int NGW, int lane, int mask) {
    if (mask & 1) {
        h16* wg = (h16*)(p.ws + WS_WG16);
        const float* src = p.w_in + (size_t)l * DM * NIN + NPROJ;
        for (int e = gw * 64 + lane; e < 16 * 1024; e += NGW * 64) { const int k = e >> 4, g = e & 15; wg[g * 1024 + k] = (h16)src[(size_t)k * NIN + g]; }
    }
    h16* win = (h16*)(p.ws + WS_WIN); h16* wout = (h16*)(p.ws + WS_WOUT); h16* wgu = (h16*)(p.ws + WS_WGU); h16* wdn = (h16*)(p.ws + WS_WDN);
    constexpr int I_IN = 16 * 144, I_OUT = 16 * 32, I_G = 16 * 88, I_DN = 44 * 32;
    for (int it = gw; it < I_IN + I_OUT + 2 * I_G + I_DN; it += NGW) {
        int r = it;
        if (r < I_IN) { if (!(mask & 1)) continue; const int kb = r / 144, nb = r % 144; transpose_item(p.w_in + (size_t)l * DM * NIN, DM, NIN, win, kb, 32 * nb, 32 * nb, scr, lane); continue; } r -= I_IN;
        if (r < I_OUT) { if (!(mask & 2)) continue; const int kb = r / 32, nb = r % 32; transpose_item(p.w_out + (size_t)l * DM * DM, DM, DM, wout, kb, 32 * nb, 32 * nb, scr, lane); continue; } r -= I_OUT;
        if (r < I_G) { if (!(mask & 4)) continue; const int kb = r / 88, nb = r % 88, n0 = 32 * nb; transpose_item(p.w_gate + (size_t)l * DM * DFF, DM, DFF, wgu, kb, n0, (n0 >> 7) * 256 + (n0 & 127), scr, lane); continue; } r -= I_G;
        if (r < I_G) { if (!(mask & 4)) continue; const int kb = r / 88, nb = r % 88, n0 = 32 * nb; transpose_item(p.w_up + (size_t)l * DM * DFF, DM, DFF, wgu, kb, n0, (n0 >> 7) * 256 + 128 + (n0 & 127), scr, lane); continue; } r -= I_G;
        if (mask & 8) { const int kb = r / 32, nb = r % 32; transpose_item(p.w_down + (size_t)l * DFF * DM, DFF, DM, wdn, kb, 32 * nb, 32 * nb, scr, lane); }
    }
}
__device__ __forceinline__ void norm_mod_row(const float* xrow, const float* nw, const float* sc, const float* sh, h16* orow, int lane) {
    const f32x4* xr = (const f32x4*)xrow + lane;
    f32x4 v[4]; float s = 0.f;
#pragma unroll
    for (int j = 0; j < 4; ++j) { v[j] = xr[64 * j]; s += (v[j].x * v[j].x + v[j].y * v[j].y) + (v[j].z * v[j].z + v[j].w * v[j].w); }
    const float rstd = rsqrtf(wave_sum(s) * (1.f / DM) + EPS);
#pragma unroll
    for (int j = 0; j < 4; ++j) {
        const int col = 4 * lane + 256 * j;
        const f32x4 w4 = *(const f32x4*)(nw + col), s4 = *(const f32x4*)(sc + col), h4 = *(const f32x4*)(sh + col);
        const f32x4 y = v[j] * rstd * w4 * (1.f + s4) + h4;
        uint2 o; o.x = pkh(y.x, y.y); o.y = pkh(y.z, y.w);
        *(uint2*)(orow + col) = o;
    }
}
__device__ __forceinline__ void phase_norm(const Params& p, int l, int which, bool from_inputs, int gw, int NGW, int lane) {
    const float* mod = (const float*)(p.ws + WS_MOD) + (size_t)l * 9 * 6144;
    const float* nw = (which == 0 ? p.n1w : p.n2w) + l * DM;
    h16* hn = (h16*)(p.ws + WS_HN);
    for (int r = gw; r < T_ALL; r += NGW) {
        const float* xrow = from_inputs ? (r < T_CTX ? p.x_prompt + (size_t)r * DM : p.x_sample + (size_t)(r - T_CTX) * DM) : p.out + (size_t)r * DM;
        const float* m = mod + row_cidx(r) * 6144 + which * 3072;
        norm_mod_row(xrow, nw, m + 1024, m, hn + (size_t)r * DM, lane);
    }
}
__device__ __forceinline__ void phase_final_norm(const Params& p, int gw, int NGW, int lane) {
    for (int r = gw; r < T_ALL; r += NGW) {
        f32x4* xr = (f32x4*)(p.out + (size_t)r * DM) + lane;
        f32x4 v[4]; float s = 0.f;
#pragma unroll
        for (int j = 0; j < 4; ++j) { v[j] = xr[64 * j]; s += (v[j].x * v[j].x + v[j].y * v[j].y) + (v[j].z * v[j].z + v[j].w * v[j].w); }
        const float rstd = rsqrtf(wave_sum(s) * (1.f / DM) + EPS);
#pragma unroll
        for (int j = 0; j < 4; ++j) { const f32x4 w4 = *(const f32x4*)(p.fin_w + 4 * lane + 256 * j); xr[64 * j] = v[j] * rstd * w4; }
    }
}
__device__ __forceinline__ void phase_gates(const Params& p, int l, int gw, int NGW, int lane) {
    const h16* hn = (const h16*)(p.ws + WS_HN); const h16* wg = (const h16*)(p.ws + WS_WG16);
    float* gates = (float*)(p.ws + WS_GATES);
    const int c = lane & 15, q = lane >> 4;
    for (int grp = gw; grp < T_ALL / 16; grp += NGW) {
        const h16* ar = hn + (size_t)(16 * grp + c) * DM + 8 * q;
        const h16* br = wg + (size_t)c * DM + 8 * q;
        f32x4 acc = {0.f, 0.f, 0.f, 0.f};
#pragma unroll 8
        for (int kp = 0; kp < 32; ++kp) {
            const h16x8 a = *(const h16x8*)(ar + 32 * kp), bq = *(const h16x8*)(br + 32 * kp);
            acc = __builtin_amdgcn_mfma_f32_16x16x32_f16(a, bq, acc, 0, 0, 0);
        }
        const float bias = p.gate_b[l * 16 + c];
#pragma unroll
        for (int j = 0; j < 4; ++j) gates[(size_t)(16 * grp + 4 * q + j) * 16 + c] = acc[j] + bias;
    }
}
__device__ __forceinline__ void phase_conv(const Params& p, int l) {
    const h16* proj = (const h16*)(p.ws + WS_PROJ); h16* qkm = (h16*)(p.ws + WS_QKM);
    const float* cw = p.conv_w + (size_t)l * 9 * 1024; const float* cb = p.conv_b + l * 1024;
    for (int idx = blockIdx.x * NTHR + ltid(); idx < T_ALL * 128; idx += gridDim.x * NTHR) {
        const int r = idx >> 7, ch0 = (idx & 127) * 8;
        float acc[8];
        { const f32x4 b0 = *(const f32x4*)(cb + ch0), b1 = *(const f32x4*)(cb + ch0 + 4); acc[0] = b0.x; acc[1] = b0.y; acc[2] = b0.z; acc[3] = b0.w; acc[4] = b1.x; acc[5] = b1.y; acc[6] = b1.z; acc[7] = b1.w; }
        const h16* src = proj + 2560 + ch0;
        const bool lat = r >= T_CTX;
        const int pp = lat ? ((r - T_CTX) & 2047) : (r & 255);
        const int gy = lat ? (pp >> 6) : 0, gx = lat ? (pp & 63) : pp;
        const int H = lat ? 32 : 1, W = lat ? 64 : 256;
#pragma unroll
        for (int a = 0; a < 3; ++a) {
            const int yy = gy + a - 1;
            if (!lat && a != 1) continue;
            if (yy < 0 || yy >= H) continue;
#pragma unroll
            for (int b = 0; b < 3; ++b) {
                const int xx = gx + b - 1;
                if (xx < 0 || xx >= W) continue;
                const int rr = r + (a - 1) * 64 + (b - 1);
                const h16x8 x = *(const h16x8*)(src + (size_t)rr * NPROJ);
                const f32x4 t0 = *(const f32x4*)(cw + (a * 3 + b) * 1024 + ch0), t1 = *(const f32x4*)(cw + (a * 3 + b) * 1024 + ch0 + 4);
                acc[0] += t0.x * (float)x[0]; acc[1] += t0.y * (float)x[1]; acc[2] += t0.z * (float)x[2]; acc[3] += t0.w * (float)x[3];
                acc[4] += t1.x * (float)x[4]; acc[5] += t1.y * (float)x[5]; acc[6] += t1.z * (float)x[6]; acc[7] += t1.w * (float)x[7];
            }
        }
        const float sc = ch0 >= 512 ? 0.08838834764831845f : 1.f;
        u32x4 w; w.x = pkh(siluf_(acc[0]) * sc, siluf_(acc[1]) * sc); w.y = pkh(siluf_(acc[2]) * sc, siluf_(acc[3]) * sc);
        w.z = pkh(siluf_(acc[4]) * sc, siluf_(acc[5]) * sc); w.w = pkh(siluf_(acc[6]) * sc, siluf_(acc[7]) * sc);
        *(u32x4*)(qkm + (size_t)r * DM + ch0) = w;
    }
}

template <int TYPE  , int CMP = 0>
__device__ __forceinline__ void scan_item(const Params& p, int l, int lat, int b, int h, int dir, LAS float* lds) {
    const int tid = ltid(), lane = tid & 63, w = __builtin_amdgcn_readfirstlane(tid >> 6);
    const int L = lat ? 2048 : 256, row0 = lat ? T_CTX + b * 2048 : b * 256, NB = L / 16;
    LAS float* qs = lds;
    LAS float* fs = lds + 2048;
    LAS float* vs = lds + 4096;
    LAS float* part = lds + 6144;
    LAS float* partn = lds + 6144 + 16384;
    LAS float* scal = partn + 128;
    LAS float* mst = scal + 128;
    LAS float* cerr = mst + 16;
    LAS float* cref = cerr + 32;
    const h16* proj = (const h16*)(p.ws + WS_PROJ); const h16* qkm = (const h16*)(p.ws + WS_QKM); const float* gates = (const float*)(p.ws + WS_GATES);
    h16* odst = (h16*)(p.ws + (ODIR(dir) ? WS_OB : WS_HN));
    const size_t sidx = (((size_t)b * 4 + l) * 2 + dir) * 4 + h;
    if (CMP) { if (tid < 64) cerr[tid] = 0.f; __syncthreads(); }

    f32x2 S[16]; float nv = 0.f;
    if (lat) {
        const float* src = (TYPE == 0 ? p.st_hg : p.st_mc) + sidx * 16384;
#pragma unroll
        for (int dd = 0; dd < 16; ++dd) S[dd] = *(const f32x2*)(src + (16 * w + dd) * 128 + 2 * lane);
        if (TYPE == 1) { nv = lane < 16 ? p.st_mn[sidx * 128 + 16 * w + lane] : 0.f; if (tid == 0) mst[0] = p.st_mm[sidx]; }
    } else {
#pragma unroll
        for (int dd = 0; dd < 16; ++dd) S[dd] = (f32x2){0.f, 0.f};
        if (TYPE == 1 && tid == 0) mst[0] = 0.f;
    }
    const int tl = tid >> 5, d0 = 4 * (tid & 31);
    f32x4 lb4 = {0.f, 0.f, 0.f, 0.f};
    if (TYPE == 0) lb4 = *(const f32x4*)((const float*)(p.ws + WS_LB) + (l * 2 + dir) * 512 + h * 128 + d0);
    h16x4 pq, pz, pv; float pgi = 0.f, pgf = 0.f;
#define SCAN_LOAD(ii) do { const int pos_ = 16 * (ii) + tl, tok_ = dir ? L - 1 - pos_ : pos_; const size_t r_ = (size_t)(row0 + tok_); \
        if (TYPE == 0) { pq = *(const h16x4*)(proj + r_ * NPROJ + h * 128 + d0); pz = *(const h16x4*)(proj + r_ * NPROJ + 512 + dir * 512 + h * 128 + d0); pv = *(const h16x4*)(proj + r_ * NPROJ + 1536 + h * 128 + d0); } \
        else { pq = *(const h16x4*)(qkm + r_ * DM + h * 128 + d0); pz = *(const h16x4*)(qkm + r_ * DM + 512 + h * 128 + d0); pv = *(const h16x4*)(proj + r_ * NPROJ + 3584 + h * 128 + d0); \
               if (w == 0) { const int ps_ = 16 * (ii) + (lane & 15), tk_ = dir ? L - 1 - ps_ : ps_; const float* g_ = gates + (size_t)(row0 + tk_) * 16; pgi = g_[dir * 4 + h]; pgf = g_[8 + dir * 4 + h]; } } } while (0)
    SCAN_LOAD(0);
    for (int i = 0; i < NB; ++i) {
        const int par = i & 1;
        const int pos = 16 * i + tl, tok = dir ? L - 1 - pos : pos;
        const size_t r = (size_t)(row0 + tok);
        {
            *(LAS f32x4*)(qs + tl * 128 + d0) = (f32x4){(float)pq[0], (float)pq[1], (float)pq[2], (float)pq[3]};
            *(LAS f32x4*)(vs + tl * 128 + d0) = (f32x4){(float)pv[0], (float)pv[1], (float)pv[2], (float)pv[3]};
            if (TYPE == 0) {
                f32x4 f4;
#pragma unroll
                for (int j = 0; j < 4; ++j) f4[j] = lb4[j] + (1.f - lb4[j]) * sigmoidf_((float)pz[j]);
                *(LAS f32x4*)(fs + tl * 128 + d0) = f4;
            } else {
                *(LAS f32x4*)(fs + tl * 128 + d0) = (f32x4){(float)pz[0], (float)pz[1], (float)pz[2], (float)pz[3]};
                if (w == 0) {
                    const int t = lane & 15;
                    const float m0 = mst[0];
                    const float gi = pgi, lf = fminf(pgf, 0.f) - log1pf(__expf(-fabsf(pgf)));
                    float bc = lf;
#pragma unroll
                    for (int o = 1; o < 16; o <<= 1) { const float x = __shfl_up(bc, o, 16); if (t >= o) bc += x; }
                    float pm = gi - bc;
#pragma unroll
                    for (int o = 1; o < 16; o <<= 1) { const float x = __shfl_up(pm, o, 16); if (t >= o) pm = fmaxf(pm, x); }
                    const float mt = bc + fmaxf(m0, pm);
                    float mp = __shfl_up(mt, 1, 16); if (t == 0) mp = m0;
                    if (lane < 16) {
                        scal[(par * 16 + t) * 4 + 0] = __expf(lf + mp - mt);
                        scal[(par * 16 + t) * 4 + 1] = __expf(gi - mt);
                        scal[(par * 16 + t) * 4 + 2] = __expf(-mt);
                    }
                    asm volatile("s_waitcnt lgkmcnt(0)" ::: "memory");
                    if (lane == 15) mst[0] = mt;
                }
            }
        }
        if (i + 1 < NB) SCAN_LOAD(i + 1);
        __syncthreads();
#pragma unroll 2
        for (int t = 0; t < 16; ++t) {
            float fv = 0.f, qv = 0.f;
            if (lane < 16) { fv = fs[t * 128 + 16 * w + lane]; qv = qs[t * 128 + 16 * w + lane]; }
            const f32x2 v2 = *(const LAS f32x2*)(vs + t * 128 + 2 * lane);
            f32x2 o = {0.f, 0.f};
            if (TYPE == 0) {
#pragma unroll
                for (int dd = 0; dd < 16; ++dd) { const float sf = rdlane(fv, dd), sq = rdlane(qv, dd); S[dd] = v2 + sf * (S[dd] - v2); o += S[dd] * sq; }
            } else {
                const float a = __builtin_bit_cast(float, __builtin_amdgcn_readfirstlane(__builtin_bit_cast(int, scal[(par * 16 + t) * 4 + 0])));
                const float g = __builtin_bit_cast(float, __builtin_amdgcn_readfirstlane(__builtin_bit_cast(int, scal[(par * 16 + t) * 4 + 1])));
                const float gk = g * fv;
                nv = a * nv + gk;
                float nq = nv * qv;
                nq += __shfl_xor(nq, 8); nq += __shfl_xor(nq, 4); nq += __shfl_xor(nq, 2); nq += __shfl_xor(nq, 1);
                if (lane == 0) partn[t * 8 + w] = nq;
#pragma unroll
                for (int dd = 0; dd < 16; ++dd) { const float sk = rdlane(gk, dd), sq = rdlane(qv, dd); S[dd] = a * S[dd] + sk * v2; o += S[dd] * sq; }
            }
            *(LAS f32x2*)(part + (t * 8 + w) * 128 + 2 * lane) = o;
        }
        __syncthreads();
        {
            f32x4 acc = {0.f, 0.f, 0.f, 0.f};
#pragma unroll
            for (int ww = 0; ww < 8; ++ww) acc += *(const LAS f32x4*)(part + (tl * 8 + ww) * 128 + d0);
            if (TYPE == 1) {
                float den = 0.f;
#pragma unroll
                for (int ww = 0; ww < 8; ++ww) den += partn[tl * 8 + ww];
                const float sc = 1.f / fmaxf(fabsf(den), scal[(par * 16 + tl) * 4 + 2]);
                acc = acc * sc;
            }
            uint2 o; o.x = pkh(acc.x, acc.y); o.y = pkh(acc.z, acc.w);
            if (CMP) {
                const h16x4 old = *(const h16x4*)(odst + r * DM + TYPE * 512 + h * 128 + d0);
                float e = 0.f, rr = 0.f;
#pragma unroll
                for (int j = 0; j < 4; ++j) { const float df = (float)old[j] - acc[j]; e += df * df; rr += acc[j] * acc[j]; }
                e = wave_sum(e); rr = wave_sum(rr);
                if (lane == 0) { atomicAdd((float*)(cerr + (i >> 2)), e); atomicAdd((float*)(cref + (i >> 2)), rr); }
            }
            *(uint2*)(odst + r * DM + TYPE * 512 + h * 128 + d0) = o;
        }
    }
    if (CMP) {
        __syncthreads();
        if (tid == 0) {
            float best = -1.f; int bc_ = 0; float tot_e = 0.f, tot_r = 0.f;
            for (int cI = 0; cI < 32; ++cI) { const float rt = cerr[cI] / fmaxf(cref[cI], 1e-30f); tot_e += cerr[cI]; tot_r += cref[cI]; if (rt > best) { best = rt; bc_ = cI; } }
            float* dg = (float*)(p.ws + WS_MODP) + 4 * blockIdx.x;
#if defined(DIAG_ALL)
            const float tot = tot_e / fmaxf(tot_r, 1e-30f);
            if (tot > dg[0]) { dg[0] = tot; dg[1] = (float)(l * 8 + TYPE * 4 + lat * 2 + dir); dg[2] = best; dg[3] = (float)bc_; }
#else
            dg[0] = best; dg[1] = (float)bc_; dg[2] = tot_e / fmaxf(tot_r, 1e-30f); dg[3] = 0.f;
#endif
        }
    }
    if (!lat) {
        float* dst = p.out + (TYPE == 0 ? OUT_HG : OUT_MC) + sidx * 16384;
#pragma unroll
        for (int dd = 0; dd < 16; ++dd) *(f32x2*)(dst + (16 * w + dd) * 128 + 2 * lane) = S[dd];
        if (TYPE == 1) { if (lane < 16) p.out[OUT_MN + sidx * 128 + 16 * w + lane] = nv; if (tid == 0) p.out[OUT_MM + sidx] = mst[0]; }
    }
    __syncthreads();
#undef SCAN_LOAD
}
typedef unsigned u32x2 __attribute__((ext_vector_type(2)));
typedef short s16x8 __attribute__((ext_vector_type(8)));
typedef short s16x4 __attribute__((ext_vector_type(4)));
typedef __bf16 bf16x2_t __attribute__((ext_vector_type(2)));
__device__ __forceinline__ unsigned pkb(float a, float b) { f32x2 v = {a, b}; bf16x2_t r = __builtin_convertvector(v, bf16x2_t); return __builtin_bit_cast(unsigned, r); }
__device__ __forceinline__ unsigned short f2b(float a) { return (unsigned short)(pkb(a, 0.f) & 0xffffu); }
__device__ __forceinline__ s16x4 tr_read(LAS const unsigned char* ptr) { return __builtin_bit_cast(s16x4, __builtin_amdgcn_ds_read_tr16_b64_v4i16((LAS s16x4*)ptr)); }
constexpr int HP = 272;
__device__ __forceinline__ void scan_hgrn_mfma(const Params& p, int l, int lat, int b, int h, int dir, LAS unsigned char* lds) {
    const int tid = ltid(), lane = tid & 63, w = __builtin_amdgcn_readfirstlane(tid >> 6), c = lane & 15, q = lane >> 4;
    const int L = lat ? 2048 : 256, row0 = lat ? T_CTX + b * 2048 : b * 256, NB = L / 16;
    constexpr int IMG = 16 * HP, BUF = 4 * IMG + 512;
    LAS float* GS = (LAS float*)(lds + 2 * BUF);
    const h16* proj = (const h16*)(p.ws + WS_PROJ);
    h16* odst = (h16*)(p.ws + (ODIR(dir) ? WS_OB : WS_HN));
    const size_t sidx = (((size_t)b * 4 + l) * 2 + dir) * 4 + h;
    f32x4 S[8];
    if (lat) {
        const float* src = p.st_hg + sidx * 16384;
#pragma unroll
        for (int dt = 0; dt < 8; ++dt)
#pragma unroll
            for (int j = 0; j < 4; ++j) S[dt][j] = src[(16 * dt + 4 * q + j) * 128 + 16 * w + c];
    } else {
#pragma unroll
        for (int dt = 0; dt < 8; ++dt) S[dt] = (f32x4){0.f, 0.f, 0.f, 0.f};
    }
    const int pt = lane & 15, d0 = 16 * w + 4 * (lane >> 4);
    const f32x4 lb4 = *(const f32x4*)((const float*)(p.ws + WS_LB) + (l * 2 + dir) * 512 + h * 128 + d0);
    h16x4 rq, rz, rv;
#define HG_LOAD(ii) do { const int pos_ = 16 * (ii) + pt, tok_ = dir ? L - 1 - pos_ : pos_; const h16* r_ = proj + (size_t)(row0 + tok_) * NPROJ + h * 128 + d0; \
        rq = *(const h16x4*)(r_); rz = *(const h16x4*)(r_ + 512 + dir * 512); rv = *(const h16x4*)(r_ + 1536); } while (0)
#define HG_ROW_SHR(x, ctl) __builtin_bit_cast(float, __builtin_amdgcn_update_dpp(0, __builtin_bit_cast(int, (x)), (ctl), 0xF, 0xF, false))
    HG_LOAD(0);
    u32x2 o_prev = {0u, 0u}; h16* o_ptr = odst;
    for (int i = 0; i < NB; ++i) {
        LAS unsigned char* buf = lds + (i & 1) * BUF;
        LAS unsigned char* QT = buf; LAS unsigned char* KT = buf + IMG; LAS unsigned char* KH = buf + 2 * IMG; LAS unsigned char* VV = buf + 3 * IMG; LAS float* AD = (LAS float*)(buf + 4 * IMG);
        asm volatile("s_waitcnt vmcnt(0)" ::: "memory");
        if (i > 0) *(u32x2*)o_ptr = o_prev;
        {
            float kk[4], G[4];
#pragma unroll
            for (int j = 0; j < 4; ++j) { const float f = lb4[j] + (1.f - lb4[j]) * sigmoidf_((float)rz[j]); kk[j] = 1.f - f; G[j] = __logf(f); }
#pragma unroll
            for (int j = 0; j < 4; ++j) {
                G[j] += HG_ROW_SHR(G[j], 0x111); G[j] += HG_ROW_SHR(G[j], 0x112); G[j] += HG_ROW_SHR(G[j], 0x114); G[j] += HG_ROW_SHR(G[j], 0x118);
            }
            float oq[4], ok[4], oh[4];
            float ev[4];
#pragma unroll
            for (int j = 0; j < 4; ++j) {
                const float e = __expf(G[j]), ei = __builtin_amdgcn_rcpf(fmaxf(e, 8.7565e-27f)); ev[j] = e;
                const float et = __builtin_bit_cast(float, __builtin_amdgcn_update_dpp(0, __builtin_bit_cast(int, e), 0x15F, 0xF, 0xF, false));
                oq[j] = (float)rq[j] * e; ok[j] = kk[j] * ei; oh[j] = kk[j] * (et * ei);
            }
            u32x2 wq, wk, wh, wv;
            wq.x = pkb(oq[0], oq[1]); wq.y = pkb(oq[2], oq[3]); wk.x = pkb(ok[0], ok[1]); wk.y = pkb(ok[2], ok[3]);
            wh.x = pkb(oh[0], oh[1]); wh.y = pkb(oh[2], oh[3]); wv.x = pkb((float)rv[0], (float)rv[1]); wv.y = pkb((float)rv[2], (float)rv[3]);
            *(LAS u32x2*)(QT + pt * HP + 2 * d0) = wq; *(LAS u32x2*)(KT + pt * HP + 2 * d0) = wk; *(LAS u32x2*)(KH + pt * HP + 2 * d0) = wh; *(LAS u32x2*)(VV + pt * HP + 2 * d0) = wv;
            if (pt == 15) *(LAS f32x4*)(AD + d0) = (f32x4){ev[0], ev[1], ev[2], ev[3]};
        }
        { const int nx = (i + 1 < NB) ? i + 1 : NB - 1; HG_LOAD(nx); }
        __syncthreads();
        {
            f32x4 accO = {0.f, 0.f, 0.f, 0.f};
#pragma unroll
            for (int kp = 0; kp < 4; ++kp) {
                u32x4 sa; sa.x = pkb(S[2 * kp][0], S[2 * kp][1]); sa.y = pkb(S[2 * kp][2], S[2 * kp][3]); sa.z = pkb(S[2 * kp + 1][0], S[2 * kp + 1][1]); sa.w = pkb(S[2 * kp + 1][2], S[2 * kp + 1][3]);
                const u32x2 b0 = *(const LAS u32x2*)(QT + c * HP + 2 * (32 * kp + 4 * q)), b1 = *(const LAS u32x2*)(QT + c * HP + 2 * (32 * kp + 16 + 4 * q));
                u32x4 bb; bb.x = b0.x; bb.y = b0.y; bb.z = b1.x; bb.w = b1.y;
                accO = __builtin_amdgcn_mfma_f32_16x16x32_bf16(__builtin_bit_cast(s16x8, sa), __builtin_bit_cast(s16x8, bb), accO, 0, 0, 0);
            }
            f32x4 accP = {0.f, 0.f, 0.f, 0.f};
#pragma unroll
            for (int kp = 0; kp < 4; ++kp) {
                const s16x8 a = *(const LAS s16x8*)(KT + c * HP + 2 * (32 * kp + 8 * q));
                const s16x8 bq = *(const LAS s16x8*)(QT + c * HP + 2 * (32 * kp + 8 * q));
                accP = __builtin_amdgcn_mfma_f32_16x16x32_bf16(a, bq, accP, 0, 0, 0);
            }
#pragma unroll
            for (int j = 0; j < 4; ++j) accP[j] = (4 * q + j > c) ? 0.f : accP[j];
            u32x2 pb; pb.x = pkb(accP[0], accP[1]); pb.y = pkb(accP[2], accP[3]);
            const s16x4 vtr = tr_read(VV + (4 * q + (c >> 2)) * HP + 2 * (16 * w + 4 * (c & 3)));
            accO = __builtin_amdgcn_mfma_f32_16x16x16bf16_1k(vtr, __builtin_bit_cast(s16x4, pb), accO, 0, 0, 0);
            {
                const int pos = 16 * i + c, tok = dir ? L - 1 - pos : pos;
                o_prev.x = pkh(accO[0], accO[1]); o_prev.y = pkh(accO[2], accO[3]);
                o_ptr = odst + (size_t)(row0 + tok) * DM + h * 128 + 16 * w + 4 * q;
            }
#pragma unroll
            for (int dt = 0; dt < 8; ++dt) {
                const s16x4 ktr = tr_read(KH + (4 * q + (c >> 2)) * HP + 2 * (16 * dt + 4 * (c & 3)));
                const f32x4 ad = *(const LAS f32x4*)(AD + 16 * dt + 4 * q);
                S[dt] = S[dt] * ad;
                S[dt] = __builtin_amdgcn_mfma_f32_16x16x16bf16_1k(ktr, vtr, S[dt], 0, 0, 0);
            }
        }
#if defined(HG_EXTRA_SYNC)
        asm volatile("s_waitcnt vmcnt(0) lgkmcnt(0)" ::: "memory");
        __syncthreads();
#endif
    }
    *(u32x2*)o_ptr = o_prev;
    if (!lat) {
        float* dst = p.out + OUT_HG + sidx * 16384;
#pragma unroll
        for (int dt = 0; dt < 8; ++dt)
#pragma unroll
            for (int j = 0; j < 4; ++j) dst[(16 * dt + 4 * q + j) * 128 + 16 * w + c] = S[dt][j];
    }
    __syncthreads();
#undef HG_LOAD
#undef HG_ROW_SHR
}
constexpr int MP = 272;
constexpr int PP = 144;
__device__ __forceinline__ void scan_mlstm_mfma(const Params& p, int l, int lat, int b, int h, int dir, LAS unsigned char* lds) {
    const int tid = ltid(), lane = tid & 63, w = __builtin_amdgcn_readfirstlane(tid >> 6), c = lane & 15, q = lane >> 4;
    const int L = lat ? 2048 : 256, row0 = lat ? T_CTX + b * 2048 : b * 256, NC = L / 64;
    constexpr int IMG = 64 * MP, BUF = 3 * IMG + 1536;
    LAS unsigned char* PM = lds + 2 * BUF;
    LAS float* DENP = (LAS float*)(PM + 64 * PP);
    LAS float* QNP = DENP + 256;
    LAS float* NP = QNP + 512;
    LAS float* NV = NP + 512;
    LAS float* mst = NV + 128;
    const h16* proj = (const h16*)(p.ws + WS_PROJ); const h16* qkm = (const h16*)(p.ws + WS_QKM); const float* gates = (const float*)(p.ws + WS_GATES);
    h16* odst = (h16*)(p.ws + (ODIR(dir) ? WS_OB : WS_HN));
    const size_t sidx = (((size_t)b * 4 + l) * 2 + dir) * 4 + h;
    f32x4 C[8];
    if (lat) {
        const float* src = p.st_mc + sidx * 16384;
#pragma unroll
        for (int dt = 0; dt < 8; ++dt)
#pragma unroll
            for (int j = 0; j < 4; ++j) C[dt][j] = src[(16 * dt + 4 * q + j) * 128 + 16 * w + c];
        if (tid < 128) NV[tid] = p.st_mn[sidx * 128 + tid];
        if (tid == 0) mst[0] = p.st_mm[sidx];
    } else {
#pragma unroll
        for (int dt = 0; dt < 8; ++dt) C[dt] = (f32x4){0.f, 0.f, 0.f, 0.f};
        if (tid < 128) NV[tid] = 0.f;
        if (tid == 0) mst[0] = 0.f;
    }
    u32x4 pq[2], pk[2], pv[2]; float pgi = 0.f, pgf = 0.f;
#define ML_LOAD(ii) do { _Pragma("unroll") for (int j_ = 0; j_ < 2; ++j_) { const int e_ = tid + 512 * j_, rw_ = e_ >> 4, pc_ = e_ & 15; const int pos_ = 64 * (ii) + rw_, tok_ = dir ? L - 1 - pos_ : pos_; \
            const size_t r_ = (size_t)(row0 + tok_); pq[j_] = *(const u32x4*)(qkm + r_ * DM + h * 128 + 8 * pc_); pk[j_] = *(const u32x4*)(qkm + r_ * DM + 512 + h * 128 + 8 * pc_); \
            pv[j_] = *(const u32x4*)(proj + r_ * NPROJ + 3584 + h * 128 + 8 * pc_); } \
        if (w == 0) { const int ps_ = 64 * (ii) + lane, tk_ = dir ? L - 1 - ps_ : ps_; const float* g_ = gates + (size_t)(row0 + tk_) * 16; pgi = g_[dir * 4 + h]; pgf = g_[8 + dir * 4 + h]; } } while (0)
    ML_LOAD(0);
    for (int i = 0; i < NC; ++i) {
        LAS unsigned char* buf = lds + (i & 1) * BUF;
        LAS unsigned char* QM = buf; LAS unsigned char* KM = buf + IMG; LAS unsigned char* VM = buf + 2 * IMG;
        LAS float* U = (LAS float*)(buf + 3 * IMG); LAS float* MM = U + 64; LAS float* AI = U + 128; LAS float* EN = U + 192; LAS float* UE = U + 256;
        asm volatile("s_waitcnt vmcnt(0)" ::: "memory");
#pragma unroll
        for (int j = 0; j < 2; ++j) { const int e = tid + 512 * j, rw = e >> 4, pc = e & 15;
            *(LAS u32x4*)(QM + rw * MP + 16 * pc) = pq[j]; *(LAS u32x4*)(KM + rw * MP + 16 * pc) = pk[j]; *(LAS u32x4*)(VM + rw * MP + 16 * pc) = pv[j]; }
        if (w == 0) {
            const float m0 = mst[0];
            const float gi = pgi, lf = fminf(pgf, 0.f) - log1pf(__expf(-fabsf(pgf)));
            float bc = lf;
#pragma unroll
            for (int o = 1; o < 64; o <<= 1) { const float x = __shfl_up(bc, o); if (lane >= o) bc += x; }
            const float u = gi - bc;
            float pm = u;
#pragma unroll
            for (int o = 1; o < 64; o <<= 1) { const float x = __shfl_up(pm, o); if (lane >= o) pm = fmaxf(pm, x); }
            const float Mt = fmaxf(m0, pm);
            const float M63 = rdlane(Mt, 63), bc63 = rdlane(bc, 63);
            U[lane] = u; MM[lane] = Mt; AI[lane] = __expf(m0 - Mt); EN[lane] = __expf(-(bc + Mt)); UE[lane] = __expf(u - M63);
            asm volatile("s_waitcnt lgkmcnt(0)" ::: "memory");
            if (lane == 0) mst[0] = bc63 + M63;
        }
        { const int nx = (i + 1 < NC) ? i + 1 : NC - 1; ML_LOAD(nx); }
        __syncthreads();
        {
            const int tt = w >> 1;
#pragma unroll
            for (int k2 = 0; k2 < 2; ++k2) {
                const int st = 2 * (w & 1) + k2;
                if (st <= tt) {
                    f32x4 accP = {0.f, 0.f, 0.f, 0.f};
#pragma unroll
                    for (int kp = 0; kp < 4; ++kp) {
                        const h16x8 a = *(const LAS h16x8*)(KM + (16 * st + c) * MP + 2 * (32 * kp + 8 * q));
                        const h16x8 bq = *(const LAS h16x8*)(QM + (16 * tt + c) * MP + 2 * (32 * kp + 8 * q));
                        accP = __builtin_amdgcn_mfma_f32_16x16x32_f16(a, bq, accP, 0, 0, 0);
                    }
                    const f32x4 u4 = *(const LAS f32x4*)(U + 16 * st + 4 * q); const float mt = MM[16 * tt + c];
                    float pj[4];
#pragma unroll
                    for (int j = 0; j < 4; ++j) { const float e = accP[j] * __expf(u4[j] - mt); pj[j] = (16 * st + 4 * q + j <= 16 * tt + c) ? e : 0.f; }
                    u32x2 pw; pw.x = pkh(pj[0], pj[1]); pw.y = pkh(pj[2], pj[3]);
                    *(LAS u32x2*)(PM + (16 * tt + c) * PP + 2 * (16 * st + 4 * q)) = pw;
                    float cs = (pj[0] + pj[1]) + (pj[2] + pj[3]);
                    cs += __shfl_xor(cs, 16); cs += __shfl_xor(cs, 32);
                    if (q == 0) DENP[st * 64 + 16 * tt + c] = cs;
                }
            }
            {
                const h16x8 qa = *(const LAS h16x8*)(QM + lane * MP + 2 * (16 * w)), qb = *(const LAS h16x8*)(QM + lane * MP + 2 * (16 * w + 8));
                const f32x4 n0 = *(const LAS f32x4*)(NV + 16 * w), n1 = *(const LAS f32x4*)(NV + 16 * w + 4), n2 = *(const LAS f32x4*)(NV + 16 * w + 8), n3 = *(const LAS f32x4*)(NV + 16 * w + 12);
                float s = 0.f;
#pragma unroll
                for (int j = 0; j < 4; ++j) s += (float)qa[j] * n0[j] + (float)qa[4 + j] * n1[j] + (float)qb[j] * n2[j] + (float)qb[4 + j] * n3[j];
                QNP[w * 64 + lane] = s;
            }
            {
                const int d = tid & 127, part = tid >> 7;
                float s = 0.f;
#pragma unroll
                for (int ss = 0; ss < 16; ++ss) s += UE[16 * part + ss] * (float)*(const LAS h16*)(KM + (16 * part + ss) * MP + 2 * d);
                NP[part * 128 + d] = s;
            }
        }
        __syncthreads();
        {
            h16x4 vtr[4];
#pragma unroll
            for (int st = 0; st < 4; ++st) vtr[st] = __builtin_bit_cast(h16x4, tr_read(VM + (16 * st + 4 * q + (c >> 2)) * MP + 2 * (16 * w + 4 * (c & 3))));
            h16x8 cp[4];
#pragma unroll
            for (int kp = 0; kp < 4; ++kp) { u32x4 sa; sa.x = pkh(C[2 * kp][0], C[2 * kp][1]); sa.y = pkh(C[2 * kp][2], C[2 * kp][3]); sa.z = pkh(C[2 * kp + 1][0], C[2 * kp + 1][1]); sa.w = pkh(C[2 * kp + 1][2], C[2 * kp + 1][3]); cp[kp] = __builtin_bit_cast(h16x8, sa); }
#pragma unroll
            for (int tt = 0; tt < 4; ++tt) {
                const int t = 16 * tt + c;
                f32x4 accI = {0.f, 0.f, 0.f, 0.f}, accN = {0.f, 0.f, 0.f, 0.f};
#pragma unroll
                for (int kp = 0; kp < 4; ++kp) {
                    const u32x2 b0 = *(const LAS u32x2*)(QM + t * MP + 2 * (32 * kp + 4 * q)), b1 = *(const LAS u32x2*)(QM + t * MP + 2 * (32 * kp + 16 + 4 * q));
                    u32x4 bb; bb.x = b0.x; bb.y = b0.y; bb.z = b1.x; bb.w = b1.y;
                    accI = __builtin_amdgcn_mfma_f32_16x16x32_f16(cp[kp], __builtin_bit_cast(h16x8, bb), accI, 0, 0, 0);
                }
                float den = 0.f;
#pragma unroll
                for (int st = 0; st < 4; ++st) if (st <= tt) {
                    const u32x2 pb = *(const LAS u32x2*)(PM + t * PP + 2 * (16 * st + 4 * q));
                    accN = __builtin_amdgcn_mfma_f32_16x16x16f16(vtr[st], __builtin_bit_cast(h16x4, pb), accN, 0, 0, 0);
                    den += DENP[st * 64 + t];
                }
                float qn = 0.f;
#pragma unroll
                for (int ww = 0; ww < 8; ++ww) qn += QNP[ww * 64 + t];
                const float ai = AI[t];
                den += ai * qn;
                const float sc = 1.f / fmaxf(fabsf(den), EN[t]);
                f32x4 hv = (accN + accI * ai) * sc;
#pragma unroll
                for (int j = 0; j < 4; ++j) hv[j] = fminf(fmaxf(hv[j], -60000.f), 60000.f);
                const int pos = 64 * i + t, tok = dir ? L - 1 - pos : pos;
                u32x2 o; o.x = pkh(hv[0], hv[1]); o.y = pkh(hv[2], hv[3]);
                *(u32x2*)(odst + (size_t)(row0 + tok) * DM + 512 + h * 128 + 16 * w + 4 * q) = o;
            }
            const float a63 = AI[63];
            h16x4 vs[4];
#pragma unroll
            for (int st = 0; st < 4; ++st) { const f32x4 ue4 = *(const LAS f32x4*)(UE + 16 * st + 4 * q);
#pragma unroll
                for (int j = 0; j < 4; ++j) vs[st][j] = (h16)((float)vtr[st][j] * ue4[j]); }
#pragma unroll
            for (int dt = 0; dt < 8; ++dt) {
                C[dt] = C[dt] * a63;
#pragma unroll
                for (int st = 0; st < 4; ++st) {
                    const h16x4 ktr = __builtin_bit_cast(h16x4, tr_read(KM + (16 * st + 4 * q + (c >> 2)) * MP + 2 * (16 * dt + 4 * (c & 3))));
                    C[dt] = __builtin_amdgcn_mfma_f32_16x16x16f16(ktr, vs[st], C[dt], 0, 0, 0);
                }
            }
            if (tid < 128) NV[tid] = a63 * NV[tid] + (NP[tid] + NP[128 + tid]) + (NP[256 + tid] + NP[384 + tid]);
        }
#if defined(ML_EXTRA_SYNC)
        asm volatile("s_waitcnt vmcnt(0) lgkmcnt(0)" ::: "memory");
        __syncthreads();
#endif
    }
    __syncthreads();
    if (!lat) {
        float* dst = p.out + OUT_MC + sidx * 16384;
#pragma unroll
        for (int dt = 0; dt < 8; ++dt)
#pragma unroll
            for (int j = 0; j < 4; ++j) dst[(16 * dt + 4 * q + j) * 128 + 16 * w + c] = C[dt][j];
        if (tid < 128) p.out[OUT_MN + sidx * 128 + tid] = NV[tid];
        if (tid == 0) p.out[OUT_MM + sidx] = mst[0];
    }
    __syncthreads();
#undef ML_LOAD
}
#if defined(DIAG_ALL)
#define SCAN_HG(p, l, lat, b, h, dir, lds) do { scan_hgrn_mfma(p, l, lat, b, h, dir, (LAS unsigned char*)(lds)); asm volatile("s_waitcnt vmcnt(0)" ::: "memory"); __syncthreads(); scan_item<0, 1>(p, l, lat, b, h, dir, lds); } while (0)
#elif defined(HGRN_VALU)
#define SCAN_HG(p, l, lat, b, h, dir, lds) scan_item<0>(p, l, lat, b, h, dir, lds)
#else
#define SCAN_HG(p, l, lat, b, h, dir, lds) scan_hgrn_mfma(p, l, lat, b, h, dir, (LAS unsigned char*)(lds))
#endif
#if defined(MLSTM_VALU)
#define SCAN_ML(p, l, lat, b, h, dir, lds) scan_item<1>(p, l, lat, b, h, dir, lds)
#else
#if defined(DIAG_ALL)
#define SCAN_ML(p, l, lat, b, h, dir, lds) do { scan_mlstm_mfma(p, l, lat, b, h, dir, (LAS unsigned char*)(lds)); asm volatile("s_waitcnt vmcnt(0)" ::: "memory"); __syncthreads(); scan_item<1, 1>(p, l, lat, b, h, dir, lds); } while (0)
#elif defined(MLSTM_DIAG)
#define SCAN_ML(p, l, lat, b, h, dir, lds) do { scan_mlstm_mfma(p, l, lat, b, h, dir, (LAS unsigned char*)(lds)); \
        if ((lat) && (dir) == 0 && (l) == DIAG_LAYER) { asm volatile("s_waitcnt vmcnt(0)" ::: "memory"); __syncthreads(); scan_item<1, 1>(p, l, lat, b, h, dir, lds); } } while (0)
#elif defined(MLSTM_VALU_CTX)
#define SCAN_ML(p, l, lat, b, h, dir, lds) do { if (lat) scan_mlstm_mfma(p, l, lat, b, h, dir, (LAS unsigned char*)(lds)); else scan_item<1>(p, l, lat, b, h, dir, lds); } while (0)
#elif defined(MLSTM_MFMA_DIR0)
#define SCAN_ML(p, l, lat, b, h, dir, lds) do { if ((dir) == 0) scan_mlstm_mfma(p, l, lat, b, h, dir, (LAS unsigned char*)(lds)); else scan_item<1>(p, l, lat, b, h, dir, lds); } while (0)
#elif defined(MLSTM_BISECT)
#define SCAN_ML(p, l, lat, b, h, dir, lds) do { if (!((lat) && (dir) == 0 && (MLSTM_BISECT_COND))) scan_mlstm_mfma(p, l, lat, b, h, dir, (LAS unsigned char*)(lds)); else scan_item<1>(p, l, lat, b, h, dir, lds); } while (0)
#elif defined(MLSTM_VALU_LAT)
#define SCAN_ML(p, l, lat, b, h, dir, lds) do { if (!(lat)) scan_mlstm_mfma(p, l, lat, b, h, dir, (LAS unsigned char*)(lds)); else scan_item<1>(p, l, lat, b, h, dir, lds); } while (0)
#else
#define SCAN_ML(p, l, lat, b, h, dir, lds) scan_mlstm_mfma(p, l, lat, b, h, dir, (LAS unsigned char*)(lds))
#endif
#endif
__device__ __forceinline__ void scan_dispatch(const Params& p, int l, int it, LAS float* lds) {
    if (it < 128) { const int type = it >> 6, r = it & 63, b = r >> 3, h = (r >> 1) & 3, dir = r & 1; if (type == 0) SCAN_HG(p, l, 1, b, h, dir, lds); else SCAN_ML(p, l, 1, b, h, dir, lds); }
    else { const int q = it - 128, type = q >> 8, r = q & 255, b = r >> 3, h = (r >> 1) & 3, dir = r & 1; if (type == 0) SCAN_HG(p, l, 0, b, h, dir, lds); else SCAN_ML(p, l, 0, b, h, dir, lds); }
}
__device__ __forceinline__ void ctx_pair_mixnorm(const Params& p, int l, int b, int h) {
    asm volatile("s_waitcnt vmcnt(0)" ::: "memory");
    __syncthreads();
    const int tid = ltid(), lane = tid & 63, wave = __builtin_amdgcn_readfirstlane(tid >> 6);
    const h16* of = (const h16*)(p.ws + WS_HN); const h16* ob = (const h16*)(p.ws + WS_OB); const h16* proj = (const h16*)(p.ws + WS_PROJ);
    h16* mix = (h16*)(p.ws + WS_QKM);
    const float wh0 = p.hg_nw[l * 512 + h * 128 + 2 * lane], wh1 = p.hg_nw[l * 512 + h * 128 + 2 * lane + 1];
    const float wm0 = p.ml_nw[l * 512 + h * 128 + 2 * lane], wm1 = p.ml_nw[l * 512 + h * 128 + 2 * lane + 1];
    for (int pi = wave; pi < 512; pi += NWV) {
        const int row = b * 256 + (pi >> 1), type = pi & 1;
        const int cb = type * 512 + h * 128 + 2 * lane, gc = (type ? 4096 : 2048) + h * 128 + 2 * lane;
        const h16x2 a = *(const h16x2*)(of + (size_t)row * DM + cb), c2 = *(const h16x2*)(ob + (size_t)row * DM + cb), g = *(const h16x2*)(proj + (size_t)row * NPROJ + gc);
        const float o0 = (float)a[0] + (float)c2[0], o1 = (float)a[1] + (float)c2[1];
        const float ss = wave_sum(o0 * o0 + o1 * o1);
        const float rstd = rsqrtf(ss * (1.f / 128.f) + EPS);
        const float w0 = type ? wm0 : wh0, w1 = type ? wm1 : wh1;
        *(unsigned*)(mix + (size_t)row * DM + cb) = pkh(o0 * rstd * w0 * (float)g[0], o1 * rstd * w1 * (float)g[1]);
    }
}
__device__ __forceinline__ void phase_scan(const Params& p, int l, LAS float* lds) {
    const int G = gridDim.x, bid = blockIdx.x;
    if (G == 256) {
        if (bid < 128) scan_dispatch(p, l, bid, lds);
        else {
            const int pr = bid - 128, b = pr >> 2, h = pr & 3;
            SCAN_HG(p, l, 0, b, h, 0, lds); SCAN_HG(p, l, 0, b, h, 1, lds); SCAN_ML(p, l, 0, b, h, 0, lds); SCAN_ML(p, l, 0, b, h, 1, lds);
            ctx_pair_mixnorm(p, l, b, h);
            if (l == 0) { __syncthreads(); const int t_ = ltid(); phase_mod_partial(p, lds, 768, 3072, (bid - 128) * NWV + __builtin_amdgcn_readfirstlane(t_ >> 6), 128 * NWV); }
            {
                __syncthreads(); const int t_ = ltid(), wv_ = __builtin_amdgcn_readfirstlane(t_ >> 6);
                convert_weights(p, l, lds + wv_ * 2176, (bid - 128) * NWV + wv_, 128 * NWV, t_ & 63, 14);
            }
        }
    } else {
        for (int it = bid; it < 640; it += G) scan_dispatch(p, l, it, lds);
    }
}
__device__ __forceinline__ void phase_mixnorm(const Params& p, int l, int gw, int NGW, int lane, int row_begin) {
    const h16* of = (const h16*)(p.ws + WS_HN); const h16* ob = (const h16*)(p.ws + WS_OB); const h16* proj = (const h16*)(p.ws + WS_PROJ);
    h16* mix = (h16*)(p.ws + WS_QKM);
    const int col = 16 * lane;
    const float* nw = col < 512 ? p.hg_nw + l * 512 + col : p.ml_nw + l * 512 + (col - 512);
    float wv[16];
#pragma unroll
    for (int j = 0; j < 4; ++j) { const f32x4 t = *(const f32x4*)(nw + 4 * j); wv[4 * j] = t.x; wv[4 * j + 1] = t.y; wv[4 * j + 2] = t.z; wv[4 * j + 3] = t.w; }
    const int gcol = col < 512 ? 2048 + col : 4096 + (col - 512);
    for (int r = row_begin + gw; r < T_ALL; r += NGW) {
        const h16x8 a0 = *(const h16x8*)(of + (size_t)r * DM + col), a1 = *(const h16x8*)(of + (size_t)r * DM + col + 8);
        const h16x8 b0 = *(const h16x8*)(ob + (size_t)r * DM + col), b1 = *(const h16x8*)(ob + (size_t)r * DM + col + 8);
        const h16x8 g0 = *(const h16x8*)(proj + (size_t)r * NPROJ + gcol), g1 = *(const h16x8*)(proj + (size_t)r * NPROJ + gcol + 8);
        float o[16]; float ss = 0.f;
#pragma unroll
        for (int j = 0; j < 8; ++j) { o[j] = (float)a0[j] + (float)b0[j]; o[8 + j] = (float)a1[j] + (float)b1[j]; }
#pragma unroll
        for (int j = 0; j < 16; ++j) ss += o[j] * o[j];
        ss += __shfl_xor(ss, 1); ss += __shfl_xor(ss, 2); ss += __shfl_xor(ss, 4);
        const float rstd = rsqrtf(ss * (1.f / 128.f) + EPS);
        u32x4 w0, w1;
        w0.x = pkh(o[0] * rstd * wv[0] * (float)g0[0], o[1] * rstd * wv[1] * (float)g0[1]); w0.y = pkh(o[2] * rstd * wv[2] * (float)g0[2], o[3] * rstd * wv[3] * (float)g0[3]);
        w0.z = pkh(o[4] * rstd * wv[4] * (float)g0[4], o[5] * rstd * wv[5] * (float)g0[5]); w0.w = pkh(o[6] * rstd * wv[6] * (float)g0[6], o[7] * rstd * wv[7] * (float)g0[7]);
        w1.x = pkh(o[8] * rstd * wv[8] * (float)g1[0], o[9] * rstd * wv[9] * (float)g1[1]); w1.y = pkh(o[10] * rstd * wv[10] * (float)g1[2], o[11] * rstd * wv[11] * (float)g1[3]);
        w1.z = pkh(o[12] * rstd * wv[12] * (float)g1[4], o[13] * rstd * wv[13] * (float)g1[5]); w1.w = pkh(o[14] * rstd * wv[14] * (float)g1[6], o[15] * rstd * wv[15] * (float)g1[7]);
        *(u32x4*)(mix + (size_t)r * DM + col) = w0; *(u32x4*)(mix + (size_t)r * DM + col + 8) = w1;
    }
}

#define XB_TMO      128
#define XB_XCNT(j)  (256  + 64 * (j))
#define XB_XSUB(j)  (1280 + 64 * (j))
#define XB_XGEN(j)  (2304 + 64 * (j))
#define XB_TOP      3328
#define XB_TOPGEN   3392
#define XCD_BAR_WORDS 3456
#define XB_SPIN_CAP (1u << 18)

__device__ __forceinline__ unsigned xb_ld(unsigned* p)              { return __hip_atomic_load(p, __ATOMIC_RELAXED, __HIP_MEMORY_SCOPE_AGENT); }
__device__ __forceinline__ unsigned xb_add(unsigned* p, unsigned v) { return __hip_atomic_fetch_add(p, v, __ATOMIC_RELAXED, __HIP_MEMORY_SCOPE_AGENT); }
__device__ __forceinline__ unsigned xb_xcc_id() { return (unsigned)__builtin_amdgcn_s_getreg((3 << 11) | 20) & 0xFu; }
#define XB_SPIN(cond, bar) do { unsigned _sp = 0; while (cond) { __builtin_amdgcn_s_sleep(1); \
    if ((++_sp & 255u) == 0u) { if (xb_ld(&(bar)[XB_TMO])) break; if (_sp > XB_SPIN_CAP) { atomicAdd(&(bar)[XB_TMO], 1u); break; } } } } while (0)

struct XcdBarrier {
    unsigned* bar; unsigned x;
    volatile LAS unsigned* st;
};

__device__ __forceinline__ XcdBarrier xcd_barrier_post(unsigned* bar, volatile LAS unsigned* st) {
    XcdBarrier b; b.bar = bar; b.x = xb_xcc_id(); b.st = st;
    if (threadIdx.x == 0) (void)xb_add(&bar[XB_XCNT(b.x)], 1u);
    return b;
}
__device__ __forceinline__ void xcd_barrier_complete(unsigned* bar, unsigned x, unsigned& nloc, unsigned& nx) {
    const unsigned G = gridDim.x * gridDim.y * gridDim.z;
    unsigned sum, cnt, mine, sp = 0u;
    for (;;) {
        sum = 0u; cnt = 0u; mine = 0u;
#pragma unroll
        for (unsigned j = 0; j < 16; ++j) { const unsigned c = xb_ld(&bar[XB_XCNT(j)]); sum += c; cnt += (c > 0u) ? 1u : 0u; mine = (j == x) ? c : mine; }
        if (sum == G) break;
        __builtin_amdgcn_s_sleep(1);
        if ((++sp & 255u) == 0u) { if (xb_ld(&bar[XB_TMO])) break; if (sp > XB_SPIN_CAP) { atomicAdd(&bar[XB_TMO], 1u); break; } }
    }
    nloc = mine > 0u ? mine : 1u; nx = cnt > 0u ? cnt : 1u;
}

__device__ __forceinline__ void xcd_barrier(const XcdBarrier& b) {
    asm volatile("s_waitcnt vmcnt(0)" ::: "memory");
    __syncthreads();
    if (threadIdx.x == 0) {
        unsigned* bar = b.bar;
        __builtin_amdgcn_s_waitcnt(0);
        unsigned nloc = b.st[0], nx = b.st[1];
        if (nloc == 0u) { xcd_barrier_complete(bar, b.x, nloc, nx); b.st[0] = nloc; b.st[1] = nx; }
        const unsigned old = xb_add(&bar[XB_XSUB(b.x)], 1u);
        const unsigned gen = old / nloc;
        if (old + 1u == (gen + 1u) * nloc) {
            __builtin_amdgcn_fence(__ATOMIC_RELEASE, "agent");
            asm volatile("s_waitcnt vmcnt(0)" ::: "memory");
            const unsigned og = xb_add(&bar[XB_TOP], 1u);
            const unsigned tg = og / nx;
            if (og + 1u == (tg + 1u) * nx) xb_add(&bar[XB_TOPGEN], 1u);
            else XB_SPIN(xb_ld(&bar[XB_TOPGEN]) == tg, bar);
            __builtin_amdgcn_fence(__ATOMIC_ACQUIRE, "agent");
            xb_add(&bar[XB_XGEN(b.x)], 1u);
            asm volatile("s_waitcnt vmcnt(0)" ::: "memory");
        } else {
            XB_SPIN(xb_ld(&bar[XB_XGEN(b.x)]) == gen, bar);
            __builtin_amdgcn_fence(__ATOMIC_ACQUIRE, "agent");
            asm volatile("s_waitcnt vmcnt(0)" ::: "memory");
        }
    }
    __syncthreads();
}


__global__ void __launch_bounds__(NTHR, 2) fwd_megakernel(Params p) {
    extern __shared__ __attribute__((aligned(16))) unsigned char lds_raw[];
    cg::grid_group grid = cg::this_grid();
#if defined(USE_CG_SYNC)
#define GSYNC() do { asm volatile("s_waitcnt vmcnt(0)" ::: "memory"); grid.sync(); } while (0)
#else
#define GSYNC() do { XcdBarrier xb_; xb_.bar = (unsigned*)(p.ws + WS_BAR); xb_.x = xb_xcc_id(); xb_.st = (volatile LAS unsigned*)(lds + 131072 + 512); xcd_barrier(xb_); } while (0)
#endif
    LAS unsigned char* lds = (LAS unsigned char*)lds_raw;
    LAS float* ldsf = (LAS float*)lds_raw;
    const int G = gridDim.x, NGW = G * NWV;
#define PHASE_IDS() const int tid = ltid(), lane = tid & 63, wave = __builtin_amdgcn_readfirstlane(tid >> 6), gw = blockIdx.x * NWV + wave; (void)tid; (void)lane; (void)gw
    const float* mod = (const float*)(p.ws + WS_MOD);
    h16* hn = (h16*)(p.ws + WS_HN); h16* proj = (h16*)(p.ws + WS_PROJ); h16* mix = (h16*)(p.ws + WS_QKM); h16* ff = (h16*)(p.ws + WS_PROJ);

    volatile LAS unsigned* xst = (volatile LAS unsigned*)(lds + 131072 + 512);
    if (ltid() < 4) xst[ltid()] = 0u;
    __syncthreads();
    XcdBarrier xbar = xcd_barrier_post((unsigned*)(p.ws + WS_BAR), xst);
    const bool split_mod = (G == 256);
    { PHASE_IDS(); phase_mod_partial(p, ldsf, 0, split_mod ? 768 : 3072, gw, NGW); }
    asm volatile("s_waitcnt vmcnt(0)" ::: "memory"); grid.sync();
    (void)xbar;
    phase_mod_reduce(p, 0, split_mod ? 9 * 6144 : 4 * 9 * 6144);
    GSYNC();
#if defined(DIAG_ALL)
    if (ltid() == 0) { float* dg = (float*)(p.ws + WS_MODP) + 4 * blockIdx.x; dg[0] = 0.f; dg[1] = 0.f; dg[2] = 0.f; dg[3] = 0.f; }
#endif
    for (int l = 0; l < 4; ++l) {
        { PHASE_IDS(); convert_weights(p, l, ldsf + wave * 2176, gw, NGW, lane, G == 256 ? 1 : 15); }
        { PHASE_IDS(); phase_norm(p, l, 0, l == 0, gw, NGW, lane); }
        GSYNC();
        {
            pg8::Gemm g{(const pg8::bf16_t*)hn, (const pg8::bf16_t*)(p.ws + WS_WIN), T_ALL, NPROJ_PAD, DM}; pg8::StaticOrder S; S.init(T_ALL, NPROJ_PAD, G, (int)blockIdx.x);
            EpiInProj E{proj, (float*)(p.ws + WS_GATES), p.gate_b + l * 16};
            pg8::gemm_phase<EpiInProj, pg8::StaticOrder, true, true>(lds, g, S, E);
#if defined(PROBE_GEMM2)
            GSYNC();
            pg8::gemm_phase<EpiInProj, pg8::StaticOrder, true, true>(lds, g, S, E);
#endif
        }
        GSYNC();
        { PHASE_IDS(); phase_gates(p, l, gw, NGW, lane); }
        phase_conv(p, l);
        GSYNC();
#if defined(PERTURB)
        { if (ltid() == 0) { const unsigned long long t0_ = __builtin_amdgcn_s_memrealtime(); const unsigned long long dl_ = (unsigned long long)(((blockIdx.x * 37u + l * 11u) % 64u) * 300u); while (__builtin_amdgcn_s_memrealtime() - t0_ < dl_) __builtin_amdgcn_s_sleep(4); } __syncthreads(); }
#endif
        phase_scan(p, l, ldsf);
#if defined(PERTURB)
        { if (ltid() == 0) { const unsigned long long t0_ = __builtin_amdgcn_s_memrealtime(); const unsigned long long dl_ = (unsigned long long)(((blockIdx.x * 53u + l * 7u) % 32u) * 400u); while (__builtin_amdgcn_s_memrealtime() - t0_ < dl_) __builtin_amdgcn_s_sleep(4); } __syncthreads(); }
#endif
#if defined(DELAY_AFTER_SCAN)
        { if (ltid() == 0) { const unsigned long long t0_ = __builtin_amdgcn_s_memrealtime(); while (__builtin_amdgcn_s_memrealtime() - t0_ < (unsigned long long)(DELAY_AFTER_SCAN) * 100ull) __builtin_amdgcn_s_sleep(8); } __syncthreads(); }
#endif
#if defined(LDS_CLEAR)
        { __syncthreads(); const int t_ = ltid(); for (int e = t_; e < 32768; e += NTHR) ldsf[e] = LDS_CLEAR_VAL; __syncthreads(); }
#endif
        GSYNC();
#if defined(MLSTM_DIAG)
        if (l == DIAG_LAYER && blockIdx.x == 0 && ltid() == 0) {
            const float* dg = (const float*)(p.ws + WS_MODP);
            float best = -1.f; int code = 0;
            for (int bb = 64; bb < 128; bb += 2) { const float rt = dg[4 * bb + DIAG_FIELD]; if (rt > best) { best = rt; int lg = 0; float x = rt; while (x < 1.f && lg < 31) { x *= 2.f; ++lg; } code = DIAG_CODE; } }
            const unsigned long long t0 = __builtin_amdgcn_s_memrealtime();
            while (__builtin_amdgcn_s_memrealtime() - t0 < (unsigned long long)code * 5000ull) __builtin_amdgcn_s_sleep(8);
        }
#endif
#if defined(PROBE_GSYNC10)
        for (int rep = 0; rep < 10; ++rep) GSYNC();
#endif
#if defined(PROBE_SCAN_TYPE)
        { const int bid_ = blockIdx.x;
          if (bid_ < 128) { if ((bid_ >> 6) == PROBE_SCAN_TYPE) scan_dispatch(p, l, bid_, ldsf); }
          else for (int it = 128 + (bid_ - 128); it < 640; it += 128) { if (((it - 128) >> 8) == PROBE_SCAN_TYPE) scan_dispatch(p, l, it, ldsf); } }
        GSYNC();
#endif
#if defined(PROBE_SCAN2)
        phase_scan(p, l, ldsf);
        GSYNC();
#endif
        { PHASE_IDS(); phase_mixnorm(p, l, gw, NGW, lane, G == 256 ? T_CTX : 0); }
        if (l == 0 && split_mod) phase_mod_reduce(p, 9 * 6144, 4 * 9 * 6144);
        GSYNC();
        {
            pg8::Gemm g{(const pg8::bf16_t*)mix, (const pg8::bf16_t*)(p.ws + WS_WOUT), T_ALL, DM, DM}; pg8::StaticOrder S; S.init(T_ALL, DM, G, (int)blockIdx.x);
            EpiResid E{l == 0 ? p.x_prompt : p.out, l == 0 ? p.x_sample : p.out + (size_t)T_CTX * DM, p.out, mod + (size_t)l * 9 * 6144 + 2048};
#if defined(PROBE_GEMM2)
            { EpiResid E2 = E; E2.out = (float*)(p.ws + WS_PROJ); pg8::gemm_phase<EpiResid, pg8::StaticOrder, true, true>(lds, g, S, E2); GSYNC(); }
#endif
            pg8::gemm_phase<EpiResid, pg8::StaticOrder, true, true>(lds, g, S, E);
        }
        GSYNC();
        { PHASE_IDS(); phase_norm(p, l, 1, false, gw, NGW, lane); }
        GSYNC();
        {
            pg8::Gemm g{(const pg8::bf16_t*)hn, (const pg8::bf16_t*)(p.ws + WS_WGU), T_ALL, NGU, DM}; pg8::StaticOrder S; S.init(T_ALL, NGU, G, (int)blockIdx.x);
            EpiGateUp E{ff};
            pg8::gemm_phase<EpiGateUp, pg8::StaticOrder, true, true>(lds, g, S, E);
#if defined(PROBE_GEMM2)
            GSYNC();
            pg8::gemm_phase<EpiGateUp, pg8::StaticOrder, true, true>(lds, g, S, E);
#endif
        }
        GSYNC();
        {
            pg8::Gemm g{(const pg8::bf16_t*)ff, (const pg8::bf16_t*)(p.ws + WS_WDN), T_ALL, DM, DFF}; pg8::StaticOrder S; S.init(T_ALL, DM, G, (int)blockIdx.x);
            EpiResid E{p.out, p.out + (size_t)T_CTX * DM, p.out, mod + (size_t)l * 9 * 6144 + 5120};
#if defined(PROBE_GEMM2)
            { EpiResid E2 = E; E2.out = (float*)(p.ws + WS_QKM); pg8::gemm_phase<EpiResid, pg8::StaticOrder, true, true>(lds, g, S, E2); GSYNC(); }
#endif
            pg8::gemm_phase<EpiResid, pg8::StaticOrder, true, true>(lds, g, S, E);
        }
        GSYNC();
    }
    { PHASE_IDS(); phase_final_norm(p, gw, NGW, lane); }
#if defined(DIAG_ALL)
    if (blockIdx.x == 0 && ltid() == 0) {
        const float* dg = (const float*)(p.ws + WS_MODP);
        float best = -1.f; int code = 0;
        for (int bb = 0; bb < (int)gridDim.x; ++bb) { const float rt = dg[4 * bb]; if (rt > best) { best = rt; int lg = 0; float x = rt; while (x < 1.f && lg < 31) { x *= 2.f; ++lg; } code = DIAG_ALL_CODE; } }
        const unsigned long long t0 = __builtin_amdgcn_s_memrealtime();
        while (__builtin_amdgcn_s_memrealtime() - t0 < (unsigned long long)code * 5000ull) __builtin_amdgcn_s_sleep(8);
    }
#endif
}

extern "C" void kernel_launch(void* const* d_in, const int* in_sizes, int n_in, void* d_out, int out_size, void* d_ws, size_t ws_size, hipStream_t stream) {
    static int grid_blocks = 0;
    if (grid_blocks == 0) {
        if (n_in != 24 || (size_t)out_size != OUT_TOTAL || ws_size < WS_END) {
            fprintf(stderr, "kernel_launch: unexpected sizes n_in %d out %d ws %zu (need %zu)\n", n_in, out_size, ws_size, (size_t)WS_END); grid_blocks = -1; return;
        }
        int dev = 0, cus = 0, per_cu = 0;
        hipGetDevice(&dev);
        hipDeviceGetAttribute(&cus, hipDeviceAttributeMultiprocessorCount, dev);
        hipFuncSetAttribute((const void*)fwd_megakernel, hipFuncAttributeMaxDynamicSharedMemorySize, LDS_BYTES);
        hipOccupancyMaxActiveBlocksPerMultiprocessor(&per_cu, (const void*)fwd_megakernel, NTHR, LDS_BYTES);
        if (per_cu < 1) { fprintf(stderr, "kernel_launch: occupancy query says %d blocks per CU\n", per_cu); per_cu = 1; }
        grid_blocks = cus * 1;
        (void)hipGetLastError();
    }
    if (grid_blocks < 0) return;
    Params p{};
    const float** f = (const float**)&p;
    for (int i = 0; i < 24; ++i) f[i] = (const float*)d_in[i];
    p.out = (float*)d_out; p.ws = (unsigned char*)d_ws;
    if (hipMemsetAsync((char*)d_ws + WS_BAR, 0, 16384, stream) != hipSuccess) { fprintf(stderr, "kernel_launch: memset of the barrier words failed\n"); return; }
    void* args[] = {&p};
    hipError_t e = hipLaunchCooperativeKernel((const void*)fwd_megakernel, dim3(grid_blocks), dim3(NTHR), args, LDS_BYTES, stream);
    if (e != hipSuccess) fprintf(stderr, "cooperative launch failed: %s (grid %d)\n", hipGetErrorString(e), grid_blocks);
}
```
